# Optimizing an MI355X kernel written in HIP

```python
import math
import jax
import jax.numpy as jnp
from jax import lax
import numpy as np

D_MODEL = 1024
BATCH = 4
SEQ = 8192
DEPTH = 2

CTX_LEN = 256
GRID_W = 64
D_MIX = D_MODEL
D_FF = 4 * D_MODEL
N_MOD = 6
EPS = 1e-6

HY_WIDTH = D_MIX // 4
HY_ORDER = 2
HY_SHORT = 3
HY_EMB = 33
HY_BANDS = (HY_EMB - 1) // 2
HY_FFN = 64
HY_TARGET = 1e-2
HY_FAST_PCT = 0.3
HY_SLOW_PCT = 1.5
HY_COLS = (HY_ORDER + 1) * HY_WIDTH
HY_FILT_OUT = 2 * HY_ORDER * HY_WIDTH

RET_DK = 64
RET_DV = 64
RET_HEADS = (D_MIX // 4) // RET_DV
RET_CHUNK = 128
RET_COLS = RET_HEADS * (2 * RET_DK + 2 * RET_DV)

MLA_V = 64
MLA_HEADS = (D_MIX // 2) // MLA_V
MLA_NOPE = 64
MLA_ROPE = 32
MLA_QK = MLA_NOPE + MLA_ROPE
MLA_Q_LORA = D_MODEL // 4
MLA_KV_LORA = D_MODEL // 8
MLA_COLS = MLA_Q_LORA + MLA_KV_LORA + MLA_ROPE
ROPE_BASE = 10000.0
ATTN_BLOCK = 128

IN_COLS = HY_COLS + RET_COLS + MLA_COLS

kernel_name = 'hybrid_hyena_retnet_mla_dit'


def rms_norm(x, gain):
    xf = x.astype(jnp.float32)
    y = xf * lax.rsqrt(jnp.mean(xf * xf, axis=-1, keepdims=True) + EPS)
    return (y * gain.astype(jnp.float32)).astype(x.dtype)


def modulate(x, gain, shift, scale):
    return rms_norm(x, gain) * (1 + scale) + shift


def ada_terms(cond, w, b):
    m = jax.nn.silu(cond) @ w + b
    return jnp.split(m[..., None, :], N_MOD, axis=-1)


def squared_relu_mlp(h, w1, w2):
    return jnp.square(jax.nn.relu(h @ w1)) @ w2


def short_conv(u, w, b):
    L = u.shape[1]
    pad = HY_SHORT // 2
    up = jnp.pad(u, ((0, 0), (pad, pad), (0, 0)))
    out = b
    for j in range(HY_SHORT):
        out = out + up[:, j:j + L] * w[j]
    return out


def hyena_filter_spectrum(L, w1, b1, sin_freq, w2, b2, w3):
    f32 = jnp.float32
    t = jnp.linspace(0.0, 1.0, L, dtype=f32)[:, None]
    bands = jnp.linspace(1e-4, HY_BANDS - 1, HY_BANDS, dtype=f32)[None, :]
    ang = (2.0 * math.pi / L) * jnp.arange(L, dtype=f32)[:, None] * bands
    z = jnp.concatenate([t, jnp.cos(ang), -jnp.sin(ang)], axis=-1)
    h = jnp.sin(sin_freq[0] * (z @ w1 + b1))
    h = jnp.sin(sin_freq[1] * (h @ w2 + b2))
    h = (h @ w3).reshape(L, 2, HY_ORDER, HY_WIDTH)
    max_decay = math.log(HY_TARGET) / HY_FAST_PCT
    min_decay = math.log(HY_TARGET) / HY_SLOW_PCT
    deltas = jnp.abs(jnp.linspace(min_decay, max_decay, HY_WIDTH, dtype=f32))
    h = h * jnp.exp(-t[:, :, None, None] * deltas)
    fwd, bwd = h[:, 0], h[:, 1]
    kern = jnp.concatenate([(fwd[0] + bwd[0])[None], fwd[1:], jnp.zeros_like(fwd[:1]), bwd[1:][::-1]], axis=0)
    kern = kern / jnp.sum(jnp.abs(kern), axis=0, keepdims=True)
    return jnp.fft.rfft(kern, axis=0)


def long_conv(z, kf, bias):
    L = z.shape[1]
    zf = z.astype(jnp.float32)
    y = jnp.fft.irfft(jnp.fft.rfft(zf, n=2 * L, axis=1) * kf, n=2 * L, axis=1)[:, :L]
    return (y + zf * bias).astype(z.dtype)


def hyena_mixer(u, conv_w, conv_b, w1, b1, sin_freq, w2, b2, w3, bias):
    f32 = jnp.float32
    L = u.shape[1]
    u = short_conv(u, conv_w, conv_b)
    x1, x2, v = jnp.split(u, 3, axis=-1)
    kf = hyena_filter_spectrum(L, w1.astype(f32), b1.astype(f32), sin_freq.astype(f32),
                               w2.astype(f32), b2.astype(f32), w3.astype(f32))
    bias = bias.astype(f32)
    z = x1 * long_conv(v, kf[:, 0], bias[0])
    return x2 * long_conv(z, kf[:, 1], bias[1])


def retention_heads(cols):
    B, L, _ = cols.shape
    hk, hv = RET_HEADS * RET_DK, RET_HEADS * RET_DV
    q, k, v, g = jnp.split(cols, [hk, 2 * hk, 2 * hk + hv], axis=-1)
    to_heads = lambda a, d: a.reshape(B, L, RET_HEADS, d).transpose(0, 2, 1, 3)
    return to_heads(q, RET_DK), to_heads(k, RET_DK) * RET_DK ** -0.5, to_heads(v, RET_DV), g


def retention_final_state(k, v, log_gamma):
    L = k.shape[2]
    w = jnp.exp(log_gamma[:, None] * (L - 1 - jnp.arange(L, dtype=jnp.float32)))
    return jnp.einsum('bhld,bhle,hl->bhde', k.astype(jnp.float32), v.astype(jnp.float32), w)


def retention_chunkwise(q, k, v, log_gamma, s0):
    f32 = jnp.float32
    B, H, L, dk = q.shape
    dv = v.shape[-1]
    C = RET_CHUNK
    N = L // C
    qc = q.astype(f32).reshape(B, H, N, C, dk)
    kc = k.astype(f32).reshape(B, H, N, C, dk)
    vc = v.astype(f32).reshape(B, H, N, C, dv)
    pos = jnp.arange(C, dtype=f32)
    lg = log_gamma[:, None]
    diff = pos[:, None] - pos[None, :]
    decay = jnp.where(diff >= 0, jnp.exp(lg[:, :, None] * jnp.maximum(diff, 0.0)), 0.0)
    scores = jnp.einsum('bhncd,bhnmd->bhncm', qc, kc) * decay[:, None]
    inner = jnp.einsum('bhncm,bhnme->bhnce', scores, vc)
    zeta = jnp.exp(lg * (C - 1 - pos))
    xi = jnp.exp(lg * (pos + 1))
    chunk_kv = jnp.einsum('bhnmd,bhnme,hm->nbhde', kc, vc, zeta)
    g_chunk = jnp.exp(log_gamma * C)[:, None, None]

    def step(s, kv):
        return g_chunk * s + kv, s

    _, s_prev = lax.scan(step, s0.astype(f32), chunk_kv)
    cross = jnp.einsum('bhncd,nbhde,hc->bhnce', qc, s_prev, xi)
    return (inner + cross).reshape(B, H, L, dv)


def retention_bidir(q, k, v, lg_f, lg_b, s_f, s_b):
    flip = lambda a: jnp.flip(a, axis=2)
    out_f = retention_chunkwise(q, k, v, lg_f, s_f)
    out_b = flip(retention_chunkwise(flip(q), flip(k), flip(v), lg_b, s_b))
    return out_f + out_b


def retention_output(o, g):
    B, H, L, dv = o.shape
    o = o * lax.rsqrt(jnp.mean(o * o, axis=-1, keepdims=True) + EPS)
    o = o.transpose(0, 2, 1, 3).reshape(B, L, H * dv).astype(g.dtype)
    return jax.nn.silu(g) * o


def axial_rope_tables(L, dtype):
    f32 = jnp.float32
    rows = L // GRID_W
    row = jnp.repeat(jnp.arange(rows), GRID_W).astype(f32)
    col = jnp.tile(jnp.arange(GRID_W), rows).astype(f32)
    n_freq = MLA_ROPE // 4
    inv = ROPE_BASE ** (-jnp.arange(n_freq, dtype=f32) / n_freq)
    ang_r = row[:, None] * inv
    ang_c = col[:, None] * inv
    return tuple(a[:, None, :].astype(dtype) for a in
                 (jnp.cos(ang_r), jnp.sin(ang_r), jnp.cos(ang_c), jnp.sin(ang_c)))


def rotate(x, cos, sin):
    x1, x2 = jnp.split(x, 2, axis=-1)
    return jnp.concatenate([x1 * cos - x2 * sin, x1 * sin + x2 * cos], axis=-1)


def apply_axial_rope(x, cos_r, sin_r, cos_c, sin_c):
    xr, xc = jnp.split(x, 2, axis=-1)
    return jnp.concatenate([rotate(xr, cos_r, sin_r), rotate(xc, cos_c, sin_c)], axis=-1)


def mla_split(cols):
    return jnp.split(cols, [MLA_Q_LORA, MLA_Q_LORA + MLA_KV_LORA], axis=-1)


def mla_queries(c_q, q_norm_g, w_uq, rope):
    B, L, _ = c_q.shape
    q = (rms_norm(c_q, q_norm_g) @ w_uq).reshape(B, L, MLA_HEADS, MLA_QK)
    q_nope, q_rope = q[..., :MLA_NOPE], q[..., MLA_NOPE:]
    if rope is not None:
        q_rope = apply_axial_rope(q_rope, *rope)
    return jnp.concatenate([q_nope, q_rope], axis=-1) * MLA_QK ** -0.5


def mla_keys_values(c_kv, k_rope, kv_norm_g, w_ukv, rope):
    B, L, _ = c_kv.shape
    kv = (rms_norm(c_kv, kv_norm_g) @ w_ukv).reshape(B, L, MLA_HEADS, MLA_NOPE + MLA_V)
    k_nope, v = kv[..., :MLA_NOPE], kv[..., MLA_NOPE:]
    k_rope = k_rope[:, :, None, :]
    if rope is not None:
        k_rope = apply_axial_rope(k_rope, *rope)
    k = jnp.concatenate([k_nope, jnp.broadcast_to(k_rope, (B, L, MLA_HEADS, MLA_ROPE))], axis=-1)
    return k, v


def block_softmax_attention(q, k, v):
    B, Lq, H, dq = q.shape
    nb = Lq // ATTN_BLOCK
    qb = jnp.moveaxis(q.reshape(B, nb, ATTN_BLOCK, H, dq), 1, 0)

    def one_block(qi):
        s = jnp.einsum('bqhd,bkhd->bhqk', qi, k, preferred_element_type=jnp.float32)
        p = jax.nn.softmax(s, axis=-1).astype(v.dtype)
        return jnp.einsum('bhqk,bkhd->bqhd', p, v)

    o = lax.map(one_block, qb)
    return jnp.moveaxis(o, 0, 1).reshape(B, Lq, H * v.shape[-1])


def trunk_layer(x, xc, c, c_ctx, rope, p, last):
    f32 = jnp.float32
    sh1, sc1, ga1, sh2, sc2, ga2 = ada_terms(c, p['w_ada'], p['b_ada'])
    csh1, csc1, cga1, csh2, csc2, cga2 = ada_terms(c_ctx, p['w_ada'], p['b_ada'])

    u = modulate(x, p['norm1_g'], sh1, sc1) @ p['w_in']
    uc = modulate(xc, p['norm1_g'], csh1, csc1) @ p['w_in']
    u_hy, u_ret, u_mla = jnp.split(u, [HY_COLS, HY_COLS + RET_COLS], axis=-1)
    uc_hy, uc_ret, uc_mla = jnp.split(uc, [HY_COLS, HY_COLS + RET_COLS], axis=-1)
    hy_params = (p['hy_conv_w'], p['hy_conv_b'], p['hy_ffn_w1'], p['hy_ffn_b1'], p['hy_sin_freq'],
                 p['hy_ffn_w2'], p['hy_ffn_b2'], p['hy_ffn_w3'], p['hy_bias'])

    hy = hyena_mixer(u_hy, *hy_params)

    lg = jnp.log1p(-jnp.exp(p['ret_log_decay'].astype(f32)))
    q, k, v, g = retention_heads(u_ret)
    cq, ck, cv, cg = retention_heads(uc_ret)
    s_f = retention_final_state(ck, cv, lg[0])
    s_b = retention_final_state(jnp.flip(ck, axis=2), jnp.flip(cv, axis=2), lg[1])
    ret = retention_output(retention_bidir(q, k, v, lg[0], lg[1], s_f, s_b), g)

    lcq, lckv, lkr = mla_split(u_mla)
    ccq, cckv, ckr = mla_split(uc_mla)
    k_ctx, v_ctx = mla_keys_values(cckv, ckr, p['mla_kv_norm_g'], p['mla_w_ukv'], None)
    k_lat, v_lat = mla_keys_values(lckv, lkr, p['mla_kv_norm_g'], p['mla_w_ukv'], rope)
    q_lat = mla_queries(lcq, p['mla_q_norm_g'], p['mla_w_uq'], rope)
    att = block_softmax_attention(q_lat, jnp.concatenate([k_lat, k_ctx], axis=1),
                                  jnp.concatenate([v_lat, v_ctx], axis=1))

    x = x + ga1 * (jnp.concatenate([hy, ret, att], axis=-1) @ p['w_out'])
    x = x + ga2 * squared_relu_mlp(modulate(x, p['norm2_g'], sh2, sc2), p['mlp_w1'], p['mlp_w2'])

    if not last:
        hy_c = hyena_mixer(uc_hy, *hy_params)
        zero = jnp.zeros_like(s_f)
        ret_c = retention_output(retention_bidir(cq, ck, cv, lg[0], lg[1], zero, zero), cg)
        att_c = block_softmax_attention(mla_queries(ccq, p['mla_q_norm_g'], p['mla_w_uq'], None), k_ctx, v_ctx)
        xc = xc + cga1 * (jnp.concatenate([hy_c, ret_c, att_c], axis=-1) @ p['w_out'])
        xc = xc + cga2 * squared_relu_mlp(modulate(xc, p['norm2_g'], csh2, csc2), p['mlp_w1'], p['mlp_w2'])
    return x, xc


def setup_inputs(seed: int = 0) -> dict:
    key = jax.random.key(seed)
    ks = iter(jax.random.split(key, 32))
    nrm = lambda shape, scale: jax.random.normal(next(ks), shape, jnp.float32) * scale
    L = DEPTH
    ret_base = -(5.0 + jnp.arange(RET_HEADS, dtype=jnp.float32)) * math.log(2.0)
    return {
        'x': nrm((BATCH, SEQ, D_MODEL), 1.0),
        'c': nrm((BATCH, D_MODEL), 1.0),
        'ctx': nrm((BATCH, CTX_LEN, D_MODEL), 1.0),
        'c_ctx': nrm((D_MODEL,), 1.0),
        'w_ada': nrm((L, D_MODEL, N_MOD * D_MODEL), 0.5 * D_MODEL ** -0.5),
        'b_ada': nrm((L, N_MOD * D_MODEL), 0.02),
        'norm1_g': 1.0 + nrm((L, D_MODEL), 0.05),
        'norm2_g': 1.0 + nrm((L, D_MODEL), 0.05),
        'w_in': nrm((L, D_MODEL, IN_COLS), D_MODEL ** -0.5),
        'w_out': nrm((L, D_MIX, D_MODEL), D_MIX ** -0.5),
        'hy_conv_w': nrm((L, HY_SHORT, HY_COLS), HY_SHORT ** -0.5),
        'hy_conv_b': nrm((L, HY_COLS), 0.02),
        'hy_ffn_w1': nrm((L, HY_EMB, HY_FFN), HY_EMB ** -0.5),
        'hy_ffn_b1': nrm((L, HY_FFN), 0.1),
        'hy_sin_freq': 1.0 + nrm((L, 2, HY_FFN), 0.05),
        'hy_ffn_w2': nrm((L, HY_FFN, HY_FFN), HY_FFN ** -0.5),
        'hy_ffn_b2': nrm((L, HY_FFN), 0.1),
        'hy_ffn_w3': nrm((L, HY_FFN, HY_FILT_OUT), HY_FFN ** -0.5),
        'hy_bias': nrm((L, HY_ORDER, HY_WIDTH), 0.5),
        'ret_log_decay': ret_base + nrm((L, 2, RET_HEADS), 0.1),
        'mla_q_norm_g': 1.0 + nrm((L, MLA_Q_LORA), 0.05),
        'mla_w_uq': nrm((L, MLA_Q_LORA, MLA_HEADS * MLA_QK), MLA_Q_LORA ** -0.5),
        'mla_kv_norm_g': 1.0 + nrm((L, MLA_KV_LORA), 0.05),
        'mla_w_ukv': nrm((L, MLA_KV_LORA, MLA_HEADS * (MLA_NOPE + MLA_V)), MLA_KV_LORA ** -0.5),
        'mlp_w1': nrm((L, D_MODEL, D_FF), D_MODEL ** -0.5),
        'mlp_w2': nrm((L, D_FF, D_MODEL), D_FF ** -0.5),
        'final_norm_g': 1.0 + nrm((D_MODEL,), 0.05),
    }


def reference(x, c, ctx, c_ctx, w_ada, b_ada, norm1_g, norm2_g, w_in, w_out, hy_conv_w, hy_conv_b,
              hy_ffn_w1, hy_ffn_b1, hy_sin_freq, hy_ffn_w2, hy_ffn_b2, hy_ffn_w3, hy_bias, ret_log_decay,
              mla_q_norm_g, mla_w_uq, mla_kv_norm_g, mla_w_ukv, mlp_w1, mlp_w2, final_norm_g):
    rope = axial_rope_tables(x.shape[1], x.dtype)
    xc = ctx
    for i in range(DEPTH):
        p = {
            'w_ada': w_ada[i], 'b_ada': b_ada[i], 'norm1_g': norm1_g[i], 'norm2_g': norm2_g[i],
            'w_in': w_in[i], 'w_out': w_out[i], 'hy_conv_w': hy_conv_w[i], 'hy_conv_b': hy_conv_b[i],
            'hy_ffn_w1': hy_ffn_w1[i], 'hy_ffn_b1': hy_ffn_b1[i], 'hy_sin_freq': hy_sin_freq[i],
            'hy_ffn_w2': hy_ffn_w2[i], 'hy_ffn_b2': hy_ffn_b2[i], 'hy_ffn_w3': hy_ffn_w3[i],
            'hy_bias': hy_bias[i], 'ret_log_decay': ret_log_decay[i], 'mla_q_norm_g': mla_q_norm_g[i],
            'mla_w_uq': mla_w_uq[i], 'mla_kv_norm_g': mla_kv_norm_g[i], 'mla_w_ukv': mla_w_ukv[i],
            'mlp_w1': mlp_w1[i], 'mlp_w2': mlp_w2[i],
        }
        x, xc = trunk_layer(x, xc, c, c_ctx, rope, p, last=(i == DEPTH - 1))
    return rms_norm(x, final_norm_g)
```

```cpp
#include <hip/hip_runtime.h>
#include <hip/hip_cooperative_groups.h>
namespace cg = cooperative_groups;

#ifndef MULTI_LAUNCH
#define MULTI_LAUNCH 1
#endif

#define DI __device__ __forceinline__
#define NI __device__ __noinline__
typedef unsigned short u16;
typedef short bf16x8 __attribute__((ext_vector_type(8)));
typedef float f32x16 __attribute__((ext_vector_type(16)));
typedef __bf16 bf2_t __attribute__((ext_vector_type(2)));
typedef unsigned u32x4 __attribute__((ext_vector_type(4)));
#define MFMA32(a, b, c) __builtin_amdgcn_mfma_f32_32x32x16_bf16((a), (b), (c), 0, 0, 0)

constexpr int NB = 4, SEQ = 8192, LCTX = 256, DM = 1024, DFF = 4096;
constexpr int TLAT = NB * SEQ;
constexpr int TALL = TLAT + NB * LCTX;
constexpr int NIN = 2208, NINP = 2304;
constexpr int LKEY = SEQ + LCTX;
constexpr int NCH = 66;
constexpr int SMEM_BYTES = 73728;
#ifndef SUBSEL
#define SUBSEL -1
#endif
#define SUB_ON(k) (SUBSEL < 0 || SUBSEL == (k))

constexpr size_t WL_WIN = 0;
constexpr size_t WL_WOUT = WL_WIN + (size_t)NINP * 1024 * 2;
constexpr size_t WL_W1 = WL_WOUT + (size_t)1024 * 1024 * 2;
constexpr size_t WL_W2 = WL_W1 + (size_t)4096 * 1024 * 2;
constexpr size_t WL_WUQ = WL_W2 + (size_t)1024 * 4096 * 2;
constexpr size_t WL_WUKV = WL_WUQ + (size_t)768 * 256 * 2;
constexpr size_t WL_SIZE = WL_WUKV + (size_t)1024 * 128 * 2;
constexpr size_t OFF_W = 0;
constexpr size_t OFF_MOD = OFF_W + 2 * WL_SIZE;
constexpr size_t OFF_TW = OFF_MOD + (size_t)2 * 5 * 6144 * 4;
constexpr size_t OFF_ROPE = OFF_TW + 65536;
constexpr size_t OFF_XC = OFF_ROPE + 192 * 8 * 8 + 4096;
constexpr size_t OFF_H = OFF_XC + (size_t)1024 * 1024 * 4;
constexpr size_t OFF_H2F = OFF_H + (size_t)TALL * 1024 * 2;
constexpr size_t OFF_H2C = OFF_H2F + (size_t)8192 * 64 * 4;
constexpr size_t OFF_KC = OFF_H2C + (size_t)256 * 64 * 4;
constexpr size_t OFF_BIG = OFF_KC + (size_t)2 * 256 * 512 * 4;
constexpr size_t OFF_UT = OFF_BIG;
constexpr size_t OFF_UTC = OFF_UT + (size_t)NB * 768 * SEQ * 2;
constexpr size_t OFF_RET = OFF_UTC + (size_t)NB * 768 * LCTX * 2;
constexpr size_t OFF_CQ = OFF_RET + (size_t)TALL * 1024 * 2;
constexpr size_t OFF_CKV = OFF_CQ + (size_t)TALL * 256 * 2;
constexpr size_t OFF_Q = OFF_CKV + (size_t)TALL * 128 * 2;
constexpr size_t OFF_KF = OFF_Q + (size_t)TALL * 768 * 2;
constexpr size_t OFF_VT = OFF_KF + (size_t)NB * 8 * LKEY * 96 * 2;
constexpr size_t OFF_ST = OFF_VT + (size_t)NB * 8 * 64 * LKEY * 2;
constexpr size_t OFF_KSPEC = OFF_ST + (size_t)2 * 16 * NCH * 4096 * 4;
constexpr size_t OFF_END = OFF_KSPEC + (size_t)2 * 256 * 2 * 8192 * 8;
constexpr size_t OFF_ACT = OFF_BIG;
static_assert(OFF_ACT + (size_t)TALL * 4096 * 2 <= OFF_END, "act fits");
static_assert(OFF_END <= (size_t)536870912, "workspace");

struct Params {
  const float* in[27];
  float* out;
  char* ws;
};
enum { I_X = 0, I_C, I_CTX, I_CCTX, I_WADA, I_BADA, I_N1G, I_N2G, I_WIN, I_WOUT, I_HCW, I_HCB, I_HW1, I_HB1, I_HSF, I_HW2,
       I_HB2, I_HW3, I_HBIAS, I_RLD, I_QNG, I_WUQ, I_KVNG, I_WUKV, I_W1, I_W2, I_FNG };

DI u16 f2bf(float x) { return __builtin_bit_cast(u16, (__bf16)x); }
DI float bf2f(u16 v) { return __uint_as_float(((unsigned)v) << 16); }
DI unsigned pack2(float a, float b) { bf2_t v; v[0] = (__bf16)a; v[1] = (__bf16)b; return __builtin_bit_cast(unsigned, v); }
DI float wave_sum(float v) {
#pragma unroll
  for (int o = 32; o > 0; o >>= 1) v += __shfl_xor(v, o);
  return v;
}
DI int crow(int reg, int h) { return (reg & 3) + 8 * (reg >> 2) + 4 * h; }
DI float bfe(u32x4 v, int j) {
  unsigned w = v[j >> 1];
  return __uint_as_float((j & 1) ? (w & 0xffff0000u) : (w << 16));
}
DI u16 bfu(u32x4 v, int j) {
  unsigned w = v[j >> 1];
  return (u16)((j & 1) ? (w >> 16) : (w & 0xffffu));
}
DI float silu_f(float x) { return x / (1.f + __expf(-x)); }
DI void row_info(int row, int& b, int& t, int& key, int& cond) {
  if (row < TLAT) { b = row >> 13; t = row & 8191; key = t; cond = b; }
  else { int rc = row - TLAT; b = rc >> 8; t = rc & 255; key = SEQ + t; cond = 4; }
}
DI int chunk_row0(int b, int ci) { return ci < 2 ? TLAT + b * LCTX + ci * 128 : b * SEQ + (ci - 2) * 128; }
DI float rope_apply(const float2* __restrict__ tab, float val, int jj, int t) {
  float partner = __shfl_xor(val, 8);
  int pos = (jj & 16) ? 128 + (t & 63) : (t >> 6);
  float2 cs = tab[pos * 8 + (jj & 7)];
  return (jj & 8) ? (val * cs.x + partner * cs.y) : (val * cs.x - partner * cs.y);
}

DI void convT_item(const float* __restrict__ src, u16* __restrict__ dst, int K, int N, int Npad, const float* __restrict__ gain,
                   int item, float* tile, bool perm = false) {
  int ntn = Npad >> 6;
  int kt = item / ntn, nt = item - kt * ntn;
  int k0 = kt * 64, n0 = nt * 64;
  int c = threadIdx.x & 63, q = threadIdx.x >> 6;
#pragma unroll 4
  for (int i = 0; i < 16; i++) {
    int kk = i * 4 + q, n = n0 + c;
    float v = 0.f;
    if (n < N) { int sn = perm ? ((n & 511) >> 6) * 128 + (n >> 9) * 64 + (n & 63) : n; v = src[(size_t)(k0 + kk) * N + sn]; if (gain) v *= gain[k0 + kk]; }
    tile[kk * 65 + c] = v;
  }
  __syncthreads();
#pragma unroll 4
  for (int i = 0; i < 16; i++) {
    int nn = i * 4 + q;
    dst[(size_t)(n0 + nn) * K + k0 + c] = f2bf(tile[c * 65 + nn]);
  }
  __syncthreads();
}

DI void phase_s0(const Params& p, char* smem) {
  const int per_layer = 576 + 256 + 1024 + 1024 + 48 + 32;
  const int n_conv = 2 * per_layer, n_mod = 2 * 96, n_tw = 32 + 6;
  const int total = n_conv + n_mod + n_tw;
  for (int it = blockIdx.x; it < total; it += gridDim.x) {
    if (it < n_conv) {
      int l = it / per_layer, r = it - l * per_layer;
      char* wl = p.ws + OFF_W + (size_t)l * WL_SIZE;
      float* tile = (float*)smem;
      if (r < 576) convT_item(p.in[I_WIN] + (size_t)l * 1024 * NIN, (u16*)(wl + WL_WIN), 1024, NIN, NINP, nullptr, r, tile);
      else if ((r -= 576) < 256) convT_item(p.in[I_WOUT] + (size_t)l * 1024 * 1024, (u16*)(wl + WL_WOUT), 1024, 1024, 1024, nullptr, r, tile);
      else if ((r -= 256) < 1024) convT_item(p.in[I_W1] + (size_t)l * 1024 * 4096, (u16*)(wl + WL_W1), 1024, 4096, 4096, nullptr, r, tile);
      else if ((r -= 1024) < 1024) convT_item(p.in[I_W2] + (size_t)l * 4096 * 1024, (u16*)(wl + WL_W2), 4096, 1024, 1024, nullptr, r, tile);
      else if ((r -= 1024) < 48) convT_item(p.in[I_WUQ] + (size_t)l * 256 * 768, (u16*)(wl + WL_WUQ), 256, 768, 768, p.in[I_QNG] + l * 256, r, tile);
      else { r -= 48; convT_item(p.in[I_WUKV] + (size_t)l * 128 * 1024, (u16*)(wl + WL_WUKV), 128, 1024, 1024, p.in[I_KVNG] + l * 128, r, tile, true); }
    } else if (it < n_conv + n_mod) {
      int r = it - n_conv;
      int l = r / 96, n0 = (r - l * 96) * 64;
      float* sc = (float*)smem;
      float* red = sc + 5120;
      for (int i = threadIdx.x; i < 5120; i += 256) {
        int rr = i >> 10, k = i & 1023;
        float cv = rr < 4 ? p.in[I_C][rr * 1024 + k] : p.in[I_CCTX][k];
        sc[i] = cv / (1.f + expf(-cv));
      }
      __syncthreads();
      int nn = threadIdx.x & 63, kq = threadIdx.x >> 6;
      float a0 = 0, a1 = 0, a2 = 0, a3 = 0, a4 = 0;
      const float* w = p.in[I_WADA] + ((size_t)l * 1024 + kq * 256) * 6144 + n0 + nn;
      for (int k = 0; k < 256; k++) {
        float wv = w[(size_t)k * 6144];
        int kk = kq * 256 + k;
        a0 += sc[kk] * wv; a1 += sc[1024 + kk] * wv; a2 += sc[2048 + kk] * wv; a3 += sc[3072 + kk] * wv; a4 += sc[4096 + kk] * wv;
      }
      red[(kq * 5 + 0) * 64 + nn] = a0; red[(kq * 5 + 1) * 64 + nn] = a1; red[(kq * 5 + 2) * 64 + nn] = a2;
      red[(kq * 5 + 3) * 64 + nn] = a3; red[(kq * 5 + 4) * 64 + nn] = a4;
      __syncthreads();
      if (threadIdx.x < 64) {
        float* mod = (float*)(p.ws + OFF_MOD);
        float bb = p.in[I_BADA][l * 6144 + n0 + nn];
        for (int rr = 0; rr < 5; rr++) {
          float s = red[(0 * 5 + rr) * 64 + nn] + red[(1 * 5 + rr) * 64 + nn] + red[(2 * 5 + rr) * 64 + nn] + red[(3 * 5 + rr) * 64 + nn];
          mod[(size_t)(l * 5 + rr) * 6144 + n0 + nn] = s + bb;
        }
      }
      __syncthreads();
    } else {
      int q = it - n_conv - n_mod;
      if (q < 32) {
        int n = q * 256 + threadIdx.x;
        float sn, cs;
        sincospif((float)n / 8192.f, &sn, &cs);
        ((float2*)(p.ws + OFF_TW))[n] = make_float2(cs, -sn);
      } else {
        int e = (q - 32) * 256 + threadIdx.x;
        int pos = e >> 3, f = e & 7;
        float pv = pos < 128 ? (float)pos : (float)(pos - 128);
        float inv = powf(10000.f, -(float)f / 8.f);
        float sn, cs;
        sincosf(pv * inv, &sn, &cs);
        ((float2*)(p.ws + OFF_ROPE))[e] = make_float2(cs, sn);
      }
    }
  }
}

DI void filt_a_item(const Params& p, int l, int Lf, float* h2out, int pos) {
  int lane = threadIdx.x & 63;
  float tpos = (float)pos / (float)(Lf - 1);
  float zval = 0.f;
  if (lane == 0) zval = tpos;
  else if (lane < 33) {
    int jj = (lane - 1) & 15;
    float band = 1e-4f + (float)jj * ((15.f - 1e-4f) / 15.f);
    float ang = ((float)(6.283185307179586 / (double)Lf)) * (float)pos * band;
    zval = lane < 17 ? cosf(ang) : -sinf(ang);
  }
  const float* w1 = p.in[I_HW1] + l * 33 * 64;
  const float* w2 = p.in[I_HW2] + l * 64 * 64;
  float acc = p.in[I_HB1][l * 64 + lane];
  for (int i = 0; i < 33; i++) acc += __shfl(zval, i) * w1[i * 64 + lane];
  float h1 = sinf(p.in[I_HSF][l * 128 + lane] * acc);
  float acc2 = p.in[I_HB2][l * 64 + lane];
  for (int i = 0; i < 64; i++) acc2 += __shfl(h1, i) * w2[i * 64 + lane];
  h2out[(size_t)pos * 64 + lane] = sinf(p.in[I_HSF][l * 128 + 64 + lane] * acc2);
}

DI void phase_norm(const Params& p, int l, int which, int nrows, bool with_filter) {
  const int lane = threadIdx.x & 63, wid = threadIdx.x >> 6;
  const bool first = (l == 0 && which == 1);
  const int n_norm = nrows >> 2;
  const int n_fa = with_filter ? (8192 / 4 + (l == 0 ? 256 / 4 : 0)) : 0;
  const float* gsrc = p.in[which == 1 ? I_N1G : I_N2G] + l * 1024;
  u16* H = (u16*)(p.ws + OFF_H);
  for (int it = blockIdx.x; it < n_norm + n_fa; it += gridDim.x) {
    if (it < n_norm) {
      int row = it * 4 + wid;
      const float* src;
      int cond;
      if (row < TLAT) { src = (first ? p.in[I_X] : p.out) + (size_t)row * 1024; cond = row >> 13; }
      else { src = (first ? p.in[I_CTX] : (const float*)(p.ws + OFF_XC)) + (size_t)(row - TLAT) * 1024; cond = 4; }
      const float* m = (const float*)(p.ws + OFF_MOD) + (size_t)(l * 5 + cond) * 6144 + (which == 1 ? 0 : 3072);
      float4 v[4];
      float ssq = 0.f;
#pragma unroll
      for (int i = 0; i < 4; i++) {
        v[i] = *(const float4*)(src + i * 256 + lane * 4);
        ssq += v[i].x * v[i].x + v[i].y * v[i].y + v[i].z * v[i].z + v[i].w * v[i].w;
      }
      ssq = wave_sum(ssq);
      float rstd = rsqrtf(ssq * (1.f / 1024.f) + 1e-6f);
#pragma unroll
      for (int i = 0; i < 4; i++) {
        int col = i * 256 + lane * 4;
        float4 g = *(const float4*)(gsrc + col), sh = *(const float4*)(m + col), sc = *(const float4*)(m + 1024 + col);
        float o0 = v[i].x * rstd * g.x * (1.f + sc.x) + sh.x, o1 = v[i].y * rstd * g.y * (1.f + sc.y) + sh.y;
        float o2 = v[i].z * rstd * g.z * (1.f + sc.z) + sh.z, o3 = v[i].w * rstd * g.w * (1.f + sc.w) + sh.w;
        *(uint2*)(H + (size_t)row * 1024 + col) = make_uint2(pack2(o0, o1), pack2(o2, o3));
      }
    } else {
      int q = it - n_norm;
      if (q < 2048) filt_a_item(p, l, 8192, (float*)(p.ws + OFF_H2F), q * 4 + wid);
      else filt_a_item(p, l, 256, (float*)(p.ws + OFF_H2C), (q - 2048) * 4 + wid);
    }
  }
}

constexpr int GLD = 40;
template <bool ROWNORM, bool TR0, bool TR1, class Epi>
DI void gemm_tile(const u16* __restrict__ A, int lda, const u16* __restrict__ Bt, int ldb, int K, int m0, int n0,
                  const u16* __restrict__ at_src, int at_kt, char* smem, Epi epi) {
  u16* As = (u16*)smem;
  u16* Bs = As + 256 * GLD;
  float* rs = (float*)(Bs + 128 * GLD);
  int tid_o = threadIdx.x;
  asm volatile("" : "+v"(tid_o));
  const int tid = tid_o, lane = tid & 63, wid = tid >> 6, wm = wid >> 1, wn = wid & 1, r = lane & 31, h = lane >> 5;
  const bool trans = (TR0 == TR1) ? TR0 : (wn ? TR1 : TR0);
  f32x16 acc[4][2];
#pragma unroll
  for (int mi = 0; mi < 4; mi++)
#pragma unroll
    for (int ni = 0; ni < 2; ni++)
#pragma unroll
      for (int e = 0; e < 16; e++) acc[mi][ni][e] = 0.f;
  u32x4 ra[4], rb[2];
  float ssq[4];
#pragma unroll
  for (int i = 0; i < 4; i++) ssq[i] = 0.f;
  const int nk = K >> 5;
  const int lrow = tid >> 2, lkc = tid & 3;
  const int tch = tid >> 5, ttc = tid & 31;
  const bool has_at = at_src != nullptr;

#define GEMM_GLOAD(KT)                                                                                                      \
  {                                                                                                                         \
    const int kt_ = (KT);                                                                                                   \
    if (has_at && kt_ < at_kt) {                                                                                            \
      _Pragma("unroll") for (int i = 0; i < 4; i++) ra[i] = *(const u32x4*)(at_src + (size_t)(kt_ * 32 + tch + 8 * i) * 8192 + ttc * 8); \
    } else {                                                                                                                \
      _Pragma("unroll") for (int i = 0; i < 4; i++) ra[i] = *(const u32x4*)(A + (size_t)(m0 + lrow + 64 * i) * lda + kt_ * 32 + lkc * 8);  \
    }                                                                                                                       \
    _Pragma("unroll") for (int i = 0; i < 2; i++) rb[i] = *(const u32x4*)(Bt + (size_t)(n0 + lrow + 64 * i) * ldb + kt_ * 32 + lkc * 8);   \
  }
  GEMM_GLOAD(0)
  for (int kt = 0; kt < nk; kt++) {
    __syncthreads();
    if (has_at && kt < at_kt) {
#pragma unroll
      for (int i = 0; i < 4; i++)
#pragma unroll
        for (int j = 0; j < 8; j++) As[(ttc * 8 + j) * GLD + tch + 8 * i] = bfu(ra[i], j);
    } else {
#pragma unroll
      for (int i = 0; i < 4; i++) *(u32x4*)(As + (lrow + 64 * i) * GLD + lkc * 8) = ra[i];
    }
#pragma unroll
    for (int i = 0; i < 2; i++) *(u32x4*)(Bs + (lrow + 64 * i) * GLD + lkc * 8) = rb[i];
    if (ROWNORM) {
#pragma unroll
      for (int i = 0; i < 4; i++)
#pragma unroll
        for (int j = 0; j < 8; j++) { float x = bfe(ra[i], j); ssq[i] += x * x; }
    }
    __syncthreads();
    if (kt + 1 < nk) GEMM_GLOAD(kt + 1)
#pragma unroll
    for (int ks = 0; ks < 2; ks++) {
      bf16x8 a[4], b[2];
#pragma unroll
      for (int mi = 0; mi < 4; mi++) a[mi] = *(const bf16x8*)(As + (wm * 128 + mi * 32 + r) * GLD + ks * 16 + h * 8);
#pragma unroll
      for (int ni = 0; ni < 2; ni++) b[ni] = *(const bf16x8*)(Bs + (wn * 64 + ni * 32 + r) * GLD + ks * 16 + h * 8);
      if (!trans) {
#pragma unroll
        for (int mi = 0; mi < 4; mi++)
#pragma unroll
          for (int ni = 0; ni < 2; ni++) acc[mi][ni] = MFMA32(a[mi], b[ni], acc[mi][ni]);
      } else {
#pragma unroll
        for (int mi = 0; mi < 4; mi++)
#pragma unroll
          for (int ni = 0; ni < 2; ni++) acc[mi][ni] = MFMA32(b[ni], a[mi], acc[mi][ni]);
      }
    }
  }
  if (ROWNORM) {
#pragma unroll
    for (int i = 0; i < 4; i++) {
      float s = ssq[i];
      s += __shfl_xor(s, 1); s += __shfl_xor(s, 2);
      if (lkc == 0) rs[lrow + 64 * i] = rsqrtf(s / (float)K + 1e-6f);
    }
    __syncthreads();
  }
#define EPI_CALL(mi, ni) epi(m0 + wm * 128 + (mi) * 32, n0 + wn * 64 + (ni) * 32, acc[mi][ni], rs);
  EPI_CALL(0, 0) EPI_CALL(0, 1) EPI_CALL(1, 0) EPI_CALL(1, 1) EPI_CALL(2, 0) EPI_CALL(2, 1) EPI_CALL(3, 0) EPI_CALL(3, 1)
#undef EPI_CALL
  __syncthreads();
}

DI void phase_win(const Params& p, int l, char* smem) {
  const u16* H = (const u16*)(p.ws + OFF_H);
  const u16* W = (const u16*)(p.ws + OFF_W + (size_t)l * WL_SIZE + WL_WIN);
  u16* UT = (u16*)(p.ws + OFF_UT);
  u16* UTC = (u16*)(p.ws + OFF_UTC);
  u16* RET = (u16*)(p.ws + OFF_RET);
  u16* CQ = (u16*)(p.ws + OFF_CQ);
  u16* CKV = (u16*)(p.ws + OFF_CKV);
  u16* KF = (u16*)(p.ws + OFF_KF);
  const int lane = threadIdx.x & 63, r = lane & 31, h = lane >> 5;
  const int total = 132 * 18;
  for (int it = blockIdx.x; it < total; it += gridDim.x) {
    int mt = it / 18, nt = it - mt * 18;
    int m0 = mt * 256, n0 = nt * 128;
    if (nt < 6) {
      gemm_tile<false, true, true>(H, 1024, W, 1024, 1024, m0, n0, nullptr, 0, smem,
        [&](int bm, int bn, const f32x16& acc, const float*) __attribute__((always_inline)) {
          int row = bm + r, b, t, key, cond;
          row_info(row, b, t, key, cond);
          u16* dstp = row < TLAT ? UT + ((size_t)(b * 768)) * SEQ + t : UTC + ((size_t)(b * 768)) * LCTX + t;
          int strd = row < TLAT ? SEQ : LCTX;
#pragma unroll
          for (int reg = 0; reg < 16; reg++) dstp[(size_t)(bn + crow(reg, h)) * strd] = f2bf(acc[reg]);
        });
    } else {
      gemm_tile<false, false, false>(H, 1024, W, 1024, 1024, m0, n0, nullptr, 0, smem,
        [&](int bm, int bn, const f32x16& acc, const float*) __attribute__((always_inline)) {
        if (nt < 14) {

          int col = bn + r - 768;
          float sc = (col >= 256 && col < 512) ? 0.125f : 1.f;
#pragma unroll
          for (int reg = 0; reg < 16; reg++) RET[(size_t)(bm + crow(reg, h)) * 1024 + col] = f2bf(acc[reg] * sc);
        } else if (nt < 16) {
          int col = bn + r - 1792;
#pragma unroll
          for (int reg = 0; reg < 16; reg++) CQ[(size_t)(bm + crow(reg, h)) * 256 + col] = f2bf(acc[reg]);
        } else if (nt == 16) {
          int col = bn + r - 2048;
#pragma unroll
          for (int reg = 0; reg < 16; reg++) CKV[(size_t)(bm + crow(reg, h)) * 128 + col] = f2bf(acc[reg]);
        } else if (bn == 2176) {
#pragma unroll
          for (int reg = 0; reg < 16; reg++) {
            int row = bm + crow(reg, h), b, t, key, cond;
            row_info(row, b, t, key, cond);
            float v = acc[reg];
            float vr = rope_apply((const float2*)(p.ws + OFF_ROPE), v, r, t);
            if (row < TLAT) v = vr;
            u16 o = f2bf(v);
#pragma unroll
            for (int hh = 0; hh < 8; hh++) KF[((size_t)(b * 8 + hh) * LKEY + key) * 96 + 64 + r] = o;
          }
        }
      });
    }
  }
}

DI void ret_gammas(const Params& p, int l, int hh, float& lgf, float& lgb) {
  lgf = log1pf(-expf(p.in[I_RLD][l * 8 + hh]));
  lgb = log1pf(-expf(p.in[I_RLD][l * 8 + 4 + hh]));
}
DI void ret_kv_item(const Params& p, int l, int b, int hh, int ci, char* smem) {
  const u16* RET = (const u16*)(p.ws + OFF_RET);
  float* ST = (float*)(p.ws + OFF_ST);
  u16* KfT = (u16*)smem;
  u16* KbT = KfT + 64 * 136;
  u16* VsT = KbT + 64 * 136;
  int tid_o = threadIdx.x;
  asm volatile("" : "+v"(tid_o));
  const int tid = tid_o, lane = tid & 63, wid = tid >> 6, r = lane & 31, h = lane >> 5;
  float lgf, lgb;
  ret_gammas(p, l, hh, lgf, lgb);
  const int row0 = chunk_row0(b, ci);
#pragma unroll
  for (int i = 0; i < 4; i++) {
    int id = tid + 256 * i, m = id >> 3, dc = id & 7;
    u32x4 kv = *(const u32x4*)(RET + (size_t)(row0 + m) * 1024 + 256 + hh * 64 + dc * 8);
    u32x4 vv = *(const u32x4*)(RET + (size_t)(row0 + m) * 1024 + 512 + hh * 64 + dc * 8);
    float zf = __expf(lgf * (float)(127 - m)), zb = __expf(lgb * (float)m);
#pragma unroll
    for (int j = 0; j < 8; j++) {
      float kval = bfe(kv, j);
      KfT[(dc * 8 + j) * 136 + m] = f2bf(kval * zf);
      KbT[(dc * 8 + j) * 136 + m] = f2bf(kval * zb);
      VsT[(dc * 8 + j) * 136 + m] = bfu(vv, j);
    }
  }
  __syncthreads();
  const int dir = wid >> 1, dh = wid & 1;
  const u16* Asrc = dir ? KbT : KfT;
  f32x16 c0, c1;
#pragma unroll
  for (int e = 0; e < 16; e++) { c0[e] = 0.f; c1[e] = 0.f; }
#pragma unroll
  for (int ks = 0; ks < 8; ks++) {
    bf16x8 a = *(const bf16x8*)(Asrc + (dh * 32 + r) * 136 + ks * 16 + h * 8);
    bf16x8 b0 = *(const bf16x8*)(VsT + (r) * 136 + ks * 16 + h * 8);
    bf16x8 b1 = *(const bf16x8*)(VsT + (32 + r) * 136 + ks * 16 + h * 8);
    c0 = MFMA32(a, b0, c0);
    c1 = MFMA32(a, b1, c1);
  }
  float* dst = ST + ((size_t)((dir * 4 + b) * 4 + hh) * NCH + ci) * 4096;
#pragma unroll
  for (int reg = 0; reg < 16; reg++) {
    int d = dh * 32 + crow(reg, h);
    dst[d * 64 + r] = c0[reg];
    dst[d * 64 + 32 + r] = c1[reg];
  }
  __syncthreads();
}

DI void fft_dif(float2* X, const float2* __restrict__ TW, int tid) {
#pragma unroll 1
  for (int s = 0; s < 13; s++) {
    const int half = 4096 >> s, sh = 12 - s;
#pragma unroll 4
    for (int jj = 0; jj < 16; jj++) {
      int j = tid + jj * 256;
      int g = j >> sh, pos = j & (half - 1);
      int i0 = (g << (sh + 1)) + pos, i1 = i0 + half;
      float2 w = TW[(pos << s) << 1];
      float2 a = X[i0], b = X[i1];
      X[i0] = make_float2(a.x + b.x, a.y + b.y);
      float dx = a.x - b.x, dy = a.y - b.y;
      X[i1] = make_float2(dx * w.x - dy * w.y, dx * w.y + dy * w.x);
    }
    __syncthreads();
  }
}
DI void fft_dit(float2* X, const float2* __restrict__ TW, int tid) {
#pragma unroll 1
  for (int s = 12; s >= 0; s--) {
    const int half = 4096 >> s, sh = 12 - s;
#pragma unroll 4
    for (int jj = 0; jj < 16; jj++) {
      int j = tid + jj * 256;
      int g = j >> sh, pos = j & (half - 1);
      int i0 = (g << (sh + 1)) + pos, i1 = i0 + half;
      float2 w = TW[(pos << s) << 1];
      float2 a = X[i0], b = X[i1];
      float bx = b.x * w.x + b.y * w.y, by = b.y * w.x - b.x * w.y;
      X[i0] = make_float2(a.x + bx, a.y + by);
      X[i1] = make_float2(a.x - bx, a.y - by);
    }
    __syncthreads();
  }
}

DI void filt_fft_item(const Params& p, int l, int o, int c, char* smem) {
  float2* X = (float2*)smem;
  float* Xf = (float*)smem;
  float* w3s = (float*)(smem + 65536);
  float* red = w3s + 128;
  const float2* TW = (const float2*)(p.ws + OFF_TW);
  const float* H2 = (const float*)(p.ws + OFF_H2F);
  float2* KS = (float2*)(p.ws + OFF_KSPEC) + (size_t)(o * 256 + c) * 2 * 8192;
  int tid_o = threadIdx.x;
  asm volatile("" : "+v"(tid_o));
  const int tid = tid_o;
  if (tid < 128) { int j = tid & 63, side = tid >> 6; w3s[tid] = p.in[I_HW3][((size_t)l * 64 + j) * 1024 + side * 512 + o * 256 + c]; }
  __syncthreads();
  const float min_decay = -3.0701134573253944f, max_decay = -15.350567286626972f;
  const float delta = fabsf(min_decay + (float)c * ((max_decay - min_decay) / 255.f));
  float* Ff = Xf;
  float* Fb = Xf + 8192;
#pragma unroll 1
  for (int i = 0; i < 32; i++) {
    int n = tid + 256 * i;
    const float4* hp = (const float4*)(H2 + (size_t)n * 64);
    float f = 0.f, bsum = 0.f;
#pragma unroll
    for (int q = 0; q < 16; q++) {
      float4 hv = hp[q];
      f += hv.x * w3s[q * 4] + hv.y * w3s[q * 4 + 1] + hv.z * w3s[q * 4 + 2] + hv.w * w3s[q * 4 + 3];
      bsum += hv.x * w3s[64 + q * 4] + hv.y * w3s[64 + q * 4 + 1] + hv.z * w3s[64 + q * 4 + 2] + hv.w * w3s[64 + q * 4 + 3];
    }
    float win = expf(-((float)n / 8191.f) * delta);
    Ff[n] = f * win; Fb[n] = bsum * win;
  }
  __syncthreads();
  float part = 0.f;
#pragma unroll 2
  for (int i = 0; i < 32; i++) {
    int n = tid + 256 * i;
    float k1 = Ff[n], k2 = 0.f;
    if (n == 0) k1 += Fb[0]; else k2 = Fb[8192 - n];
    part += fabsf(k1) + fabsf(k2);
    KS[8192 + n] = make_float2(k1, k2);
  }
  part = wave_sum(part);
  if ((tid & 63) == 0) red[tid >> 6] = part;
  __syncthreads();
  const float inv = 1.f / (red[0] + red[1] + red[2] + red[3]);
#pragma unroll 2
  for (int i = 0; i < 32; i++) { int n = tid + 256 * i; float2 kp = KS[8192 + n]; X[n] = make_float2((kp.x + kp.y) * inv, 0.f); }
  __syncthreads();
  fft_dif(X, TW, tid);
#pragma unroll 2
  for (int i = 0; i < 32; i++) { int n = tid + 256 * i; KS[n] = X[n]; }
  __syncthreads();
#pragma unroll 2
  for (int i = 0; i < 32; i++) { int n = tid + 256 * i; float2 w = TW[n]; float2 kp = KS[8192 + n]; float d = (kp.x - kp.y) * inv; X[n] = make_float2(d * w.x, d * w.y); }
  __syncthreads();
  fft_dif(X, TW, tid);
#pragma unroll 2
  for (int i = 0; i < 32; i++) { int n = tid + 256 * i; KS[8192 + n] = X[n]; }
  __syncthreads();
}

DI void filt_ctx_item(const Params& p, int l, int o, int c, char* smem) {
  float* red = (float*)smem;
  const float* H2 = (const float*)(p.ws + OFF_H2C);
  float* KC = (float*)(p.ws + OFF_KC) + (size_t)(o * 256 + c) * 512;
  int tid_o = threadIdx.x;
  asm volatile("" : "+v"(tid_o));
  const int n = tid_o;
  const float min_decay = -3.0701134573253944f, max_decay = -15.350567286626972f;
  const float delta = fabsf(min_decay + (float)c * ((max_decay - min_decay) / 255.f));
  float f = 0.f, bsum = 0.f;
  for (int j = 0; j < 64; j++) {
    float hv = H2[n * 64 + j];
    f += hv * p.in[I_HW3][((size_t)l * 64 + j) * 1024 + o * 256 + c];
    bsum += hv * p.in[I_HW3][((size_t)l * 64 + j) * 1024 + 512 + o * 256 + c];
  }
  float win = expf(-((float)n / 255.f) * delta);
  f *= win; bsum *= win;
  float part = n == 0 ? fabsf(f + bsum) : fabsf(f) + fabsf(bsum);
  part = wave_sum(part);
  __syncthreads();
  if ((n & 63) == 0) red[n >> 6] = part;
  __syncthreads();
  float inv = 1.f / (red[0] + red[1] + red[2] + red[3]);
  if (n == 0) { KC[256] = (f + bsum) * inv; KC[0] = 0.f; }
  else { KC[256 + n] = f * inv; KC[256 - n] = bsum * inv; }
  __syncthreads();
}

DI void phase_p3(const Params& p, int l, char* smem) {
  const int lane = threadIdx.x & 63, r = lane & 31, h = lane >> 5;
  const int n_uq = (l == 0 ? 132 : 128) * 6, n_ukv = 132 * 8, n_r1 = 16 * NCH, n_ff = 512, n_fc = (l == 0 ? 512 : 0);
  const int total = n_uq + n_ukv + n_r1 + n_ff + n_fc;
  const char* wl = p.ws + OFF_W + (size_t)l * WL_SIZE;
  u16* Q = (u16*)(p.ws + OFF_Q);
  u16* KF = (u16*)(p.ws + OFF_KF);
  u16* VT = (u16*)(p.ws + OFF_VT);
  for (int it = blockIdx.x; it < total; it += gridDim.x) {
    int q = it;
    if (q < n_uq) {
      int mt = q / 6, nt = q - mt * 6;
      if (SUB_ON(0)) gemm_tile<true, false, false>((const u16*)(p.ws + OFF_CQ), 256, (const u16*)(wl + WL_WUQ), 256, 256, mt * 256, nt * 128, nullptr, 0, smem,
        [&](int bm, int bn, const f32x16& acc, const float* rs) __attribute__((always_inline)) {
          int col = bn + r;
          int j = col % 96;
          const float qscale = 0.10206207261596577f * 1.4426950408889634f;
#pragma unroll
          for (int reg = 0; reg < 16; reg++) {
            int row = bm + crow(reg, h);
            float v = acc[reg] * rs[row - mt * 256];
            if (j >= 64) {
              int b, t, key, cond;
              row_info(row, b, t, key, cond);
              float vr = rope_apply((const float2*)(p.ws + OFF_ROPE), v, r, t);
              if (row < TLAT) v = vr;
            }
            Q[(size_t)row * 768 + col] = f2bf(v * qscale);
          }
        });
    } else if ((q -= n_uq) < n_ukv) {
      int mt = q >> 3, nt = q & 7;
      if (nt < 4) {
        if (SUB_ON(1)) gemm_tile<true, false, false>((const u16*)(p.ws + OFF_CKV), 128, (const u16*)(wl + WL_WUKV), 128, 128, mt * 256, nt * 128, nullptr, 0, smem,
          [&](int bm, int bn, const f32x16& acc, const float* rs) __attribute__((always_inline)) {
            int hd = bn >> 6, j = (bn & 63) + r;
#pragma unroll
            for (int reg = 0; reg < 16; reg++) {
              int row = bm + crow(reg, h), b, t, key, cond;
              row_info(row, b, t, key, cond);
              KF[((size_t)(b * 8 + hd) * LKEY + key) * 96 + j] = f2bf(acc[reg] * rs[row - mt * 256]);
            }
          });
      } else {
        if (SUB_ON(1)) gemm_tile<true, true, true>((const u16*)(p.ws + OFF_CKV), 128, (const u16*)(wl + WL_WUKV), 128, 128, mt * 256, nt * 128, nullptr, 0, smem,
          [&](int bm, int bn, const f32x16& acc, const float* rs) __attribute__((always_inline)) {
            int row = bm + r, b, t, key, cond;
            row_info(row, b, t, key, cond);
            float rr = rs[row - mt * 256];
            int hd = (bn - 512) >> 6, e0 = (bn - 512) & 63;
            u16* dstp = VT + ((size_t)(b * 8 + hd) * 64 + e0) * LKEY + key;
#pragma unroll
            for (int reg = 0; reg < 16; reg++) dstp[(size_t)crow(reg, h) * LKEY] = f2bf(acc[reg] * rr);
          });
      }
    } else if ((q -= n_ukv) < n_r1) {
      int bh = q / NCH, ci = q - bh * NCH;
      if (SUB_ON(2)) ret_kv_item(p, l, bh >> 2, bh & 3, ci, smem);
    } else if ((q -= n_r1) < n_ff) {
      if (SUB_ON(3)) filt_fft_item(p, l, q >> 8, q & 255, smem);
    } else {
      q -= n_ff;
      if (SUB_ON(4)) filt_ctx_item(p, l, q >> 8, q & 255, smem);
    }
  }
}

DI void phase_scan(const Params& p, int l) {
  float* ST = (float*)(p.ws + OFF_ST);
  for (int idx = blockIdx.x * 256 + threadIdx.x; idx < 2 * 16 * 4096; idx += gridDim.x * 256) {
    int dir = idx >> 16, bh = (idx >> 12) & 15, el = idx & 4095, hh = bh & 3;
    float* base = ST + (size_t)((dir * 16 + bh) * NCH) * 4096 + el;
    float lg = log1pf(-expf(p.in[I_RLD][l * 8 + dir * 4 + hh]));
    float gC = expf(lg * 128.f);
    float s = 0.f;
    if (dir == 0) {
      for (int ci = 0; ci < NCH; ci++) { float tmp = base[(size_t)ci * 4096]; base[(size_t)ci * 4096] = s; s = gC * s + tmp; }
    } else {
      for (int ci = 1; ci >= 0; ci--) { float tmp = base[(size_t)ci * 4096]; base[(size_t)ci * 4096] = s; s = gC * s + tmp; }
      for (int ci = NCH - 1; ci >= 2; ci--) { float tmp = base[(size_t)ci * 4096]; base[(size_t)ci * 4096] = s; s = gC * s + tmp; }
    }
  }
}

DI void attn_item(const Params& p, int b, int hh, int qrow0, int key0, int nkeys, char* smem) {
  u16* Ks = (u16*)smem;
  u16* Vs = Ks + 64 * 104;
  const u16* Q = (const u16*)(p.ws + OFF_Q);
  const u16* KF = (const u16*)(p.ws + OFF_KF);
  const u16* VT = (const u16*)(p.ws + OFF_VT);
  u16* MIX = (u16*)(p.ws + OFF_H);
  int tid_o = threadIdx.x;
  asm volatile("" : "+v"(tid_o));
  const int tid = tid_o, lane = tid & 63, wid = tid >> 6, r = lane & 31, h = lane >> 5;
  const int qrow = qrow0 + wid * 32 + r;
  bf16x8 qf[6];
#pragma unroll
  for (int ks = 0; ks < 6; ks++) qf[ks] = *(const bf16x8*)(Q + (size_t)qrow * 768 + hh * 96 + ks * 16 + h * 8);
  f32x16 o0, o1;
#pragma unroll
  for (int e = 0; e < 16; e++) { o0[e] = 0.f; o1[e] = 0.f; }
  float m = -1e30f, lsum = 0.f;
  const u32x4* kbase = (const u32x4*)(KF + ((size_t)(b * 8 + hh) * LKEY + key0) * 96);
  const u16* vbase = VT + (size_t)(b * 8 + hh) * 64 * LKEY + key0;
  u32x4 rk[3], rv[2];
  const int nt = nkeys >> 6;
#define ATT_GLOAD(T)                                                                                                        \
  {                                                                                                                         \
    const int t_ = (T);                                                                                                     \
    _Pragma("unroll") for (int i = 0; i < 3; i++) rk[i] = kbase[(size_t)t_ * 768 + tid + 256 * i];                          \
    _Pragma("unroll") for (int i = 0; i < 2; i++) { int id = tid + 256 * i; rv[i] = *(const u32x4*)(vbase + (size_t)(id >> 3) * LKEY + t_ * 64 + (id & 7) * 8); } \
  }
  ATT_GLOAD(0)
  for (int t = 0; t < nt; t++) {
    __syncthreads();
#pragma unroll
    for (int i = 0; i < 3; i++) { int id = tid + 256 * i; int kr = id / 12, c = id - kr * 12; *(u32x4*)(Ks + kr * 104 + c * 8) = rk[i]; }
#pragma unroll
    for (int i = 0; i < 2; i++) { int id = tid + 256 * i; *(u32x4*)(Vs + (id >> 3) * 72 + (id & 7) * 8) = rv[i]; }
    __syncthreads();
    if (t + 1 < nt) ATT_GLOAD(t + 1)
    f32x16 s0, s1;
#pragma unroll
    for (int e = 0; e < 16; e++) { s0[e] = 0.f; s1[e] = 0.f; }
#pragma unroll
    for (int ks = 0; ks < 6; ks++) {
      bf16x8 k0 = *(const bf16x8*)(Ks + (r) * 104 + ks * 16 + h * 8);
      bf16x8 k1 = *(const bf16x8*)(Ks + (32 + r) * 104 + ks * 16 + h * 8);
      s0 = MFMA32(k0, qf[ks], s0);
      s1 = MFMA32(k1, qf[ks], s1);
    }
    float mx = s0[0];
#pragma unroll
    for (int e = 0; e < 16; e++) { mx = fmaxf(mx, s0[e]); mx = fmaxf(mx, s1[e]); }
    mx = fmaxf(mx, __shfl_xor(mx, 32));
    float mnew = fmaxf(m, mx);
    float alpha = __builtin_amdgcn_exp2f(m - mnew);
    float ps = 0.f;
#pragma unroll
    for (int e = 0; e < 16; e++) {
      s0[e] = __builtin_amdgcn_exp2f(s0[e] - mnew); ps += s0[e];
      s1[e] = __builtin_amdgcn_exp2f(s1[e] - mnew); ps += s1[e];
    }
    ps += __shfl_xor(ps, 32);
    lsum = lsum * alpha + ps;
    m = mnew;
#pragma unroll
    for (int e = 0; e < 16; e++) { o0[e] *= alpha; o1[e] *= alpha; }
#pragma unroll
    for (int kt2 = 0; kt2 < 2; kt2++) {
#pragma unroll
      for (int sx = 0; sx < 2; sx++) {
        u32x4 pw;
        if (kt2 == 0) {
          pw.x = pack2(s0[8 * sx + 0], s0[8 * sx + 1]); pw.y = pack2(s0[8 * sx + 2], s0[8 * sx + 3]);
          pw.z = pack2(s0[8 * sx + 4], s0[8 * sx + 5]); pw.w = pack2(s0[8 * sx + 6], s0[8 * sx + 7]);
        } else {
          pw.x = pack2(s1[8 * sx + 0], s1[8 * sx + 1]); pw.y = pack2(s1[8 * sx + 2], s1[8 * sx + 3]);
          pw.z = pack2(s1[8 * sx + 4], s1[8 * sx + 5]); pw.w = pack2(s1[8 * sx + 6], s1[8 * sx + 7]);
        }
        bf16x8 pb = __builtin_bit_cast(bf16x8, pw);
        int kb = kt2 * 32 + 16 * sx + 4 * h;
        {
          const u16* vp = Vs + (r) * 72 + kb;
          uint2 lo = *(const uint2*)vp, hi = *(const uint2*)(vp + 8);
          u32x4 vw = {lo.x, lo.y, hi.x, hi.y};
          o0 = MFMA32(__builtin_bit_cast(bf16x8, vw), pb, o0);
        }
        {
          const u16* vp = Vs + (32 + r) * 72 + kb;
          uint2 lo = *(const uint2*)vp, hi = *(const uint2*)(vp + 8);
          u32x4 vw = {lo.x, lo.y, hi.x, hi.y};
          o1 = MFMA32(__builtin_bit_cast(bf16x8, vw), pb, o1);
        }
      }
    }
  }
  const float inv = 1.f / lsum;
  u16* dst = MIX + (size_t)qrow * 1024 + 512 + hh * 64;
#pragma unroll
  for (int g = 0; g < 4; g++) {
    int e = 8 * g + 4 * h;
    *(uint2*)(dst + e) = make_uint2(pack2(o0[4 * g] * inv, o0[4 * g + 1] * inv), pack2(o0[4 * g + 2] * inv, o0[4 * g + 3] * inv));
    *(uint2*)(dst + 32 + e) = make_uint2(pack2(o1[4 * g] * inv, o1[4 * g + 1] * inv), pack2(o1[4 * g + 2] * inv, o1[4 * g + 3] * inv));
  }
  __syncthreads();
}

DI void ret_out_item(const Params& p, int l, int b, int hh, int ci, char* smem) {
  const u16* RET = (const u16*)(p.ws + OFF_RET);
  const float* ST = (const float*)(p.ws + OFF_ST);
  u16* MIX = (u16*)(p.ws + OFF_H);
  u16* Qs = (u16*)smem;
  u16* Ks = Qs + 128 * 72;
  u16* Ps = Qs;
  u16* VsT = Ks + 128 * 72;
  u16* SfT = VsT + 64 * 136;
  u16* SbT = SfT + 64 * 72;
  float* dmk = (float*)(SbT + 64 * 72);
  int tid_o = threadIdx.x;
  asm volatile("" : "+v"(tid_o));
  const int tid = tid_o, lane = tid & 63, wid = tid >> 6, r = lane & 31, h = lane >> 5;
  float lgf, lgb;
  ret_gammas(p, l, hh, lgf, lgb);
  const int row0 = chunk_row0(b, ci);
  { int d = tid - 128; dmk[tid] = d > 0 ? __expf(lgf * (float)d) : (d < 0 ? __expf(lgb * (float)(-d)) : 2.f); }
#pragma unroll 1
  for (int i = 0; i < 4; i++) {
    int id = tid + 256 * i, m = id >> 3, dc = id & 7;
    const u16* rp = RET + (size_t)(row0 + m) * 1024 + hh * 64 + dc * 8;
    *(uint4*)(Qs + m * 72 + dc * 8) = *(const uint4*)(rp);
    *(uint4*)(Ks + m * 72 + dc * 8) = *(const uint4*)(rp + 256);
    u32x4 vv = *(const u32x4*)(rp + 512);
#pragma unroll
    for (int j = 0; j < 8; j++) VsT[(dc * 8 + j) * 136 + m] = bfu(vv, j);
  }
  const float* Sf = ST + ((size_t)((0 * 4 + b) * 4 + hh) * NCH + ci) * 4096;
  const float* Sb = ST + ((size_t)((1 * 4 + b) * 4 + hh) * NCH + ci) * 4096;
#pragma unroll 2
  for (int i = 0; i < 16; i++) {
    int id = tid + 256 * i, d = id >> 6, e = id & 63;
    SfT[e * 72 + d] = f2bf(Sf[id]);
    SbT[e * 72 + d] = f2bf(Sb[id]);
  }
  __syncthreads();
  const int cw = wid * 32;
  f32x16 in0, in1, sc[4];
  {
    f32x16 cf0, cf1, cb0, cb1;
#pragma unroll
    for (int e = 0; e < 16; e++) { cf0[e] = cf1[e] = cb0[e] = cb1[e] = 0.f; }
#pragma unroll
    for (int ks = 0; ks < 4; ks++) {
      bf16x8 qa = *(const bf16x8*)(Qs + (cw + r) * 72 + ks * 16 + h * 8);
      cf0 = MFMA32(qa, *(const bf16x8*)(SfT + (r) * 72 + ks * 16 + h * 8), cf0);
      cf1 = MFMA32(qa, *(const bf16x8*)(SfT + (32 + r) * 72 + ks * 16 + h * 8), cf1);
      cb0 = MFMA32(qa, *(const bf16x8*)(SbT + (r) * 72 + ks * 16 + h * 8), cb0);
      cb1 = MFMA32(qa, *(const bf16x8*)(SbT + (32 + r) * 72 + ks * 16 + h * 8), cb1);
    }
#pragma unroll
    for (int reg = 0; reg < 16; reg++) {
      int c = cw + crow(reg, h);
      float xf = __expf(lgf * (float)(c + 1)), xb = __expf(lgb * (float)(128 - c));
      in0[reg] = xf * cf0[reg] + xb * cb0[reg];
      in1[reg] = xf * cf1[reg] + xb * cb1[reg];
    }
  }
#pragma unroll
  for (int e = 0; e < 16; e++) { sc[0][e] = sc[1][e] = sc[2][e] = sc[3][e] = 0.f; }
#pragma unroll
  for (int ks = 0; ks < 4; ks++) {
    bf16x8 qa = *(const bf16x8*)(Qs + (cw + r) * 72 + ks * 16 + h * 8);
#pragma unroll
    for (int mt = 0; mt < 4; mt++) sc[mt] = MFMA32(qa, *(const bf16x8*)(Ks + (mt * 32 + r) * 72 + ks * 16 + h * 8), sc[mt]);
  }
  __syncthreads();
#pragma unroll
  for (int mt = 0; mt < 4; mt++)
#pragma unroll
    for (int reg = 0; reg < 16; reg++) {
      int c = cw + crow(reg, h), mm = mt * 32 + r;
      Ps[c * 136 + mm] = f2bf(sc[mt][reg] * dmk[c - mm + 128]);
      if ((reg & 3) == 3) __builtin_amdgcn_sched_barrier(0);
    }
  __syncthreads();
#pragma unroll
  for (int ks = 0; ks < 8; ks++) {
    bf16x8 pa = *(const bf16x8*)(Ps + (cw + r) * 136 + ks * 16 + h * 8);
    in0 = MFMA32(pa, *(const bf16x8*)(VsT + (r) * 136 + ks * 16 + h * 8), in0);
    in1 = MFMA32(pa, *(const bf16x8*)(VsT + (32 + r) * 136 + ks * 16 + h * 8), in1);
  }
#pragma unroll
  for (int reg = 0; reg < 16; reg++) {
    int c = cw + crow(reg, h);
    float oa = in0[reg], ob = in1[reg];
    float ss = oa * oa + ob * ob;
    ss += __shfl_xor(ss, 1); ss += __shfl_xor(ss, 2); ss += __shfl_xor(ss, 4); ss += __shfl_xor(ss, 8); ss += __shfl_xor(ss, 16);
    float rstd = rsqrtf(ss * (1.f / 64.f) + 1e-6f);
    int rowi = row0 + c;
    asm volatile("" : "+v"(rowi));
    size_t row = (size_t)rowi;
    float g0 = bf2f(RET[row * 1024 + 768 + hh * 64 + r]), g1 = bf2f(RET[row * 1024 + 768 + hh * 64 + 32 + r]);
    MIX[row * 1024 + 256 + hh * 64 + r] = f2bf(silu_f(g0) * oa * rstd);
    MIX[row * 1024 + 256 + hh * 64 + 32 + r] = f2bf(silu_f(g1) * ob * rstd);
    __builtin_amdgcn_sched_barrier(0);
  }
  __syncthreads();
}

typedef _Float16 h2_t __attribute__((ext_vector_type(2)));
DI unsigned packh(float a, float b) { h2_t v; v[0] = (_Float16)a; v[1] = (_Float16)b; return __builtin_bit_cast(unsigned, v); }
template <class ZF, class CF>
DI void hy_conv(float2* X, const float2* __restrict__ TW, const float2* __restrict__ Ke, const float2* __restrict__ Ko,
                ZF zf, CF consume, int tid) {
  const float scl = 0.5f / 8192.f;
#pragma unroll 2
  for (int i = 0; i < 32; i++) { int n = tid + 256 * i; X[n] = zf(n); }
  __syncthreads();
  fft_dif(X, TW, tid);
#pragma unroll 2
  for (int i = 0; i < 32; i++) { int k = tid + 256 * i; float2 a = X[k], w = Ke[k]; X[k] = make_float2(a.x * w.x - a.y * w.y, a.x * w.y + a.y * w.x); }
  __syncthreads();
  fft_dit(X, TW, tid);
  unsigned ye[32];
#pragma unroll
  for (int i = 0; i < 32; i++) { int n = tid + 256 * i; asm volatile("" : "+v"(n)); float2 e = X[n]; ye[i] = packh(e.x * scl, e.y * scl); if ((i & 1) == 1) __builtin_amdgcn_sched_barrier(0); }
  __syncthreads();
#pragma unroll 2
  for (int i = 0; i < 32; i++) { int n = tid + 256 * i; float2 z = zf(n), w = TW[n]; X[n] = make_float2(z.x * w.x - z.y * w.y, z.x * w.y + z.y * w.x); }
  __syncthreads();
  fft_dif(X, TW, tid);
#pragma unroll 2
  for (int i = 0; i < 32; i++) { int k = tid + 256 * i; float2 a = X[k], w = Ko[k]; X[k] = make_float2(a.x * w.x - a.y * w.y, a.x * w.y + a.y * w.x); }
  __syncthreads();
  fft_dit(X, TW, tid);
#pragma unroll
  for (int i = 0; i < 32; i++) {
    int n = tid + 256 * i;
    asm volatile("" : "+v"(n));
    float2 o = X[n], w = TW[n];
    float tx = o.x * w.x + o.y * w.y, ty = o.y * w.x - o.x * w.y;
    h2_t e = __builtin_bit_cast(h2_t, ye[i]);
    consume(n, (float)e[0] + tx * scl, (float)e[1] + ty * scl);
    __builtin_amdgcn_sched_barrier(0);
  }
  __syncthreads();
}

DI float sconv_at(const u16* __restrict__ u, int n, int Ls, float w0, float w1, float w2, float bias) {
  float um = n > 0 ? bf2f(u[n - 1]) : 0.f, uc = bf2f(u[n]), up = n < Ls - 1 ? bf2f(u[n + 1]) : 0.f;
  return bias + w0 * um + w1 * uc + w2 * up;
}

DI void hyena_item(const Params& p, int l, int c, int pair, char* smem) {
  float2* X = (float2*)smem;
  const float2* TW = (const float2*)(p.ws + OFF_TW);
  const float2* KS = (const float2*)(p.ws + OFF_KSPEC);
  const u16* UT = (const u16*)(p.ws + OFF_UT);
  u16* YT = (u16*)(p.ws + OFF_CQ);
  int tid_o = threadIdx.x;
  asm volatile("" : "+v"(tid_o));
  const int tid = tid_o;
  const float* cw = p.in[I_HCW] + l * 3 * 768;
  const float* cb = p.in[I_HCB] + l * 768;
  const int b0 = 2 * pair, b1 = b0 + 1;
  u16* y0 = YT + (size_t)(b0 * 256 + c) * SEQ;
  u16* y1 = YT + (size_t)(b1 * 256 + c) * SEQ;
  const float vw0 = cw[512 + c], vw1 = cw[768 + 512 + c], vw2 = cw[1536 + 512 + c], vbs = cb[512 + c];
  const u16* v0p = UT + (size_t)(b0 * 768 + 512 + c) * SEQ;
  const u16* v1p = UT + (size_t)(b1 * 768 + 512 + c) * SEQ;
  {
    const float w0 = cw[c], w1 = cw[768 + c], w2 = cw[1536 + c], bs = cb[c];
    const float bias0 = p.in[I_HBIAS][(l * 2 + 0) * 256 + c];
    const u16* u0 = UT + (size_t)(b0 * 768 + c) * SEQ;
    const u16* u1 = UT + (size_t)(b1 * 768 + c) * SEQ;
    hy_conv(X, TW, KS + (size_t)(0 * 256 + c) * 2 * 8192, KS + (size_t)(0 * 256 + c) * 2 * 8192 + 8192,
            [&](int n) __attribute__((always_inline)) { return make_float2(sconv_at(v0p, n, SEQ, vw0, vw1, vw2, vbs), sconv_at(v1p, n, SEQ, vw0, vw1, vw2, vbs)); },
            [&](int n, float ya, float yb) __attribute__((always_inline)) {
              float va = sconv_at(v0p, n, SEQ, vw0, vw1, vw2, vbs), vb = sconv_at(v1p, n, SEQ, vw0, vw1, vw2, vbs);
              y0[n] = f2bf(sconv_at(u0, n, SEQ, w0, w1, w2, bs) * (ya + va * bias0));
              y1[n] = f2bf(sconv_at(u1, n, SEQ, w0, w1, w2, bs) * (yb + vb * bias0));
            }, tid);
  }
  {
    const int col = 256 + c;
    const float w0 = cw[col], w1 = cw[768 + col], w2 = cw[1536 + col], bs = cb[col];
    const float bias1 = p.in[I_HBIAS][(l * 2 + 1) * 256 + c];
    const u16* u0 = UT + (size_t)(b0 * 768 + col) * SEQ;
    const u16* u1 = UT + (size_t)(b1 * 768 + col) * SEQ;
    hy_conv(X, TW, KS + (size_t)(1 * 256 + c) * 2 * 8192, KS + (size_t)(1 * 256 + c) * 2 * 8192 + 8192,
            [&](int n) __attribute__((always_inline)) { return make_float2(bf2f(y0[n]), bf2f(y1[n])); },
            [&](int n, float ya, float yb) __attribute__((always_inline)) {
              float za = bf2f(y0[n]), zb = bf2f(y1[n]);
              y0[n] = f2bf(sconv_at(u0, n, SEQ, w0, w1, w2, bs) * (ya + za * bias1));
              y1[n] = f2bf(sconv_at(u1, n, SEQ, w0, w1, w2, bs) * (yb + zb * bias1));
            }, tid);
  }
}

DI void hyena_ctx_item(const Params& p, int l, int b, int c, char* smem) {
  float* k0s = (float*)smem;
  float* k1s = k0s + 512;
  float* vs = k1s + 512;
  float* zs = vs + 256;
  const float* KC = (const float*)(p.ws + OFF_KC);
  const u16* UTC = (const u16*)(p.ws + OFF_UTC);
  u16* MIX = (u16*)(p.ws + OFF_H);
  int tid_o = threadIdx.x;
  asm volatile("" : "+v"(tid_o));
  const int n = tid_o;
  const float* cw = p.in[I_HCW] + l * 3 * 768;
  const float* cb = p.in[I_HCB] + l * 768;
  k0s[n] = KC[(size_t)(0 * 256 + c) * 512 + n]; k0s[256 + n] = KC[(size_t)(0 * 256 + c) * 512 + 256 + n];
  k1s[n] = KC[(size_t)(1 * 256 + c) * 512 + n]; k1s[256 + n] = KC[(size_t)(1 * 256 + c) * 512 + 256 + n];
  float v = sconv_at(UTC + (size_t)(b * 768 + 512 + c) * LCTX, n, LCTX, cw[512 + c], cw[768 + 512 + c], cw[1536 + 512 + c], cb[512 + c]);
  float x1 = sconv_at(UTC + (size_t)(b * 768 + c) * LCTX, n, LCTX, cw[c], cw[768 + c], cw[1536 + c], cb[c]);
  float x2 = sconv_at(UTC + (size_t)(b * 768 + 256 + c) * LCTX, n, LCTX, cw[256 + c], cw[768 + 256 + c], cw[1536 + 256 + c], cb[256 + c]);
  vs[n] = v;
  __syncthreads();
  float a = 0.f;
  for (int s = 0; s < 256; s++) a += k0s[n - s + 256] * vs[s];
  float z = x1 * (a + v * p.in[I_HBIAS][(l * 2 + 0) * 256 + c]);
  zs[n] = z;
  __syncthreads();
  float a2 = 0.f;
  for (int s = 0; s < 256; s++) a2 += k1s[n - s + 256] * zs[s];
  float y = x2 * (a2 + z * p.in[I_HBIAS][(l * 2 + 1) * 256 + c]);
  MIX[(size_t)(TLAT + b * LCTX + n) * 1024 + c] = f2bf(y);
  __syncthreads();
}

DI void phase_p4(const Params& p, int l, char* smem) {
  const int n_al = 2048, n_ac = (l == 0 ? 64 : 0), n_hy = 512, n_r3 = (l == 0 ? 16 * NCH : 16 * 64), n_hc = (l == 0 ? 1024 : 0);
  const int total = n_al + n_ac + n_hy + n_r3 + n_hc;
  for (int it = blockIdx.x; it < total; it += gridDim.x) {
    int q = it;
    if (q < n_al) {
      int b = q >> 9, hh = (q >> 6) & 7, qb = q & 63;
      if (SUB_ON(0)) attn_item(p, b, hh, b * SEQ + qb * 128, 0, LKEY, smem);
    } else if ((q -= n_al) < n_ac) {
      int b = q >> 4, hh = (q >> 1) & 7, qb = q & 1;
      if (SUB_ON(0)) attn_item(p, b, hh, TLAT + b * LCTX + qb * 128, SEQ, LCTX, smem);
    } else if ((q -= n_ac) < n_hy) {
      if (SUB_ON(1)) hyena_item(p, l, q >> 1, q & 1, smem);
    } else if ((q -= n_hy) < n_r3) {
      int bh, ci;
      if (l == 0) { bh = q / NCH; ci = q - bh * NCH; } else { bh = q >> 6; ci = 2 + (q & 63); }
      if (SUB_ON(2)) ret_out_item(p, l, bh >> 2, bh & 3, ci, smem);
    } else {
      q -= n_r3;
      if (SUB_ON(3)) hyena_ctx_item(p, l, q >> 8, q & 255, smem);
    }
  }
}

DI void phase_res_gemm(const Params& p, int l, int which  , char* smem) {
  const int lane = threadIdx.x & 63, r = lane & 31, h = lane >> 5;
  const int nmt = (l == 0 ? 132 : 128);
  const char* wl = p.ws + OFF_W + (size_t)l * WL_SIZE;
  const u16* A = (const u16*)(p.ws + (which == 1 ? OFF_H : OFF_ACT));
  const int K = which == 1 ? 1024 : 4096;
  const u16* Bt = (const u16*)(wl + (which == 1 ? WL_WOUT : WL_W2));
  const bool first = (l == 0 && which == 1);
  const float* mod = (const float*)(p.ws + OFF_MOD);
  float* XC = (float*)(p.ws + OFF_XC);
  const int total = nmt * 8;
  for (int it = blockIdx.x; it < total; it += gridDim.x) {
    int mt = it >> 3, nt = it & 7;
    int m0 = mt * 256;
    const u16* at = nullptr;
    if (which == 1 && m0 < TLAT) at = (const u16*)(p.ws + OFF_CQ) + (size_t)((m0 >> 13) * 256) * SEQ + (m0 & 8191);
    int cond = m0 < TLAT ? (m0 >> 13) : 4;
    const float* ga = mod + (size_t)(l * 5 + cond) * 6144 + (which == 1 ? 2048 : 5120);
    const float* src; float* dst;
    if (m0 < TLAT) { src = first ? p.in[I_X] : p.out; dst = p.out; }
    else { src = (first ? p.in[I_CTX] : XC) - (size_t)TLAT * 1024; dst = XC - (size_t)TLAT * 1024; }
    gemm_tile<false, false, false>(A, K, Bt, K, K, m0, nt * 128, at, 8, smem,
      [&](int bm, int bn, const f32x16& acc, const float*) __attribute__((always_inline)) {
        int col = bn + r;
        float g = ga[col];
#pragma unroll
        for (int reg = 0; reg < 16; reg++) {
          size_t idx = (size_t)(bm + crow(reg, h)) * 1024 + col;
          dst[idx] = src[idx] + g * acc[reg];
        }
      });
  }
}

DI void phase_mlp1(const Params& p, int l, char* smem) {
  const int lane = threadIdx.x & 63, r = lane & 31, h = lane >> 5;
  const int nmt = (l == 0 ? 132 : 128);
  const u16* A = (const u16*)(p.ws + OFF_H);
  const u16* Bt = (const u16*)(p.ws + OFF_W + (size_t)l * WL_SIZE + WL_W1);
  u16* ACT = (u16*)(p.ws + OFF_ACT);
  const int total = nmt * 32;
  for (int it = blockIdx.x; it < total; it += gridDim.x) {
    int mt = it >> 5, nt = it & 31;
    gemm_tile<false, false, false>(A, 1024, Bt, 1024, 1024, mt * 256, nt * 128, nullptr, 0, smem,
      [&](int bm, int bn, const f32x16& acc, const float*) __attribute__((always_inline)) {
        int col = bn + r;
#pragma unroll
        for (int reg = 0; reg < 16; reg++) {
          float v = fmaxf(acc[reg], 0.f);
          ACT[(size_t)(bm + crow(reg, h)) * 4096 + col] = f2bf(v * v);
        }
      });
  }
}

DI void phase_final(const Params& p) {
  const int lane = threadIdx.x & 63, wid = threadIdx.x >> 6;
  const float* g = p.in[I_FNG];
  for (int it = blockIdx.x; it < TLAT / 4; it += gridDim.x) {
    float* row = p.out + (size_t)(it * 4 + wid) * 1024;
    float4 v[4];
    float ssq = 0.f;
#pragma unroll
    for (int i = 0; i < 4; i++) {
      v[i] = *(const float4*)(row + i * 256 + lane * 4);
      ssq += v[i].x * v[i].x + v[i].y * v[i].y + v[i].z * v[i].z + v[i].w * v[i].w;
    }
    ssq = wave_sum(ssq);
    float rstd = rsqrtf(ssq * (1.f / 1024.f) + 1e-6f);
#pragma unroll
    for (int i = 0; i < 4; i++) {
      float4 gg = *(const float4*)(g + i * 256 + lane * 4);
      *(float4*)(row + i * 256 + lane * 4) = make_float4(v[i].x * rstd * gg.x, v[i].y * rstd * gg.y, v[i].z * rstd * gg.z, v[i].w * rstd * gg.w);
    }
  }
}

constexpr int NPHASE = 20;
#ifndef ONLY_PHASE
#define ONLY_PHASE -1
#endif
#define PH_ON(k) (ONLY_PHASE < 0 || ONLY_PHASE == (k))
DI void run_phase(const Params& p, int ph, char* smem) {
  if (ph == 0) { if (PH_ON(0)) phase_s0(p, smem); return; }
  if (ph == NPHASE - 1) { if (PH_ON(8)) phase_final(p); return; }
  int l = (ph - 1) / 9, s = (ph - 1) % 9;
  switch (s) {
    case 0: if (PH_ON(1)) phase_norm(p, l, 1, TALL, true); break;
    case 1: if (PH_ON(2)) phase_win(p, l, smem); break;
    case 2: if (PH_ON(3)) phase_p3(p, l, smem); break;
    case 3: if (PH_ON(4)) phase_scan(p, l); break;
    case 4: if (PH_ON(5)) phase_p4(p, l, smem); break;
    case 5: if (PH_ON(6)) phase_res_gemm(p, l, 1, smem); break;
    case 6: if (PH_ON(1)) phase_norm(p, l, 2, l == 0 ? TALL : TLAT, false); break;
    case 7: if (PH_ON(7)) phase_mlp1(p, l, smem); break;
    default: if (PH_ON(6)) phase_res_gemm(p, l, 2, smem); break;
  }
}

#if !MULTI_LAUNCH
extern "C" __global__ void __launch_bounds__(256, 2) mk_all(Params p) {
  extern __shared__ __attribute__((aligned(16))) char smem[];
  cg::grid_group grid = cg::this_grid();
  for (int ph = 0; ph < NPHASE; ph++) {
    run_phase(p, ph, smem);
    if (ph + 1 < NPHASE) grid.sync();
  }
}
#define MK_KERNEL mk_all
#else
#define MK_KERNEL mk_phase
extern "C" __global__ void __launch_bounds__(256, 2) mk_phase(Params p, int ph) {
  extern __shared__ __attribute__((aligned(16))) char smem[];
  run_phase(p, ph, smem);
}
#endif

extern "C" void kernel_launch(void* const* d_in, const int* in_sizes, int n_in, void* d_out, int out_size, void* d_ws, size_t ws_size,
                              hipStream_t stream) {
  Params p{};
  for (int i = 0; i < 27; i++) p.in[i] = (const float*)d_in[i];
  p.out = (float*)d_out;
  p.ws = (char*)d_ws;
  static int grid_blocks = 0;
  if (!grid_blocks) {
    int dev = 0, cus = 0, per_cu = 0;
    (void)hipGetDevice(&dev);
    (void)hipDeviceGetAttribute(&cus, hipDeviceAttributeMultiprocessorCount, dev);
    (void)hipFuncSetAttribute((const void*)MK_KERNEL, hipFuncAttributeMaxDynamicSharedMemorySize, SMEM_BYTES);
    (void)hipOccupancyMaxActiveBlocksPerMultiprocessor(&per_cu, MK_KERNEL, 256, SMEM_BYTES);
    if (per_cu < 1) per_cu = 1;
    if (per_cu > 2) per_cu = 2;
    grid_blocks = cus * per_cu;
  }
#if MULTI_LAUNCH
  for (int ph = 0; ph < NPHASE; ph++) hipLaunchKernelGGL(mk_phase, dim3(grid_blocks), dim3(256), SMEM_BYTES, stream, p, ph);
#else
  void* args[] = {&p};
  (void)hipLaunchCooperativeKernel((void*)mk_all, dim3(grid_blocks), dim3(256), args, SMEM_BYTES, stream);
#endif
}
```

```cpp
#include <hip/hip_runtime.h>
#include <hip/hip_cooperative_groups.h>
namespace cg = cooperative_groups;

#ifndef MULTI_LAUNCH
#define MULTI_LAUNCH 0
#endif

#define DI __device__ __forceinline__
#define NI __device__ __noinline__
typedef unsigned short u16;
typedef short bf16x8 __attribute__((ext_vector_type(8)));
typedef float f32x16 __attribute__((ext_vector_type(16)));
typedef __bf16 bf2_t __attribute__((ext_vector_type(2)));
typedef unsigned u32x4 __attribute__((ext_vector_type(4)));
#define MFMA32(a, b, c) __builtin_amdgcn_mfma_f32_32x32x16_bf16((a), (b), (c), 0, 0, 0)

constexpr int NB = 4, SEQ = 8192, LCTX = 256, DM = 1024, DFF = 4096;
constexpr int TLAT = NB * SEQ;
constexpr int TALL = TLAT + NB * LCTX;
constexpr int NIN = 2208, NINP = 2304;
constexpr int LKEY = SEQ + LCTX;
constexpr int NCH = 66;
constexpr int SMEM_BYTES = 73728;
#ifndef SUBSEL
#define SUBSEL -1
#endif
#define SUB_ON(k) (SUBSEL < 0 || SUBSEL == (k))

constexpr size_t WL_WIN = 0;
constexpr size_t WL_WOUT = WL_WIN + (size_t)NINP * 1024 * 2;
constexpr size_t WL_W1 = WL_WOUT + (size_t)1024 * 1024 * 2;
constexpr size_t WL_W2 = WL_W1 + (size_t)4096 * 1024 * 2;
constexpr size_t WL_WUQ = WL_W2 + (size_t)1024 * 4096 * 2;
constexpr size_t WL_WUKV = WL_WUQ + (size_t)768 * 256 * 2;
constexpr size_t WL_SIZE = WL_WUKV + (size_t)1024 * 128 * 2;
constexpr size_t OFF_W = 0;
constexpr size_t OFF_MOD = OFF_W + 2 * WL_SIZE;
constexpr size_t OFF_TW = OFF_MOD + (size_t)2 * 5 * 6144 * 4;
constexpr size_t OFF_ROPE = OFF_TW + 65536;
constexpr size_t OFF_XC = OFF_ROPE + 192 * 8 * 8 + 4096;
constexpr size_t OFF_H = OFF_XC + (size_t)1024 * 1024 * 4;
constexpr size_t OFF_H2F = OFF_H + (size_t)TALL * 1024 * 2;
constexpr size_t OFF_H2C = OFF_H2F + (size_t)8192 * 64 * 4;
constexpr size_t OFF_KC = OFF_H2C + (size_t)256 * 64 * 4;
constexpr size_t OFF_BIG = OFF_KC + (size_t)2 * 256 * 512 * 4;
constexpr size_t OFF_UT = OFF_BIG;
constexpr size_t OFF_UTC = OFF_UT + (size_t)NB * 768 * SEQ * 2;
constexpr size_t OFF_RET = OFF_UTC + (size_t)NB * 768 * LCTX * 2;
constexpr size_t OFF_CQ = OFF_RET + (size_t)TALL * 1024 * 2;
constexpr size_t OFF_CKV = OFF_CQ + (size_t)TALL * 256 * 2;
constexpr size_t OFF_Q = OFF_CKV + (size_t)TALL * 128 * 2;
constexpr size_t OFF_KF = OFF_Q + (size_t)TALL * 768 * 2;
constexpr size_t OFF_VT = OFF_KF + (size_t)NB * 8 * LKEY * 96 * 2;
constexpr size_t OFF_ST = OFF_VT + (size_t)NB * 8 * 64 * LKEY * 2;
constexpr size_t OFF_KSPEC = OFF_ST + (size_t)2 * 16 * NCH * 4096 * 4;
constexpr size_t OFF_END = OFF_KSPEC + (size_t)2 * 256 * 2 * 8192 * 8;
constexpr size_t OFF_ACT = OFF_BIG;
static_assert(OFF_ACT + (size_t)TALL * 4096 * 2 <= OFF_END, "act fits");
static_assert(OFF_END <= (size_t)536870912, "workspace");

struct Params {
  const float* in[27];
  float* out;
  char* ws;
};
enum { I_X = 0, I_C, I_CTX, I_CCTX, I_WADA, I_BADA, I_N1G, I_N2G, I_WIN, I_WOUT, I_HCW, I_HCB, I_HW1, I_HB1, I_HSF, I_HW2,
       I_HB2, I_HW3, I_HBIAS, I_RLD, I_QNG, I_WUQ, I_KVNG, I_WUKV, I_W1, I_W2, I_FNG };

DI int tidx() { int t = __builtin_amdgcn_workitem_id_x(); asm volatile("" : "+v"(t)); return t; }
DI u16 f2bf(float x) { return __builtin_bit_cast(u16, (__bf16)x); }
DI float bf2f(u16 v) { return __uint_as_float(((unsigned)v) << 16); }
DI unsigned pack2(float a, float b) { bf2_t v; v[0] = (__bf16)a; v[1] = (__bf16)b; return __builtin_bit_cast(unsigned, v); }
DI float wave_sum(float v) {
#pragma unroll
  for (int o = 32; o > 0; o >>= 1) v += __shfl_xor(v, o);
  return v;
}
DI int crow(int reg, int h) { return (reg & 3) + 8 * (reg >> 2) + 4 * h; }
DI float bfe(u32x4 v, int j) {
  unsigned w = v[j >> 1];
  return __uint_as_float((j & 1) ? (w & 0xffff0000u) : (w << 16));
}
DI u16 bfu(u32x4 v, int j) {
  unsigned w = v[j >> 1];
  return (u16)((j & 1) ? (w >> 16) : (w & 0xffffu));
}
DI float silu_f(float x) { return x / (1.f + __expf(-x)); }
DI void row_info(int row, int& b, int& t, int& key, int& cond) {
  if (row < TLAT) { b = row >> 13; t = row & 8191; key = t; cond = b; }
  else { int rc = row - TLAT; b = rc >> 8; t = rc & 255; key = SEQ + t; cond = 4; }
}
DI int chunk_row0(int b, int ci) { return ci < 2 ? TLAT + b * LCTX + ci * 128 : b * SEQ + (ci - 2) * 128; }
DI float rope_apply(const float2* __restrict__ tab, float val, int jj, int t) {
  float partner = __shfl_xor(val, 8);
  int pos = (jj & 16) ? 128 + (t & 63) : (t >> 6);
  float2 cs = tab[pos * 8 + (jj & 7)];
  return (jj & 8) ? (val * cs.x + partner * cs.y) : (val * cs.x - partner * cs.y);
}

DI void convT_item(const float* __restrict__ src, u16* __restrict__ dst, int K, int N, int Npad, const float* __restrict__ gain,
                   int item, float* tile, bool perm = false) {
  int ntn = Npad >> 6;
  int kt = item / ntn, nt = item - kt * ntn;
  int k0 = kt * 64, n0 = nt * 64;
  int c = tidx() & 63, q = tidx() >> 6;
#pragma unroll 4
  for (int i = 0; i < 16; i++) {
    int kk = i * 4 + q, n = n0 + c;
    float v = 0.f;
    if (n < N) { int sn = perm ? ((n & 511) >> 6) * 128 + (n >> 9) * 64 + (n & 63) : n; v = src[(size_t)(k0 + kk) * N + sn]; if (gain) v *= gain[k0 + kk]; }
    tile[kk * 65 + c] = v;
  }
  __syncthreads();
#pragma unroll 4
  for (int i = 0; i < 16; i++) {
    int nn = i * 4 + q;
    dst[(size_t)(n0 + nn) * K + k0 + c] = f2bf(tile[c * 65 + nn]);
  }
  __syncthreads();
}

DI void phase_s0(const Params& p, char* smem) {
  const int per_layer = 576 + 256 + 1024 + 1024 + 48 + 32;
  const int n_conv = 2 * per_layer, n_mod = 2 * 96, n_tw = 32 + 6;
  const int total = n_conv + n_mod + n_tw;
  for (int it = blockIdx.x; it < total; it += gridDim.x) {
    if (it < n_conv) {
      int l = it / per_layer, r = it - l * per_layer;
      char* wl = p.ws + OFF_W + (size_t)l * WL_SIZE;
      float* tile = (float*)smem;
      if (r < 576) convT_item(p.in[I_WIN] + (size_t)l * 1024 * NIN, (u16*)(wl + WL_WIN), 1024, NIN, NINP, nullptr, r, tile);
      else if ((r -= 576) < 256) convT_item(p.in[I_WOUT] + (size_t)l * 1024 * 1024, (u16*)(wl + WL_WOUT), 1024, 1024, 1024, nullptr, r, tile);
      else if ((r -= 256) < 1024) convT_item(p.in[I_W1] + (size_t)l * 1024 * 4096, (u16*)(wl + WL_W1), 1024, 4096, 4096, nullptr, r, tile);
      else if ((r -= 1024) < 1024) convT_item(p.in[I_W2] + (size_t)l * 4096 * 1024, (u16*)(wl + WL_W2), 4096, 1024, 1024, nullptr, r, tile);
      else if ((r -= 1024) < 48) convT_item(p.in[I_WUQ] + (size_t)l * 256 * 768, (u16*)(wl + WL_WUQ), 256, 768, 768, p.in[I_QNG] + l * 256, r, tile);
      else { r -= 48; convT_item(p.in[I_WUKV] + (size_t)l * 128 * 1024, (u16*)(wl + WL_WUKV), 128, 1024, 1024, p.in[I_KVNG] + l * 128, r, tile, true); }
    } else if (it < n_conv + n_mod) {
      int r = it - n_conv;
      int l = r / 96, n0 = (r - l * 96) * 64;
      float* sc = (float*)smem;
      float* red = sc + 5120;
      for (int i = tidx(); i < 5120; i += 256) {
        int rr = i >> 10, k = i & 1023;
        float cv = rr < 4 ? p.in[I_C][rr * 1024 + k] : p.in[I_CCTX][k];
        sc[i] = cv / (1.f + expf(-cv));
      }
      __syncthreads();
      int nn = tidx() & 63, kq = tidx() >> 6;
      float a0 = 0, a1 = 0, a2 = 0, a3 = 0, a4 = 0;
      const float* w = p.in[I_WADA] + ((size_t)l * 1024 + kq * 256) * 6144 + n0 + nn;
      for (int k = 0; k < 256; k++) {
        float wv = w[(size_t)k * 6144];
        int kk = kq * 256 + k;
        a0 += sc[kk] * wv; a1 += sc[1024 + kk] * wv; a2 += sc[2048 + kk] * wv; a3 += sc[3072 + kk] * wv; a4 += sc[4096 + kk] * wv;
      }
      red[(kq * 5 + 0) * 64 + nn] = a0; red[(kq * 5 + 1) * 64 + nn] = a1; red[(kq * 5 + 2) * 64 + nn] = a2;
      red[(kq * 5 + 3) * 64 + nn] = a3; red[(kq * 5 + 4) * 64 + nn] = a4;
      __syncthreads();
      if (tidx() < 64) {
        float* mod = (float*)(p.ws + OFF_MOD);
        float bb = p.in[I_BADA][l * 6144 + n0 + nn];
        for (int rr = 0; rr < 5; rr++) {
          float s = red[(0 * 5 + rr) * 64 + nn] + red[(1 * 5 + rr) * 64 + nn] + red[(2 * 5 + rr) * 64 + nn] + red[(3 * 5 + rr) * 64 + nn];
          mod[(size_t)(l * 5 + rr) * 6144 + n0 + nn] = s + bb;
        }
      }
      __syncthreads();
    } else {
      int q = it - n_conv - n_mod;
      if (q < 32) {
        int n = q * 256 + tidx();
        float sn, cs;
        sincospif((float)n / 8192.f, &sn, &cs);
        ((float2*)(p.ws + OFF_TW))[n] = make_float2(cs, -sn);
      } else {
        int e = (q - 32) * 256 + tidx();
        int pos = e >> 3, f = e & 7;
        float pv = pos < 128 ? (float)pos : (float)(pos - 128);
        float inv = powf(10000.f, -(float)f / 8.f);
        float sn, cs;
        sincosf(pv * inv, &sn, &cs);
        ((float2*)(p.ws + OFF_ROPE))[e] = make_float2(cs, sn);
      }
    }
  }
}

DI void filt_a_item(const Params& p, int l, int Lf, float* h2out, int pos) {
  int lane = tidx() & 63;
  float tpos = (float)pos / (float)(Lf - 1);
  float zval = 0.f;
  if (lane == 0) zval = tpos;
  else if (lane < 33) {
    int jj = (lane - 1) & 15;
    float band = 1e-4f + (float)jj * ((15.f - 1e-4f) / 15.f);
    float ang = ((float)(6.283185307179586 / (double)Lf)) * (float)pos * band;
    zval = lane < 17 ? cosf(ang) : -sinf(ang);
  }
  const float* w1 = p.in[I_HW1] + l * 33 * 64;
  const float* w2 = p.in[I_HW2] + l * 64 * 64;
  float acc = p.in[I_HB1][l * 64 + lane];
  for (int i = 0; i < 33; i++) acc += __shfl(zval, i) * w1[i * 64 + lane];
  float h1 = sinf(p.in[I_HSF][l * 128 + lane] * acc);
  float acc2 = p.in[I_HB2][l * 64 + lane];
  for (int i = 0; i < 64; i++) acc2 += __shfl(h1, i) * w2[i * 64 + lane];
  h2out[(size_t)pos * 64 + lane] = sinf(p.in[I_HSF][l * 128 + 64 + lane] * acc2);
}

DI void phase_norm(const Params& p, int l, int which, int nrows, bool with_filter) {
  const int lane = tidx() & 63, wid = tidx() >> 6;
  const bool first = (l == 0 && which == 1);
  const int n_norm = nrows >> 2;
  const int n_fa = with_filter ? (8192 / 4 + (l == 0 ? 256 / 4 : 0)) : 0;
  const float* gsrc = p.in[which == 1 ? I_N1G : I_N2G] + l * 1024;
  u16* H = (u16*)(p.ws + OFF_H);
  for (int it = blockIdx.x; it < n_norm + n_fa; it += gridDim.x) {
    if (it < n_norm) {
      int row = it * 4 + wid;
      const float* src;
      int cond;
      if (row < TLAT) { src = (first ? p.in[I_X] : p.out) + (size_t)row * 1024; cond = row >> 13; }
      else { src = (first ? p.in[I_CTX] : (const float*)(p.ws + OFF_XC)) + (size_t)(row - TLAT) * 1024; cond = 4; }
      const float* m = (const float*)(p.ws + OFF_MOD) + (size_t)(l * 5 + cond) * 6144 + (which == 1 ? 0 : 3072);
      float4 v[4];
      float ssq = 0.f;
#pragma unroll
      for (int i = 0; i < 4; i++) {
        v[i] = *(const float4*)(src + i * 256 + lane * 4);
        ssq += v[i].x * v[i].x + v[i].y * v[i].y + v[i].z * v[i].z + v[i].w * v[i].w;
      }
      ssq = wave_sum(ssq);
      float rstd = rsqrtf(ssq * (1.f / 1024.f) + 1e-6f);
#pragma unroll
      for (int i = 0; i < 4; i++) {
        int col = i * 256 + lane * 4;
        float4 g = *(const float4*)(gsrc + col), sh = *(const float4*)(m + col), sc = *(const float4*)(m + 1024 + col);
        float o0 = v[i].x * rstd * g.x * (1.f + sc.x) + sh.x, o1 = v[i].y * rstd * g.y * (1.f + sc.y) + sh.y;
        float o2 = v[i].z * rstd * g.z * (1.f + sc.z) + sh.z, o3 = v[i].w * rstd * g.w * (1.f + sc.w) + sh.w;
        *(uint2*)(H + (size_t)row * 1024 + col) = make_uint2(pack2(o0, o1), pack2(o2, o3));
      }
    } else {
      int q = it - n_norm;
      if (q < 2048) filt_a_item(p, l, 8192, (float*)(p.ws + OFF_H2F), q * 4 + wid);
      else filt_a_item(p, l, 256, (float*)(p.ws + OFF_H2C), (q - 2048) * 4 + wid);
    }
  }
}

constexpr int GLD = 40;
template <bool ROWNORM, bool TR0, bool TR1, class Epi>
DI void gemm_tile(const u16* __restrict__ A, int lda, const u16* __restrict__ Bt, int ldb, int K, int m0, int n0,
                  const u16* __restrict__ at_src, int at_kt, char* smem, Epi epi) {
  u16* As = (u16*)smem;
  u16* Bs = As + 256 * GLD;
  float* rs = (float*)(Bs + 128 * GLD);
  int tid_o = tidx();
  asm volatile("" : "+v"(tid_o));
  const int tid = tid_o, lane = tid & 63, wid = tid >> 6, wm = wid >> 1, wn = wid & 1, r = lane & 31, h = lane >> 5;
  const bool trans = (TR0 == TR1) ? TR0 : (wn ? TR1 : TR0);
  f32x16 acc[4][2];
#pragma unroll
  for (int mi = 0; mi < 4; mi++)
#pragma unroll
    for (int ni = 0; ni < 2; ni++)
#pragma unroll
      for (int e = 0; e < 16; e++) acc[mi][ni][e] = 0.f;
  u32x4 ra[4], rb[2];
  float ssq[4];
#pragma unroll
  for (int i = 0; i < 4; i++) ssq[i] = 0.f;
  const int nk = K >> 5;
  const int lrow = tid >> 2, lkc = tid & 3;
  const int tch = tid >> 5, ttc = tid & 31;
  const bool has_at = at_src != nullptr;

#define GEMM_GLOAD(KT)                                                                                                      \
  {                                                                                                                         \
    const int kt_ = (KT);                                                                                                   \
    if (has_at && kt_ < at_kt) {                                                                                            \
      _Pragma("unroll") for (int i = 0; i < 4; i++) ra[i] = *(const u32x4*)(at_src + (size_t)(kt_ * 32 + tch + 8 * i) * 8192 + ttc * 8); \
    } else {                                                                                                                \
      _Pragma("unroll") for (int i = 0; i < 4; i++) ra[i] = *(const u32x4*)(A + (size_t)(m0 + lrow + 64 * i) * lda + kt_ * 32 + lkc * 8);  \
    }                                                                                                                       \
    _Pragma("unroll") for (int i = 0; i < 2; i++) rb[i] = *(const u32x4*)(Bt + (size_t)(n0 + lrow + 64 * i) * ldb + kt_ * 32 + lkc * 8);   \
  }
  GEMM_GLOAD(0)
  for (int kt = 0; kt < nk; kt++) {
    __syncthreads();
    if (has_at && kt < at_kt) {
#pragma unroll
      for (int i = 0; i < 4; i++)
#pragma unroll
        for (int j = 0; j < 8; j++) As[(ttc * 8 + j) * GLD + tch + 8 * i] = bfu(ra[i], j);
    } else {
#pragma unroll
      for (int i = 0; i < 4; i++) *(u32x4*)(As + (lrow + 64 * i) * GLD + lkc * 8) = ra[i];
    }
#pragma unroll
    for (int i = 0; i < 2; i++) *(u32x4*)(Bs + (lrow + 64 * i) * GLD + lkc * 8) = rb[i];
    if (ROWNORM) {
#pragma unroll
      for (int i = 0; i < 4; i++)
#pragma unroll
        for (int j = 0; j < 8; j++) { float x = bfe(ra[i], j); ssq[i] += x * x; }
    }
    __syncthreads();
    if (kt + 1 < nk) GEMM_GLOAD(kt + 1)
#pragma unroll
    for (int ks = 0; ks < 2; ks++) {
      bf16x8 a[4], b[2];
#pragma unroll
      for (int mi = 0; mi < 4; mi++) a[mi] = *(const bf16x8*)(As + (wm * 128 + mi * 32 + r) * GLD + ks * 16 + h * 8);
#pragma unroll
      for (int ni = 0; ni < 2; ni++) b[ni] = *(const bf16x8*)(Bs + (wn * 64 + ni * 32 + r) * GLD + ks * 16 + h * 8);
      if (!trans) {
#pragma unroll
        for (int mi = 0; mi < 4; mi++)
#pragma unroll
          for (int ni = 0; ni < 2; ni++) acc[mi][ni] = MFMA32(a[mi], b[ni], acc[mi][ni]);
      } else {
#pragma unroll
        for (int mi = 0; mi < 4; mi++)
#pragma unroll
          for (int ni = 0; ni < 2; ni++) acc[mi][ni] = MFMA32(b[ni], a[mi], acc[mi][ni]);
      }
    }
  }
  if (ROWNORM) {
    float* rsp = rs + 256;
#pragma unroll
    for (int i = 0; i < 4; i++) rsp[(lrow + 64 * i) * 4 + lkc] = ssq[i];
    __syncthreads();
    {
      float4 q = *(const float4*)(rsp + tid * 4);
      rs[tid] = rsqrtf((q.x + q.y + q.z + q.w) / (float)K + 1e-6f);
    }
    __syncthreads();
  }
#define EPI_CALL(mi, ni) epi(m0 + wm * 128 + (mi) * 32, n0 + wn * 64 + (ni) * 32, acc[mi][ni], rs);
  EPI_CALL(0, 0) EPI_CALL(0, 1) EPI_CALL(1, 0) EPI_CALL(1, 1) EPI_CALL(2, 0) EPI_CALL(2, 1) EPI_CALL(3, 0) EPI_CALL(3, 1)
#undef EPI_CALL
  __syncthreads();
}

DI void phase_win(const Params& p, int l, char* smem) {
  const u16* H = (const u16*)(p.ws + OFF_H);
  const u16* W = (const u16*)(p.ws + OFF_W + (size_t)l * WL_SIZE + WL_WIN);
  u16* UT = (u16*)(p.ws + OFF_UT);
  u16* UTC = (u16*)(p.ws + OFF_UTC);
  u16* RET = (u16*)(p.ws + OFF_RET);
  u16* CQ = (u16*)(p.ws + OFF_CQ);
  u16* CKV = (u16*)(p.ws + OFF_CKV);
  u16* KF = (u16*)(p.ws + OFF_KF);
  const int lane = tidx() & 63, r = lane & 31, h = lane >> 5;
  const int total = 132 * 18;
  for (int it = blockIdx.x; it < total; it += gridDim.x) {
    int mt = it / 18, nt = it - mt * 18;
    int m0 = mt * 256, n0 = nt * 128;
    if (nt < 6) {
      gemm_tile<false, true, true>(H, 1024, W, 1024, 1024, m0, n0, nullptr, 0, smem,
        [&](int bm, int bn, const f32x16& acc, const float*) __attribute__((always_inline)) {
          int row = bm + r, b, t, key, cond;
          row_info(row, b, t, key, cond);
          u16* dstp = row < TLAT ? UT + ((size_t)(b * 768)) * SEQ + t : UTC + ((size_t)(b * 768)) * LCTX + t;
          int strd = row < TLAT ? SEQ : LCTX;
#pragma unroll
          for (int reg = 0; reg < 16; reg++) dstp[(size_t)(bn + crow(reg, h)) * strd] = f2bf(acc[reg]);
        });
    } else {
      gemm_tile<false, false, false>(H, 1024, W, 1024, 1024, m0, n0, nullptr, 0, smem,
        [&](int bm, int bn, const f32x16& acc, const float*) __attribute__((always_inline)) {
        if (nt < 14) {

          int col = bn + r - 768;
          float sc = (col >= 256 && col < 512) ? 0.125f : 1.f;
#pragma unroll
          for (int reg = 0; reg < 16; reg++) RET[(size_t)(bm + crow(reg, h)) * 1024 + col] = f2bf(acc[reg] * sc);
        } else if (nt < 16) {
          int col = bn + r - 1792;
#pragma unroll
          for (int reg = 0; reg < 16; reg++) CQ[(size_t)(bm + crow(reg, h)) * 256 + col] = f2bf(acc[reg]);
        } else if (nt == 16) {
          int col = bn + r - 2048;
#pragma unroll
          for (int reg = 0; reg < 16; reg++) CKV[(size_t)(bm + crow(reg, h)) * 128 + col] = f2bf(acc[reg]);
        } else if (bn == 2176) {
#pragma unroll
          for (int reg = 0; reg < 16; reg++) {
            int row = bm + crow(reg, h), b, t, key, cond;
            row_info(row, b, t, key, cond);
            float v = acc[reg];
            float vr = rope_apply((const float2*)(p.ws + OFF_ROPE), v, r, t);
            if (row < TLAT) v = vr;
            u16 o = f2bf(v);
#pragma unroll
            for (int hh = 0; hh < 8; hh++) KF[((size_t)(b * 8 + hh) * LKEY + key) * 96 + 64 + r] = o;
          }
        }
      });
    }
  }
}

DI void ret_gammas(const Params& p, int l, int hh, float& lgf, float& lgb) {
  lgf = log1pf(-expf(p.in[I_RLD][l * 8 + hh]));
  lgb = log1pf(-expf(p.in[I_RLD][l * 8 + 4 + hh]));
}
DI void ret_kv_item(const Params& p, int l, int b, int hh, int ci, char* smem) {
  const u16* RET = (const u16*)(p.ws + OFF_RET);
  float* ST = (float*)(p.ws + OFF_ST);
  u16* KfT = (u16*)smem;
  u16* KbT = KfT + 64 * 136;
  u16* VsT = KbT + 64 * 136;
  int tid_o = tidx();
  asm volatile("" : "+v"(tid_o));
  const int tid = tid_o, lane = tid & 63, wid = tid >> 6, r = lane & 31, h = lane >> 5;
  float lgf, lgb;
  ret_gammas(p, l, hh, lgf, lgb);
  const int row0 = chunk_row0(b, ci);
#pragma unroll
  for (int i = 0; i < 4; i++) {
    int id = tid + 256 * i, m = id >> 3, dc = id & 7;
    u32x4 kv = *(const u32x4*)(RET + (size_t)(row0 + m) * 1024 + 256 + hh * 64 + dc * 8);
    u32x4 vv = *(const u32x4*)(RET + (size_t)(row0 + m) * 1024 + 512 + hh * 64 + dc * 8);
    float zf = __expf(lgf * (float)(127 - m)), zb = __expf(lgb * (float)m);
#pragma unroll
    for (int j = 0; j < 8; j++) {
      float kval = bfe(kv, j);
      KfT[(dc * 8 + j) * 136 + m] = f2bf(kval * zf);
      KbT[(dc * 8 + j) * 136 + m] = f2bf(kval * zb);
      VsT[(dc * 8 + j) * 136 + m] = bfu(vv, j);
    }
  }
  __syncthreads();
  const int dir = wid >> 1, dh = wid & 1;
  const u16* Asrc = dir ? KbT : KfT;
  f32x16 c0, c1;
#pragma unroll
  for (int e = 0; e < 16; e++) { c0[e] = 0.f; c1[e] = 0.f; }
#pragma unroll
  for (int ks = 0; ks < 8; ks++) {
    bf16x8 a = *(const bf16x8*)(Asrc + (dh * 32 + r) * 136 + ks * 16 + h * 8);
    bf16x8 b0 = *(const bf16x8*)(VsT + (r) * 136 + ks * 16 + h * 8);
    bf16x8 b1 = *(const bf16x8*)(VsT + (32 + r) * 136 + ks * 16 + h * 8);
    c0 = MFMA32(a, b0, c0);
    c1 = MFMA32(a, b1, c1);
  }
  float* dst = ST + ((size_t)((dir * 4 + b) * 4 + hh) * NCH + ci) * 4096;
#pragma unroll
  for (int reg = 0; reg < 16; reg++) {
    int d = dh * 32 + crow(reg, h);
    dst[d * 64 + r] = c0[reg];
    dst[d * 64 + 32 + r] = c1[reg];
  }
  __syncthreads();
}

DI void fft_dif(float2* X, const float2* __restrict__ TW, int tid) {
#pragma unroll 1
  for (int s = 0; s < 13; s++) {
    const int half = 4096 >> s, sh = 12 - s;
#pragma unroll 4
    for (int jj = 0; jj < 16; jj++) {
      int j = tid + jj * 256;
      int g = j >> sh, pos = j & (half - 1);
      int i0 = (g << (sh + 1)) + pos, i1 = i0 + half;
      float2 w = TW[(pos << s) << 1];
      float2 a = X[i0], b = X[i1];
      X[i0] = make_float2(a.x + b.x, a.y + b.y);
      float dx = a.x - b.x, dy = a.y - b.y;
      X[i1] = make_float2(dx * w.x - dy * w.y, dx * w.y + dy * w.x);
    }
    __syncthreads();
  }
}
DI void fft_dit(float2* X, const float2* __restrict__ TW, int tid) {
#pragma unroll 1
  for (int s = 12; s >= 0; s--) {
    const int half = 4096 >> s, sh = 12 - s;
#pragma unroll 4
    for (int jj = 0; jj < 16; jj++) {
      int j = tid + jj * 256;
      int g = j >> sh, pos = j & (half - 1);
      int i0 = (g << (sh + 1)) + pos, i1 = i0 + half;
      float2 w = TW[(pos << s) << 1];
      float2 a = X[i0], b = X[i1];
      float bx = b.x * w.x + b.y * w.y, by = b.y * w.x - b.x * w.y;
      X[i0] = make_float2(a.x + bx, a.y + by);
      X[i1] = make_float2(a.x - bx, a.y - by);
    }
    __syncthreads();
  }
}

DI void filt_fft_item(const Params& p, int l, int o, int c, char* smem) {
  float2* X = (float2*)smem;
  float* Xf = (float*)smem;
  float* w3s = (float*)(smem + 65536);
  float* red = w3s + 128;
  const float2* TW = (const float2*)(p.ws + OFF_TW);
  const float* H2 = (const float*)(p.ws + OFF_H2F);
  float2* KS = (float2*)(p.ws + OFF_KSPEC) + (size_t)(o * 256 + c) * 2 * 8192;
  int tid_o = tidx();
  asm volatile("" : "+v"(tid_o));
  const int tid = tid_o;
  if (tid < 128) { int j = tid & 63, side = tid >> 6; w3s[tid] = p.in[I_HW3][((size_t)l * 64 + j) * 1024 + side * 512 + o * 256 + c]; }
  __syncthreads();
  const float min_decay = -3.0701134573253944f, max_decay = -15.350567286626972f;
  const float delta = fabsf(min_decay + (float)c * ((max_decay - min_decay) / 255.f));
  float* Ff = Xf;
  float* Fb = Xf + 8192;
#pragma unroll 1
  for (int i = 0; i < 32; i++) {
    int n = tid + 256 * i;
    const float4* hp = (const float4*)(H2 + (size_t)n * 64);
    float f = 0.f, bsum = 0.f;
#pragma unroll
    for (int q = 0; q < 16; q++) {
      float4 hv = hp[q];
      f += hv.x * w3s[q * 4] + hv.y * w3s[q * 4 + 1] + hv.z * w3s[q * 4 + 2] + hv.w * w3s[q * 4 + 3];
      bsum += hv.x * w3s[64 + q * 4] + hv.y * w3s[64 + q * 4 + 1] + hv.z * w3s[64 + q * 4 + 2] + hv.w * w3s[64 + q * 4 + 3];
    }
    float win = expf(-((float)n / 8191.f) * delta);
    Ff[n] = f * win; Fb[n] = bsum * win;
  }
  __syncthreads();
  float part = 0.f;
#pragma unroll 2
  for (int i = 0; i < 32; i++) {
    int n = tid + 256 * i;
    float k1 = Ff[n], k2 = 0.f;
    if (n == 0) k1 += Fb[0]; else k2 = Fb[8192 - n];
    part += fabsf(k1) + fabsf(k2);
    KS[8192 + n] = make_float2(k1, k2);
  }
  part = wave_sum(part);
  if ((tid & 63) == 0) red[tid >> 6] = part;
  __syncthreads();
  const float inv = 1.f / (red[0] + red[1] + red[2] + red[3]);
#pragma unroll 2
  for (int i = 0; i < 32; i++) { int n = tid + 256 * i; float2 kp = KS[8192 + n]; X[n] = make_float2((kp.x + kp.y) * inv, 0.f); }
  __syncthreads();
  fft_dif(X, TW, tid);
#pragma unroll 2
  for (int i = 0; i < 32; i++) { int n = tid + 256 * i; KS[n] = X[n]; }
  __syncthreads();
#pragma unroll 2
  for (int i = 0; i < 32; i++) { int n = tid + 256 * i; float2 w = TW[n]; float2 kp = KS[8192 + n]; float d = (kp.x - kp.y) * inv; X[n] = make_float2(d * w.x, d * w.y); }
  __syncthreads();
  fft_dif(X, TW, tid);
#pragma unroll 2
  for (int i = 0; i < 32; i++) { int n = tid + 256 * i; KS[8192 + n] = X[n]; }
  __syncthreads();
}

DI void filt_ctx_item(const Params& p, int l, int o, int c, char* smem) {
  float* red = (float*)smem;
  const float* H2 = (const float*)(p.ws + OFF_H2C);
  float* KC = (float*)(p.ws + OFF_KC) + (size_t)(o * 256 + c) * 512;
  int tid_o = tidx();
  asm volatile("" : "+v"(tid_o));
  const int n = tid_o;
  const float min_decay = -3.0701134573253944f, max_decay = -15.350567286626972f;
  const float delta = fabsf(min_decay + (float)c * ((max_decay - min_decay) / 255.f));
  float f = 0.f, bsum = 0.f;
  for (int j = 0; j < 64; j++) {
    float hv = H2[n * 64 + j];
    f += hv * p.in[I_HW3][((size_t)l * 64 + j) * 1024 + o * 256 + c];
    bsum += hv * p.in[I_HW3][((size_t)l * 64 + j) * 1024 + 512 + o * 256 + c];
  }
  float win = expf(-((float)n / 255.f) * delta);
  f *= win; bsum *= win;
  float part = n == 0 ? fabsf(f + bsum) : fabsf(f) + fabsf(bsum);
  part = wave_sum(part);
  __syncthreads();
  if ((n & 63) == 0) red[n >> 6] = part;
  __syncthreads();
  float inv = 1.f / (red[0] + red[1] + red[2] + red[3]);
  if (n == 0) { KC[256] = (f + bsum) * inv; KC[0] = 0.f; }
  else { KC[256 + n] = f * inv; KC[256 - n] = bsum * inv; }
  __syncthreads();
}

DI void phase_p3(const Params& p, int l, char* smem) {
  const int lane = tidx() & 63, r = lane & 31, h = lane >> 5;
  const int n_uq = (l == 0 ? 132 : 128) * 6, n_ukv = 132 * 8, n_r1 = 16 * NCH, n_ff = 512, n_fc = (l == 0 ? 512 : 0);
  const int total = n_uq + n_ukv + n_r1 + n_ff + n_fc;
  const char* wl = p.ws + OFF_W + (size_t)l * WL_SIZE;
  u16* Q = (u16*)(p.ws + OFF_Q);
  u16* KF = (u16*)(p.ws + OFF_KF);
  u16* VT = (u16*)(p.ws + OFF_VT);
  for (int it = blockIdx.x; it < total; it += gridDim.x) {
    int q = it;
    if (q < n_uq) {
      int mt = q / 6, nt = q - mt * 6;
      if (SUB_ON(0)) gemm_tile<true, false, false>((const u16*)(p.ws + OFF_CQ), 256, (const u16*)(wl + WL_WUQ), 256, 256, mt * 256, nt * 128, nullptr, 0, smem,
        [&](int bm, int bn, const f32x16& acc, const float* rs) __attribute__((always_inline)) {
          int col = bn + r;
          int j = col % 96;
          const float qscale = 0.10206207261596577f * 1.4426950408889634f;
#pragma unroll
          for (int reg = 0; reg < 16; reg++) {
            int row = bm + crow(reg, h);
            float v = acc[reg] * rs[row - mt * 256];
            if (j >= 64) {
              int b, t, key, cond;
              row_info(row, b, t, key, cond);
              float vr = rope_apply((const float2*)(p.ws + OFF_ROPE), v, r, t);
              if (row < TLAT) v = vr;
            }
            Q[(size_t)row * 768 + col] = f2bf(v * qscale);
          }
        });
    } else if ((q -= n_uq) < n_ukv) {
      int mt = q >> 3, nt = q & 7;
      if (nt < 4) {
        if (SUB_ON(1)) gemm_tile<true, false, false>((const u16*)(p.ws + OFF_CKV), 128, (const u16*)(wl + WL_WUKV), 128, 128, mt * 256, nt * 128, nullptr, 0, smem,
          [&](int bm, int bn, const f32x16& acc, const float* rs) __attribute__((always_inline)) {
            int hd = bn >> 6, j = (bn & 63) + r;
#pragma unroll
            for (int reg = 0; reg < 16; reg++) {
              int row = bm + crow(reg, h), b, t, key, cond;
              row_info(row, b, t, key, cond);
              KF[((size_t)(b * 8 + hd) * LKEY + key) * 96 + j] = f2bf(acc[reg] * rs[row - mt * 256]);
            }
          });
      } else {
        if (SUB_ON(1)) gemm_tile<true, true, true>((const u16*)(p.ws + OFF_CKV), 128, (const u16*)(wl + WL_WUKV), 128, 128, mt * 256, nt * 128, nullptr, 0, smem,
          [&](int bm, int bn, const f32x16& acc, const float* rs) __attribute__((always_inline)) {
            int row = bm + r, b, t, key, cond;
            row_info(row, b, t, key, cond);
            float rr = rs[row - mt * 256];
            int hd = (bn - 512) >> 6, e0 = (bn - 512) & 63;
            u16* dstp = VT + ((size_t)(b * 8 + hd) * 64 + e0) * LKEY + key;
#pragma unroll
            for (int reg = 0; reg < 16; reg++) dstp[(size_t)crow(reg, h) * LKEY] = f2bf(acc[reg] * rr);
          });
      }
    } else if ((q -= n_ukv) < n_r1) {
      int bh = q / NCH, ci = q - bh * NCH;
      if (SUB_ON(2)) ret_kv_item(p, l, bh >> 2, bh & 3, ci, smem);
    } else if ((q -= n_r1) < n_ff) {
      if (SUB_ON(3)) filt_fft_item(p, l, q >> 8, q & 255, smem);
    } else {
      q -= n_ff;
      if (SUB_ON(4)) filt_ctx_item(p, l, q >> 8, q & 255, smem);
    }
  }
}

DI void phase_scan(const Params& p, int l) {
  float* ST = (float*)(p.ws + OFF_ST);
  for (int idx = blockIdx.x * 256 + tidx(); idx < 2 * 16 * 4096; idx += gridDim.x * 256) {
    int dir = idx >> 16, bh = (idx >> 12) & 15, el = idx & 4095, hh = bh & 3;
    float* base = ST + (size_t)((dir * 16 + bh) * NCH) * 4096 + el;
    float lg = log1pf(-expf(p.in[I_RLD][l * 8 + dir * 4 + hh]));
    float gC = expf(lg * 128.f);
    float s = 0.f;
    if (dir == 0) {
      for (int ci = 0; ci < NCH; ci++) { float tmp = base[(size_t)ci * 4096]; base[(size_t)ci * 4096] = s; s = gC * s + tmp; }
    } else {
      for (int ci = 1; ci >= 0; ci--) { float tmp = base[(size_t)ci * 4096]; base[(size_t)ci * 4096] = s; s = gC * s + tmp; }
      for (int ci = NCH - 1; ci >= 2; ci--) { float tmp = base[(size_t)ci * 4096]; base[(size_t)ci * 4096] = s; s = gC * s + tmp; }
    }
  }
}

DI void attn_item(const Params& p, int b, int hh, int qrow0, int key0, int nkeys, char* smem) {
  u16* Ks = (u16*)smem;
  u16* Vs = Ks + 64 * 104;
  const u16* Q = (const u16*)(p.ws + OFF_Q);
  const u16* KF = (const u16*)(p.ws + OFF_KF);
  const u16* VT = (const u16*)(p.ws + OFF_VT);
  u16* MIX = (u16*)(p.ws + OFF_H);
  int tid_o = tidx();
  asm volatile("" : "+v"(tid_o));
  const int tid = tid_o, lane = tid & 63, wid = tid >> 6, r = lane & 31, h = lane >> 5;
  const int qrow = qrow0 + wid * 32 + r;
  bf16x8 qf[6];
#pragma unroll
  for (int ks = 0; ks < 6; ks++) qf[ks] = *(const bf16x8*)(Q + (size_t)qrow * 768 + hh * 96 + ks * 16 + h * 8);
  f32x16 o0, o1;
#pragma unroll
  for (int e = 0; e < 16; e++) { o0[e] = 0.f; o1[e] = 0.f; }
  float m = -1e30f, lsum = 0.f;
  const u32x4* kbase = (const u32x4*)(KF + ((size_t)(b * 8 + hh) * LKEY + key0) * 96);
  const u16* vbase = VT + (size_t)(b * 8 + hh) * 64 * LKEY + key0;
  u32x4 rk[3], rv[2];
  const int nt = nkeys >> 6;
#define ATT_GLOAD(T)                                                                                                        \
  {                                                                                                                         \
    const int t_ = (T);                                                                                                     \
    _Pragma("unroll") for (int i = 0; i < 3; i++) rk[i] = kbase[(size_t)t_ * 768 + tid + 256 * i];                          \
    _Pragma("unroll") for (int i = 0; i < 2; i++) { int id = tid + 256 * i; rv[i] = *(const u32x4*)(vbase + (size_t)(id >> 3) * LKEY + t_ * 64 + (id & 7) * 8); } \
  }
  ATT_GLOAD(0)
  for (int t = 0; t < nt; t++) {
    __syncthreads();
#pragma unroll
    for (int i = 0; i < 3; i++) { int id = tid + 256 * i; int kr = id / 12, c = id - kr * 12; *(u32x4*)(Ks + kr * 104 + c * 8) = rk[i]; }
#pragma unroll
    for (int i = 0; i < 2; i++) { int id = tid + 256 * i; *(u32x4*)(Vs + (id >> 3) * 72 + (id & 7) * 8) = rv[i]; }
    __syncthreads();
    if (t + 1 < nt) ATT_GLOAD(t + 1)
    f32x16 s0, s1;
#pragma unroll
    for (int e = 0; e < 16; e++) { s0[e] = 0.f; s1[e] = 0.f; }
#pragma unroll
    for (int ks = 0; ks < 6; ks++) {
      bf16x8 k0 = *(const bf16x8*)(Ks + (r) * 104 + ks * 16 + h * 8);
      bf16x8 k1 = *(const bf16x8*)(Ks + (32 + r) * 104 + ks * 16 + h * 8);
      s0 = MFMA32(k0, qf[ks], s0);
      s1 = MFMA32(k1, qf[ks], s1);
    }
    float mx = s0[0];
#pragma unroll
    for (int e = 0; e < 16; e++) { mx = fmaxf(mx, s0[e]); mx = fmaxf(mx, s1[e]); }
    mx = fmaxf(mx, __shfl_xor(mx, 32));
    float mnew = fmaxf(m, mx);
    float alpha = __builtin_amdgcn_exp2f(m - mnew);
    float ps = 0.f;
#pragma unroll
    for (int e = 0; e < 16; e++) {
      s0[e] = __builtin_amdgcn_exp2f(s0[e] - mnew); ps += s0[e];
      s1[e] = __builtin_amdgcn_exp2f(s1[e] - mnew); ps += s1[e];
    }
    ps += __shfl_xor(ps, 32);
    lsum = lsum * alpha + ps;
    m = mnew;
#pragma unroll
    for (int e = 0; e < 16; e++) { o0[e] *= alpha; o1[e] *= alpha; }
#pragma unroll
    for (int kt2 = 0; kt2 < 2; kt2++) {
#pragma unroll
      for (int sx = 0; sx < 2; sx++) {
        u32x4 pw;
        if (kt2 == 0) {
          pw.x = pack2(s0[8 * sx + 0], s0[8 * sx + 1]); pw.y = pack2(s0[8 * sx + 2], s0[8 * sx + 3]);
          pw.z = pack2(s0[8 * sx + 4], s0[8 * sx + 5]); pw.w = pack2(s0[8 * sx + 6], s0[8 * sx + 7]);
        } else {
          pw.x = pack2(s1[8 * sx + 0], s1[8 * sx + 1]); pw.y = pack2(s1[8 * sx + 2], s1[8 * sx + 3]);
          pw.z = pack2(s1[8 * sx + 4], s1[8 * sx + 5]); pw.w = pack2(s1[8 * sx + 6], s1[8 * sx + 7]);
        }
        bf16x8 pb = __builtin_bit_cast(bf16x8, pw);
        int kb = kt2 * 32 + 16 * sx + 4 * h;
        {
          const u16* vp = Vs + (r) * 72 + kb;
          uint2 lo = *(const uint2*)vp, hi = *(const uint2*)(vp + 8);
          u32x4 vw = {lo.x, lo.y, hi.x, hi.y};
          o0 = MFMA32(__builtin_bit_cast(bf16x8, vw), pb, o0);
        }
        {
          const u16* vp = Vs + (32 + r) * 72 + kb;
          uint2 lo = *(const uint2*)vp, hi = *(const uint2*)(vp + 8);
          u32x4 vw = {lo.x, lo.y, hi.x, hi.y};
          o1 = MFMA32(__builtin_bit_cast(bf16x8, vw), pb, o1);
        }
      }
    }
  }
  const float inv = 1.f / lsum;
  u16* dst = MIX + (size_t)qrow * 1024 + 512 + hh * 64;
#pragma unroll
  for (int g = 0; g < 4; g++) {
    int e = 8 * g + 4 * h;
    *(uint2*)(dst + e) = make_uint2(pack2(o0[4 * g] * inv, o0[4 * g + 1] * inv), pack2(o0[4 * g + 2] * inv, o0[4 * g + 3] * inv));
    *(uint2*)(dst + 32 + e) = make_uint2(pack2(o1[4 * g] * inv, o1[4 * g + 1] * inv), pack2(o1[4 * g + 2] * inv, o1[4 * g + 3] * inv));
  }
  __syncthreads();
}

DI void ret_out_item(const Params& p, int l, int b, int hh, int ci, char* smem) {
  const u16* RET = (const u16*)(p.ws + OFF_RET);
  const float* ST = (const float*)(p.ws + OFF_ST);
  u16* MIX = (u16*)(p.ws + OFF_H);
  u16* Qs = (u16*)smem;
  u16* Ks = Qs + 128 * 72;
  u16* Ps = Qs;
  u16* VsT = Ks + 128 * 72;
  u16* SfT = VsT + 64 * 136;
  u16* SbT = SfT + 64 * 72;
  float* dmk = (float*)(SbT + 64 * 72);
  int tid_o = tidx();
  asm volatile("" : "+v"(tid_o));
  const int tid = tid_o, lane = tid & 63, wid = tid >> 6, r = lane & 31, h = lane >> 5;
  float lgf, lgb;
  ret_gammas(p, l, hh, lgf, lgb);
  const int row0 = chunk_row0(b, ci);
  { int d = tid - 128; dmk[tid] = d > 0 ? __expf(lgf * (float)d) : (d < 0 ? __expf(lgb * (float)(-d)) : 2.f); }
#pragma unroll 1
  for (int i = 0; i < 4; i++) {
    int id = tid + 256 * i, m = id >> 3, dc = id & 7;
    const u16* rp = RET + (size_t)(row0 + m) * 1024 + hh * 64 + dc * 8;
    *(uint4*)(Qs + m * 72 + dc * 8) = *(const uint4*)(rp);
    *(uint4*)(Ks + m * 72 + dc * 8) = *(const uint4*)(rp + 256);
    u32x4 vv = *(const u32x4*)(rp + 512);
#pragma unroll
    for (int j = 0; j < 8; j++) VsT[(dc * 8 + j) * 136 + m] = bfu(vv, j);
  }
  const float* Sf = ST + ((size_t)((0 * 4 + b) * 4 + hh) * NCH + ci) * 4096;
  const float* Sb = ST + ((size_t)((1 * 4 + b) * 4 + hh) * NCH + ci) * 4096;
#pragma unroll 2
  for (int i = 0; i < 16; i++) {
    int id = tid + 256 * i, d = id >> 6, e = id & 63;
    SfT[e * 72 + d] = f2bf(Sf[id]);
    SbT[e * 72 + d] = f2bf(Sb[id]);
  }
  __syncthreads();
  const int cw = wid * 32;
  f32x16 in0, in1, sc[4];
  {
    f32x16 cf0, cf1, cb0, cb1;
#pragma unroll
    for (int e = 0; e < 16; e++) { cf0[e] = cf1[e] = cb0[e] = cb1[e] = 0.f; }
#pragma unroll
    for (int ks = 0; ks < 4; ks++) {
      bf16x8 qa = *(const bf16x8*)(Qs + (cw + r) * 72 + ks * 16 + h * 8);
      cf0 = MFMA32(qa, *(const bf16x8*)(SfT + (r) * 72 + ks * 16 + h * 8), cf0);
      cf1 = MFMA32(qa, *(const bf16x8*)(SfT + (32 + r) * 72 + ks * 16 + h * 8), cf1);
      cb0 = MFMA32(qa, *(const bf16x8*)(SbT + (r) * 72 + ks * 16 + h * 8), cb0);
      cb1 = MFMA32(qa, *(const bf16x8*)(SbT + (32 + r) * 72 + ks * 16 + h * 8), cb1);
    }
#pragma unroll
    for (int reg = 0; reg < 16; reg++) {
      int c = cw + crow(reg, h);
      float xf = __expf(lgf * (float)(c + 1)), xb = __expf(lgb * (float)(128 - c));
      in0[reg] = xf * cf0[reg] + xb * cb0[reg];
      in1[reg] = xf * cf1[reg] + xb * cb1[reg];
    }
  }
#pragma unroll
  for (int e = 0; e < 16; e++) { sc[0][e] = sc[1][e] = sc[2][e] = sc[3][e] = 0.f; }
#pragma unroll
  for (int ks = 0; ks < 4; ks++) {
    bf16x8 qa = *(const bf16x8*)(Qs + (cw + r) * 72 + ks * 16 + h * 8);
#pragma unroll
    for (int mt = 0; mt < 4; mt++) sc[mt] = MFMA32(qa, *(const bf16x8*)(Ks + (mt * 32 + r) * 72 + ks * 16 + h * 8), sc[mt]);
  }
  __syncthreads();
#pragma unroll
  for (int mt = 0; mt < 4; mt++)
#pragma unroll
    for (int reg = 0; reg < 16; reg++) {
      int c = cw + crow(reg, h), mm = mt * 32 + r;
      Ps[c * 136 + mm] = f2bf(sc[mt][reg] * dmk[c - mm + 128]);
      if ((reg & 3) == 3) __builtin_amdgcn_sched_barrier(0);
    }
  __syncthreads();
#pragma unroll
  for (int ks = 0; ks < 8; ks++) {
    bf16x8 pa = *(const bf16x8*)(Ps + (cw + r) * 136 + ks * 16 + h * 8);
    in0 = MFMA32(pa, *(const bf16x8*)(VsT + (r) * 136 + ks * 16 + h * 8), in0);
    in1 = MFMA32(pa, *(const bf16x8*)(VsT + (32 + r) * 136 + ks * 16 + h * 8), in1);
  }
#pragma unroll
  for (int reg = 0; reg < 16; reg++) {
    int c = cw + crow(reg, h);
    float oa = in0[reg], ob = in1[reg];
    float ss = oa * oa + ob * ob;
    ss += __shfl_xor(ss, 1); ss += __shfl_xor(ss, 2); ss += __shfl_xor(ss, 4); ss += __shfl_xor(ss, 8); ss += __shfl_xor(ss, 16);
    float rstd = rsqrtf(ss * (1.f / 64.f) + 1e-6f);
    int rowi = row0 + c;
    asm volatile("" : "+v"(rowi));
    size_t row = (size_t)rowi;
    float g0 = bf2f(RET[row * 1024 + 768 + hh * 64 + r]), g1 = bf2f(RET[row * 1024 + 768 + hh * 64 + 32 + r]);
    MIX[row * 1024 + 256 + hh * 64 + r] = f2bf(silu_f(g0) * oa * rstd);
    MIX[row * 1024 + 256 + hh * 64 + 32 + r] = f2bf(silu_f(g1) * ob * rstd);
    __builtin_amdgcn_sched_barrier(0);
  }
  __syncthreads();
}

typedef _Float16 h2_t __attribute__((ext_vector_type(2)));
DI unsigned packh(float a, float b) { h2_t v; v[0] = (_Float16)a; v[1] = (_Float16)b; return __builtin_bit_cast(unsigned, v); }
template <class ZF, class CF>
DI void hy_conv(float2* X, const float2* __restrict__ TW, const float2* __restrict__ Ke, const float2* __restrict__ Ko,
                ZF zf, CF consume, int tid) {
  const float scl = 0.5f / 8192.f;
#pragma unroll 2
  for (int i = 0; i < 32; i++) { int n = tid + 256 * i; X[n] = zf(n); }
  __syncthreads();
  fft_dif(X, TW, tid);
#pragma unroll 2
  for (int i = 0; i < 32; i++) { int k = tid + 256 * i; float2 a = X[k], w = Ke[k]; X[k] = make_float2(a.x * w.x - a.y * w.y, a.x * w.y + a.y * w.x); }
  __syncthreads();
  fft_dit(X, TW, tid);
  unsigned ye[32];
#pragma unroll
  for (int i = 0; i < 32; i++) { int n = tid + 256 * i; asm volatile("" : "+v"(n)); float2 e = X[n]; ye[i] = packh(e.x * scl, e.y * scl); if ((i & 1) == 1) __builtin_amdgcn_sched_barrier(0); }
  __syncthreads();
#pragma unroll 2
  for (int i = 0; i < 32; i++) { int n = tid + 256 * i; float2 z = zf(n), w = TW[n]; X[n] = make_float2(z.x * w.x - z.y * w.y, z.x * w.y + z.y * w.x); }
  __syncthreads();
  fft_dif(X, TW, tid);
#pragma unroll 2
  for (int i = 0; i < 32; i++) { int k = tid + 256 * i; float2 a = X[k], w = Ko[k]; X[k] = make_float2(a.x * w.x - a.y * w.y, a.x * w.y + a.y * w.x); }
  __syncthreads();
  fft_dit(X, TW, tid);
#pragma unroll
  for (int i = 0; i < 32; i++) {
    int n = tid + 256 * i;
    asm volatile("" : "+v"(n));
    float2 o = X[n], w = TW[n];
    float tx = o.x * w.x + o.y * w.y, ty = o.y * w.x - o.x * w.y;
    h2_t e = __builtin_bit_cast(h2_t, ye[i]);
    consume(n, (float)e[0] + tx * scl, (float)e[1] + ty * scl);
    __builtin_amdgcn_sched_barrier(0);
  }
  __syncthreads();
}

DI float sconv_at(const u16* __restrict__ u, int n, int Ls, float w0, float w1, float w2, float bias) {
  float um = n > 0 ? bf2f(u[n - 1]) : 0.f, uc = bf2f(u[n]), up = n < Ls - 1 ? bf2f(u[n + 1]) : 0.f;
  return bias + w0 * um + w1 * uc + w2 * up;
}

DI void hyena_item(const Params& p, int l, int c, int pair, char* smem) {
  float2* X = (float2*)smem;
  const float2* TW = (const float2*)(p.ws + OFF_TW);
  const float2* KS = (const float2*)(p.ws + OFF_KSPEC);
  const u16* UT = (const u16*)(p.ws + OFF_UT);
  u16* YT = (u16*)(p.ws + OFF_CQ);
  int tid_o = tidx();
  asm volatile("" : "+v"(tid_o));
  const int tid = tid_o;
  const float* cw = p.in[I_HCW] + l * 3 * 768;
  const float* cb = p.in[I_HCB] + l * 768;
  const int b0 = 2 * pair, b1 = b0 + 1;
  u16* y0 = YT + (size_t)(b0 * 256 + c) * SEQ;
  u16* y1 = YT + (size_t)(b1 * 256 + c) * SEQ;
  const float vw0 = cw[512 + c], vw1 = cw[768 + 512 + c], vw2 = cw[1536 + 512 + c], vbs = cb[512 + c];
  const u16* v0p = UT + (size_t)(b0 * 768 + 512 + c) * SEQ;
  const u16* v1p = UT + (size_t)(b1 * 768 + 512 + c) * SEQ;
  {
    const float w0 = cw[c], w1 = cw[768 + c], w2 = cw[1536 + c], bs = cb[c];
    const float bias0 = p.in[I_HBIAS][(l * 2 + 0) * 256 + c];
    const u16* u0 = UT + (size_t)(b0 * 768 + c) * SEQ;
    const u16* u1 = UT + (size_t)(b1 * 768 + c) * SEQ;
    hy_conv(X, TW, KS + (size_t)(0 * 256 + c) * 2 * 8192, KS + (size_t)(0 * 256 + c) * 2 * 8192 + 8192,
            [&](int n) __attribute__((always_inline)) { return make_float2(sconv_at(v0p, n, SEQ, vw0, vw1, vw2, vbs), sconv_at(v1p, n, SEQ, vw0, vw1, vw2, vbs)); },
            [&](int n, float ya, float yb) __attribute__((always_inline)) {
              float va = sconv_at(v0p, n, SEQ, vw0, vw1, vw2, vbs), vb = sconv_at(v1p, n, SEQ, vw0, vw1, vw2, vbs);
              y0[n] = f2bf(sconv_at(u0, n, SEQ, w0, w1, w2, bs) * (ya + va * bias0));
              y1[n] = f2bf(sconv_at(u1, n, SEQ, w0, w1, w2, bs) * (yb + vb * bias0));
            }, tid);
  }
  {
    const int col = 256 + c;
    const float w0 = cw[col], w1 = cw[768 + col], w2 = cw[1536 + col], bs = cb[col];
    const float bias1 = p.in[I_HBIAS][(l * 2 + 1) * 256 + c];
    const u16* u0 = UT + (size_t)(b0 * 768 + col) * SEQ;
    const u16* u1 = UT + (size_t)(b1 * 768 + col) * SEQ;
    hy_conv(X, TW, KS + (size_t)(1 * 256 + c) * 2 * 8192, KS + (size_t)(1 * 256 + c) * 2 * 8192 + 8192,
            [&](int n) __attribute__((always_inline)) { return make_float2(bf2f(y0[n]), bf2f(y1[n])); },
            [&](int n, float ya, float yb) __attribute__((always_inline)) {
              float za = bf2f(y0[n]), zb = bf2f(y1[n]);
              y0[n] = f2bf(sconv_at(u0, n, SEQ, w0, w1, w2, bs) * (ya + za * bias1));
              y1[n] = f2bf(sconv_at(u1, n, SEQ, w0, w1, w2, bs) * (yb + zb * bias1));
            }, tid);
  }
}

DI void hyena_ctx_item(const Params& p, int l, int b, int c, char* smem) {
  float* k0s = (float*)smem;
  float* k1s = k0s + 512;
  float* vs = k1s + 512;
  float* zs = vs + 256;
  const float* KC = (const float*)(p.ws + OFF_KC);
  const u16* UTC = (const u16*)(p.ws + OFF_UTC);
  u16* MIX = (u16*)(p.ws + OFF_H);
  int tid_o = tidx();
  asm volatile("" : "+v"(tid_o));
  const int n = tid_o;
  const float* cw = p.in[I_HCW] + l * 3 * 768;
  const float* cb = p.in[I_HCB] + l * 768;
  k0s[n] = KC[(size_t)(0 * 256 + c) * 512 + n]; k0s[256 + n] = KC[(size_t)(0 * 256 + c) * 512 + 256 + n];
  k1s[n] = KC[(size_t)(1 * 256 + c) * 512 + n]; k1s[256 + n] = KC[(size_t)(1 * 256 + c) * 512 + 256 + n];
  float v = sconv_at(UTC + (size_t)(b * 768 + 512 + c) * LCTX, n, LCTX, cw[512 + c], cw[768 + 512 + c], cw[1536 + 512 + c], cb[512 + c]);
  float x1 = sconv_at(UTC + (size_t)(b * 768 + c) * LCTX, n, LCTX, cw[c], cw[768 + c], cw[1536 + c], cb[c]);
  float x2 = sconv_at(UTC + (size_t)(b * 768 + 256 + c) * LCTX, n, LCTX, cw[256 + c], cw[768 + 256 + c], cw[1536 + 256 + c], cb[256 + c]);
  vs[n] = v;
  __syncthreads();
  float a = 0.f;
  for (int s = 0; s < 256; s++) a += k0s[n - s + 256] * vs[s];
  float z = x1 * (a + v * p.in[I_HBIAS][(l * 2 + 0) * 256 + c]);
  zs[n] = z;
  __syncthreads();
  float a2 = 0.f;
  for (int s = 0; s < 256; s++) a2 += k1s[n - s + 256] * zs[s];
  float y = x2 * (a2 + z * p.in[I_HBIAS][(l * 2 + 1) * 256 + c]);
  MIX[(size_t)(TLAT + b * LCTX + n) * 1024 + c] = f2bf(y);
  __syncthreads();
}

DI void phase_p4(const Params& p, int l, char* smem) {
  const int n_al = 2048, n_ac = (l == 0 ? 64 : 0), n_hy = 512, n_r3 = (l == 0 ? 16 * NCH : 16 * 64), n_hc = (l == 0 ? 1024 : 0);
  const int total = n_al + n_ac + n_hy + n_r3 + n_hc;
  for (int it = blockIdx.x; it < total; it += gridDim.x) {
    int q = it;
    if (q < n_al) {
      int b = q >> 9, hh = (q >> 6) & 7, qb = q & 63;
      if (SUB_ON(0)) attn_item(p, b, hh, b * SEQ + qb * 128, 0, LKEY, smem);
    } else if ((q -= n_al) < n_ac) {
      int b = q >> 4, hh = (q >> 1) & 7, qb = q & 1;
      if (SUB_ON(0)) attn_item(p, b, hh, TLAT + b * LCTX + qb * 128, SEQ, LCTX, smem);
    } else if ((q -= n_ac) < n_hy) {
      if (SUB_ON(1)) hyena_item(p, l, q >> 1, q & 1, smem);
    } else if ((q -= n_hy) < n_r3) {
      int bh, ci;
      if (l == 0) { bh = q / NCH; ci = q - bh * NCH; } else { bh = q >> 6; ci = 2 + (q & 63); }
      if (SUB_ON(2)) ret_out_item(p, l, bh >> 2, bh & 3, ci, smem);
    } else {
      q -= n_r3;
      if (SUB_ON(3)) hyena_ctx_item(p, l, q >> 8, q & 255, smem);
    }
  }
}

DI void phase_res_gemm(const Params& p, int l, int which  , char* smem) {
  const int lane = tidx() & 63, r = lane & 31, h = lane >> 5;
  const int nmt = (l == 0 ? 132 : 128);
  const char* wl = p.ws + OFF_W + (size_t)l * WL_SIZE;
  const u16* A = (const u16*)(p.ws + (which == 1 ? OFF_H : OFF_ACT));
  const int K = which == 1 ? 1024 : 4096;
  const u16* Bt = (const u16*)(wl + (which == 1 ? WL_WOUT : WL_W2));
  const bool first = (l == 0 && which == 1);
  const float* mod = (const float*)(p.ws + OFF_MOD);
  float* XC = (float*)(p.ws + OFF_XC);
  const int total = nmt * 8;
  for (int it = blockIdx.x; it < total; it += gridDim.x) {
    int mt = it >> 3, nt = it & 7;
    int m0 = mt * 256;
    const u16* at = nullptr;
    if (which == 1 && m0 < TLAT) at = (const u16*)(p.ws + OFF_CQ) + (size_t)((m0 >> 13) * 256) * SEQ + (m0 & 8191);
    int cond = m0 < TLAT ? (m0 >> 13) : 4;
    const float* ga = mod + (size_t)(l * 5 + cond) * 6144 + (which == 1 ? 2048 : 5120);
    const float* src; float* dst;
    if (m0 < TLAT) { src = first ? p.in[I_X] : p.out; dst = p.out; }
    else { src = (first ? p.in[I_CTX] : XC) - (size_t)TLAT * 1024; dst = XC - (size_t)TLAT * 1024; }
    gemm_tile<false, false, false>(A, K, Bt, K, K, m0, nt * 128, at, 8, smem,
      [&](int bm, int bn, const f32x16& acc, const float*) __attribute__((always_inline)) {
        int col = bn + r;
        float g = ga[col];
#pragma unroll
        for (int reg = 0; reg < 16; reg++) {
          size_t idx = (size_t)(bm + crow(reg, h)) * 1024 + col;
          dst[idx] = src[idx] + g * acc[reg];
        }
      });
  }
}

DI void phase_mlp1(const Params& p, int l, char* smem) {
  const int lane = tidx() & 63, r = lane & 31, h = lane >> 5;
  const int nmt = (l == 0 ? 132 : 128);
  const u16* A = (const u16*)(p.ws + OFF_H);
  const u16* Bt = (const u16*)(p.ws + OFF_W + (size_t)l * WL_SIZE + WL_W1);
  u16* ACT = (u16*)(p.ws + OFF_ACT);
  const int total = nmt * 32;
  for (int it = blockIdx.x; it < total; it += gridDim.x) {
    int mt = it >> 5, nt = it & 31;
    gemm_tile<false, false, false>(A, 1024, Bt, 1024, 1024, mt * 256, nt * 128, nullptr, 0, smem,
      [&](int bm, int bn, const f32x16& acc, const float*) __attribute__((always_inline)) {
        int col = bn + r;
#pragma unroll
        for (int reg = 0; reg < 16; reg++) {
          float v = fmaxf(acc[reg], 0.f);
          ACT[(size_t)(bm + crow(reg, h)) * 4096 + col] = f2bf(v * v);
        }
      });
  }
}

DI void phase_final(const Params& p) {
  const int lane = tidx() & 63, wid = tidx() >> 6;
  const float* g = p.in[I_FNG];
  for (int it = blockIdx.x; it < TLAT / 4; it += gridDim.x) {
    float* row = p.out + (size_t)(it * 4 + wid) * 1024;
    float4 v[4];
    float ssq = 0.f;
#pragma unroll
    for (int i = 0; i < 4; i++) {
      v[i] = *(const float4*)(row + i * 256 + lane * 4);
      ssq += v[i].x * v[i].x + v[i].y * v[i].y + v[i].z * v[i].z + v[i].w * v[i].w;
    }
    ssq = wave_sum(ssq);
    float rstd = rsqrtf(ssq * (1.f / 1024.f) + 1e-6f);
#pragma unroll
    for (int i = 0; i < 4; i++) {
      float4 gg = *(const float4*)(g + i * 256 + lane * 4);
      *(float4*)(row + i * 256 + lane * 4) = make_float4(v[i].x * rstd * gg.x, v[i].y * rstd * gg.y, v[i].z * rstd * gg.z, v[i].w * rstd * gg.w);
    }
  }
}

constexpr int NPHASE = 20;
#ifndef ONLY_PHASE
#define ONLY_PHASE -1
#endif
#define PH_ON(k) (ONLY_PHASE < 0 || ONLY_PHASE == (k))
DI void run_phase(const Params& p, int ph, char* smem) {
  if (ph == 0) { if (PH_ON(0)) phase_s0(p, smem); return; }
  if (ph == NPHASE - 1) { if (PH_ON(8)) phase_final(p); return; }
  int l = (ph - 1) / 9, s = (ph - 1) % 9;
  switch (s) {
    case 0: if (PH_ON(1)) phase_norm(p, l, 1, TALL, true); break;
    case 1: if (PH_ON(2)) phase_win(p, l, smem); break;
    case 2: if (PH_ON(3)) phase_p3(p, l, smem); break;
    case 3: if (PH_ON(4)) phase_scan(p, l); break;
    case 4: if (PH_ON(5)) phase_p4(p, l, smem); break;
    case 5: if (PH_ON(6)) phase_res_gemm(p, l, 1, smem); break;
    case 6: if (PH_ON(1)) phase_norm(p, l, 2, l == 0 ? TALL : TLAT, false); break;
    case 7: if (PH_ON(7)) phase_mlp1(p, l, smem); break;
    default: if (PH_ON(6)) phase_res_gemm(p, l, 2, smem); break;
  }
}

#if !MULTI_LAUNCH
extern "C" __global__ void __launch_bounds__(256, 2) mk_all(Params p) {
  extern __shared__ __attribute__((aligned(16))) char smem[];
  cg::grid_group grid = cg::this_grid();
  for (int ph = 0; ph < NPHASE; ph++) {
    run_phase(p, ph, smem);
    if (ph + 1 < NPHASE) grid.sync();
  }
}
#define MK_KERNEL mk_all
#else
#define MK_KERNEL mk_phase
extern "C" __global__ void __launch_bounds__(256, 2) mk_phase(Params p, int ph) {
  extern __shared__ __attribute__((aligned(16))) char smem[];
  run_phase(p, ph, smem);
}
#endif

extern "C" void kernel_launch(void* const* d_in, const int* in_sizes, int n_in, void* d_out, int out_size, void* d_ws, size_t ws_size,
                              hipStream_t stream) {
  Params p{};
  for (int i = 0; i < 27; i++) p.in[i] = (const float*)d_in[i];
  p.out = (float*)d_out;
  p.ws = (char*)d_ws;
  static int grid_blocks = 0;
  if (!grid_blocks) {
    int dev = 0, cus = 0, per_cu = 0;
    (void)hipGetDevice(&dev);
    (void)hipDeviceGetAttribute(&cus, hipDeviceAttributeMultiprocessorCount, dev);
    (void)hipFuncSetAttribute((const void*)MK_KERNEL, hipFuncAttributeMaxDynamicSharedMemorySize, SMEM_BYTES);
    (void)hipOccupancyMaxActiveBlocksPerMultiprocessor(&per_cu, MK_KERNEL, 256, SMEM_BYTES);
    if (per_cu < 1) per_cu = 1;
    if (per_cu > 2) per_cu = 2;
    grid_blocks = cus * per_cu;
  }
#if MULTI_LAUNCH
  for (int ph = 0; ph < NPHASE; ph++) hipLaunchKernelGGL(mk_phase, dim3(grid_blocks), dim3(256), SMEM_BYTES, stream, p, ph);
#else
  void* args[] = {&p};
  (void)hipLaunchCooperativeKernel((void*)mk_all, dim3(grid_blocks), dim3(256), args, SMEM_BYTES, stream);
#endif
}
```

```cpp
#include <hip/hip_runtime.h>
#include <hip/hip_cooperative_groups.h>
namespace cg = cooperative_groups;

#ifndef MULTI_LAUNCH
#define MULTI_LAUNCH 0
#endif

#define DI __device__ __forceinline__
#define NI __device__ __noinline__
typedef unsigned short u16;
typedef short bf16x8 __attribute__((ext_vector_type(8)));
typedef float f32x16 __attribute__((ext_vector_type(16)));
typedef __bf16 bf2_t __attribute__((ext_vector_type(2)));
typedef unsigned u32x4 __attribute__((ext_vector_type(4)));
#define MFMA32(a, b, c) __builtin_amdgcn_mfma_f32_32x32x16_bf16((a), (b), (c), 0, 0, 0)

constexpr int NB = 4, SEQ = 8192, LCTX = 256, DM = 1024, DFF = 4096;
constexpr int TLAT = NB * SEQ;
constexpr int TALL = TLAT + NB * LCTX;
constexpr int NIN = 2208, NINP = 2304;
constexpr int LKEY = SEQ + LCTX;
constexpr int NCH = 66;
constexpr int SMEM_BYTES = 73728;
#ifndef SUBSEL
#define SUBSEL -1
#endif
#define SUB_ON(k) (SUBSEL < 0 || SUBSEL == (k))

constexpr size_t WL_WIN = 0;
constexpr size_t WL_WOUT = WL_WIN + (size_t)NINP * 1024 * 2;
constexpr size_t WL_W1 = WL_WOUT + (size_t)1024 * 1024 * 2;
constexpr size_t WL_W2 = WL_W1 + (size_t)4096 * 1024 * 2;
constexpr size_t WL_WUQ = WL_W2 + (size_t)1024 * 4096 * 2;
constexpr size_t WL_WUKV = WL_WUQ + (size_t)768 * 256 * 2;
constexpr size_t WL_SIZE = WL_WUKV + (size_t)1024 * 128 * 2;
constexpr size_t OFF_W = 0;
constexpr size_t OFF_MOD = OFF_W + 2 * WL_SIZE;
constexpr size_t OFF_TW = OFF_MOD + (size_t)2 * 5 * 6144 * 4;
constexpr size_t OFF_ROPE = OFF_TW + 65536;
constexpr size_t OFF_XC = OFF_ROPE + 192 * 8 * 8 + 4096;
constexpr size_t OFF_H = OFF_XC + (size_t)1024 * 1024 * 4;
constexpr size_t OFF_H2F = OFF_H + (size_t)TALL * 1024 * 2;
constexpr size_t OFF_H2C = OFF_H2F + (size_t)8192 * 64 * 4;
constexpr size_t OFF_KC = OFF_H2C + (size_t)256 * 64 * 4;
constexpr size_t OFF_BIG = OFF_KC + (size_t)2 * 256 * 512 * 4;
constexpr size_t OFF_UT = OFF_BIG;
constexpr size_t OFF_UTC = OFF_UT + (size_t)NB * 768 * SEQ * 2;
constexpr size_t OFF_RET = OFF_UTC + (size_t)NB * 768 * LCTX * 2;
constexpr size_t OFF_CQ = OFF_RET + (size_t)TALL * 1024 * 2;
constexpr size_t OFF_CKV = OFF_CQ + (size_t)TALL * 256 * 2;
constexpr size_t OFF_Q = OFF_CKV + (size_t)TALL * 128 * 2;
constexpr size_t OFF_KF = OFF_Q + (size_t)TALL * 768 * 2;
constexpr size_t OFF_VT = OFF_KF + (size_t)NB * 8 * LKEY * 96 * 2;
constexpr size_t OFF_ST = OFF_VT + (size_t)NB * 8 * 64 * LKEY * 2;
constexpr size_t OFF_KSPEC = OFF_ST + (size_t)2 * 16 * NCH * 4096 * 4;
constexpr size_t OFF_END = OFF_KSPEC + (size_t)2 * 256 * 2 * 8192 * 8;
constexpr size_t OFF_ACT = OFF_BIG;
static_assert(OFF_ACT + (size_t)TALL * 4096 * 2 <= OFF_END, "act fits");
static_assert(OFF_END <= (size_t)536870912, "workspace");

struct Params {
  const float* in[27];
  float* out;
  char* ws;
};
enum { I_X = 0, I_C, I_CTX, I_CCTX, I_WADA, I_BADA, I_N1G, I_N2G, I_WIN, I_WOUT, I_HCW, I_HCB, I_HW1, I_HB1, I_HSF, I_HW2,
       I_HB2, I_HW3, I_HBIAS, I_RLD, I_QNG, I_WUQ, I_KVNG, I_WUKV, I_W1, I_W2, I_FNG };

DI int tidx() { int t = __builtin_amdgcn_workitem_id_x(); asm volatile("" : "+v"(t)); return t; }
DI u16 f2bf(float x) { return __builtin_bit_cast(u16, (__bf16)x); }
DI float bf2f(u16 v) { return __uint_as_float(((unsigned)v) << 16); }
DI unsigned pack2(float a, float b) { bf2_t v; v[0] = (__bf16)a; v[1] = (__bf16)b; return __builtin_bit_cast(unsigned, v); }
DI float wave_sum(float v) {
#pragma unroll
  for (int o = 32; o > 0; o >>= 1) v += __shfl_xor(v, o);
  return v;
}
DI int crow(int reg, int h) { return (reg & 3) + 8 * (reg >> 2) + 4 * h; }
DI float bfe(u32x4 v, int j) {
  unsigned w = v[j >> 1];
  return __uint_as_float((j & 1) ? (w & 0xffff0000u) : (w << 16));
}
DI u16 bfu(u32x4 v, int j) {
  unsigned w = v[j >> 1];
  return (u16)((j & 1) ? (w >> 16) : (w & 0xffffu));
}
DI float silu_f(float x) { return x / (1.f + __expf(-x)); }
DI void row_info(int row, int& b, int& t, int& key, int& cond) {
  if (row < TLAT) { b = row >> 13; t = row & 8191; key = t; cond = b; }
  else { int rc = row - TLAT; b = rc >> 8; t = rc & 255; key = SEQ + t; cond = 4; }
}
DI int chunk_row0(int b, int ci) { return ci < 2 ? TLAT + b * LCTX + ci * 128 : b * SEQ + (ci - 2) * 128; }
DI float rope_apply(const float2* __restrict__ tab, float val, int jj, int t) {
  float partner = __shfl_xor(val, 8);
  int pos = (jj & 16) ? 128 + (t & 63) : (t >> 6);
  float2 cs = tab[pos * 8 + (jj & 7)];
  return (jj & 8) ? (val * cs.x + partner * cs.y) : (val * cs.x - partner * cs.y);
}

DI void convT_item(const float* __restrict__ src, u16* __restrict__ dst, int K, int N, int Npad, const float* __restrict__ gain,
                   int item, float* tile, bool perm = false) {
  int ntn = Npad >> 6;
  int kt = item / ntn, nt = item - kt * ntn;
  int k0 = kt * 64, n0 = nt * 64;
  int c = tidx() & 63, q = tidx() >> 6;
#pragma unroll 4
  for (int i = 0; i < 16; i++) {
    int kk = i * 4 + q, n = n0 + c;
    float v = 0.f;
    if (n < N) { int sn = perm ? ((n & 511) >> 6) * 128 + (n >> 9) * 64 + (n & 63) : n; v = src[(size_t)(k0 + kk) * N + sn]; if (gain) v *= gain[k0 + kk]; }
    tile[kk * 65 + c] = v;
  }
  __syncthreads();
#pragma unroll 4
  for (int i = 0; i < 16; i++) {
    int nn = i * 4 + q;
    dst[(size_t)(n0 + nn) * K + k0 + c] = f2bf(tile[c * 65 + nn]);
  }
  __syncthreads();
}

DI void phase_s0(const Params& p, char* smem) {
  const int per_layer = 576 + 256 + 1024 + 1024 + 48 + 32;
  const int n_conv = 2 * per_layer, n_mod = 2 * 96, n_tw = 32 + 6;
  const int total = n_conv + n_mod + n_tw;
  for (int it = blockIdx.x; it < total; it += gridDim.x) {
    if (it < n_conv) {
      int l = it / per_layer, r = it - l * per_layer;
      char* wl = p.ws + OFF_W + (size_t)l * WL_SIZE;
      float* tile = (float*)smem;
      if (r < 576) convT_item(p.in[I_WIN] + (size_t)l * 1024 * NIN, (u16*)(wl + WL_WIN), 1024, NIN, NINP, nullptr, r, tile);
      else if ((r -= 576) < 256) convT_item(p.in[I_WOUT] + (size_t)l * 1024 * 1024, (u16*)(wl + WL_WOUT), 1024, 1024, 1024, nullptr, r, tile);
      else if ((r -= 256) < 1024) convT_item(p.in[I_W1] + (size_t)l * 1024 * 4096, (u16*)(wl + WL_W1), 1024, 4096, 4096, nullptr, r, tile);
      else if ((r -= 1024) < 1024) convT_item(p.in[I_W2] + (size_t)l * 4096 * 1024, (u16*)(wl + WL_W2), 4096, 1024, 1024, nullptr, r, tile);
      else if ((r -= 1024) < 48) convT_item(p.in[I_WUQ] + (size_t)l * 256 * 768, (u16*)(wl + WL_WUQ), 256, 768, 768, p.in[I_QNG] + l * 256, r, tile);
      else { r -= 48; convT_item(p.in[I_WUKV] + (size_t)l * 128 * 1024, (u16*)(wl + WL_WUKV), 128, 1024, 1024, p.in[I_KVNG] + l * 128, r, tile, true); }
    } else if (it < n_conv + n_mod) {
      int r = it - n_conv;
      int l = r / 96, n0 = (r - l * 96) * 64;
      float* sc = (float*)smem;
      float* red = sc + 5120;
      for (int i = tidx(); i < 5120; i += 256) {
        int rr = i >> 10, k = i & 1023;
        float cv = rr < 4 ? p.in[I_C][rr * 1024 + k] : p.in[I_CCTX][k];
        sc[i] = cv / (1.f + expf(-cv));
      }
      __syncthreads();
      int nn = tidx() & 63, kq = tidx() >> 6;
      float a0 = 0, a1 = 0, a2 = 0, a3 = 0, a4 = 0;
      const float* w = p.in[I_WADA] + ((size_t)l * 1024 + kq * 256) * 6144 + n0 + nn;
      for (int k = 0; k < 256; k++) {
        float wv = w[(size_t)k * 6144];
        int kk = kq * 256 + k;
        a0 += sc[kk] * wv; a1 += sc[1024 + kk] * wv; a2 += sc[2048 + kk] * wv; a3 += sc[3072 + kk] * wv; a4 += sc[4096 + kk] * wv;
      }
      red[(kq * 5 + 0) * 64 + nn] = a0; red[(kq * 5 + 1) * 64 + nn] = a1; red[(kq * 5 + 2) * 64 + nn] = a2;
      red[(kq * 5 + 3) * 64 + nn] = a3; red[(kq * 5 + 4) * 64 + nn] = a4;
      __syncthreads();
      if (tidx() < 64) {
        float* mod = (float*)(p.ws + OFF_MOD);
        float bb = p.in[I_BADA][l * 6144 + n0 + nn];
        for (int rr = 0; rr < 5; rr++) {
          float s = red[(0 * 5 + rr) * 64 + nn] + red[(1 * 5 + rr) * 64 + nn] + red[(2 * 5 + rr) * 64 + nn] + red[(3 * 5 + rr) * 64 + nn];
          mod[(size_t)(l * 5 + rr) * 6144 + n0 + nn] = s + bb;
        }
      }
      __syncthreads();
    } else {
      int q = it - n_conv - n_mod;
      if (q < 32) {
        int n = q * 256 + tidx();
        float sn, cs;
        sincospif((float)n / 8192.f, &sn, &cs);
        ((float2*)(p.ws + OFF_TW))[n] = make_float2(cs, -sn);
      } else {
        int e = (q - 32) * 256 + tidx();
        int pos = e >> 3, f = e & 7;
        float pv = pos < 128 ? (float)pos : (float)(pos - 128);
        float inv = powf(10000.f, -(float)f / 8.f);
        float sn, cs;
        sincosf(pv * inv, &sn, &cs);
        ((float2*)(p.ws + OFF_ROPE))[e] = make_float2(cs, sn);
      }
    }
  }
}

DI void filt_a_item(const Params& p, int l, int Lf, float* h2out, int pos) {
  int lane = tidx() & 63;
  float tpos = (float)pos / (float)(Lf - 1);
  float zval = 0.f;
  if (lane == 0) zval = tpos;
  else if (lane < 33) {
    int jj = (lane - 1) & 15;
    float band = 1e-4f + (float)jj * ((15.f - 1e-4f) / 15.f);
    float ang = ((float)(6.283185307179586 / (double)Lf)) * (float)pos * band;
    zval = lane < 17 ? cosf(ang) : -sinf(ang);
  }
  const float* w1 = p.in[I_HW1] + l * 33 * 64;
  const float* w2 = p.in[I_HW2] + l * 64 * 64;
  float acc = p.in[I_HB1][l * 64 + lane];
  for (int i = 0; i < 33; i++) acc += __shfl(zval, i) * w1[i * 64 + lane];
  float h1 = sinf(p.in[I_HSF][l * 128 + lane] * acc);
  float acc2 = p.in[I_HB2][l * 64 + lane];
  for (int i = 0; i < 64; i++) acc2 += __shfl(h1, i) * w2[i * 64 + lane];
  h2out[(size_t)pos * 64 + lane] = sinf(p.in[I_HSF][l * 128 + 64 + lane] * acc2);
}

DI void phase_norm(const Params& p, int l, int which, int nrows, bool with_filter) {
  const int lane = tidx() & 63, wid = tidx() >> 6;
  const bool first = (l == 0 && which == 1);
  const int n_norm = nrows >> 2;
  const int n_fa = with_filter ? (8192 / 4 + (l == 0 ? 256 / 4 : 0)) : 0;
  const float* gsrc = p.in[which == 1 ? I_N1G : I_N2G] + l * 1024;
  u16* H = (u16*)(p.ws + OFF_H);
  for (int it = blockIdx.x; it < n_norm + n_fa; it += gridDim.x) {
    if (it < n_norm) {
      int row = it * 4 + wid;
      const float* src;
      int cond;
      if (row < TLAT) { src = (first ? p.in[I_X] : p.out) + (size_t)row * 1024; cond = row >> 13; }
      else { src = (first ? p.in[I_CTX] : (const float*)(p.ws + OFF_XC)) + (size_t)(row - TLAT) * 1024; cond = 4; }
      const float* m = (const float*)(p.ws + OFF_MOD) + (size_t)(l * 5 + cond) * 6144 + (which == 1 ? 0 : 3072);
      float4 v[4];
      float ssq = 0.f;
#pragma unroll
      for (int i = 0; i < 4; i++) {
        v[i] = *(const float4*)(src + i * 256 + lane * 4);
        ssq += v[i].x * v[i].x + v[i].y * v[i].y + v[i].z * v[i].z + v[i].w * v[i].w;
      }
      ssq = wave_sum(ssq);
      float rstd = rsqrtf(ssq * (1.f / 1024.f) + 1e-6f);
#pragma unroll
      for (int i = 0; i < 4; i++) {
        int col = i * 256 + lane * 4;
        float4 g = *(const float4*)(gsrc + col), sh = *(const float4*)(m + col), sc = *(const float4*)(m + 1024 + col);
        float o0 = v[i].x * rstd * g.x * (1.f + sc.x) + sh.x, o1 = v[i].y * rstd * g.y * (1.f + sc.y) + sh.y;
        float o2 = v[i].z * rstd * g.z * (1.f + sc.z) + sh.z, o3 = v[i].w * rstd * g.w * (1.f + sc.w) + sh.w;
        *(uint2*)(H + (size_t)row * 1024 + col) = make_uint2(pack2(o0, o1), pack2(o2, o3));
      }
    } else {
      int q = it - n_norm;
      if (q < 2048) filt_a_item(p, l, 8192, (float*)(p.ws + OFF_H2F), q * 4 + wid);
      else filt_a_item(p, l, 256, (float*)(p.ws + OFF_H2C), (q - 2048) * 4 + wid);
    }
  }
}

constexpr int GLD = 40;
template <bool ROWNORM, bool TR0, bool TR1, class Epi>
DI void gemm_tile(const u16* __restrict__ A, int lda, const u16* __restrict__ Bt, int ldb, int K, int m0, int n0,
                  const u16* __restrict__ at_src, int at_kt, char* smem, Epi epi) {
  u16* As = (u16*)smem;
  u16* Bs = As + 256 * GLD;
  float* rs = (float*)(Bs + 128 * GLD);
  int tid_o = tidx();
  asm volatile("" : "+v"(tid_o));
  const int tid = tid_o, lane = tid & 63, wid = tid >> 6, wm = wid >> 1, wn = wid & 1, r = lane & 31, h = lane >> 5;
  const bool trans = (TR0 == TR1) ? TR0 : (wn ? TR1 : TR0);
  f32x16 acc[4][2];
#pragma unroll
  for (int mi = 0; mi < 4; mi++)
#pragma unroll
    for (int ni = 0; ni < 2; ni++)
#pragma unroll
      for (int e = 0; e < 16; e++) acc[mi][ni][e] = 0.f;
  u32x4 ra[4], rb[2];
  float ssq[4];
#pragma unroll
  for (int i = 0; i < 4; i++) ssq[i] = 0.f;
  const int nk = K >> 5;
  const int lrow = tid >> 2, lkc = tid & 3;
  const int tch = tid >> 5, ttc = tid & 31;
  const bool has_at = at_src != nullptr;

#define GEMM_GLOAD(KT)                                                                                                      \
  {                                                                                                                         \
    const int kt_ = (KT);                                                                                                   \
    if (has_at && kt_ < at_kt) {                                                                                            \
      _Pragma("unroll") for (int i = 0; i < 4; i++) ra[i] = *(const u32x4*)(at_src + (size_t)(kt_ * 32 + tch + 8 * i) * 8192 + ttc * 8); \
    } else {                                                                                                                \
      _Pragma("unroll") for (int i = 0; i < 4; i++) ra[i] = *(const u32x4*)(A + (size_t)(m0 + lrow + 64 * i) * lda + kt_ * 32 + lkc * 8);  \
    }                                                                                                                       \
    _Pragma("unroll") for (int i = 0; i < 2; i++) rb[i] = *(const u32x4*)(Bt + (size_t)(n0 + lrow + 64 * i) * ldb + kt_ * 32 + lkc * 8);   \
  }
  GEMM_GLOAD(0)
  for (int kt = 0; kt < nk; kt++) {
    __syncthreads();
    if (has_at && kt < at_kt) {
#pragma unroll
      for (int i = 0; i < 4; i++)
#pragma unroll
        for (int j = 0; j < 8; j++) As[(ttc * 8 + j) * GLD + tch + 8 * i] = bfu(ra[i], j);
    } else {
#pragma unroll
      for (int i = 0; i < 4; i++) *(u32x4*)(As + (lrow + 64 * i) * GLD + lkc * 8) = ra[i];
    }
#pragma unroll
    for (int i = 0; i < 2; i++) *(u32x4*)(Bs + (lrow + 64 * i) * GLD + lkc * 8) = rb[i];
    if (ROWNORM) {
#pragma unroll
      for (int i = 0; i < 4; i++)
#pragma unroll
        for (int j = 0; j < 8; j++) { float x = bfe(ra[i], j); ssq[i] += x * x; }
    }
    __syncthreads();
    if (kt + 1 < nk) GEMM_GLOAD(kt + 1)
#pragma unroll
    for (int ks = 0; ks < 2; ks++) {
      bf16x8 a[4], b[2];
#pragma unroll
      for (int mi = 0; mi < 4; mi++) a[mi] = *(const bf16x8*)(As + (wm * 128 + mi * 32 + r) * GLD + ks * 16 + h * 8);
#pragma unroll
      for (int ni = 0; ni < 2; ni++) b[ni] = *(const bf16x8*)(Bs + (wn * 64 + ni * 32 + r) * GLD + ks * 16 + h * 8);
      if (!trans) {
#pragma unroll
        for (int mi = 0; mi < 4; mi++)
#pragma unroll
          for (int ni = 0; ni < 2; ni++) acc[mi][ni] = MFMA32(a[mi], b[ni], acc[mi][ni]);
      } else {
#pragma unroll
        for (int mi = 0; mi < 4; mi++)
#pragma unroll
          for (int ni = 0; ni < 2; ni++) acc[mi][ni] = MFMA32(b[ni], a[mi], acc[mi][ni]);
      }
    }
  }
  if (ROWNORM) {
    float* rsp = rs + 256;
#pragma unroll
    for (int i = 0; i < 4; i++) rsp[(lrow + 64 * i) * 4 + lkc] = ssq[i];
    __syncthreads();
    {
      float4 q = *(const float4*)(rsp + tid * 4);
      rs[tid] = rsqrtf((q.x + q.y + q.z + q.w) / (float)K + 1e-6f);
    }
    __syncthreads();
  }
#define EPI_CALL(mi, ni) epi(m0 + wm * 128 + (mi) * 32, n0 + wn * 64 + (ni) * 32, acc[mi][ni], rs);
  EPI_CALL(0, 0) EPI_CALL(0, 1) EPI_CALL(1, 0) EPI_CALL(1, 1) EPI_CALL(2, 0) EPI_CALL(2, 1) EPI_CALL(3, 0) EPI_CALL(3, 1)
#undef EPI_CALL
  __syncthreads();
}

DI void phase_win(const Params& p, int l, char* smem) {
  const u16* H = (const u16*)(p.ws + OFF_H);
  const u16* W = (const u16*)(p.ws + OFF_W + (size_t)l * WL_SIZE + WL_WIN);
  u16* UT = (u16*)(p.ws + OFF_UT);
  u16* UTC = (u16*)(p.ws + OFF_UTC);
  u16* RET = (u16*)(p.ws + OFF_RET);
  u16* CQ = (u16*)(p.ws + OFF_CQ);
  u16* CKV = (u16*)(p.ws + OFF_CKV);
  u16* KF = (u16*)(p.ws + OFF_KF);
  const int lane = tidx() & 63, r = lane & 31, h = lane >> 5;
  const int total = 132 * 18;
  for (int it = blockIdx.x; it < total; it += gridDim.x) {
    int mt = it / 18, nt = it - mt * 18;
    int m0 = mt * 256, n0 = nt * 128;
    if (nt < 6) {
      gemm_tile<false, true, true>(H, 1024, W, 1024, 1024, m0, n0, nullptr, 0, smem,
        [&](int bm, int bn, const f32x16& acc, const float*) __attribute__((always_inline)) {
          int row = bm + r, b, t, key, cond;
          row_info(row, b, t, key, cond);
          u16* dstp = row < TLAT ? UT + ((size_t)(b * 768)) * SEQ + t : UTC + ((size_t)(b * 768)) * LCTX + t;
          int strd = row < TLAT ? SEQ : LCTX;
#pragma unroll
          for (int reg = 0; reg < 16; reg++) dstp[(size_t)(bn + crow(reg, h)) * strd] = f2bf(acc[reg]);
        });
    } else {
      gemm_tile<false, false, false>(H, 1024, W, 1024, 1024, m0, n0, nullptr, 0, smem,
        [&](int bm, int bn, const f32x16& acc, const float*) __attribute__((always_inline)) {
        if (nt < 14) {

          int col = bn + r - 768;
          float sc = (col >= 256 && col < 512) ? 0.125f : 1.f;
#pragma unroll
          for (int reg = 0; reg < 16; reg++) RET[(size_t)(bm + crow(reg, h)) * 1024 + col] = f2bf(acc[reg] * sc);
        } else if (nt < 16) {
          int col = bn + r - 1792;
#pragma unroll
          for (int reg = 0; reg < 16; reg++) CQ[(size_t)(bm + crow(reg, h)) * 256 + col] = f2bf(acc[reg]);
        } else if (nt == 16) {
          int col = bn + r - 2048;
#pragma unroll
          for (int reg = 0; reg < 16; reg++) CKV[(size_t)(bm + crow(reg, h)) * 128 + col] = f2bf(acc[reg]);
        } else if (bn == 2176) {
#pragma unroll
          for (int reg = 0; reg < 16; reg++) {
            int row = bm + crow(reg, h), b, t, key, cond;
            row_info(row, b, t, key, cond);
            float v = acc[reg];
            float vr = rope_apply((const float2*)(p.ws + OFF_ROPE), v, r, t);
            if (row < TLAT) v = vr;
            u16 o = f2bf(v);
#pragma unroll
            for (int hh = 0; hh < 8; hh++) KF[((size_t)(b * 8 + hh) * LKEY + key) * 96 + 64 + r] = o;
          }
        }
      });
    }
  }
}

DI void ret_gammas(const Params& p, int l, int hh, float& lgf, float& lgb) {
  lgf = log1pf(-expf(p.in[I_RLD][l * 8 + hh]));
  lgb = log1pf(-expf(p.in[I_RLD][l * 8 + 4 + hh]));
}
DI void ret_kv_item(const Params& p, int l, int b, int hh, int ci, char* smem) {
  const u16* RET = (const u16*)(p.ws + OFF_RET);
  float* ST = (float*)(p.ws + OFF_ST);
  u16* KfT = (u16*)smem;
  u16* KbT = KfT + 64 * 136;
  u16* VsT = KbT + 64 * 136;
  int tid_o = tidx();
  asm volatile("" : "+v"(tid_o));
  const int tid = tid_o, lane = tid & 63, wid = tid >> 6, r = lane & 31, h = lane >> 5;
  float lgf, lgb;
  ret_gammas(p, l, hh, lgf, lgb);
  const int row0 = chunk_row0(b, ci);
#pragma unroll
  for (int i = 0; i < 4; i++) {
    int id = tid + 256 * i, m = id >> 3, dc = id & 7;
    u32x4 kv = *(const u32x4*)(RET + (size_t)(row0 + m) * 1024 + 256 + hh * 64 + dc * 8);
    u32x4 vv = *(const u32x4*)(RET + (size_t)(row0 + m) * 1024 + 512 + hh * 64 + dc * 8);
    float zf = __expf(lgf * (float)(127 - m)), zb = __expf(lgb * (float)m);
#pragma unroll
    for (int j = 0; j < 8; j++) {
      float kval = bfe(kv, j);
      KfT[(dc * 8 + j) * 136 + m] = f2bf(kval * zf);
      KbT[(dc * 8 + j) * 136 + m] = f2bf(kval * zb);
      VsT[(dc * 8 + j) * 136 + m] = bfu(vv, j);
    }
  }
  __syncthreads();
  const int dir = wid >> 1, dh = wid & 1;
  const u16* Asrc = dir ? KbT : KfT;
  f32x16 c0, c1;
#pragma unroll
  for (int e = 0; e < 16; e++) { c0[e] = 0.f; c1[e] = 0.f; }
#pragma unroll
  for (int ks = 0; ks < 8; ks++) {
    bf16x8 a = *(const bf16x8*)(Asrc + (dh * 32 + r) * 136 + ks * 16 + h * 8);
    bf16x8 b0 = *(const bf16x8*)(VsT + (r) * 136 + ks * 16 + h * 8);
    bf16x8 b1 = *(const bf16x8*)(VsT + (32 + r) * 136 + ks * 16 + h * 8);
    c0 = MFMA32(a, b0, c0);
    c1 = MFMA32(a, b1, c1);
  }
  float* dst = ST + ((size_t)((dir * 4 + b) * 4 + hh) * NCH + ci) * 4096;
#pragma unroll
  for (int reg = 0; reg < 16; reg++) {
    int d = dh * 32 + crow(reg, h);
    dst[d * 64 + r] = c0[reg];
    dst[d * 64 + 32 + r] = c1[reg];
  }
  __syncthreads();
}

#define PX(i) ((i) + ((i) >> 4))
typedef float cf2 __attribute__((ext_vector_type(2)));
DI cf2 mk2(float x, float y) { cf2 r; r.x = x; r.y = y; return r; }
DI cf2 cmul(cf2 a, cf2 b) { return mk2(a.x * b.x - a.y * b.y, a.x * b.y + a.y * b.x); }
DI cf2 cmulc(cf2 a, cf2 b) { return mk2(a.x * b.x + a.y * b.y, a.y * b.x - a.x * b.y); }
DI cf2 cadd(cf2 a, cf2 b) { return mk2(a.x + b.x, a.y + b.y); }
DI cf2 csub(cf2 a, cf2 b) { return mk2(a.x - b.x, a.y - b.y); }
DI cf2 twid_rev(float rev) { return mk2(__builtin_amdgcn_cosf(rev), -__builtin_amdgcn_sinf(rev)); }

template <int S, bool INV>
DI void fft_pass8(float2* Xf2, int tid) {
  cf2* X = (cf2*)Xf2;
  constexpr int span = 8192 >> S, q = span >> 3, lq = 10 - S;
  const float R = 0.70710678118654752f;
#pragma unroll 2
  for (int gi = 0; gi < 4; gi++) {
    int g = tid + 256 * gi;
    int j = g & (q - 1), blk = g >> lq, base = blk * span + j;
    cf2 v[8];
#pragma unroll
    for (int k = 0; k < 8; k++) v[k] = X[PX(base + k * q)];
    cf2 W = twid_rev((float)j * (1.f / (float)span));
    cf2 W2 = cmul(W, W), W4 = cmul(W2, W2);
    cf2 w1 = cmul(W, mk2(R, -R)), w2 = mk2(W.y, -W.x), w3 = cmul(W, mk2(-R, -R));
    cf2 w2b = mk2(W2.y, -W2.x);
    if (!INV) {
      { cf2 a, d;
        a = v[0]; d = csub(a, v[4]); v[0] = cadd(a, v[4]); v[4] = cmul(d, W);
        a = v[1]; d = csub(a, v[5]); v[1] = cadd(a, v[5]); v[5] = cmul(d, w1);
        a = v[2]; d = csub(a, v[6]); v[2] = cadd(a, v[6]); v[6] = cmul(d, w2);
        a = v[3]; d = csub(a, v[7]); v[3] = cadd(a, v[7]); v[7] = cmul(d, w3); }
#pragma unroll
      for (int b4 = 0; b4 < 8; b4 += 4) { cf2 a, d;
        a = v[b4]; d = csub(a, v[b4 + 2]); v[b4] = cadd(a, v[b4 + 2]); v[b4 + 2] = cmul(d, W2);
        a = v[b4 + 1]; d = csub(a, v[b4 + 3]); v[b4 + 1] = cadd(a, v[b4 + 3]); v[b4 + 3] = cmul(d, w2b); }
#pragma unroll
      for (int k = 0; k < 8; k += 2) { cf2 a = v[k], d = csub(a, v[k + 1]); v[k] = cadd(a, v[k + 1]); v[k + 1] = cmul(d, W4); }
    } else {
#pragma unroll
      for (int k = 0; k < 8; k += 2) { cf2 a = v[k], bb = cmulc(v[k + 1], W4); v[k] = cadd(a, bb); v[k + 1] = csub(a, bb); }
#pragma unroll
      for (int b4 = 0; b4 < 8; b4 += 4) { cf2 a, bb;
        a = v[b4]; bb = cmulc(v[b4 + 2], W2); v[b4] = cadd(a, bb); v[b4 + 2] = csub(a, bb);
        a = v[b4 + 1]; bb = cmulc(v[b4 + 3], w2b); v[b4 + 1] = cadd(a, bb); v[b4 + 3] = csub(a, bb); }
      { cf2 a, bb;
        a = v[0]; bb = cmulc(v[4], W); v[0] = cadd(a, bb); v[4] = csub(a, bb);
        a = v[1]; bb = cmulc(v[5], w1); v[1] = cadd(a, bb); v[5] = csub(a, bb);
        a = v[2]; bb = cmulc(v[6], w2); v[2] = cadd(a, bb); v[6] = csub(a, bb);
        a = v[3]; bb = cmulc(v[7], w3); v[3] = cadd(a, bb); v[7] = csub(a, bb); }
    }
#pragma unroll
    for (int k = 0; k < 8; k++) X[PX(base + k * q)] = v[k];
  }
  __syncthreads();
}

DI cf2 t16f(int k) {
  const float C1 = 0.92387953251128674f, S1 = 0.38268343236508977f, R = 0.70710678118654752f;
  return k == 0 ? mk2(1.f, 0.f) : k == 1 ? mk2(C1, -S1) : k == 2 ? mk2(R, -R) : k == 3 ? mk2(S1, -C1) : k == 4 ? mk2(0.f, -1.f)
       : k == 5 ? mk2(-S1, -C1) : k == 6 ? mk2(-R, -R) : mk2(-C1, -S1);
}
template <bool INV>
DI void fft_pass16(float2* Xf2, int tid) {
  cf2* X = (cf2*)Xf2;
#pragma unroll 1
  for (int gi = 0; gi < 2; gi++) {
    int g = tid + 256 * gi;
    cf2* xp = X + 17 * g;
    cf2 v[16];
#pragma unroll
    for (int k = 0; k < 16; k++) v[k] = xp[k];
    if (!INV) {
#pragma unroll
      for (int k = 0; k < 8; k++) { cf2 a = v[k], d = csub(a, v[k + 8]); v[k] = cadd(a, v[k + 8]); v[k + 8] = cmul(d, t16f(k)); }
#pragma unroll
      for (int b8 = 0; b8 < 16; b8 += 8)
#pragma unroll
        for (int k = 0; k < 4; k++) { cf2 a = v[b8 + k], d = csub(a, v[b8 + k + 4]); v[b8 + k] = cadd(a, v[b8 + k + 4]); v[b8 + k + 4] = cmul(d, t16f(2 * k)); }
#pragma unroll
      for (int b4 = 0; b4 < 16; b4 += 4)
#pragma unroll
        for (int k = 0; k < 2; k++) { cf2 a = v[b4 + k], d = csub(a, v[b4 + k + 2]); v[b4 + k] = cadd(a, v[b4 + k + 2]); v[b4 + k + 2] = cmul(d, t16f(4 * k)); }
#pragma unroll
      for (int k = 0; k < 16; k += 2) { cf2 a = v[k], bb = v[k + 1]; v[k] = cadd(a, bb); v[k + 1] = csub(a, bb); }
    } else {
#pragma unroll
      for (int k = 0; k < 16; k += 2) { cf2 a = v[k], bb = v[k + 1]; v[k] = cadd(a, bb); v[k + 1] = csub(a, bb); }
#pragma unroll
      for (int b4 = 0; b4 < 16; b4 += 4)
#pragma unroll
        for (int k = 0; k < 2; k++) { cf2 a = v[b4 + k], bb = cmulc(v[b4 + k + 2], t16f(4 * k)); v[b4 + k] = cadd(a, bb); v[b4 + k + 2] = csub(a, bb); }
#pragma unroll
      for (int b8 = 0; b8 < 16; b8 += 8)
#pragma unroll
        for (int k = 0; k < 4; k++) { cf2 a = v[b8 + k], bb = cmulc(v[b8 + k + 4], t16f(2 * k)); v[b8 + k] = cadd(a, bb); v[b8 + k + 4] = csub(a, bb); }
#pragma unroll
      for (int k = 0; k < 8; k++) { cf2 a = v[k], bb = cmulc(v[k + 8], t16f(k)); v[k] = cadd(a, bb); v[k + 8] = csub(a, bb); }
    }
#pragma unroll
    for (int k = 0; k < 16; k++) xp[k] = v[k];
  }
  __syncthreads();
}
DI void fft_dif(float2* X, const float2* __restrict__, int tid) {
  fft_pass8<0, false>(X, tid); fft_pass8<3, false>(X, tid); fft_pass8<6, false>(X, tid); fft_pass16<false>(X, tid);
}
DI void fft_dit(float2* X, const float2* __restrict__, int tid) {
  fft_pass16<true>(X, tid); fft_pass8<6, true>(X, tid); fft_pass8<3, true>(X, tid); fft_pass8<0, true>(X, tid);
}

DI void filt_fft_item(const Params& p, int l, int o, int c, char* smem) {
  float2* X = (float2*)smem;
  float* Xf = (float*)smem;
  float* w3s = (float*)(smem + 69632);
  float* red = w3s + 128;
  const float2* TW = (const float2*)(p.ws + OFF_TW);
  const float* H2 = (const float*)(p.ws + OFF_H2F);
  float2* KS = (float2*)(p.ws + OFF_KSPEC) + (size_t)(o * 256 + c) * 2 * 8192;
  int tid_o = tidx();
  asm volatile("" : "+v"(tid_o));
  const int tid = tid_o;
  if (tid < 128) { int j = tid & 63, side = tid >> 6; w3s[tid] = p.in[I_HW3][((size_t)l * 64 + j) * 1024 + side * 512 + o * 256 + c]; }
  __syncthreads();
  const float min_decay = -3.0701134573253944f, max_decay = -15.350567286626972f;
  const float delta = fabsf(min_decay + (float)c * ((max_decay - min_decay) / 255.f));
  float* Ff = Xf;
  float* Fb = Xf + 8192;
#pragma unroll 1
  for (int i = 0; i < 32; i++) {
    int n = tid + 256 * i;
    const float4* hp = (const float4*)(H2 + (size_t)n * 64);
    float f = 0.f, bsum = 0.f;
#pragma unroll
    for (int q = 0; q < 16; q++) {
      float4 hv = hp[q];
      f += hv.x * w3s[q * 4] + hv.y * w3s[q * 4 + 1] + hv.z * w3s[q * 4 + 2] + hv.w * w3s[q * 4 + 3];
      bsum += hv.x * w3s[64 + q * 4] + hv.y * w3s[64 + q * 4 + 1] + hv.z * w3s[64 + q * 4 + 2] + hv.w * w3s[64 + q * 4 + 3];
    }
    float win = expf(-((float)n / 8191.f) * delta);
    Ff[n] = f * win; Fb[n] = bsum * win;
  }
  __syncthreads();
  float part = 0.f;
#pragma unroll 2
  for (int i = 0; i < 32; i++) {
    int n = tid + 256 * i;
    float k1 = Ff[n], k2 = 0.f;
    if (n == 0) k1 += Fb[0]; else k2 = Fb[8192 - n];
    part += fabsf(k1) + fabsf(k2);
    KS[8192 + n] = make_float2(k1, k2);
  }
  part = wave_sum(part);
  if ((tid & 63) == 0) red[tid >> 6] = part;
  __syncthreads();
  const float inv = 1.f / (red[0] + red[1] + red[2] + red[3]);
#pragma unroll 2
  for (int i = 0; i < 32; i++) { int n = tidx() + 256 * i; float2 kp = KS[8192 + n]; X[PX(n)] = make_float2((kp.x + kp.y) * inv, 0.f); }
  __syncthreads();
  fft_dif(X, TW, tid);
#pragma unroll 2
  for (int i = 0; i < 32; i++) { int n = tidx() + 256 * i; KS[n] = X[PX(n)]; }
  __syncthreads();
#pragma unroll 2
  for (int i = 0; i < 32; i++) { int n = tidx() + 256 * i; float2 w = TW[n]; float2 kp = KS[8192 + n]; float d = (kp.x - kp.y) * inv; X[PX(n)] = make_float2(d * w.x, d * w.y); }
  __syncthreads();
  fft_dif(X, TW, tid);
#pragma unroll 2
  for (int i = 0; i < 32; i++) { int n = tidx() + 256 * i; KS[8192 + n] = X[PX(n)]; }
  __syncthreads();
}

DI void filt_ctx_item(const Params& p, int l, int o, int c, char* smem) {
  float* red = (float*)smem;
  const float* H2 = (const float*)(p.ws + OFF_H2C);
  float* KC = (float*)(p.ws + OFF_KC) + (size_t)(o * 256 + c) * 512;
  int tid_o = tidx();
  asm volatile("" : "+v"(tid_o));
  const int n = tid_o;
  const float min_decay = -3.0701134573253944f, max_decay = -15.350567286626972f;
  const float delta = fabsf(min_decay + (float)c * ((max_decay - min_decay) / 255.f));
  float f = 0.f, bsum = 0.f;
  for (int j = 0; j < 64; j++) {
    float hv = H2[n * 64 + j];
    f += hv * p.in[I_HW3][((size_t)l * 64 + j) * 1024 + o * 256 + c];
    bsum += hv * p.in[I_HW3][((size_t)l * 64 + j) * 1024 + 512 + o * 256 + c];
  }
  float win = expf(-((float)n / 255.f) * delta);
  f *= win; bsum *= win;
  float part = n == 0 ? fabsf(f + bsum) : fabsf(f) + fabsf(bsum);
  part = wave_sum(part);
  __syncthreads();
  if ((n & 63) == 0) red[n >> 6] = part;
  __syncthreads();
  float inv = 1.f / (red[0] + red[1] + red[2] + red[3]);
  if (n == 0) { KC[256] = (f + bsum) * inv; KC[0] = 0.f; }
  else { KC[256 + n] = f * inv; KC[256 - n] = bsum * inv; }
  __syncthreads();
}

DI void phase_p3(const Params& p, int l, char* smem) {
  const int lane = tidx() & 63, r = lane & 31, h = lane >> 5;
  const int n_uq = (l == 0 ? 132 : 128) * 6, n_ukv = 132 * 8, n_r1 = 16 * NCH, n_ff = 512, n_fc = (l == 0 ? 512 : 0);
  const int total = n_uq + n_ukv + n_r1 + n_ff + n_fc;
  const char* wl = p.ws + OFF_W + (size_t)l * WL_SIZE;
  u16* Q = (u16*)(p.ws + OFF_Q);
  u16* KF = (u16*)(p.ws + OFF_KF);
  u16* VT = (u16*)(p.ws + OFF_VT);
  for (int it = blockIdx.x; it < total; it += gridDim.x) {
    int q = it;
    if (q < n_uq) {
      int mt = q / 6, nt = q - mt * 6;
      if (SUB_ON(0)) gemm_tile<true, false, false>((const u16*)(p.ws + OFF_CQ), 256, (const u16*)(wl + WL_WUQ), 256, 256, mt * 256, nt * 128, nullptr, 0, smem,
        [&](int bm, int bn, const f32x16& acc, const float* rs) __attribute__((always_inline)) {
          int col = bn + r;
          int j = col % 96;
          const float qscale = 0.10206207261596577f * 1.4426950408889634f;
#pragma unroll
          for (int reg = 0; reg < 16; reg++) {
            int row = bm + crow(reg, h);
            float v = acc[reg] * rs[row - mt * 256];
            if (j >= 64) {
              int b, t, key, cond;
              row_info(row, b, t, key, cond);
              float vr = rope_apply((const float2*)(p.ws + OFF_ROPE), v, r, t);
              if (row < TLAT) v = vr;
            }
            Q[(size_t)row * 768 + col] = f2bf(v * qscale);
          }
        });
    } else if ((q -= n_uq) < n_ukv) {
      int mt = q >> 3, nt = q & 7;
      if (nt < 4) {
        if (SUB_ON(1)) gemm_tile<true, false, false>((const u16*)(p.ws + OFF_CKV), 128, (const u16*)(wl + WL_WUKV), 128, 128, mt * 256, nt * 128, nullptr, 0, smem,
          [&](int bm, int bn, const f32x16& acc, const float* rs) __attribute__((always_inline)) {
            int hd = bn >> 6, j = (bn & 63) + r;
#pragma unroll
            for (int reg = 0; reg < 16; reg++) {
              int row = bm + crow(reg, h), b, t, key, cond;
              row_info(row, b, t, key, cond);
              KF[((size_t)(b * 8 + hd) * LKEY + key) * 96 + j] = f2bf(acc[reg] * rs[row - mt * 256]);
            }
          });
      } else {
        if (SUB_ON(1)) gemm_tile<true, true, true>((const u16*)(p.ws + OFF_CKV), 128, (const u16*)(wl + WL_WUKV), 128, 128, mt * 256, nt * 128, nullptr, 0, smem,
          [&](int bm, int bn, const f32x16& acc, const float* rs) __attribute__((always_inline)) {
            int row = bm + r, b, t, key, cond;
            row_info(row, b, t, key, cond);
            float rr = rs[row - mt * 256];
            int hd = (bn - 512) >> 6, e0 = (bn - 512) & 63;
            u16* dstp = VT + ((size_t)(b * 8 + hd) * 64 + e0) * LKEY + key;
#pragma unroll
            for (int reg = 0; reg < 16; reg++) dstp[(size_t)crow(reg, h) * LKEY] = f2bf(acc[reg] * rr);
          });
      }
    } else if ((q -= n_ukv) < n_r1) {
      int bh = q / NCH, ci = q - bh * NCH;
      if (SUB_ON(2)) ret_kv_item(p, l, bh >> 2, bh & 3, ci, smem);
    } else if ((q -= n_r1) < n_ff) {
      if (SUB_ON(3)) filt_fft_item(p, l, q >> 8, q & 255, smem);
    } else {
      q -= n_ff;
      if (SUB_ON(4)) filt_ctx_item(p, l, q >> 8, q & 255, smem);
    }
  }
}

DI void phase_scan(const Params& p, int l) {
  float* ST = (float*)(p.ws + OFF_ST);
  for (int idx = blockIdx.x * 256 + tidx(); idx < 2 * 16 * 4096; idx += gridDim.x * 256) {
    int dir = idx >> 16, bh = (idx >> 12) & 15, el = idx & 4095, hh = bh & 3;
    float* base = ST + (size_t)((dir * 16 + bh) * NCH) * 4096 + el;
    float lg = log1pf(-expf(p.in[I_RLD][l * 8 + dir * 4 + hh]));
    float gC = expf(lg * 128.f);
    float s = 0.f;
    if (dir == 0) {
      for (int ci = 0; ci < NCH; ci++) { float tmp = base[(size_t)ci * 4096]; base[(size_t)ci * 4096] = s; s = gC * s + tmp; }
    } else {
      for (int ci = 1; ci >= 0; ci--) { float tmp = base[(size_t)ci * 4096]; base[(size_t)ci * 4096] = s; s = gC * s + tmp; }
      for (int ci = NCH - 1; ci >= 2; ci--) { float tmp = base[(size_t)ci * 4096]; base[(size_t)ci * 4096] = s; s = gC * s + tmp; }
    }
  }
}

DI void attn_item(const Params& p, int b, int hh, int qrow0, int key0, int nkeys, char* smem) {
  u16* Ks = (u16*)smem;
  u16* Vs = Ks + 64 * 104;
  const u16* Q = (const u16*)(p.ws + OFF_Q);
  const u16* KF = (const u16*)(p.ws + OFF_KF);
  const u16* VT = (const u16*)(p.ws + OFF_VT);
  u16* MIX = (u16*)(p.ws + OFF_H);
  int tid_o = tidx();
  asm volatile("" : "+v"(tid_o));
  const int tid = tid_o, lane = tid & 63, wid = tid >> 6, r = lane & 31, h = lane >> 5;
  const int qrow = qrow0 + wid * 32 + r;
  bf16x8 qf[6];
#pragma unroll
  for (int ks = 0; ks < 6; ks++) qf[ks] = *(const bf16x8*)(Q + (size_t)qrow * 768 + hh * 96 + ks * 16 + h * 8);
  f32x16 o0, o1;
#pragma unroll
  for (int e = 0; e < 16; e++) { o0[e] = 0.f; o1[e] = 0.f; }
  float m = -1e30f, lsum = 0.f;
  const u32x4* kbase = (const u32x4*)(KF + ((size_t)(b * 8 + hh) * LKEY + key0) * 96);
  const u16* vbase = VT + (size_t)(b * 8 + hh) * 64 * LKEY + key0;
  u32x4 rk[3], rv[2];
  const int nt = nkeys >> 6;
#define ATT_GLOAD(T)                                                                                                        \
  {                                                                                                                         \
    const int t_ = (T);                                                                                                     \
    _Pragma("unroll") for (int i = 0; i < 3; i++) rk[i] = kbase[(size_t)t_ * 768 + tid + 256 * i];                          \
    _Pragma("unroll") for (int i = 0; i < 2; i++) { int id = tid + 256 * i; rv[i] = *(const u32x4*)(vbase + (size_t)(id >> 3) * LKEY + t_ * 64 + (id & 7) * 8); } \
  }
  ATT_GLOAD(0)
  for (int t = 0; t < nt; t++) {
    __syncthreads();
#pragma unroll
    for (int i = 0; i < 3; i++) { int id = tid + 256 * i; int kr = id / 12, c = id - kr * 12; *(u32x4*)(Ks + kr * 104 + c * 8) = rk[i]; }
#pragma unroll
    for (int i = 0; i < 2; i++) { int id = tid + 256 * i; *(u32x4*)(Vs + (id >> 3) * 72 + (id & 7) * 8) = rv[i]; }
    __syncthreads();
    if (t + 1 < nt) ATT_GLOAD(t + 1)
    f32x16 s0, s1;
#pragma unroll
    for (int e = 0; e < 16; e++) { s0[e] = 0.f; s1[e] = 0.f; }
#pragma unroll
    for (int ks = 0; ks < 6; ks++) {
      bf16x8 k0 = *(const bf16x8*)(Ks + (r) * 104 + ks * 16 + h * 8);
      bf16x8 k1 = *(const bf16x8*)(Ks + (32 + r) * 104 + ks * 16 + h * 8);
      s0 = MFMA32(k0, qf[ks], s0);
      s1 = MFMA32(k1, qf[ks], s1);
    }
    float mx = s0[0];
#pragma unroll
    for (int e = 0; e < 16; e++) { mx = fmaxf(mx, s0[e]); mx = fmaxf(mx, s1[e]); }
    mx = fmaxf(mx, __shfl_xor(mx, 32));
    float mnew = fmaxf(m, mx);
    float alpha = __builtin_amdgcn_exp2f(m - mnew);
    float ps = 0.f;
#pragma unroll
    for (int e = 0; e < 16; e++) {
      s0[e] = __builtin_amdgcn_exp2f(s0[e] - mnew); ps += s0[e];
      s1[e] = __builtin_amdgcn_exp2f(s1[e] - mnew); ps += s1[e];
    }
    ps += __shfl_xor(ps, 32);
    lsum = lsum * alpha + ps;
    m = mnew;
#pragma unroll
    for (int e = 0; e < 16; e++) { o0[e] *= alpha; o1[e] *= alpha; }
#pragma unroll
    for (int kt2 = 0; kt2 < 2; kt2++) {
#pragma unroll
      for (int sx = 0; sx < 2; sx++) {
        u32x4 pw;
        if (kt2 == 0) {
          pw.x = pack2(s0[8 * sx + 0], s0[8 * sx + 1]); pw.y = pack2(s0[8 * sx + 2], s0[8 * sx + 3]);
          pw.z = pack2(s0[8 * sx + 4], s0[8 * sx + 5]); pw.w = pack2(s0[8 * sx + 6], s0[8 * sx + 7]);
        } else {
          pw.x = pack2(s1[8 * sx + 0], s1[8 * sx + 1]); pw.y = pack2(s1[8 * sx + 2], s1[8 * sx + 3]);
          pw.z = pack2(s1[8 * sx + 4], s1[8 * sx + 5]); pw.w = pack2(s1[8 * sx + 6], s1[8 * sx + 7]);
        }
        bf16x8 pb = __builtin_bit_cast(bf16x8, pw);
        int kb = kt2 * 32 + 16 * sx + 4 * h;
        {
          const u16* vp = Vs + (r) * 72 + kb;
          uint2 lo = *(const uint2*)vp, hi = *(const uint2*)(vp + 8);
          u32x4 vw = {lo.x, lo.y, hi.x, hi.y};
          o0 = MFMA32(__builtin_bit_cast(bf16x8, vw), pb, o0);
        }
        {
          const u16* vp = Vs + (32 + r) * 72 + kb;
          uint2 lo = *(const uint2*)vp, hi = *(const uint2*)(vp + 8);
          u32x4 vw = {lo.x, lo.y, hi.x, hi.y};
          o1 = MFMA32(__builtin_bit_cast(bf16x8, vw), pb, o1);
        }
      }
    }
  }
  const float inv = 1.f / lsum;
  u16* dst = MIX + (size_t)qrow * 1024 + 512 + hh * 64;
#pragma unroll
  for (int g = 0; g < 4; g++) {
    int e = 8 * g + 4 * h;
    *(uint2*)(dst + e) = make_uint2(pack2(o0[4 * g] * inv, o0[4 * g + 1] * inv), pack2(o0[4 * g + 2] * inv, o0[4 * g + 3] * inv));
    *(uint2*)(dst + 32 + e) = make_uint2(pack2(o1[4 * g] * inv, o1[4 * g + 1] * inv), pack2(o1[4 * g + 2] * inv, o1[4 * g + 3] * inv));
  }
  __syncthreads();
}

DI void ret_out_item(const Params& p, int l, int b, int hh, int ci, char* smem) {
  const u16* RET = (const u16*)(p.ws + OFF_RET);
  const float* ST = (const float*)(p.ws + OFF_ST);
  u16* MIX = (u16*)(p.ws + OFF_H);
  u16* Qs = (u16*)smem;
  u16* Ks = Qs + 128 * 72;
  u16* Ps = Qs;
  u16* VsT = Ks + 128 * 72;
  u16* SfT = VsT + 64 * 136;
  u16* SbT = SfT + 64 * 72;
  float* dmk = (float*)(SbT + 64 * 72);
  int tid_o = tidx();
  asm volatile("" : "+v"(tid_o));
  const int tid = tid_o, lane = tid & 63, wid = tid >> 6, r = lane & 31, h = lane >> 5;
  float lgf, lgb;
  ret_gammas(p, l, hh, lgf, lgb);
  const int row0 = chunk_row0(b, ci);
  { int d = tid - 128; dmk[tid] = d > 0 ? __expf(lgf * (float)d) : (d < 0 ? __expf(lgb * (float)(-d)) : 2.f); }
#pragma unroll 1
  for (int i = 0; i < 4; i++) {
    int id = tid + 256 * i, m = id >> 3, dc = id & 7;
    const u16* rp = RET + (size_t)(row0 + m) * 1024 + hh * 64 + dc * 8;
    *(uint4*)(Qs + m * 72 + dc * 8) = *(const uint4*)(rp);
    *(uint4*)(Ks + m * 72 + dc * 8) = *(const uint4*)(rp + 256);
    u32x4 vv = *(const u32x4*)(rp + 512);
#pragma unroll
    for (int j = 0; j < 8; j++) VsT[(dc * 8 + j) * 136 + m] = bfu(vv, j);
  }
  const float* Sf = ST + ((size_t)((0 * 4 + b) * 4 + hh) * NCH + ci) * 4096;
  const float* Sb = ST + ((size_t)((1 * 4 + b) * 4 + hh) * NCH + ci) * 4096;
#pragma unroll 2
  for (int i = 0; i < 16; i++) {
    int id = tid + 256 * i, d = id >> 6, e = id & 63;
    SfT[e * 72 + d] = f2bf(Sf[id]);
    SbT[e * 72 + d] = f2bf(Sb[id]);
  }
  __syncthreads();
  const int cw = wid * 32;
  f32x16 in0, in1, sc[4];
  {
    f32x16 cf0, cf1, cb0, cb1;
#pragma unroll
    for (int e = 0; e < 16; e++) { cf0[e] = cf1[e] = cb0[e] = cb1[e] = 0.f; }
#pragma unroll
    for (int ks = 0; ks < 4; ks++) {
      bf16x8 qa = *(const bf16x8*)(Qs + (cw + r) * 72 + ks * 16 + h * 8);
      cf0 = MFMA32(qa, *(const bf16x8*)(SfT + (r) * 72 + ks * 16 + h * 8), cf0);
      cf1 = MFMA32(qa, *(const bf16x8*)(SfT + (32 + r) * 72 + ks * 16 + h * 8), cf1);
      cb0 = MFMA32(qa, *(const bf16x8*)(SbT + (r) * 72 + ks * 16 + h * 8), cb0);
      cb1 = MFMA32(qa, *(const bf16x8*)(SbT + (32 + r) * 72 + ks * 16 + h * 8), cb1);
    }
#pragma unroll
    for (int reg = 0; reg < 16; reg++) {
      int c = cw + crow(reg, h);
      float xf = __expf(lgf * (float)(c + 1)), xb = __expf(lgb * (float)(128 - c));
      in0[reg] = xf * cf0[reg] + xb * cb0[reg];
      in1[reg] = xf * cf1[reg] + xb * cb1[reg];
    }
  }
#pragma unroll
  for (int e = 0; e < 16; e++) { sc[0][e] = sc[1][e] = sc[2][e] = sc[3][e] = 0.f; }
#pragma unroll
  for (int ks = 0; ks < 4; ks++) {
    bf16x8 qa = *(const bf16x8*)(Qs + (cw + r) * 72 + ks * 16 + h * 8);
#pragma unroll
    for (int mt = 0; mt < 4; mt++) sc[mt] = MFMA32(qa, *(const bf16x8*)(Ks + (mt * 32 + r) * 72 + ks * 16 + h * 8), sc[mt]);
  }
  __syncthreads();
#pragma unroll
  for (int mt = 0; mt < 4; mt++)
#pragma unroll
    for (int reg = 0; reg < 16; reg++) {
      int c = cw + crow(reg, h), mm = mt * 32 + r;
      Ps[c * 136 + mm] = f2bf(sc[mt][reg] * dmk[c - mm + 128]);
      if ((reg & 3) == 3) __builtin_amdgcn_sched_barrier(0);
    }
  __syncthreads();
#pragma unroll
  for (int ks = 0; ks < 8; ks++) {
    bf16x8 pa = *(const bf16x8*)(Ps + (cw + r) * 136 + ks * 16 + h * 8);
    in0 = MFMA32(pa, *(const bf16x8*)(VsT + (r) * 136 + ks * 16 + h * 8), in0);
    in1 = MFMA32(pa, *(const bf16x8*)(VsT + (32 + r) * 136 + ks * 16 + h * 8), in1);
  }
#pragma unroll
  for (int reg = 0; reg < 16; reg++) {
    int c = cw + crow(reg, h);
    float oa = in0[reg], ob = in1[reg];
    float ss = oa * oa + ob * ob;
    ss += __shfl_xor(ss, 1); ss += __shfl_xor(ss, 2); ss += __shfl_xor(ss, 4); ss += __shfl_xor(ss, 8); ss += __shfl_xor(ss, 16);
    float rstd = rsqrtf(ss * (1.f / 64.f) + 1e-6f);
    int rowi = row0 + c;
    asm volatile("" : "+v"(rowi));
    size_t row = (size_t)rowi;
    float g0 = bf2f(RET[row * 1024 + 768 + hh * 64 + r]), g1 = bf2f(RET[row * 1024 + 768 + hh * 64 + 32 + r]);
    MIX[row * 1024 + 256 + hh * 64 + r] = f2bf(silu_f(g0) * oa * rstd);
    MIX[row * 1024 + 256 + hh * 64 + 32 + r] = f2bf(silu_f(g1) * ob * rstd);
    __builtin_amdgcn_sched_barrier(0);
  }
  __syncthreads();
}

typedef _Float16 h2_t __attribute__((ext_vector_type(2)));
DI unsigned packh(float a, float b) { h2_t v; v[0] = (_Float16)a; v[1] = (_Float16)b; return __builtin_bit_cast(unsigned, v); }
template <class ZF, class CF>
DI void hy_conv(float2* X, const float2* __restrict__ TW, const float2* __restrict__ Ke, const float2* __restrict__ Ko,
                ZF zf, CF consume, int tid) {
  const float scl = 0.5f / 8192.f;
#pragma unroll 2
  for (int i = 0; i < 32; i++) { int n = tidx() + 256 * i; X[PX(n)] = zf(n); }
  __syncthreads();
  fft_dif(X, TW, tid);
#pragma unroll 2
  for (int i = 0; i < 32; i++) { int k = tidx() + 256 * i; float2 a = X[PX(k)], w = Ke[k]; X[PX(k)] = make_float2(a.x * w.x - a.y * w.y, a.x * w.y + a.y * w.x); }
  __syncthreads();
  fft_dit(X, TW, tid);
  unsigned ye[32];
#pragma unroll
  for (int i = 0; i < 32; i++) { int n = tidx() + 256 * i; asm volatile("" : "+v"(n)); float2 e = X[PX(n)]; unsigned pk = packh(e.x * scl, e.y * scl); asm volatile("" : "+v"(pk)); ye[i] = pk; if ((i & 1) == 1) __builtin_amdgcn_sched_barrier(0); }
  __syncthreads();
#pragma unroll 2
  for (int i = 0; i < 32; i++) { int n = tidx() + 256 * i; float2 z = zf(n), w = TW[n]; X[PX(n)] = make_float2(z.x * w.x - z.y * w.y, z.x * w.y + z.y * w.x); }
  __syncthreads();
  fft_dif(X, TW, tid);
#pragma unroll 2
  for (int i = 0; i < 32; i++) { int k = tidx() + 256 * i; float2 a = X[PX(k)], w = Ko[k]; X[PX(k)] = make_float2(a.x * w.x - a.y * w.y, a.x * w.y + a.y * w.x); }
  __syncthreads();
  fft_dit(X, TW, tid);
#pragma unroll
  for (int i = 0; i < 32; i++) {
    int n = tidx() + 256 * i;
    asm volatile("" : "+v"(n));
    float2 o = X[PX(n)], w = TW[n];
    float tx = o.x * w.x + o.y * w.y, ty = o.y * w.x - o.x * w.y;
    h2_t e = __builtin_bit_cast(h2_t, ye[i]);
    consume(n, (float)e[0] + tx * scl, (float)e[1] + ty * scl);
    __builtin_amdgcn_sched_barrier(0);
  }
  __syncthreads();
}

DI float sconv_at(const u16* __restrict__ u, int n, int Ls, float w0, float w1, float w2, float bias) {
  float um = n > 0 ? bf2f(u[n - 1]) : 0.f, uc = bf2f(u[n]), up = n < Ls - 1 ? bf2f(u[n + 1]) : 0.f;
  return bias + w0 * um + w1 * uc + w2 * up;
}

DI void hyena_item(const Params& p, int l, int c, int pair, char* smem) {
  float2* X = (float2*)smem;
  const float2* TW = (const float2*)(p.ws + OFF_TW);
  const float2* KS = (const float2*)(p.ws + OFF_KSPEC);
  const u16* UT = (const u16*)(p.ws + OFF_UT);
  u16* YT = (u16*)(p.ws + OFF_CQ);
  int tid_o = tidx();
  asm volatile("" : "+v"(tid_o));
  const int tid = tid_o;
  const float* cw = p.in[I_HCW] + l * 3 * 768;
  const float* cb = p.in[I_HCB] + l * 768;
  const int b0 = 2 * pair, b1 = b0 + 1;
  u16* y0 = YT + (size_t)(b0 * 256 + c) * SEQ;
  u16* y1 = YT + (size_t)(b1 * 256 + c) * SEQ;
  const float vw0 = cw[512 + c], vw1 = cw[768 + 512 + c], vw2 = cw[1536 + 512 + c], vbs = cb[512 + c];
  const u16* v0p = UT + (size_t)(b0 * 768 + 512 + c) * SEQ;
  const u16* v1p = UT + (size_t)(b1 * 768 + 512 + c) * SEQ;
  {
    const float w0 = cw[c], w1 = cw[768 + c], w2 = cw[1536 + c], bs = cb[c];
    const float bias0 = p.in[I_HBIAS][(l * 2 + 0) * 256 + c];
    const u16* u0 = UT + (size_t)(b0 * 768 + c) * SEQ;
    const u16* u1 = UT + (size_t)(b1 * 768 + c) * SEQ;
    hy_conv(X, TW, KS + (size_t)(0 * 256 + c) * 2 * 8192, KS + (size_t)(0 * 256 + c) * 2 * 8192 + 8192,
            [&](int n) __attribute__((always_inline)) { return make_float2(sconv_at(v0p, n, SEQ, vw0, vw1, vw2, vbs), sconv_at(v1p, n, SEQ, vw0, vw1, vw2, vbs)); },
            [&](int n, float ya, float yb) __attribute__((always_inline)) {
              float va = sconv_at(v0p, n, SEQ, vw0, vw1, vw2, vbs), vb = sconv_at(v1p, n, SEQ, vw0, vw1, vw2, vbs);
              y0[n] = f2bf(sconv_at(u0, n, SEQ, w0, w1, w2, bs) * (ya + va * bias0));
              y1[n] = f2bf(sconv_at(u1, n, SEQ, w0, w1, w2, bs) * (yb + vb * bias0));
            }, tid);
  }
  {
    const int col = 256 + c;
    const float w0 = cw[col], w1 = cw[768 + col], w2 = cw[1536 + col], bs = cb[col];
    const float bias1 = p.in[I_HBIAS][(l * 2 + 1) * 256 + c];
    const u16* u0 = UT + (size_t)(b0 * 768 + col) * SEQ;
    const u16* u1 = UT + (size_t)(b1 * 768 + col) * SEQ;
    hy_conv(X, TW, KS + (size_t)(1 * 256 + c) * 2 * 8192, KS + (size_t)(1 * 256 + c) * 2 * 8192 + 8192,
            [&](int n) __attribute__((always_inline)) { return make_float2(bf2f(y0[n]), bf2f(y1[n])); },
            [&](int n, float ya, float yb) __attribute__((always_inline)) {
              float za = bf2f(y0[n]), zb = bf2f(y1[n]);
              y0[n] = f2bf(sconv_at(u0, n, SEQ, w0, w1, w2, bs) * (ya + za * bias1));
              y1[n] = f2bf(sconv_at(u1, n, SEQ, w0, w1, w2, bs) * (yb + zb * bias1));
            }, tid);
  }
}

DI void hyena_ctx_item(const Params& p, int l, int b, int c, char* smem) {
  float* k0s = (float*)smem;
  float* k1s = k0s + 512;
  float* vs = k1s + 512;
  float* zs = vs + 256;
  const float* KC = (const float*)(p.ws + OFF_KC);
  const u16* UTC = (const u16*)(p.ws + OFF_UTC);
  u16* MIX = (u16*)(p.ws + OFF_H);
  int tid_o = tidx();
  asm volatile("" : "+v"(tid_o));
  const int n = tid_o;
  const float* cw = p.in[I_HCW] + l * 3 * 768;
  const float* cb = p.in[I_HCB] + l * 768;
  k0s[n] = KC[(size_t)(0 * 256 + c) * 512 + n]; k0s[256 + n] = KC[(size_t)(0 * 256 + c) * 512 + 256 + n];
  k1s[n] = KC[(size_t)(1 * 256 + c) * 512 + n]; k1s[256 + n] = KC[(size_t)(1 * 256 + c) * 512 + 256 + n];
  float v = sconv_at(UTC + (size_t)(b * 768 + 512 + c) * LCTX, n, LCTX, cw[512 + c], cw[768 + 512 + c], cw[1536 + 512 + c], cb[512 + c]);
  float x1 = sconv_at(UTC + (size_t)(b * 768 + c) * LCTX, n, LCTX, cw[c], cw[768 + c], cw[1536 + c], cb[c]);
  float x2 = sconv_at(UTC + (size_t)(b * 768 + 256 + c) * LCTX, n, LCTX, cw[256 + c], cw[768 + 256 + c], cw[1536 + 256 + c], cb[256 + c]);
  vs[n] = v;
  __syncthreads();
  float a = 0.f;
  for (int s = 0; s < 256; s++) a += k0s[n - s + 256] * vs[s];
  float z = x1 * (a + v * p.in[I_HBIAS][(l * 2 + 0) * 256 + c]);
  zs[n] = z;
  __syncthreads();
  float a2 = 0.f;
  for (int s = 0; s < 256; s++) a2 += k1s[n - s + 256] * zs[s];
  float y = x2 * (a2 + z * p.in[I_HBIAS][(l * 2 + 1) * 256 + c]);
  MIX[(size_t)(TLAT + b * LCTX + n) * 1024 + c] = f2bf(y);
  __syncthreads();
}

DI void phase_p4(const Params& p, int l, char* smem, int submask = 15) {
  const int n_al = 2048, n_ac = (l == 0 ? 64 : 0), n_hy = 512, n_r3 = (l == 0 ? 16 * NCH : 16 * 64), n_hc = (l == 0 ? 1024 : 0);
  const int total = n_al + n_ac + n_hy + n_r3 + n_hc;
  for (int it = blockIdx.x; it < total; it += gridDim.x) {
    int q = it;
    if (q < n_al) {
      int b = q >> 9, hh = (q >> 6) & 7, qb = q & 63;
      if (SUB_ON(0) && (submask & 1)) attn_item(p, b, hh, b * SEQ + qb * 128, 0, LKEY, smem);
    } else if ((q -= n_al) < n_ac) {
      int b = q >> 4, hh = (q >> 1) & 7, qb = q & 1;
      if (SUB_ON(0) && (submask & 1)) attn_item(p, b, hh, TLAT + b * LCTX + qb * 128, SEQ, LCTX, smem);
    } else if ((q -= n_ac) < n_hy) {
      if (SUB_ON(1) && (submask & 2)) hyena_item(p, l, q >> 1, q & 1, smem);
    } else if ((q -= n_hy) < n_r3) {
      int bh, ci;
      if (l == 0) { bh = q / NCH; ci = q - bh * NCH; } else { bh = q >> 6; ci = 2 + (q & 63); }
      if (SUB_ON(2) && (submask & 4)) ret_out_item(p, l, bh >> 2, bh & 3, ci, smem);
    } else {
      q -= n_r3;
      if (SUB_ON(3) && (submask & 8)) hyena_ctx_item(p, l, q >> 8, q & 255, smem);
    }
  }
}

DI void phase_res_gemm(const Params& p, int l, int which  , char* smem) {
  const int lane = tidx() & 63, r = lane & 31, h = lane >> 5;
  const int nmt = (l == 0 ? 132 : 128);
  const char* wl = p.ws + OFF_W + (size_t)l * WL_SIZE;
  const u16* A = (const u16*)(p.ws + (which == 1 ? OFF_H : OFF_ACT));
  const int K = which == 1 ? 1024 : 4096;
  const u16* Bt = (const u16*)(wl + (which == 1 ? WL_WOUT : WL_W2));
  const bool first = (l == 0 && which == 1);
  const float* mod = (const float*)(p.ws + OFF_MOD);
  float* XC = (float*)(p.ws + OFF_XC);
  const int total = nmt * 8;
  for (int it = blockIdx.x; it < total; it += gridDim.x) {
    int mt = it >> 3, nt = it & 7;
    int m0 = mt * 256;
    const u16* at = nullptr;
    if (which == 1 && m0 < TLAT) at = (const u16*)(p.ws + OFF_CQ) + (size_t)((m0 >> 13) * 256) * SEQ + (m0 & 8191);
    int cond = m0 < TLAT ? (m0 >> 13) : 4;
    const float* ga = mod + (size_t)(l * 5 + cond) * 6144 + (which == 1 ? 2048 : 5120);
    const float* src; float* dst;
    if (m0 < TLAT) { src = first ? p.in[I_X] : p.out; dst = p.out; }
    else { src = (first ? p.in[I_CTX] : XC) - (size_t)TLAT * 1024; dst = XC - (size_t)TLAT * 1024; }
    gemm_tile<false, false, false>(A, K, Bt, K, K, m0, nt * 128, at, 8, smem,
      [&](int bm, int bn, const f32x16& acc, const float*) __attribute__((always_inline)) {
        int col = bn + r;
        float g = ga[col];
#pragma unroll
        for (int reg = 0; reg < 16; reg++) {
          size_t idx = (size_t)(bm + crow(reg, h)) * 1024 + col;
          dst[idx] = src[idx] + g * acc[reg];
        }
      });
  }
}

DI void phase_mlp1(const Params& p, int l, char* smem) {
  const int lane = tidx() & 63, r = lane & 31, h = lane >> 5;
  const int nmt = (l == 0 ? 132 : 128);
  const u16* A = (const u16*)(p.ws + OFF_H);
  const u16* Bt = (const u16*)(p.ws + OFF_W + (size_t)l * WL_SIZE + WL_W1);
  u16* ACT = (u16*)(p.ws + OFF_ACT);
  const int total = nmt * 32;
  for (int it = blockIdx.x; it < total; it += gridDim.x) {
    int mt = it >> 5, nt = it & 31;
    gemm_tile<false, false, false>(A, 1024, Bt, 1024, 1024, mt * 256, nt * 128, nullptr, 0, smem,
      [&](int bm, int bn, const f32x16& acc, const float*) __attribute__((always_inline)) {
        int col = bn + r;
#pragma unroll
        for (int reg = 0; reg < 16; reg++) {
          float v = fmaxf(acc[reg], 0.f);
          ACT[(size_t)(bm + crow(reg, h)) * 4096 + col] = f2bf(v * v);
        }
      });
  }
}

DI void phase_final(const Params& p) {
  const int lane = tidx() & 63, wid = tidx() >> 6;
  const float* g = p.in[I_FNG];
  for (int it = blockIdx.x; it < TLAT / 4; it += gridDim.x) {
    float* row = p.out + (size_t)(it * 4 + wid) * 1024;
    float4 v[4];
    float ssq = 0.f;
#pragma unroll
    for (int i = 0; i < 4; i++) {
      v[i] = *(const float4*)(row + i * 256 + lane * 4);
      ssq += v[i].x * v[i].x + v[i].y * v[i].y + v[i].z * v[i].z + v[i].w * v[i].w;
    }
    ssq = wave_sum(ssq);
    float rstd = rsqrtf(ssq * (1.f / 1024.f) + 1e-6f);
#pragma unroll
    for (int i = 0; i < 4; i++) {
      float4 gg = *(const float4*)(g + i * 256 + lane * 4);
      *(float4*)(row + i * 256 + lane * 4) = make_float4(v[i].x * rstd * gg.x, v[i].y * rstd * gg.y, v[i].z * rstd * gg.z, v[i].w * rstd * gg.w);
    }
  }
}

constexpr int NPHASE = 20;
#ifndef ONLY_PHASE
#define ONLY_PHASE -1
#endif
#define PH_ON(k) (ONLY_PHASE < 0 || ONLY_PHASE == (k))
DI void run_phase(const Params& p, int ph, char* smem, int submask = 15) {
  if (ph == 0) { if (PH_ON(0)) phase_s0(p, smem); return; }
  if (ph == NPHASE - 1) { if (PH_ON(8)) phase_final(p); return; }
  int l = (ph - 1) / 9, s = (ph - 1) % 9;
  switch (s) {
    case 0: if (PH_ON(1)) phase_norm(p, l, 1, TALL, true); break;
    case 1: if (PH_ON(2)) phase_win(p, l, smem); break;
    case 2: if (PH_ON(3)) phase_p3(p, l, smem); break;
    case 3: if (PH_ON(4)) phase_scan(p, l); break;
    case 4: if (PH_ON(5)) phase_p4(p, l, smem, submask); break;
    case 5: if (PH_ON(6)) phase_res_gemm(p, l, 1, smem); break;
    case 6: if (PH_ON(1)) phase_norm(p, l, 2, l == 0 ? TALL : TLAT, false); break;
    case 7: if (PH_ON(7)) phase_mlp1(p, l, smem); break;
    default: if (PH_ON(6)) phase_res_gemm(p, l, 2, smem); break;
  }
}

#if !MULTI_LAUNCH
extern "C" __global__ void __launch_bounds__(256, 2) mk_all(Params p) {
  extern __shared__ __attribute__((aligned(16))) char smem[];
  cg::grid_group grid = cg::this_grid();
  for (int ph = 0; ph < NPHASE; ph++) {
    run_phase(p, ph, smem);
#ifdef PROBE_DUP
    if (ph == PROBE_DUP || ph == PROBE_DUP2) { grid.sync(); run_phase(p, ph, smem, PROBE_MASK); }
#endif
    if (ph + 1 < NPHASE) grid.sync();
  }
}
#define MK_KERNEL mk_all
#else
#define MK_KERNEL mk_phase
extern "C" __global__ void __launch_bounds__(256, 2) mk_phase(Params p, int ph) {
  extern __shared__ __attribute__((aligned(16))) char smem[];
  run_phase(p, ph, smem);
}
#endif

extern "C" void kernel_launch(void* const* d_in, const int* in_sizes, int n_in, void* d_out, int out_size, void* d_ws, size_t ws_size,
                              hipStream_t stream) {
  Params p{};
  for (int i = 0; i < 27; i++) p.in[i] = (const float*)d_in[i];
  p.out = (float*)d_out;
  p.ws = (char*)d_ws;
  static int grid_blocks = 0;
  if (!grid_blocks) {
    int dev = 0, cus = 0, per_cu = 0;
    (void)hipGetDevice(&dev);
    (void)hipDeviceGetAttribute(&cus, hipDeviceAttributeMultiprocessorCount, dev);
    (void)hipFuncSetAttribute((const void*)MK_KERNEL, hipFuncAttributeMaxDynamicSharedMemorySize, SMEM_BYTES);
    (void)hipOccupancyMaxActiveBlocksPerMultiprocessor(&per_cu, MK_KERNEL, 256, SMEM_BYTES);
    if (per_cu < 1) per_cu = 1;
    if (per_cu > 2) per_cu = 2;
    grid_blocks = cus * per_cu;
  }
#if MULTI_LAUNCH
  for (int ph = 0; ph < NPHASE; ph++) hipLaunchKernelGGL(mk_phase, dim3(grid_blocks), dim3(256), SMEM_BYTES, stream, p, ph);
#else
  void* args[] = {&p};
  (void)hipLaunchCooperativeKernel((void*)mk_all, dim3(grid_blocks), dim3(256), args, SMEM_BYTES, stream);
#endif
}
```

```cpp
#include <hip/hip_runtime.h>
#include <hip/hip_cooperative_groups.h>
namespace cg = cooperative_groups;

#ifndef MULTI_LAUNCH
#define MULTI_LAUNCH 0
#endif

#define DI __device__ __forceinline__
#define NI __device__ __noinline__
typedef unsigned short u16;
typedef short bf16x8 __attribute__((ext_vector_type(8)));
typedef float f32x16 __attribute__((ext_vector_type(16)));
typedef __bf16 bf2_t __attribute__((ext_vector_type(2)));
typedef unsigned u32x4 __attribute__((ext_vector_type(4)));
#define MFMA32(a, b, c) __builtin_amdgcn_mfma_f32_32x32x16_bf16((a), (b), (c), 0, 0, 0)

constexpr int NB = 4, SEQ = 8192, LCTX = 256, DM = 1024, DFF = 4096;
constexpr int TLAT = NB * SEQ;
constexpr int TALL = TLAT + NB * LCTX;
constexpr int NIN = 2208, NINP = 2304;
constexpr int LKEY = SEQ + LCTX;
constexpr int NCH = 66;
constexpr int SMEM_BYTES = 73728;
#ifndef SUBSEL
#define SUBSEL -1
#endif
#define SUB_ON(k) (SUBSEL < 0 || SUBSEL == (k))

constexpr size_t WL_WIN = 0;
constexpr size_t WL_WOUT = WL_WIN + (size_t)NINP * 1024 * 2;
constexpr size_t WL_W1 = WL_WOUT + (size_t)1024 * 1024 * 2;
constexpr size_t WL_W2 = WL_W1 + (size_t)4096 * 1024 * 2;
constexpr size_t WL_WUQ = WL_W2 + (size_t)1024 * 4096 * 2;
constexpr size_t WL_WUKV = WL_WUQ + (size_t)768 * 256 * 2;
constexpr size_t WL_SIZE = WL_WUKV + (size_t)1024 * 128 * 2;
constexpr size_t OFF_W = 0;
constexpr size_t OFF_MOD = OFF_W + 2 * WL_SIZE;
constexpr size_t OFF_TW = OFF_MOD + (size_t)2 * 5 * 6144 * 4;
constexpr size_t OFF_ROPE = OFF_TW + 65536;
constexpr size_t OFF_XC = OFF_ROPE + 192 * 8 * 8 + 4096;
constexpr size_t OFF_H = OFF_XC + (size_t)1024 * 1024 * 4;
constexpr size_t OFF_H2F = OFF_H + (size_t)TALL * 1024 * 2;
constexpr size_t OFF_H2C = OFF_H2F + (size_t)8192 * 64 * 4;
constexpr size_t OFF_KC = OFF_H2C + (size_t)256 * 64 * 4;
constexpr size_t OFF_BIG = OFF_KC + (size_t)2 * 256 * 512 * 4;
constexpr size_t OFF_UT = OFF_BIG;
constexpr size_t OFF_UTC = OFF_UT + (size_t)NB * 768 * SEQ * 2;
constexpr size_t OFF_RET = OFF_UTC + (size_t)NB * 768 * LCTX * 2;
constexpr size_t OFF_CQ = OFF_RET + (size_t)TALL * 1024 * 2;
constexpr size_t OFF_CKV = OFF_CQ + (size_t)TALL * 256 * 2;
constexpr size_t OFF_Q = OFF_CKV + (size_t)TALL * 128 * 2;
constexpr size_t OFF_KF = OFF_Q + (size_t)TALL * 768 * 2;
constexpr size_t OFF_VT = OFF_KF + (size_t)NB * 8 * LKEY * 96 * 2;
constexpr size_t OFF_ST = OFF_VT + (size_t)NB * 8 * 64 * LKEY * 2;
constexpr size_t OFF_KSPEC = OFF_ST + (size_t)2 * 16 * NCH * 4096 * 4;
constexpr size_t OFF_END = OFF_KSPEC + (size_t)2 * 256 * 2 * 8192 * 8;
constexpr size_t OFF_ACT = OFF_BIG;
static_assert(OFF_ACT + (size_t)TALL * 4096 * 2 <= OFF_END, "act fits");
static_assert(OFF_END <= (size_t)536870912, "workspace");

struct Params {
  const float* in[27];
  float* out;
  char* ws;
};
enum { I_X = 0, I_C, I_CTX, I_CCTX, I_WADA, I_BADA, I_N1G, I_N2G, I_WIN, I_WOUT, I_HCW, I_HCB, I_HW1, I_HB1, I_HSF, I_HW2,
       I_HB2, I_HW3, I_HBIAS, I_RLD, I_QNG, I_WUQ, I_KVNG, I_WUKV, I_W1, I_W2, I_FNG };

DI int tidx() { int t = __builtin_amdgcn_workitem_id_x(); asm volatile("" : "+v"(t)); return t; }
DI u16 f2bf(float x) { return __builtin_bit_cast(u16, (__bf16)x); }
DI float bf2f(u16 v) { return __uint_as_float(((unsigned)v) << 16); }
DI unsigned pack2(float a, float b) { bf2_t v; v[0] = (__bf16)a; v[1] = (__bf16)b; return __builtin_bit_cast(unsigned, v); }
DI float wave_sum(float v) {
#pragma unroll
  for (int o = 32; o > 0; o >>= 1) v += __shfl_xor(v, o);
  return v;
}
DI int crow(int reg, int h) { return (reg & 3) + 8 * (reg >> 2) + 4 * h; }
DI float bfe(u32x4 v, int j) {
  unsigned w = v[j >> 1];
  return __uint_as_float((j & 1) ? (w & 0xffff0000u) : (w << 16));
}
DI u16 bfu(u32x4 v, int j) {
  unsigned w = v[j >> 1];
  return (u16)((j & 1) ? (w >> 16) : (w & 0xffffu));
}
DI float silu_f(float x) { return x / (1.f + __expf(-x)); }
DI void row_info(int row, int& b, int& t, int& key, int& cond) {
  if (row < TLAT) { b = row >> 13; t = row & 8191; key = t; cond = b; }
  else { int rc = row - TLAT; b = rc >> 8; t = rc & 255; key = SEQ + t; cond = 4; }
}
DI int chunk_row0(int b, int ci) { return ci < 2 ? TLAT + b * LCTX + ci * 128 : b * SEQ + (ci - 2) * 128; }
DI float rope_apply(const float2* __restrict__ tab, float val, int jj, int t) {
  float partner = __shfl_xor(val, 8);
  int pos = (jj & 16) ? 128 + (t & 63) : (t >> 6);
  float2 cs = tab[pos * 8 + (jj & 7)];
  return (jj & 8) ? (val * cs.x + partner * cs.y) : (val * cs.x - partner * cs.y);
}

DI void convT_item(const float* __restrict__ src, u16* __restrict__ dst, int K, int N, int Npad, const float* __restrict__ gain,
                   int item, float* tile, bool perm = false) {
  int ntn = Npad >> 6;
  int kt = item / ntn, nt = item - kt * ntn;
  int k0 = kt * 64, n0 = nt * 64;
  int c = tidx() & 63, q = tidx() >> 6;
#pragma unroll 4
  for (int i = 0; i < 16; i++) {
    int kk = i * 4 + q, n = n0 + c;
    float v = 0.f;
    if (n < N) { int sn = perm ? ((n & 511) >> 6) * 128 + (n >> 9) * 64 + (n & 63) : n; v = src[(size_t)(k0 + kk) * N + sn]; if (gain) v *= gain[k0 + kk]; }
    tile[kk * 65 + c] = v;
  }
  __syncthreads();
#pragma unroll 4
  for (int i = 0; i < 16; i++) {
    int nn = i * 4 + q;
    dst[(size_t)(n0 + nn) * K + k0 + c] = f2bf(tile[c * 65 + nn]);
  }
  __syncthreads();
}

DI void phase_s0(const Params& p, char* smem) {
  const int per_layer = 576 + 256 + 1024 + 1024 + 48 + 32;
  const int n_conv = 2 * per_layer, n_mod = 2 * 96, n_tw = 32 + 6;
  const int total = n_conv + n_mod + n_tw;
  for (int it = blockIdx.x; it < total; it += gridDim.x) {
    if (it < n_conv) {
      int l = it / per_layer, r = it - l * per_layer;
      char* wl = p.ws + OFF_W + (size_t)l * WL_SIZE;
      float* tile = (float*)smem;
      if (r < 576) convT_item(p.in[I_WIN] + (size_t)l * 1024 * NIN, (u16*)(wl + WL_WIN), 1024, NIN, NINP, nullptr, r, tile);
      else if ((r -= 576) < 256) convT_item(p.in[I_WOUT] + (size_t)l * 1024 * 1024, (u16*)(wl + WL_WOUT), 1024, 1024, 1024, nullptr, r, tile);
      else if ((r -= 256) < 1024) convT_item(p.in[I_W1] + (size_t)l * 1024 * 4096, (u16*)(wl + WL_W1), 1024, 4096, 4096, nullptr, r, tile);
      else if ((r -= 1024) < 1024) convT_item(p.in[I_W2] + (size_t)l * 4096 * 1024, (u16*)(wl + WL_W2), 4096, 1024, 1024, nullptr, r, tile);
      else if ((r -= 1024) < 48) convT_item(p.in[I_WUQ] + (size_t)l * 256 * 768, (u16*)(wl + WL_WUQ), 256, 768, 768, p.in[I_QNG] + l * 256, r, tile);
      else { r -= 48; convT_item(p.in[I_WUKV] + (size_t)l * 128 * 1024, (u16*)(wl + WL_WUKV), 128, 1024, 1024, p.in[I_KVNG] + l * 128, r, tile, true); }
    } else if (it < n_conv + n_mod) {
      int r = it - n_conv;
      int l = r / 96, n0 = (r - l * 96) * 64;
      float* sc = (float*)smem;
      float* red = sc + 5120;
      for (int i = tidx(); i < 5120; i += 256) {
        int rr = i >> 10, k = i & 1023;
        float cv = rr < 4 ? p.in[I_C][rr * 1024 + k] : p.in[I_CCTX][k];
        sc[i] = cv / (1.f + expf(-cv));
      }
      __syncthreads();
      int nn = tidx() & 63, kq = tidx() >> 6;
      float a0 = 0, a1 = 0, a2 = 0, a3 = 0, a4 = 0;
      const float* w = p.in[I_WADA] + ((size_t)l * 1024 + kq * 256) * 6144 + n0 + nn;
      for (int k = 0; k < 256; k++) {
        float wv = w[(size_t)k * 6144];
        int kk = kq * 256 + k;
        a0 += sc[kk] * wv; a1 += sc[1024 + kk] * wv; a2 += sc[2048 + kk] * wv; a3 += sc[3072 + kk] * wv; a4 += sc[4096 + kk] * wv;
      }
      red[(kq * 5 + 0) * 64 + nn] = a0; red[(kq * 5 + 1) * 64 + nn] = a1; red[(kq * 5 + 2) * 64 + nn] = a2;
      red[(kq * 5 + 3) * 64 + nn] = a3; red[(kq * 5 + 4) * 64 + nn] = a4;
      __syncthreads();
      if (tidx() < 64) {
        float* mod = (float*)(p.ws + OFF_MOD);
        float bb = p.in[I_BADA][l * 6144 + n0 + nn];
        for (int rr = 0; rr < 5; rr++) {
          float s = red[(0 * 5 + rr) * 64 + nn] + red[(1 * 5 + rr) * 64 + nn] + red[(2 * 5 + rr) * 64 + nn] + red[(3 * 5 + rr) * 64 + nn];
          mod[(size_t)(l * 5 + rr) * 6144 + n0 + nn] = s + bb;
        }
      }
      __syncthreads();
    } else {
      int q = it - n_conv - n_mod;
      if (q < 32) {
        int n = q * 256 + tidx();
        float sn, cs;
        sincospif((float)n / 8192.f, &sn, &cs);
        ((float2*)(p.ws + OFF_TW))[n] = make_float2(cs, -sn);
      } else {
        int e = (q - 32) * 256 + tidx();
        int pos = e >> 3, f = e & 7;
        float pv = pos < 128 ? (float)pos : (float)(pos - 128);
        float inv = powf(10000.f, -(float)f / 8.f);
        float sn, cs;
        sincosf(pv * inv, &sn, &cs);
        ((float2*)(p.ws + OFF_ROPE))[e] = make_float2(cs, sn);
      }
    }
  }
}

DI void filt_a_item(const Params& p, int l, int Lf, float* h2out, int pos) {
  int lane = tidx() & 63;
  float tpos = (float)pos / (float)(Lf - 1);
  float zval = 0.f;
  if (lane == 0) zval = tpos;
  else if (lane < 33) {
    int jj = (lane - 1) & 15;
    float band = 1e-4f + (float)jj * ((15.f - 1e-4f) / 15.f);
    float ang = ((float)(6.283185307179586 / (double)Lf)) * (float)pos * band;
    zval = lane < 17 ? cosf(ang) : -sinf(ang);
  }
  const float* w1 = p.in[I_HW1] + l * 33 * 64;
  const float* w2 = p.in[I_HW2] + l * 64 * 64;
  float acc = p.in[I_HB1][l * 64 + lane];
  for (int i = 0; i < 33; i++) acc += __shfl(zval, i) * w1[i * 64 + lane];
  float h1 = sinf(p.in[I_HSF][l * 128 + lane] * acc);
  float acc2 = p.in[I_HB2][l * 64 + lane];
  for (int i = 0; i < 64; i++) acc2 += __shfl(h1, i) * w2[i * 64 + lane];
  h2out[(size_t)pos * 64 + lane] = sinf(p.in[I_HSF][l * 128 + 64 + lane] * acc2);
}

DI void phase_norm(const Params& p, int l, int which, int nrows, bool with_filter) {
  const int lane = tidx() & 63, wid = tidx() >> 6;
  const bool first = (l == 0 && which == 1);
  const int n_norm = nrows >> 2;
  const int n_fa = with_filter ? (8192 / 4 + (l == 0 ? 256 / 4 : 0)) : 0;
  const float* gsrc = p.in[which == 1 ? I_N1G : I_N2G] + l * 1024;
  u16* H = (u16*)(p.ws + OFF_H);
  for (int it = blockIdx.x; it < n_norm + n_fa; it += gridDim.x) {
    if (it < n_norm) {
      int row = it * 4 + wid;
      const float* src;
      int cond;
      if (row < TLAT) { src = (first ? p.in[I_X] : p.out) + (size_t)row * 1024; cond = row >> 13; }
      else { src = (first ? p.in[I_CTX] : (const float*)(p.ws + OFF_XC)) + (size_t)(row - TLAT) * 1024; cond = 4; }
      const float* m = (const float*)(p.ws + OFF_MOD) + (size_t)(l * 5 + cond) * 6144 + (which == 1 ? 0 : 3072);
      float4 v[4];
      float ssq = 0.f;
#pragma unroll
      for (int i = 0; i < 4; i++) {
        v[i] = *(const float4*)(src + i * 256 + lane * 4);
        ssq += v[i].x * v[i].x + v[i].y * v[i].y + v[i].z * v[i].z + v[i].w * v[i].w;
      }
      ssq = wave_sum(ssq);
      float rstd = rsqrtf(ssq * (1.f / 1024.f) + 1e-6f);
#pragma unroll
      for (int i = 0; i < 4; i++) {
        int col = i * 256 + lane * 4;
        float4 g = *(const float4*)(gsrc + col), sh = *(const float4*)(m + col), sc = *(const float4*)(m + 1024 + col);
        float o0 = v[i].x * rstd * g.x * (1.f + sc.x) + sh.x, o1 = v[i].y * rstd * g.y * (1.f + sc.y) + sh.y;
        float o2 = v[i].z * rstd * g.z * (1.f + sc.z) + sh.z, o3 = v[i].w * rstd * g.w * (1.f + sc.w) + sh.w;
        *(uint2*)(H + (size_t)row * 1024 + col) = make_uint2(pack2(o0, o1), pack2(o2, o3));
      }
    } else {
      int q = it - n_norm;
      if (q < 2048) filt_a_item(p, l, 8192, (float*)(p.ws + OFF_H2F), q * 4 + wid);
      else filt_a_item(p, l, 256, (float*)(p.ws + OFF_H2C), (q - 2048) * 4 + wid);
    }
  }
}

constexpr int GLD = 40;
constexpr int GBUF = (256 + 128) * GLD;
template <bool ROWNORM, bool TR0, bool TR1, class Epi>
DI void gemm_tile(const u16* __restrict__ A, int lda, const u16* __restrict__ Bt, int ldb, int K, int m0, int n0,
                  const u16* __restrict__ at_src, int at_kt, char* smem, Epi epi) {
  u16* Ls = (u16*)smem;
  float* rs = (float*)(Ls + 2 * GBUF);
  int tid_o = tidx();
  const int tid = tid_o, lane = tid & 63, wid = tid >> 6, wm = wid >> 1, wn = wid & 1, r = lane & 31, h = lane >> 5;
  const bool trans = (TR0 == TR1) ? TR0 : (wn ? TR1 : TR0);
  f32x16 acc[4][2];
#pragma unroll
  for (int mi = 0; mi < 4; mi++)
#pragma unroll
    for (int ni = 0; ni < 2; ni++)
#pragma unroll
      for (int e = 0; e < 16; e++) acc[mi][ni][e] = 0.f;
  u32x4 ra0[4], rb0[2], ra1[4], rb1[2];
  float ssq[4];
#pragma unroll
  for (int i = 0; i < 4; i++) ssq[i] = 0.f;
  const int nk = K >> 5;
  const int lrow = tid >> 2, lkc = tid & 3;
  const int tch = tid & 31, ttc = tid >> 5;
  const bool has_at = at_src != nullptr;
#define GEMM_GLOAD(KT, RA, RB)                                                                                              \
  {                                                                                                                         \
    const int kt_ = (KT);                                                                                                   \
    if (has_at && kt_ < at_kt) {                                                                                            \
      _Pragma("unroll") for (int i = 0; i < 4; i++) RA[i] = *(const u32x4*)(at_src + (size_t)(kt_ * 32 + tch) * 8192 + (ttc + 8 * i) * 8); \
    } else {                                                                                                                \
      _Pragma("unroll") for (int i = 0; i < 4; i++) RA[i] = *(const u32x4*)(A + (size_t)(m0 + lrow + 64 * i) * lda + kt_ * 32 + lkc * 8);  \
    }                                                                                                                       \
    _Pragma("unroll") for (int i = 0; i < 2; i++) RB[i] = *(const u32x4*)(Bt + (size_t)(n0 + lrow + 64 * i) * ldb + kt_ * 32 + lkc * 8);   \
  }
#define GEMM_LWRITE(KT, RA, RB)                                                                                             \
  {                                                                                                                         \
    const int kt_ = (KT);                                                                                                   \
    u16* As_ = Ls + (kt_ & 1) * GBUF;                                                                                       \
    u16* Bs_ = As_ + 256 * GLD;                                                                                             \
    if (has_at && kt_ < at_kt) {                                                                                            \
      _Pragma("unroll") for (int i = 0; i < 4; i++)                                                                         \
        _Pragma("unroll") for (int j = 0; j < 8; j++) As_[((ttc + 8 * i) * 8 + j) * GLD + tch] = bfu(RA[i], j);             \
    } else {                                                                                                                \
      _Pragma("unroll") for (int i = 0; i < 4; i++) *(u32x4*)(As_ + (lrow + 64 * i) * GLD + lkc * 8) = RA[i];               \
    }                                                                                                                       \
    _Pragma("unroll") for (int i = 0; i < 2; i++) *(u32x4*)(Bs_ + (lrow + 64 * i) * GLD + lkc * 8) = RB[i];                 \
    if (ROWNORM) {                                                                                                          \
      _Pragma("unroll") for (int i = 0; i < 4; i++)                                                                         \
        _Pragma("unroll") for (int j = 0; j < 8; j++) { float x = bfe(RA[i], j); ssq[i] += x * x; }                         \
    }                                                                                                                       \
  }
#define GEMM_COMPUTE(KT)                                                                                                    \
  {                                                                                                                         \
    const u16* As = Ls + ((KT) & 1) * GBUF;                                                                                 \
    const u16* Bs = As + 256 * GLD;                                                                                         \
    _Pragma("unroll") for (int ks = 0; ks < 2; ks++) {                                                                      \
      __builtin_amdgcn_sched_barrier(0);                                                                                    \
      bf16x8 a[4], b[2];                                                                                                    \
      _Pragma("unroll") for (int mi = 0; mi < 4; mi++) a[mi] = *(const bf16x8*)(As + (wm * 128 + mi * 32 + r) * GLD + ks * 16 + h * 8); \
      _Pragma("unroll") for (int ni = 0; ni < 2; ni++) b[ni] = *(const bf16x8*)(Bs + (wn * 64 + ni * 32 + r) * GLD + ks * 16 + h * 8);  \
      if (!trans) {                                                                                                         \
        _Pragma("unroll") for (int mi = 0; mi < 4; mi++)                                                                    \
          _Pragma("unroll") for (int ni = 0; ni < 2; ni++) acc[mi][ni] = MFMA32(a[mi], b[ni], acc[mi][ni]);                 \
      } else {                                                                                                              \
        _Pragma("unroll") for (int mi = 0; mi < 4; mi++)                                                                    \
          _Pragma("unroll") for (int ni = 0; ni < 2; ni++) acc[mi][ni] = MFMA32(b[ni], a[mi], acc[mi][ni]);                 \
      }                                                                                                                     \
    }                                                                                                                       \
  }
  GEMM_GLOAD(0, ra0, rb0)
  GEMM_GLOAD(1, ra1, rb1)
  GEMM_LWRITE(0, ra0, rb0)
  __syncthreads();
  for (int kt = 0; kt < nk; kt += 2) {
    GEMM_LWRITE(kt + 1, ra1, rb1)
    if (kt + 2 < nk) { GEMM_GLOAD(kt + 2, ra0, rb0) GEMM_GLOAD(kt + 3, ra1, rb1) }
    GEMM_COMPUTE(kt)
    __syncthreads();
    if (kt + 2 < nk) GEMM_LWRITE(kt + 2, ra0, rb0)
    GEMM_COMPUTE(kt + 1)
    __syncthreads();
  }
#undef GEMM_COMPUTE
#undef GEMM_GLOAD
#undef GEMM_LWRITE
  if (ROWNORM) {
    float* rsp = rs + 256;
    {
      const int t2 = tidx();
#pragma unroll
      for (int i = 0; i < 4; i++) rsp[((t2 >> 2) + 64 * i) * 4 + (t2 & 3)] = ssq[i];
    }
    __syncthreads();
    {
      const int t3 = tidx();
      float4 q = *(const float4*)(rsp + t3 * 4);
      rs[t3] = rsqrtf((q.x + q.y + q.z + q.w) / (float)K + 1e-6f);
    }
    __syncthreads();
  }
#define EPI_CALL(mi, ni) epi(m0 + wm * 128 + (mi) * 32, n0 + wn * 64 + (ni) * 32, acc[mi][ni], rs);
  EPI_CALL(0, 0) EPI_CALL(0, 1) EPI_CALL(1, 0) EPI_CALL(1, 1) EPI_CALL(2, 0) EPI_CALL(2, 1) EPI_CALL(3, 0) EPI_CALL(3, 1)
#undef EPI_CALL
  __syncthreads();
}

DI void phase_win(const Params& p, int l, char* smem) {
  const u16* H = (const u16*)(p.ws + OFF_H);
  const u16* W = (const u16*)(p.ws + OFF_W + (size_t)l * WL_SIZE + WL_WIN);
  u16* UT = (u16*)(p.ws + OFF_UT);
  u16* UTC = (u16*)(p.ws + OFF_UTC);
  u16* RET = (u16*)(p.ws + OFF_RET);
  u16* CQ = (u16*)(p.ws + OFF_CQ);
  u16* CKV = (u16*)(p.ws + OFF_CKV);
  u16* KF = (u16*)(p.ws + OFF_KF);
  const int lane = tidx() & 63, r = lane & 31, h = lane >> 5;
  const int total = 132 * 18;
  for (int it = blockIdx.x; it < total; it += gridDim.x) {
    int mt = it / 18, nt = it - mt * 18;
    int m0 = mt * 256, n0 = nt * 128;
    if (nt < 6) {
      gemm_tile<false, true, true>(H, 1024, W, 1024, 1024, m0, n0, nullptr, 0, smem,
        [&](int bm, int bn, const f32x16& acc, const float*) __attribute__((always_inline)) {
        const int lz_ = tidx() & 63, r = lz_ & 31, h = lz_ >> 5;
          int row = bm + r, b, t, key, cond;
          row_info(row, b, t, key, cond);
          u16* dstp = row < TLAT ? UT + ((size_t)(b * 768)) * SEQ + t : UTC + ((size_t)(b * 768)) * LCTX + t;
          int strd = row < TLAT ? SEQ : LCTX;
#pragma unroll
          for (int reg = 0; reg < 16; reg++) dstp[(size_t)(bn + crow(reg, h)) * strd] = f2bf(acc[reg]);
        });
    } else {
      gemm_tile<false, false, false>(H, 1024, W, 1024, 1024, m0, n0, nullptr, 0, smem,
        [&](int bm, int bn, const f32x16& acc, const float*) __attribute__((always_inline)) {
        const int lz_ = tidx() & 63, r = lz_ & 31, h = lz_ >> 5;
        if (nt < 14) {

          int col = bn + r - 768;
          float sc = (col >= 256 && col < 512) ? 0.125f : 1.f;
#pragma unroll
          for (int reg = 0; reg < 16; reg++) RET[(size_t)(bm + crow(reg, h)) * 1024 + col] = f2bf(acc[reg] * sc);
        } else if (nt < 16) {
          int col = bn + r - 1792;
#pragma unroll
          for (int reg = 0; reg < 16; reg++) CQ[(size_t)(bm + crow(reg, h)) * 256 + col] = f2bf(acc[reg]);
        } else if (nt == 16) {
          int col = bn + r - 2048;
#pragma unroll
          for (int reg = 0; reg < 16; reg++) CKV[(size_t)(bm + crow(reg, h)) * 128 + col] = f2bf(acc[reg]);
        } else if (bn == 2176) {
#pragma unroll
          for (int reg = 0; reg < 16; reg++) {
            int row = bm + crow(reg, h), b, t, key, cond;
            row_info(row, b, t, key, cond);
            float v = acc[reg];
            float vr = rope_apply((const float2*)(p.ws + OFF_ROPE), v, r, t);
            if (row < TLAT) v = vr;
            u16 o = f2bf(v);
#pragma unroll
            for (int hh = 0; hh < 8; hh++) KF[((size_t)(b * 8 + hh) * LKEY + key) * 96 + 64 + r] = o;
          }
        }
      });
    }
  }
}

DI void ret_gammas(const Params& p, int l, int hh, float& lgf, float& lgb) {
  lgf = log1pf(-expf(p.in[I_RLD][l * 8 + hh]));
  lgb = log1pf(-expf(p.in[I_RLD][l * 8 + 4 + hh]));
}
DI void ret_kv_item(const Params& p, int l, int b, int hh, int ci, char* smem) {
  const u16* RET = (const u16*)(p.ws + OFF_RET);
  float* ST = (float*)(p.ws + OFF_ST);
  u16* KfT = (u16*)smem;
  u16* KbT = KfT + 64 * 136;
  u16* VsT = KbT + 64 * 136;
  int tid_o = tidx();
  asm volatile("" : "+v"(tid_o));
  const int tid = tid_o, lane = tid & 63, wid = tid >> 6, r = lane & 31, h = lane >> 5;
  float lgf, lgb;
  ret_gammas(p, l, hh, lgf, lgb);
  const int row0 = chunk_row0(b, ci);
#pragma unroll
  for (int i = 0; i < 4; i++) {
    int id = tid + 256 * i, m = id >> 3, dc = id & 7;
    u32x4 kv = *(const u32x4*)(RET + (size_t)(row0 + m) * 1024 + 256 + hh * 64 + dc * 8);
    u32x4 vv = *(const u32x4*)(RET + (size_t)(row0 + m) * 1024 + 512 + hh * 64 + dc * 8);
    float zf = __expf(lgf * (float)(127 - m)), zb = __expf(lgb * (float)m);
#pragma unroll
    for (int j = 0; j < 8; j++) {
      float kval = bfe(kv, j);
      KfT[(dc * 8 + j) * 136 + m] = f2bf(kval * zf);
      KbT[(dc * 8 + j) * 136 + m] = f2bf(kval * zb);
      VsT[(dc * 8 + j) * 136 + m] = bfu(vv, j);
    }
  }
  __syncthreads();
  const int dir = wid >> 1, dh = wid & 1;
  const u16* Asrc = dir ? KbT : KfT;
  f32x16 c0, c1;
#pragma unroll
  for (int e = 0; e < 16; e++) { c0[e] = 0.f; c1[e] = 0.f; }
#pragma unroll
  for (int ks = 0; ks < 8; ks++) {
    bf16x8 a = *(const bf16x8*)(Asrc + (dh * 32 + r) * 136 + ks * 16 + h * 8);
    bf16x8 b0 = *(const bf16x8*)(VsT + (r) * 136 + ks * 16 + h * 8);
    bf16x8 b1 = *(const bf16x8*)(VsT + (32 + r) * 136 + ks * 16 + h * 8);
    c0 = MFMA32(a, b0, c0);
    c1 = MFMA32(a, b1, c1);
  }
  float* dst = ST + ((size_t)((dir * 4 + b) * 4 + hh) * NCH + ci) * 4096;
#pragma unroll
  for (int reg = 0; reg < 16; reg++) {
    int d = dh * 32 + crow(reg, h);
    dst[d * 64 + r] = c0[reg];
    dst[d * 64 + 32 + r] = c1[reg];
  }
  __syncthreads();
}

#define PX(i) ((i) + ((i) >> 4))
typedef float cf2 __attribute__((ext_vector_type(2)));
DI cf2 mk2(float x, float y) { cf2 r; r.x = x; r.y = y; return r; }
DI cf2 cmul(cf2 a, cf2 b) { return mk2(a.x * b.x - a.y * b.y, a.x * b.y + a.y * b.x); }
DI cf2 cmulc(cf2 a, cf2 b) { return mk2(a.x * b.x + a.y * b.y, a.y * b.x - a.x * b.y); }
DI cf2 cadd(cf2 a, cf2 b) { return mk2(a.x + b.x, a.y + b.y); }
DI cf2 csub(cf2 a, cf2 b) { return mk2(a.x - b.x, a.y - b.y); }
DI cf2 twid_rev(float rev) { return mk2(__builtin_amdgcn_cosf(rev), -__builtin_amdgcn_sinf(rev)); }

template <int S, bool INV>
DI void fft_pass8(float2* Xf2, int tid) {
  cf2* X = (cf2*)Xf2;
  constexpr int span = 8192 >> S, q = span >> 3, lq = 10 - S;
  const float R = 0.70710678118654752f;
#pragma unroll 2
  for (int gi = 0; gi < 4; gi++) {
    int g = tid + 256 * gi;
    int j = g & (q - 1), blk = g >> lq, base = blk * span + j;
    cf2 v[8];
#pragma unroll
    for (int k = 0; k < 8; k++) v[k] = X[PX(base + k * q)];
    cf2 W = twid_rev((float)j * (1.f / (float)span));
    cf2 W2 = cmul(W, W), W4 = cmul(W2, W2);
    cf2 w1 = cmul(W, mk2(R, -R)), w2 = mk2(W.y, -W.x), w3 = cmul(W, mk2(-R, -R));
    cf2 w2b = mk2(W2.y, -W2.x);
    if (!INV) {
      { cf2 a, d;
        a = v[0]; d = csub(a, v[4]); v[0] = cadd(a, v[4]); v[4] = cmul(d, W);
        a = v[1]; d = csub(a, v[5]); v[1] = cadd(a, v[5]); v[5] = cmul(d, w1);
        a = v[2]; d = csub(a, v[6]); v[2] = cadd(a, v[6]); v[6] = cmul(d, w2);
        a = v[3]; d = csub(a, v[7]); v[3] = cadd(a, v[7]); v[7] = cmul(d, w3); }
#pragma unroll
      for (int b4 = 0; b4 < 8; b4 += 4) { cf2 a, d;
        a = v[b4]; d = csub(a, v[b4 + 2]); v[b4] = cadd(a, v[b4 + 2]); v[b4 + 2] = cmul(d, W2);
        a = v[b4 + 1]; d = csub(a, v[b4 + 3]); v[b4 + 1] = cadd(a, v[b4 + 3]); v[b4 + 3] = cmul(d, w2b); }
#pragma unroll
      for (int k = 0; k < 8; k += 2) { cf2 a = v[k], d = csub(a, v[k + 1]); v[k] = cadd(a, v[k + 1]); v[k + 1] = cmul(d, W4); }
    } else {
#pragma unroll
      for (int k = 0; k < 8; k += 2) { cf2 a = v[k], bb = cmulc(v[k + 1], W4); v[k] = cadd(a, bb); v[k + 1] = csub(a, bb); }
#pragma unroll
      for (int b4 = 0; b4 < 8; b4 += 4) { cf2 a, bb;
        a = v[b4]; bb = cmulc(v[b4 + 2], W2); v[b4] = cadd(a, bb); v[b4 + 2] = csub(a, bb);
        a = v[b4 + 1]; bb = cmulc(v[b4 + 3], w2b); v[b4 + 1] = cadd(a, bb); v[b4 + 3] = csub(a, bb); }
      { cf2 a, bb;
        a = v[0]; bb = cmulc(v[4], W); v[0] = cadd(a, bb); v[4] = csub(a, bb);
        a = v[1]; bb = cmulc(v[5], w1); v[1] = cadd(a, bb); v[5] = csub(a, bb);
        a = v[2]; bb = cmulc(v[6], w2); v[2] = cadd(a, bb); v[6] = csub(a, bb);
        a = v[3]; bb = cmulc(v[7], w3); v[3] = cadd(a, bb); v[7] = csub(a, bb); }
    }
#pragma unroll
    for (int k = 0; k < 8; k++) X[PX(base + k * q)] = v[k];
  }
  __syncthreads();
}

DI cf2 t16f(int k) {
  const float C1 = 0.92387953251128674f, S1 = 0.38268343236508977f, R = 0.70710678118654752f;
  return k == 0 ? mk2(1.f, 0.f) : k == 1 ? mk2(C1, -S1) : k == 2 ? mk2(R, -R) : k == 3 ? mk2(S1, -C1) : k == 4 ? mk2(0.f, -1.f)
       : k == 5 ? mk2(-S1, -C1) : k == 6 ? mk2(-R, -R) : mk2(-C1, -S1);
}
template <bool INV>
DI void fft_pass16(float2* Xf2, int tid) {
  cf2* X = (cf2*)Xf2;
#pragma unroll 1
  for (int gi = 0; gi < 2; gi++) {
    int g = tid + 256 * gi;
    cf2* xp = X + 17 * g;
    cf2 v[16];
#pragma unroll
    for (int k = 0; k < 16; k++) v[k] = xp[k];
    if (!INV) {
#pragma unroll
      for (int k = 0; k < 8; k++) { cf2 a = v[k], d = csub(a, v[k + 8]); v[k] = cadd(a, v[k + 8]); v[k + 8] = cmul(d, t16f(k)); }
#pragma unroll
      for (int b8 = 0; b8 < 16; b8 += 8)
#pragma unroll
        for (int k = 0; k < 4; k++) { cf2 a = v[b8 + k], d = csub(a, v[b8 + k + 4]); v[b8 + k] = cadd(a, v[b8 + k + 4]); v[b8 + k + 4] = cmul(d, t16f(2 * k)); }
#pragma unroll
      for (int b4 = 0; b4 < 16; b4 += 4)
#pragma unroll
        for (int k = 0; k < 2; k++) { cf2 a = v[b4 + k], d = csub(a, v[b4 + k + 2]); v[b4 + k] = cadd(a, v[b4 + k + 2]); v[b4 + k + 2] = cmul(d, t16f(4 * k)); }
#pragma unroll
      for (int k = 0; k < 16; k += 2) { cf2 a = v[k], bb = v[k + 1]; v[k] = cadd(a, bb); v[k + 1] = csub(a, bb); }
    } else {
#pragma unroll
      for (int k = 0; k < 16; k += 2) { cf2 a = v[k], bb = v[k + 1]; v[k] = cadd(a, bb); v[k + 1] = csub(a, bb); }
#pragma unroll
      for (int b4 = 0; b4 < 16; b4 += 4)
#pragma unroll
        for (int k = 0; k < 2; k++) { cf2 a = v[b4 + k], bb = cmulc(v[b4 + k + 2], t16f(4 * k)); v[b4 + k] = cadd(a, bb); v[b4 + k + 2] = csub(a, bb); }
#pragma unroll
      for (int b8 = 0; b8 < 16; b8 += 8)
#pragma unroll
        for (int k = 0; k < 4; k++) { cf2 a = v[b8 + k], bb = cmulc(v[b8 + k + 4], t16f(2 * k)); v[b8 + k] = cadd(a, bb); v[b8 + k + 4] = csub(a, bb); }
#pragma unroll
      for (int k = 0; k < 8; k++) { cf2 a = v[k], bb = cmulc(v[k + 8], t16f(k)); v[k] = cadd(a, bb); v[k + 8] = csub(a, bb); }
    }
#pragma unroll
    for (int k = 0; k < 16; k++) xp[k] = v[k];
  }
  __syncthreads();
}
DI void fft_dif(float2* X, const float2* __restrict__, int tid) {
  fft_pass8<0, false>(X, tid); fft_pass8<3, false>(X, tid); fft_pass8<6, false>(X, tid); fft_pass16<false>(X, tid);
}
DI void fft_dit(float2* X, const float2* __restrict__, int tid) {
  fft_pass16<true>(X, tid); fft_pass8<6, true>(X, tid); fft_pass8<3, true>(X, tid); fft_pass8<0, true>(X, tid);
}

DI void filt_fft_item(const Params& p, int l, int o, int c, char* smem) {
  float2* X = (float2*)smem;
  float* Xf = (float*)smem;
  float* w3s = (float*)(smem + 69632);
  float* red = w3s + 128;
  const float2* TW = (const float2*)(p.ws + OFF_TW);
  const float* H2 = (const float*)(p.ws + OFF_H2F);
  float2* KS = (float2*)(p.ws + OFF_KSPEC) + (size_t)(o * 256 + c) * 2 * 8192;
  int tid_o = tidx();
  asm volatile("" : "+v"(tid_o));
  const int tid = tid_o;
  if (tid < 128) { int j = tid & 63, side = tid >> 6; w3s[tid] = p.in[I_HW3][((size_t)l * 64 + j) * 1024 + side * 512 + o * 256 + c]; }
  __syncthreads();
  const float min_decay = -3.0701134573253944f, max_decay = -15.350567286626972f;
  const float delta = fabsf(min_decay + (float)c * ((max_decay - min_decay) / 255.f));
  float* Ff = Xf;
  float* Fb = Xf + 8192;
#pragma unroll 1
  for (int i = 0; i < 32; i++) {
    int n = tid + 256 * i;
    const float4* hp = (const float4*)(H2 + (size_t)n * 64);
    float f = 0.f, bsum = 0.f;
#pragma unroll
    for (int q = 0; q < 16; q++) {
      float4 hv = hp[q];
      f += hv.x * w3s[q * 4] + hv.y * w3s[q * 4 + 1] + hv.z * w3s[q * 4 + 2] + hv.w * w3s[q * 4 + 3];
      bsum += hv.x * w3s[64 + q * 4] + hv.y * w3s[64 + q * 4 + 1] + hv.z * w3s[64 + q * 4 + 2] + hv.w * w3s[64 + q * 4 + 3];
    }
    float win = expf(-((float)n / 8191.f) * delta);
    Ff[n] = f * win; Fb[n] = bsum * win;
  }
  __syncthreads();
  float part = 0.f;
#pragma unroll 2
  for (int i = 0; i < 32; i++) {
    int n = tid + 256 * i;
    float k1 = Ff[n], k2 = 0.f;
    if (n == 0) k1 += Fb[0]; else k2 = Fb[8192 - n];
    part += fabsf(k1) + fabsf(k2);
    KS[8192 + n] = make_float2(k1, k2);
  }
  part = wave_sum(part);
  if ((tid & 63) == 0) red[tid >> 6] = part;
  __syncthreads();
  const float inv = 1.f / (red[0] + red[1] + red[2] + red[3]);
#pragma unroll 2
  for (int i = 0; i < 32; i++) { int n = tidx() + 256 * i; float2 kp = KS[8192 + n]; X[PX(n)] = make_float2((kp.x + kp.y) * inv, 0.f); }
  __syncthreads();
  fft_dif(X, TW, tid);
#pragma unroll 2
  for (int i = 0; i < 32; i++) { int n = tidx() + 256 * i; KS[n] = X[PX(n)]; }
  __syncthreads();
#pragma unroll 2
  for (int i = 0; i < 32; i++) { int n = tidx() + 256 * i; float2 w = TW[n]; float2 kp = KS[8192 + n]; float d = (kp.x - kp.y) * inv; X[PX(n)] = make_float2(d * w.x, d * w.y); }
  __syncthreads();
  fft_dif(X, TW, tid);
#pragma unroll 2
  for (int i = 0; i < 32; i++) { int n = tidx() + 256 * i; KS[8192 + n] = X[PX(n)]; }
  __syncthreads();
}

DI void filt_ctx_item(const Params& p, int l, int o, int c, char* smem) {
  float* red = (float*)smem;
  const float* H2 = (const float*)(p.ws + OFF_H2C);
  float* KC = (float*)(p.ws + OFF_KC) + (size_t)(o * 256 + c) * 512;
  int tid_o = tidx();
  asm volatile("" : "+v"(tid_o));
  const int n = tid_o;
  const float min_decay = -3.0701134573253944f, max_decay = -15.350567286626972f;
  const float delta = fabsf(min_decay + (float)c * ((max_decay - min_decay) / 255.f));
  float f = 0.f, bsum = 0.f;
  for (int j = 0; j < 64; j++) {
    float hv = H2[n * 64 + j];
    f += hv * p.in[I_HW3][((size_t)l * 64 + j) * 1024 + o * 256 + c];
    bsum += hv * p.in[I_HW3][((size_t)l * 64 + j) * 1024 + 512 + o * 256 + c];
  }
  float win = expf(-((float)n / 255.f) * delta);
  f *= win; bsum *= win;
  float part = n == 0 ? fabsf(f + bsum) : fabsf(f) + fabsf(bsum);
  part = wave_sum(part);
  __syncthreads();
  if ((n & 63) == 0) red[n >> 6] = part;
  __syncthreads();
  float inv = 1.f / (red[0] + red[1] + red[2] + red[3]);
  if (n == 0) { KC[256] = (f + bsum) * inv; KC[0] = 0.f; }
  else { KC[256 + n] = f * inv; KC[256 - n] = bsum * inv; }
  __syncthreads();
}

DI void phase_p3(const Params& p, int l, char* smem) {
  const int lane = tidx() & 63, r = lane & 31, h = lane >> 5;
  const int n_uq = (l == 0 ? 132 : 128) * 6, n_ukv = 132 * 8, n_r1 = 16 * NCH, n_ff = 512, n_fc = (l == 0 ? 512 : 0);
  const int total = n_uq + n_ukv + n_r1 + n_ff + n_fc;
  const char* wl = p.ws + OFF_W + (size_t)l * WL_SIZE;
  u16* Q = (u16*)(p.ws + OFF_Q);
  u16* KF = (u16*)(p.ws + OFF_KF);
  u16* VT = (u16*)(p.ws + OFF_VT);
  for (int it = blockIdx.x; it < total; it += gridDim.x) {
    int q = it;
    if (q < n_uq) {
      int mt = q / 6, nt = q - mt * 6;
      if (SUB_ON(0)) gemm_tile<true, false, false>((const u16*)(p.ws + OFF_CQ), 256, (const u16*)(wl + WL_WUQ), 256, 256, mt * 256, nt * 128, nullptr, 0, smem,
        [&](int bm, int bn, const f32x16& acc, const float* rs) __attribute__((always_inline)) {
        const int lz_ = tidx() & 63, r = lz_ & 31, h = lz_ >> 5;
          int col = bn + r;
          int j = col % 96;
          const float qscale = 0.10206207261596577f * 1.4426950408889634f;
#pragma unroll
          for (int reg = 0; reg < 16; reg++) {
            int row = bm + crow(reg, h);
            float v = acc[reg] * rs[row - mt * 256];
            if (j >= 64) {
              int b, t, key, cond;
              row_info(row, b, t, key, cond);
              float vr = rope_apply((const float2*)(p.ws + OFF_ROPE), v, r, t);
              if (row < TLAT) v = vr;
            }
            Q[(size_t)row * 768 + col] = f2bf(v * qscale);
          }
        });
    } else if ((q -= n_uq) < n_ukv) {
      int mt = q >> 3, nt = q & 7;
      if (nt < 4) {
        if (SUB_ON(1)) gemm_tile<true, false, false>((const u16*)(p.ws + OFF_CKV), 128, (const u16*)(wl + WL_WUKV), 128, 128, mt * 256, nt * 128, nullptr, 0, smem,
          [&](int bm, int bn, const f32x16& acc, const float* rs) __attribute__((always_inline)) {
        const int lz_ = tidx() & 63, r = lz_ & 31, h = lz_ >> 5;
            int hd = bn >> 6, j = (bn & 63) + r;
#pragma unroll
            for (int reg = 0; reg < 16; reg++) {
              int row = bm + crow(reg, h), b, t, key, cond;
              row_info(row, b, t, key, cond);
              KF[((size_t)(b * 8 + hd) * LKEY + key) * 96 + j] = f2bf(acc[reg] * rs[row - mt * 256]);
            }
          });
      } else {
        if (SUB_ON(1)) gemm_tile<true, true, true>((const u16*)(p.ws + OFF_CKV), 128, (const u16*)(wl + WL_WUKV), 128, 128, mt * 256, nt * 128, nullptr, 0, smem,
          [&](int bm, int bn, const f32x16& acc, const float* rs) __attribute__((always_inline)) {
        const int lz_ = tidx() & 63, r = lz_ & 31, h = lz_ >> 5;
            int row = bm + r, b, t, key, cond;
            row_info(row, b, t, key, cond);
            float rr = rs[row - mt * 256];
            int hd = (bn - 512) >> 6, e0 = (bn - 512) & 63;
            u16* dstp = VT + ((size_t)(b * 8 + hd) * 64 + e0) * LKEY + key;
#pragma unroll
            for (int reg = 0; reg < 16; reg++) dstp[(size_t)crow(reg, h) * LKEY] = f2bf(acc[reg] * rr);
          });
      }
    } else if ((q -= n_ukv) < n_r1) {
      int bh = q / NCH, ci = q - bh * NCH;
      if (SUB_ON(2)) ret_kv_item(p, l, bh >> 2, bh & 3, ci, smem);
    } else if ((q -= n_r1) < n_ff) {
      if (SUB_ON(3)) filt_fft_item(p, l, q >> 8, q & 255, smem);
    } else {
      q -= n_ff;
      if (SUB_ON(4)) filt_ctx_item(p, l, q >> 8, q & 255, smem);
    }
  }
}

DI void phase_scan(const Params& p, int l) {
  float* ST = (float*)(p.ws + OFF_ST);
  for (int idx = blockIdx.x * 256 + tidx(); idx < 2 * 16 * 4096; idx += gridDim.x * 256) {
    int dir = idx >> 16, bh = (idx >> 12) & 15, el = idx & 4095, hh = bh & 3;
    float* base = ST + (size_t)((dir * 16 + bh) * NCH) * 4096 + el;
    float lg = log1pf(-expf(p.in[I_RLD][l * 8 + dir * 4 + hh]));
    float gC = expf(lg * 128.f);
    float s = 0.f;
    if (dir == 0) {
      for (int ci = 0; ci < NCH; ci++) { float tmp = base[(size_t)ci * 4096]; base[(size_t)ci * 4096] = s; s = gC * s + tmp; }
    } else {
      for (int ci = 1; ci >= 0; ci--) { float tmp = base[(size_t)ci * 4096]; base[(size_t)ci * 4096] = s; s = gC * s + tmp; }
      for (int ci = NCH - 1; ci >= 2; ci--) { float tmp = base[(size_t)ci * 4096]; base[(size_t)ci * 4096] = s; s = gC * s + tmp; }
    }
  }
}

DI void attn_item(const Params& p, int b, int hh, int qrow0, int key0, int nkeys, char* smem) {
  u16* Ks = (u16*)smem;
  u16* Vs = Ks + 64 * 104;
  const u16* Q = (const u16*)(p.ws + OFF_Q);
  const u16* KF = (const u16*)(p.ws + OFF_KF);
  const u16* VT = (const u16*)(p.ws + OFF_VT);
  u16* MIX = (u16*)(p.ws + OFF_H);
  int tid_o = tidx();
  asm volatile("" : "+v"(tid_o));
  const int tid = tid_o, lane = tid & 63, wid = tid >> 6, r = lane & 31, h = lane >> 5;
  const int qrow = qrow0 + wid * 32 + r;
  bf16x8 qf[6];
#pragma unroll
  for (int ks = 0; ks < 6; ks++) qf[ks] = *(const bf16x8*)(Q + (size_t)qrow * 768 + hh * 96 + ks * 16 + h * 8);
  f32x16 o0, o1;
#pragma unroll
  for (int e = 0; e < 16; e++) { o0[e] = 0.f; o1[e] = 0.f; }
  float m = -1e30f, lsum = 0.f;
  const u32x4* kbase = (const u32x4*)(KF + ((size_t)(b * 8 + hh) * LKEY + key0) * 96);
  const u16* vbase = VT + (size_t)(b * 8 + hh) * 64 * LKEY + key0;
  u32x4 rk[3], rv[2];
  const int nt = nkeys >> 6;
#define ATT_GLOAD(T)                                                                                                        \
  {                                                                                                                         \
    const int t_ = (T);                                                                                                     \
    _Pragma("unroll") for (int i = 0; i < 3; i++) rk[i] = kbase[(size_t)t_ * 768 + tid + 256 * i];                          \
    _Pragma("unroll") for (int i = 0; i < 2; i++) { int id = tid + 256 * i; rv[i] = *(const u32x4*)(vbase + (size_t)(id >> 3) * LKEY + t_ * 64 + (id & 7) * 8); } \
  }
  ATT_GLOAD(0)
  for (int t = 0; t < nt; t++) {
    __syncthreads();
#pragma unroll
    for (int i = 0; i < 3; i++) { int id = tid + 256 * i; int kr = id / 12, c = id - kr * 12; *(u32x4*)(Ks + kr * 104 + c * 8) = rk[i]; }
#pragma unroll
    for (int i = 0; i < 2; i++) { int id = tid + 256 * i; *(u32x4*)(Vs + (id >> 3) * 72 + (id & 7) * 8) = rv[i]; }
    __syncthreads();
    if (t + 1 < nt) ATT_GLOAD(t + 1)
    f32x16 s0, s1;
#pragma unroll
    for (int e = 0; e < 16; e++) { s0[e] = 0.f; s1[e] = 0.f; }
#pragma unroll
    for (int ks = 0; ks < 6; ks++) {
      bf16x8 k0 = *(const bf16x8*)(Ks + (r) * 104 + ks * 16 + h * 8);
      bf16x8 k1 = *(const bf16x8*)(Ks + (32 + r) * 104 + ks * 16 + h * 8);
      s0 = MFMA32(k0, qf[ks], s0);
      s1 = MFMA32(k1, qf[ks], s1);
    }
    float mx = s0[0];
#pragma unroll
    for (int e = 0; e < 16; e++) { mx = fmaxf(mx, s0[e]); mx = fmaxf(mx, s1[e]); }
    mx = fmaxf(mx, __shfl_xor(mx, 32));
    float mnew = fmaxf(m, mx);
    float alpha = __builtin_amdgcn_exp2f(m - mnew);
    float ps = 0.f;
#pragma unroll
    for (int e = 0; e < 16; e++) {
      s0[e] = __builtin_amdgcn_exp2f(s0[e] - mnew); ps += s0[e];
      s1[e] = __builtin_amdgcn_exp2f(s1[e] - mnew); ps += s1[e];
    }
    ps += __shfl_xor(ps, 32);
    lsum = lsum * alpha + ps;
    m = mnew;
#pragma unroll
    for (int e = 0; e < 16; e++) { o0[e] *= alpha; o1[e] *= alpha; }
#pragma unroll
    for (int kt2 = 0; kt2 < 2; kt2++) {
#pragma unroll
      for (int sx = 0; sx < 2; sx++) {
        u32x4 pw;
        if (kt2 == 0) {
          pw.x = pack2(s0[8 * sx + 0], s0[8 * sx + 1]); pw.y = pack2(s0[8 * sx + 2], s0[8 * sx + 3]);
          pw.z = pack2(s0[8 * sx + 4], s0[8 * sx + 5]); pw.w = pack2(s0[8 * sx + 6], s0[8 * sx + 7]);
        } else {
          pw.x = pack2(s1[8 * sx + 0], s1[8 * sx + 1]); pw.y = pack2(s1[8 * sx + 2], s1[8 * sx + 3]);
          pw.z = pack2(s1[8 * sx + 4], s1[8 * sx + 5]); pw.w = pack2(s1[8 * sx + 6], s1[8 * sx + 7]);
        }
        bf16x8 pb = __builtin_bit_cast(bf16x8, pw);
        int kb = kt2 * 32 + 16 * sx + 4 * h;
        {
          const u16* vp = Vs + (r) * 72 + kb;
          uint2 lo = *(const uint2*)vp, hi = *(const uint2*)(vp + 8);
          u32x4 vw = {lo.x, lo.y, hi.x, hi.y};
          o0 = MFMA32(__builtin_bit_cast(bf16x8, vw), pb, o0);
        }
        {
          const u16* vp = Vs + (32 + r) * 72 + kb;
          uint2 lo = *(const uint2*)vp, hi = *(const uint2*)(vp + 8);
          u32x4 vw = {lo.x, lo.y, hi.x, hi.y};
          o1 = MFMA32(__builtin_bit_cast(bf16x8, vw), pb, o1);
        }
      }
    }
  }
  const float inv = 1.f / lsum;
  u16* dst = MIX + (size_t)qrow * 1024 + 512 + hh * 64;
#pragma unroll
  for (int g = 0; g < 4; g++) {
    int e = 8 * g + 4 * h;
    *(uint2*)(dst + e) = make_uint2(pack2(o0[4 * g] * inv, o0[4 * g + 1] * inv), pack2(o0[4 * g + 2] * inv, o0[4 * g + 3] * inv));
    *(uint2*)(dst + 32 + e) = make_uint2(pack2(o1[4 * g] * inv, o1[4 * g + 1] * inv), pack2(o1[4 * g + 2] * inv, o1[4 * g + 3] * inv));
  }
  __syncthreads();
}

DI void ret_out_item(const Params& p, int l, int b, int hh, int ci, char* smem) {
  const u16* RET = (const u16*)(p.ws + OFF_RET);
  const float* ST = (const float*)(p.ws + OFF_ST);
  u16* MIX = (u16*)(p.ws + OFF_H);
  u16* Qs = (u16*)smem;
  u16* Ks = Qs + 128 * 72;
  u16* Ps = Qs;
  u16* VsT = Ks + 128 * 72;
  u16* SfT = VsT + 64 * 136;
  u16* SbT = SfT + 64 * 72;
  float* dmk = (float*)(SbT + 64 * 72);
  int tid_o = tidx();
  asm volatile("" : "+v"(tid_o));
  const int tid = tid_o, lane = tid & 63, wid = tid >> 6, r = lane & 31, h = lane >> 5;
  float lgf, lgb;
  ret_gammas(p, l, hh, lgf, lgb);
  const int row0 = chunk_row0(b, ci);
  { int d = tid - 128; dmk[tid] = d > 0 ? __expf(lgf * (float)d) : (d < 0 ? __expf(lgb * (float)(-d)) : 2.f); }
#pragma unroll 1
  for (int i = 0; i < 4; i++) {
    int id = tid + 256 * i, m = id >> 3, dc = id & 7;
    const u16* rp = RET + (size_t)(row0 + m) * 1024 + hh * 64 + dc * 8;
    *(uint4*)(Qs + m * 72 + dc * 8) = *(const uint4*)(rp);
    *(uint4*)(Ks + m * 72 + dc * 8) = *(const uint4*)(rp + 256);
    u32x4 vv = *(const u32x4*)(rp + 512);
#pragma unroll
    for (int j = 0; j < 8; j++) VsT[(dc * 8 + j) * 136 + m] = bfu(vv, j);
  }
  const float* Sf = ST + ((size_t)((0 * 4 + b) * 4 + hh) * NCH + ci) * 4096;
  const float* Sb = ST + ((size_t)((1 * 4 + b) * 4 + hh) * NCH + ci) * 4096;
#pragma unroll 2
  for (int i = 0; i < 16; i++) {
    int id = tid + 256 * i, d = id >> 6, e = id & 63;
    SfT[e * 72 + d] = f2bf(Sf[id]);
    SbT[e * 72 + d] = f2bf(Sb[id]);
  }
  __syncthreads();
  const int cw = wid * 32;
  f32x16 in0, in1, sc[4];
  {
    f32x16 cf0, cf1, cb0, cb1;
#pragma unroll
    for (int e = 0; e < 16; e++) { cf0[e] = cf1[e] = cb0[e] = cb1[e] = 0.f; }
#pragma unroll
    for (int ks = 0; ks < 4; ks++) {
      bf16x8 qa = *(const bf16x8*)(Qs + (cw + r) * 72 + ks * 16 + h * 8);
      cf0 = MFMA32(qa, *(const bf16x8*)(SfT + (r) * 72 + ks * 16 + h * 8), cf0);
      cf1 = MFMA32(qa, *(const bf16x8*)(SfT + (32 + r) * 72 + ks * 16 + h * 8), cf1);
      cb0 = MFMA32(qa, *(const bf16x8*)(SbT + (r) * 72 + ks * 16 + h * 8), cb0);
      cb1 = MFMA32(qa, *(const bf16x8*)(SbT + (32 + r) * 72 + ks * 16 + h * 8), cb1);
    }
#pragma unroll
    for (int reg = 0; reg < 16; reg++) {
      int c = cw + crow(reg, h);
      float xf = __expf(lgf * (float)(c + 1)), xb = __expf(lgb * (float)(128 - c));
      in0[reg] = xf * cf0[reg] + xb * cb0[reg];
      in1[reg] = xf * cf1[reg] + xb * cb1[reg];
    }
  }
#pragma unroll
  for (int e = 0; e < 16; e++) { sc[0][e] = sc[1][e] = sc[2][e] = sc[3][e] = 0.f; }
#pragma unroll
  for (int ks = 0; ks < 4; ks++) {
    bf16x8 qa = *(const bf16x8*)(Qs + (cw + r) * 72 + ks * 16 + h * 8);
#pragma unroll
    for (int mt = 0; mt < 4; mt++) sc[mt] = MFMA32(qa, *(const bf16x8*)(Ks + (mt * 32 + r) * 72 + ks * 16 + h * 8), sc[mt]);
  }
  __syncthreads();
#pragma unroll
  for (int mt = 0; mt < 4; mt++)
#pragma unroll
    for (int reg = 0; reg < 16; reg++) {
      int c = cw + crow(reg, h), mm = mt * 32 + r;
      Ps[c * 136 + mm] = f2bf(sc[mt][reg] * dmk[c - mm + 128]);
      if ((reg & 3) == 3) __builtin_amdgcn_sched_barrier(0);
    }
  __syncthreads();
#pragma unroll
  for (int ks = 0; ks < 8; ks++) {
    bf16x8 pa = *(const bf16x8*)(Ps + (cw + r) * 136 + ks * 16 + h * 8);
    in0 = MFMA32(pa, *(const bf16x8*)(VsT + (r) * 136 + ks * 16 + h * 8), in0);
    in1 = MFMA32(pa, *(const bf16x8*)(VsT + (32 + r) * 136 + ks * 16 + h * 8), in1);
  }
#pragma unroll
  for (int reg = 0; reg < 16; reg++) {
    int c = cw + crow(reg, h);
    float oa = in0[reg], ob = in1[reg];
    float ss = oa * oa + ob * ob;
    ss += __shfl_xor(ss, 1); ss += __shfl_xor(ss, 2); ss += __shfl_xor(ss, 4); ss += __shfl_xor(ss, 8); ss += __shfl_xor(ss, 16);
    float rstd = rsqrtf(ss * (1.f / 64.f) + 1e-6f);
    int rowi = row0 + c;
    asm volatile("" : "+v"(rowi));
    size_t row = (size_t)rowi;
    float g0 = bf2f(RET[row * 1024 + 768 + hh * 64 + r]), g1 = bf2f(RET[row * 1024 + 768 + hh * 64 + 32 + r]);
    MIX[row * 1024 + 256 + hh * 64 + r] = f2bf(silu_f(g0) * oa * rstd);
    MIX[row * 1024 + 256 + hh * 64 + 32 + r] = f2bf(silu_f(g1) * ob * rstd);
    __builtin_amdgcn_sched_barrier(0);
  }
  __syncthreads();
}

typedef _Float16 h2_t __attribute__((ext_vector_type(2)));
DI unsigned packh(float a, float b) { h2_t v; v[0] = (_Float16)a; v[1] = (_Float16)b; return __builtin_bit_cast(unsigned, v); }
template <class ZF, class CF>
DI void hy_conv(float2* X, const float2* __restrict__ TW, const float2* __restrict__ Ke, const float2* __restrict__ Ko,
                ZF zf4, CF consume4, int tid) {
  const float scl = 0.5f / 8192.f;
#pragma unroll 2
  for (int g = 0; g < 8; g++) {
    int j = tidx() + 256 * g;
    float zr[4], zi[4];
    zf4(j, zr, zi);
#pragma unroll
    for (int e = 0; e < 4; e++) X[PX(4 * j + e)] = make_float2(zr[e], zi[e]);
  }
  __syncthreads();
  fft_dif(X, TW, tid);
#pragma unroll 2
  for (int g = 0; g < 8; g++) {
    int j = tidx() + 256 * g;
    const float4* kp = (const float4*)(Ke + 4 * j);
    float4 k01 = kp[0], k23 = kp[1];
    float2 a;
    a = X[PX(4 * j + 0)]; X[PX(4 * j + 0)] = make_float2(a.x * k01.x - a.y * k01.y, a.x * k01.y + a.y * k01.x);
    a = X[PX(4 * j + 1)]; X[PX(4 * j + 1)] = make_float2(a.x * k01.z - a.y * k01.w, a.x * k01.w + a.y * k01.z);
    a = X[PX(4 * j + 2)]; X[PX(4 * j + 2)] = make_float2(a.x * k23.x - a.y * k23.y, a.x * k23.y + a.y * k23.x);
    a = X[PX(4 * j + 3)]; X[PX(4 * j + 3)] = make_float2(a.x * k23.z - a.y * k23.w, a.x * k23.w + a.y * k23.z);
  }
  __syncthreads();
  fft_dit(X, TW, tid);
  unsigned ye[32];
#pragma unroll
  for (int g = 0; g < 8; g++) {
    int j = tid + 256 * g;
    asm volatile("" : "+v"(j));
#pragma unroll
    for (int e = 0; e < 4; e++) {
      float2 ev = X[PX(4 * j + e)];
      unsigned pk = packh(ev.x * scl, ev.y * scl);
      asm volatile("" : "+v"(pk));
      ye[g * 4 + e] = pk;
    }
    if (g & 1) __builtin_amdgcn_sched_barrier(0);
  }
  __syncthreads();
#pragma unroll 2
  for (int g = 0; g < 8; g++) {
    int j = tidx() + 256 * g;
    float zr[4], zi[4];
    zf4(j, zr, zi);
    const float4* tp = (const float4*)(TW + 4 * j);
    float4 t01 = tp[0], t23 = tp[1];
    X[PX(4 * j + 0)] = make_float2(zr[0] * t01.x - zi[0] * t01.y, zr[0] * t01.y + zi[0] * t01.x);
    X[PX(4 * j + 1)] = make_float2(zr[1] * t01.z - zi[1] * t01.w, zr[1] * t01.w + zi[1] * t01.z);
    X[PX(4 * j + 2)] = make_float2(zr[2] * t23.x - zi[2] * t23.y, zr[2] * t23.y + zi[2] * t23.x);
    X[PX(4 * j + 3)] = make_float2(zr[3] * t23.z - zi[3] * t23.w, zr[3] * t23.w + zi[3] * t23.z);
  }
  __syncthreads();
  fft_dif(X, TW, tid);
#pragma unroll 2
  for (int g = 0; g < 8; g++) {
    int j = tidx() + 256 * g;
    const float4* kp = (const float4*)(Ko + 4 * j);
    float4 k01 = kp[0], k23 = kp[1];
    float2 a;
    a = X[PX(4 * j + 0)]; X[PX(4 * j + 0)] = make_float2(a.x * k01.x - a.y * k01.y, a.x * k01.y + a.y * k01.x);
    a = X[PX(4 * j + 1)]; X[PX(4 * j + 1)] = make_float2(a.x * k01.z - a.y * k01.w, a.x * k01.w + a.y * k01.z);
    a = X[PX(4 * j + 2)]; X[PX(4 * j + 2)] = make_float2(a.x * k23.x - a.y * k23.y, a.x * k23.y + a.y * k23.x);
    a = X[PX(4 * j + 3)]; X[PX(4 * j + 3)] = make_float2(a.x * k23.z - a.y * k23.w, a.x * k23.w + a.y * k23.z);
  }
  __syncthreads();
  fft_dit(X, TW, tid);
#pragma unroll
  for (int g = 0; g < 8; g++) {
    int j = tid + 256 * g;
    asm volatile("" : "+v"(j));
    const float4* tp = (const float4*)(TW + 4 * j);
    float4 t01 = tp[0], t23 = tp[1];
    float ya[4], yb[4];
    float2 o;
    h2_t ev;
    o = X[PX(4 * j + 0)]; ev = __builtin_bit_cast(h2_t, ye[g * 4 + 0]);
    ya[0] = (float)ev[0] + (o.x * t01.x + o.y * t01.y) * scl; yb[0] = (float)ev[1] + (o.y * t01.x - o.x * t01.y) * scl;
    o = X[PX(4 * j + 1)]; ev = __builtin_bit_cast(h2_t, ye[g * 4 + 1]);
    ya[1] = (float)ev[0] + (o.x * t01.z + o.y * t01.w) * scl; yb[1] = (float)ev[1] + (o.y * t01.z - o.x * t01.w) * scl;
    o = X[PX(4 * j + 2)]; ev = __builtin_bit_cast(h2_t, ye[g * 4 + 2]);
    ya[2] = (float)ev[0] + (o.x * t23.x + o.y * t23.y) * scl; yb[2] = (float)ev[1] + (o.y * t23.x - o.x * t23.y) * scl;
    o = X[PX(4 * j + 3)]; ev = __builtin_bit_cast(h2_t, ye[g * 4 + 3]);
    ya[3] = (float)ev[0] + (o.x * t23.z + o.y * t23.w) * scl; yb[3] = (float)ev[1] + (o.y * t23.z - o.x * t23.w) * scl;
    consume4(j, ya, yb);
    __builtin_amdgcn_sched_barrier(0);
  }
  __syncthreads();
}

DI float sconv_at(const u16* __restrict__ u, int n, int Ls, float w0, float w1, float w2, float bias) {
  float um = n > 0 ? bf2f(u[n - 1]) : 0.f, uc = bf2f(u[n]), up = n < Ls - 1 ? bf2f(u[n + 1]) : 0.f;
  return bias + w0 * um + w1 * uc + w2 * up;
}
DI void sconv4(const u16* __restrict__ u, int j, float w0, float w1, float w2, float bias, float (&o)[4]) {
  uint2 c = *(const uint2*)(u + 4 * j);
  float x0 = __uint_as_float(c.x << 16), x1 = __uint_as_float(c.x & 0xffff0000u);
  float x2 = __uint_as_float(c.y << 16), x3 = __uint_as_float(c.y & 0xffff0000u);
  float xm = j > 0 ? bf2f(u[4 * j - 1]) : 0.f, xp = j < 2047 ? bf2f(u[4 * j + 4]) : 0.f;
  o[0] = bias + w0 * xm + w1 * x0 + w2 * x1;
  o[1] = bias + w0 * x0 + w1 * x1 + w2 * x2;
  o[2] = bias + w0 * x1 + w1 * x2 + w2 * x3;
  o[3] = bias + w0 * x2 + w1 * x3 + w2 * xp;
}
DI void unpack4(const u16* __restrict__ p, float (&o)[4]) {
  uint2 c = *(const uint2*)p;
  o[0] = __uint_as_float(c.x << 16); o[1] = __uint_as_float(c.x & 0xffff0000u);
  o[2] = __uint_as_float(c.y << 16); o[3] = __uint_as_float(c.y & 0xffff0000u);
}

DI void hyena_item(const Params& p, int l, int c, int pair, char* smem) {
  float2* X = (float2*)smem;
  const float2* TW = (const float2*)(p.ws + OFF_TW);
  const float2* KS = (const float2*)(p.ws + OFF_KSPEC);
  const u16* UT = (const u16*)(p.ws + OFF_UT);
  u16* YT = (u16*)(p.ws + OFF_CQ);
  int tid_o = tidx();
  const int tid = tid_o;
  const float* cw = p.in[I_HCW] + l * 3 * 768;
  const float* cb = p.in[I_HCB] + l * 768;
  const int b0 = 2 * pair, b1 = b0 + 1;
  u16* y0 = YT + (size_t)(b0 * 256 + c) * SEQ;
  u16* y1 = YT + (size_t)(b1 * 256 + c) * SEQ;
  const float vw0 = cw[512 + c], vw1 = cw[768 + 512 + c], vw2 = cw[1536 + 512 + c], vbs = cb[512 + c];
  const u16* v0p = UT + (size_t)(b0 * 768 + 512 + c) * SEQ;
  const u16* v1p = UT + (size_t)(b1 * 768 + 512 + c) * SEQ;
  {
    const float w0 = cw[c], w1 = cw[768 + c], w2 = cw[1536 + c], bs = cb[c];
    const float bias0 = p.in[I_HBIAS][(l * 2 + 0) * 256 + c];
    const u16* u0 = UT + (size_t)(b0 * 768 + c) * SEQ;
    const u16* u1 = UT + (size_t)(b1 * 768 + c) * SEQ;
    hy_conv(X, TW, KS + (size_t)(0 * 256 + c) * 2 * 8192, KS + (size_t)(0 * 256 + c) * 2 * 8192 + 8192,
            [&](int j, float (&zr)[4], float (&zi)[4]) __attribute__((always_inline)) {
              sconv4(v0p, j, vw0, vw1, vw2, vbs, zr); sconv4(v1p, j, vw0, vw1, vw2, vbs, zi);
            },
            [&](int j, const float (&ya)[4], const float (&yb)[4]) __attribute__((always_inline)) {
              float va[4], vb[4], xa[4], xb[4];
              sconv4(v0p, j, vw0, vw1, vw2, vbs, va); sconv4(v1p, j, vw0, vw1, vw2, vbs, vb);
              sconv4(u0, j, w0, w1, w2, bs, xa); sconv4(u1, j, w0, w1, w2, bs, xb);
              *(uint2*)(y0 + 4 * j) = make_uint2(pack2(xa[0] * (ya[0] + va[0] * bias0), xa[1] * (ya[1] + va[1] * bias0)),
                                                 pack2(xa[2] * (ya[2] + va[2] * bias0), xa[3] * (ya[3] + va[3] * bias0)));
              *(uint2*)(y1 + 4 * j) = make_uint2(pack2(xb[0] * (yb[0] + vb[0] * bias0), xb[1] * (yb[1] + vb[1] * bias0)),
                                                 pack2(xb[2] * (yb[2] + vb[2] * bias0), xb[3] * (yb[3] + vb[3] * bias0)));
            }, tid);
  }
  {
    const int col = 256 + c;
    const float w0 = cw[col], w1 = cw[768 + col], w2 = cw[1536 + col], bs = cb[col];
    const float bias1 = p.in[I_HBIAS][(l * 2 + 1) * 256 + c];
    const u16* u0 = UT + (size_t)(b0 * 768 + col) * SEQ;
    const u16* u1 = UT + (size_t)(b1 * 768 + col) * SEQ;
    hy_conv(X, TW, KS + (size_t)(1 * 256 + c) * 2 * 8192, KS + (size_t)(1 * 256 + c) * 2 * 8192 + 8192,
            [&](int j, float (&zr)[4], float (&zi)[4]) __attribute__((always_inline)) { unpack4(y0 + 4 * j, zr); unpack4(y1 + 4 * j, zi); },
            [&](int j, const float (&ya)[4], const float (&yb)[4]) __attribute__((always_inline)) {
              float za[4], zb[4], xa[4], xb[4];
              unpack4(y0 + 4 * j, za); unpack4(y1 + 4 * j, zb);
              sconv4(u0, j, w0, w1, w2, bs, xa); sconv4(u1, j, w0, w1, w2, bs, xb);
              *(uint2*)(y0 + 4 * j) = make_uint2(pack2(xa[0] * (ya[0] + za[0] * bias1), xa[1] * (ya[1] + za[1] * bias1)),
                                                 pack2(xa[2] * (ya[2] + za[2] * bias1), xa[3] * (ya[3] + za[3] * bias1)));
              *(uint2*)(y1 + 4 * j) = make_uint2(pack2(xb[0] * (yb[0] + zb[0] * bias1), xb[1] * (yb[1] + zb[1] * bias1)),
                                                 pack2(xb[2] * (yb[2] + zb[2] * bias1), xb[3] * (yb[3] + zb[3] * bias1)));
            }, tid);
  }
}

DI void hyena_ctx_item(const Params& p, int l, int b, int c, char* smem) {
  float* k0s = (float*)smem;
  float* k1s = k0s + 512;
  float* vs = k1s + 512;
  float* zs = vs + 256;
  const float* KC = (const float*)(p.ws + OFF_KC);
  const u16* UTC = (const u16*)(p.ws + OFF_UTC);
  u16* MIX = (u16*)(p.ws + OFF_H);
  int tid_o = tidx();
  asm volatile("" : "+v"(tid_o));
  const int n = tid_o;
  const float* cw = p.in[I_HCW] + l * 3 * 768;
  const float* cb = p.in[I_HCB] + l * 768;
  k0s[n] = KC[(size_t)(0 * 256 + c) * 512 + n]; k0s[256 + n] = KC[(size_t)(0 * 256 + c) * 512 + 256 + n];
  k1s[n] = KC[(size_t)(1 * 256 + c) * 512 + n]; k1s[256 + n] = KC[(size_t)(1 * 256 + c) * 512 + 256 + n];
  float v = sconv_at(UTC + (size_t)(b * 768 + 512 + c) * LCTX, n, LCTX, cw[512 + c], cw[768 + 512 + c], cw[1536 + 512 + c], cb[512 + c]);
  float x1 = sconv_at(UTC + (size_t)(b * 768 + c) * LCTX, n, LCTX, cw[c], cw[768 + c], cw[1536 + c], cb[c]);
  float x2 = sconv_at(UTC + (size_t)(b * 768 + 256 + c) * LCTX, n, LCTX, cw[256 + c], cw[768 + 256 + c], cw[1536 + 256 + c], cb[256 + c]);
  vs[n] = v;
  __syncthreads();
  float a = 0.f;
  for (int s = 0; s < 256; s++) a += k0s[n - s + 256] * vs[s];
  float z = x1 * (a + v * p.in[I_HBIAS][(l * 2 + 0) * 256 + c]);
  zs[n] = z;
  __syncthreads();
  float a2 = 0.f;
  for (int s = 0; s < 256; s++) a2 += k1s[n - s + 256] * zs[s];
  float y = x2 * (a2 + z * p.in[I_HBIAS][(l * 2 + 1) * 256 + c]);
  MIX[(size_t)(TLAT + b * LCTX + n) * 1024 + c] = f2bf(y);
  __syncthreads();
}

DI void phase_p4(const Params& p, int l, char* smem, int submask = 15) {
  const int n_al = 2048, n_ac = (l == 0 ? 64 : 0), n_hy = 512, n_r3 = (l == 0 ? 16 * NCH : 16 * 64), n_hc = (l == 0 ? 1024 : 0);
  const int total = n_al + n_ac + n_hy + n_r3 + n_hc;
  for (int it = blockIdx.x; it < total; it += gridDim.x) {
    int q = it;
    if (q < n_al) {
      int b = q >> 9, hh = (q >> 6) & 7, qb = q & 63;
      if (SUB_ON(0) && (submask & 1)) attn_item(p, b, hh, b * SEQ + qb * 128, 0, LKEY, smem);
    } else if ((q -= n_al) < n_ac) {
      int b = q >> 4, hh = (q >> 1) & 7, qb = q & 1;
      if (SUB_ON(0) && (submask & 1)) attn_item(p, b, hh, TLAT + b * LCTX + qb * 128, SEQ, LCTX, smem);
    } else if ((q -= n_ac) < n_hy) {
      if (SUB_ON(1) && (submask & 2)) hyena_item(p, l, q >> 1, q & 1, smem);
    } else if ((q -= n_hy) < n_r3) {
      int bh, ci;
      if (l == 0) { bh = q / NCH; ci = q - bh * NCH; } else { bh = q >> 6; ci = 2 + (q & 63); }
      if (SUB_ON(2) && (submask & 4)) ret_out_item(p, l, bh >> 2, bh & 3, ci, smem);
    } else {
      q -= n_r3;
      if (SUB_ON(3) && (submask & 8)) hyena_ctx_item(p, l, q >> 8, q & 255, smem);
    }
  }
}

DI void phase_res_gemm(const Params& p, int l, int which  , char* smem) {
  const int lane = tidx() & 63, r = lane & 31, h = lane >> 5;
  const int nmt = (l == 0 ? 132 : 128);
  const char* wl = p.ws + OFF_W + (size_t)l * WL_SIZE;
  const u16* A = (const u16*)(p.ws + (which == 1 ? OFF_H : OFF_ACT));
  const int K = which == 1 ? 1024 : 4096;
  const u16* Bt = (const u16*)(wl + (which == 1 ? WL_WOUT : WL_W2));
  const bool first = (l == 0 && which == 1);
  const float* mod = (const float*)(p.ws + OFF_MOD);
  float* XC = (float*)(p.ws + OFF_XC);
  const int total = nmt * 8;
  for (int it = blockIdx.x; it < total; it += gridDim.x) {
    int mt = it >> 3, nt = it & 7;
    int m0 = mt * 256;
    const u16* at = nullptr;
    if (which == 1 && m0 < TLAT) at = (const u16*)(p.ws + OFF_CQ) + (size_t)((m0 >> 13) * 256) * SEQ + (m0 & 8191);
    int cond = m0 < TLAT ? (m0 >> 13) : 4;
    const float* ga = mod + (size_t)(l * 5 + cond) * 6144 + (which == 1 ? 2048 : 5120);
    const float* src; float* dst;
    if (m0 < TLAT) { src = first ? p.in[I_X] : p.out; dst = p.out; }
    else { src = (first ? p.in[I_CTX] : XC) - (size_t)TLAT * 1024; dst = XC - (size_t)TLAT * 1024; }
    gemm_tile<false, false, false>(A, K, Bt, K, K, m0, nt * 128, at, 8, smem,
      [&](int bm, int bn, const f32x16& acc, const float*) __attribute__((always_inline)) {
        const int lz_ = tidx() & 63, r = lz_ & 31, h = lz_ >> 5;
        int col = bn + r;
        float g = ga[col];
#pragma unroll
        for (int reg = 0; reg < 16; reg++) {
          size_t idx = (size_t)(bm + crow(reg, h)) * 1024 + col;
          dst[idx] = src[idx] + g * acc[reg];
        }
      });
  }
}

DI void phase_mlp1(const Params& p, int l, char* smem) {
  const int lane = tidx() & 63, r = lane & 31, h = lane >> 5;
  const int nmt = (l == 0 ? 132 : 128);
  const u16* A = (const u16*)(p.ws + OFF_H);
  const u16* Bt = (const u16*)(p.ws + OFF_W + (size_t)l * WL_SIZE + WL_W1);
  u16* ACT = (u16*)(p.ws + OFF_ACT);
  const int total = nmt * 32;
  for (int it = blockIdx.x; it < total; it += gridDim.x) {
    int mt = it >> 5, nt = it & 31;
    gemm_tile<false, false, false>(A, 1024, Bt, 1024, 1024, mt * 256, nt * 128, nullptr, 0, smem,
      [&](int bm, int bn, const f32x16& acc, const float*) __attribute__((always_inline)) {
        const int lz_ = tidx() & 63, r = lz_ & 31, h = lz_ >> 5;
        int col = bn + r;
#pragma unroll
        for (int reg = 0; reg < 16; reg++) {
          float v = fmaxf(acc[reg], 0.f);
          ACT[(size_t)(bm + crow(reg, h)) * 4096 + col] = f2bf(v * v);
        }
      });
  }
}

DI void phase_final(const Params& p) {
  const int lane = tidx() & 63, wid = tidx() >> 6;
  const float* g = p.in[I_FNG];
  for (int it = blockIdx.x; it < TLAT / 4; it += gridDim.x) {
    float* row = p.out + (size_t)(it * 4 + wid) * 1024;
    float4 v[4];
    float ssq = 0.f;
#pragma unroll
    for (int i = 0; i < 4; i++) {
      v[i] = *(const float4*)(row + i * 256 + lane * 4);
      ssq += v[i].x * v[i].x + v[i].y * v[i].y + v[i].z * v[i].z + v[i].w * v[i].w;
    }
    ssq = wave_sum(ssq);
    float rstd = rsqrtf(ssq * (1.f / 1024.f) + 1e-6f);
#pragma unroll
    for (int i = 0; i < 4; i++) {
      float4 gg = *(const float4*)(g + i * 256 + lane * 4);
      *(float4*)(row + i * 256 + lane * 4) = make_float4(v[i].x * rstd * gg.x, v[i].y * rstd * gg.y, v[i].z * rstd * gg.z, v[i].w * rstd * gg.w);
    }
  }
}

constexpr int NPHASE = 20;
#ifndef ONLY_PHASE
#define ONLY_PHASE -1
#endif
#define PH_ON(k) (ONLY_PHASE < 0 || ONLY_PHASE == (k))
DI void run_phase(const Params& p, int ph, char* smem, int submask = 15) {
  if (ph == 0) { if (PH_ON(0)) phase_s0(p, smem); return; }
  if (ph == NPHASE - 1) { if (PH_ON(8)) phase_final(p); return; }
  int l = (ph - 1) / 9, s = (ph - 1) % 9;
  switch (s) {
    case 0: if (PH_ON(1)) phase_norm(p, l, 1, TALL, true); break;
    case 1: if (PH_ON(2)) phase_win(p, l, smem); break;
    case 2: if (PH_ON(3)) phase_p3(p, l, smem); break;
    case 3: if (PH_ON(4)) phase_scan(p, l); break;
    case 4: if (PH_ON(5)) phase_p4(p, l, smem, submask); break;
    case 5: if (PH_ON(6)) phase_res_gemm(p, l, 1, smem); break;
    case 6: if (PH_ON(1)) phase_norm(p, l, 2, l == 0 ? TALL : TLAT, false); break;
    case 7: if (PH_ON(7)) phase_mlp1(p, l, smem); break;
    default: if (PH_ON(6)) phase_res_gemm(p, l, 2, smem); break;
  }
}

#if !MULTI_LAUNCH
extern "C" __global__ void __launch_bounds__(256, 2) mk_all(Params p) {
  extern __shared__ __attribute__((aligned(16))) char smem[];
  cg::grid_group grid = cg::this_grid();
  for (int ph = 0; ph < NPHASE; ph++) {
    run_phase(p, ph, smem);
#ifdef PROBE_DUP
    if (ph == PROBE_DUP || ph == PROBE_DUP2) { grid.sync(); run_phase(p, ph, smem, PROBE_MASK); }
#endif
    if (ph + 1 < NPHASE) grid.sync();
  }
}
#define MK_KERNEL mk_all
#else
#define MK_KERNEL mk_phase
extern "C" __global__ void __launch_bounds__(256, 2) mk_phase(Params p, int ph) {
  extern __shared__ __attribute__((aligned(16))) char smem[];
  run_phase(p, ph, smem);
}
#endif

extern "C" void kernel_launch(void* const* d_in, const int* in_sizes, int n_in, void* d_out, int out_size, void* d_ws, size_t ws_size,
                              hipStream_t stream) {
  Params p{};
  for (int i = 0; i < 27; i++) p.in[i] = (const float*)d_in[i];
  p.out = (float*)d_out;
  p.ws = (char*)d_ws;
  static int grid_blocks = 0;
  if (!grid_blocks) {
    int dev = 0, cus = 0, per_cu = 0;
    (void)hipGetDevice(&dev);
    (void)hipDeviceGetAttribute(&cus, hipDeviceAttributeMultiprocessorCount, dev);
    (void)hipFuncSetAttribute((const void*)MK_KERNEL, hipFuncAttributeMaxDynamicSharedMemorySize, SMEM_BYTES);
    (void)hipOccupancyMaxActiveBlocksPerMultiprocessor(&per_cu, MK_KERNEL, 256, SMEM_BYTES);
    if (per_cu < 1) per_cu = 1;
    if (per_cu > 2) per_cu = 2;
    grid_blocks = cus * per_cu;
  }
#if MULTI_LAUNCH
  for (int ph = 0; ph < NPHASE; ph++) hipLaunchKernelGGL(mk_phase, dim3(grid_blocks), dim3(256), SMEM_BYTES, stream, p, ph);
#else
  void* args[] = {&p};
  (void)hipLaunchCooperativeKernel((void*)mk_all, dim3(grid_blocks), dim3(256), args, SMEM_BYTES, stream);
#endif
}
```

```cpp
#include <hip/hip_runtime.h>
#include <hip/hip_cooperative_groups.h>
namespace cg = cooperative_groups;

#ifndef MULTI_LAUNCH
#define MULTI_LAUNCH 0
#endif

#define DI __device__ __forceinline__
#define NI __device__ __noinline__
typedef unsigned short u16;
typedef short bf16x8 __attribute__((ext_vector_type(8)));
typedef float f32x16 __attribute__((ext_vector_type(16)));
typedef __bf16 bf2_t __attribute__((ext_vector_type(2)));
typedef unsigned u32x4 __attribute__((ext_vector_type(4)));
#define MFMA32(a, b, c) __builtin_amdgcn_mfma_f32_32x32x16_bf16((a), (b), (c), 0, 0, 0)

constexpr int NB = 4, SEQ = 8192, LCTX = 256, DM = 1024, DFF = 4096;
constexpr int TLAT = NB * SEQ;
constexpr int TALL = TLAT + NB * LCTX;
constexpr int NIN = 2208, NINP = 2304;
constexpr int LKEY = SEQ + LCTX;
constexpr int NCH = 66;
constexpr int SMEM_BYTES = 73728;
#ifndef SUBSEL
#define SUBSEL -1
#endif
#define SUB_ON(k) (SUBSEL < 0 || SUBSEL == (k))

constexpr size_t WL_WIN = 0;
constexpr size_t WL_WOUT = WL_WIN + (size_t)NINP * 1024 * 2;
constexpr size_t WL_W1 = WL_WOUT + (size_t)1024 * 1024 * 2;
constexpr size_t WL_W2 = WL_W1 + (size_t)4096 * 1024 * 2;
constexpr size_t WL_WUQ = WL_W2 + (size_t)1024 * 4096 * 2;
constexpr size_t WL_WUKV = WL_WUQ + (size_t)768 * 256 * 2;
constexpr size_t WL_SIZE = WL_WUKV + (size_t)1024 * 128 * 2;
constexpr size_t OFF_W = 0;
constexpr size_t OFF_MOD = OFF_W + 2 * WL_SIZE;
constexpr size_t OFF_TW = OFF_MOD + (size_t)2 * 5 * 6144 * 4;
constexpr size_t OFF_ROPE = OFF_TW + 65536;
constexpr size_t OFF_XC = OFF_ROPE + 192 * 8 * 8 + 4096;
constexpr size_t OFF_H = OFF_XC + (size_t)1024 * 1024 * 4;
constexpr size_t OFF_H2F = OFF_H + (size_t)TALL * 1024 * 2;
constexpr size_t OFF_H2C = OFF_H2F + (size_t)8192 * 64 * 4;
constexpr size_t OFF_KC = OFF_H2C + (size_t)256 * 64 * 4;
constexpr size_t OFF_BIG = OFF_KC + (size_t)2 * 256 * 512 * 4;
constexpr size_t OFF_UT = OFF_BIG;
constexpr size_t OFF_UTC = OFF_UT + (size_t)NB * 768 * SEQ * 2;
constexpr size_t OFF_RET = OFF_UTC + (size_t)NB * 768 * LCTX * 2;
constexpr size_t OFF_CQ = OFF_RET + (size_t)TALL * 1024 * 2;
constexpr size_t OFF_CKV = OFF_CQ + (size_t)TALL * 256 * 2;
constexpr size_t OFF_Q = OFF_CKV + (size_t)TALL * 128 * 2;
constexpr size_t OFF_KF = OFF_Q + (size_t)TALL * 768 * 2;
constexpr size_t OFF_VT = OFF_KF + (size_t)NB * 8 * LKEY * 96 * 2;
constexpr size_t OFF_ST = OFF_VT + (size_t)NB * 8 * 64 * LKEY * 2;
constexpr size_t OFF_KSPEC = OFF_ST + (size_t)2 * 16 * NCH * 4096 * 4;
constexpr size_t OFF_END = OFF_KSPEC + (size_t)2 * 256 * 2 * 8192 * 8;
constexpr size_t OFF_BAR = OFF_END;
constexpr size_t OFF_ACT = OFF_BIG;
static_assert(OFF_ACT + (size_t)TALL * 4096 * 2 <= OFF_END, "act fits");
static_assert(OFF_END + 16384 <= (size_t)536870912, "workspace");

struct Params {
  const float* in[27];
  float* out;
  char* ws;
};
enum { I_X = 0, I_C, I_CTX, I_CCTX, I_WADA, I_BADA, I_N1G, I_N2G, I_WIN, I_WOUT, I_HCW, I_HCB, I_HW1, I_HB1, I_HSF, I_HW2,
       I_HB2, I_HW3, I_HBIAS, I_RLD, I_QNG, I_WUQ, I_KVNG, I_WUKV, I_W1, I_W2, I_FNG };

DI int tidx() { int t = __builtin_amdgcn_workitem_id_x(); asm volatile("" : "+v"(t)); return t; }
DI u16 f2bf(float x) { return __builtin_bit_cast(u16, (__bf16)x); }
DI float bf2f(u16 v) { return __uint_as_float(((unsigned)v) << 16); }
DI unsigned pack2(float a, float b) { bf2_t v; v[0] = (__bf16)a; v[1] = (__bf16)b; return __builtin_bit_cast(unsigned, v); }
DI float wave_sum(float v) {
#pragma unroll
  for (int o = 32; o > 0; o >>= 1) v += __shfl_xor(v, o);
  return v;
}
DI int crow(int reg, int h) { return (reg & 3) + 8 * (reg >> 2) + 4 * h; }
DI float bfe(u32x4 v, int j) {
  unsigned w = v[j >> 1];
  return __uint_as_float((j & 1) ? (w & 0xffff0000u) : (w << 16));
}
DI u16 bfu(u32x4 v, int j) {
  unsigned w = v[j >> 1];
  return (u16)((j & 1) ? (w >> 16) : (w & 0xffffu));
}
DI float silu_f(float x) { return x / (1.f + __expf(-x)); }
DI void row_info(int row, int& b, int& t, int& key, int& cond) {
  if (row < TLAT) { b = row >> 13; t = row & 8191; key = t; cond = b; }
  else { int rc = row - TLAT; b = rc >> 8; t = rc & 255; key = SEQ + t; cond = 4; }
}
DI int chunk_row0(int b, int ci) { return ci < 2 ? TLAT + b * LCTX + ci * 128 : b * SEQ + (ci - 2) * 128; }
DI float rope_apply(const float2* __restrict__ tab, float val, int jj, int t) {
  float partner = __shfl_xor(val, 8);
  int pos = (jj & 16) ? 128 + (t & 63) : (t >> 6);
  float2 cs = tab[pos * 8 + (jj & 7)];
  return (jj & 8) ? (val * cs.x + partner * cs.y) : (val * cs.x - partner * cs.y);
}

DI void convT_item(const float* __restrict__ src, u16* __restrict__ dst, int K, int N, int Npad, const float* __restrict__ gain,
                   int item, float* tile, bool perm = false) {
  int ntn = Npad >> 6;
  int kt = item / ntn, nt = item - kt * ntn;
  int k0 = kt * 64, n0 = nt * 64;
  int c = tidx() & 63, q = tidx() >> 6;
#pragma unroll 4
  for (int i = 0; i < 16; i++) {
    int kk = i * 4 + q, n = n0 + c;
    float v = 0.f;
    if (n < N) { int sn = perm ? ((n & 511) >> 6) * 128 + (n >> 9) * 64 + (n & 63) : n; v = src[(size_t)(k0 + kk) * N + sn]; if (gain) v *= gain[k0 + kk]; }
    tile[kk * 65 + c] = v;
  }
  __syncthreads();
#pragma unroll 4
  for (int i = 0; i < 16; i++) {
    int nn = i * 4 + q;
    dst[(size_t)(n0 + nn) * K + k0 + c] = f2bf(tile[c * 65 + nn]);
  }
  __syncthreads();
}

DI void phase_s0(const Params& p, char* smem) {
  const int per_layer = 576 + 256 + 1024 + 1024 + 48 + 32;
  const int n_conv = 2 * per_layer, n_mod = 2 * 96, n_tw = 32 + 6;
  const int total = n_conv + n_mod + n_tw;
  for (int it = blockIdx.x; it < total; it += gridDim.x) {
    if (it < n_conv) {
      int l = it / per_layer, r = it - l * per_layer;
      char* wl = p.ws + OFF_W + (size_t)l * WL_SIZE;
      float* tile = (float*)smem;
      if (r < 576) convT_item(p.in[I_WIN] + (size_t)l * 1024 * NIN, (u16*)(wl + WL_WIN), 1024, NIN, NINP, nullptr, r, tile);
      else if ((r -= 576) < 256) convT_item(p.in[I_WOUT] + (size_t)l * 1024 * 1024, (u16*)(wl + WL_WOUT), 1024, 1024, 1024, nullptr, r, tile);
      else if ((r -= 256) < 1024) convT_item(p.in[I_W1] + (size_t)l * 1024 * 4096, (u16*)(wl + WL_W1), 1024, 4096, 4096, nullptr, r, tile);
      else if ((r -= 1024) < 1024) convT_item(p.in[I_W2] + (size_t)l * 4096 * 1024, (u16*)(wl + WL_W2), 4096, 1024, 1024, nullptr, r, tile);
      else if ((r -= 1024) < 48) convT_item(p.in[I_WUQ] + (size_t)l * 256 * 768, (u16*)(wl + WL_WUQ), 256, 768, 768, p.in[I_QNG] + l * 256, r, tile);
      else { r -= 48; convT_item(p.in[I_WUKV] + (size_t)l * 128 * 1024, (u16*)(wl + WL_WUKV), 128, 1024, 1024, p.in[I_KVNG] + l * 128, r, tile, true); }
    } else if (it < n_conv + n_mod) {
      int r = it - n_conv;
      int l = r / 96, n0 = (r - l * 96) * 64;
      float* sc = (float*)smem;
      float* red = sc + 5120;
      for (int i = tidx(); i < 5120; i += 256) {
        int rr = i >> 10, k = i & 1023;
        float cv = rr < 4 ? p.in[I_C][rr * 1024 + k] : p.in[I_CCTX][k];
        sc[i] = cv / (1.f + expf(-cv));
      }
      __syncthreads();
      int nn = tidx() & 63, kq = tidx() >> 6;
      float a0 = 0, a1 = 0, a2 = 0, a3 = 0, a4 = 0;
      const float* w = p.in[I_WADA] + ((size_t)l * 1024 + kq * 256) * 6144 + n0 + nn;
#pragma unroll 8
      for (int k = 0; k < 256; k++) {
        float wv = w[(size_t)k * 6144];
        int kk = kq * 256 + k;
        a0 += sc[kk] * wv; a1 += sc[1024 + kk] * wv; a2 += sc[2048 + kk] * wv; a3 += sc[3072 + kk] * wv; a4 += sc[4096 + kk] * wv;
      }
      red[(kq * 5 + 0) * 64 + nn] = a0; red[(kq * 5 + 1) * 64 + nn] = a1; red[(kq * 5 + 2) * 64 + nn] = a2;
      red[(kq * 5 + 3) * 64 + nn] = a3; red[(kq * 5 + 4) * 64 + nn] = a4;
      __syncthreads();
      if (tidx() < 64) {
        float* mod = (float*)(p.ws + OFF_MOD);
        float bb = p.in[I_BADA][l * 6144 + n0 + nn];
        for (int rr = 0; rr < 5; rr++) {
          float s = red[(0 * 5 + rr) * 64 + nn] + red[(1 * 5 + rr) * 64 + nn] + red[(2 * 5 + rr) * 64 + nn] + red[(3 * 5 + rr) * 64 + nn];
          mod[(size_t)(l * 5 + rr) * 6144 + n0 + nn] = s + bb;
        }
      }
      __syncthreads();
    } else {
      int q = it - n_conv - n_mod;
      if (q < 32) {
        int n = q * 256 + tidx();
        float sn, cs;
        sincospif((float)n / 8192.f, &sn, &cs);
        ((float2*)(p.ws + OFF_TW))[n] = make_float2(cs, -sn);
      } else {
        int e = (q - 32) * 256 + tidx();
        int pos = e >> 3, f = e & 7;
        float pv = pos < 128 ? (float)pos : (float)(pos - 128);
        float inv = powf(10000.f, -(float)f / 8.f);
        float sn, cs;
        sincosf(pv * inv, &sn, &cs);
        ((float2*)(p.ws + OFF_ROPE))[e] = make_float2(cs, sn);
      }
    }
  }
}

DI void filt_a_item(const Params& p, int l, int Lf, float* h2out, int pos) {
  int lane = tidx() & 63;
  float tpos = (float)pos / (float)(Lf - 1);
  float zval = 0.f;
  if (lane == 0) zval = tpos;
  else if (lane < 33) {
    int jj = (lane - 1) & 15;
    float band = 1e-4f + (float)jj * ((15.f - 1e-4f) / 15.f);
    float ang = ((float)(6.283185307179586 / (double)Lf)) * (float)pos * band;
    zval = lane < 17 ? cosf(ang) : -sinf(ang);
  }
  const float* w1 = p.in[I_HW1] + l * 33 * 64;
  const float* w2 = p.in[I_HW2] + l * 64 * 64;
  float acc = p.in[I_HB1][l * 64 + lane];
  for (int i = 0; i < 33; i++) acc += __shfl(zval, i) * w1[i * 64 + lane];
  float h1 = sinf(p.in[I_HSF][l * 128 + lane] * acc);
  float acc2 = p.in[I_HB2][l * 64 + lane];
  for (int i = 0; i < 64; i++) acc2 += __shfl(h1, i) * w2[i * 64 + lane];
  h2out[(size_t)pos * 64 + lane] = sinf(p.in[I_HSF][l * 128 + 64 + lane] * acc2);
}

DI void phase_norm(const Params& p, int l, int which, int nrows, bool with_filter) {
  const int lane = tidx() & 63, wid = tidx() >> 6;
  const bool first = (l == 0 && which == 1);
  const int n_norm = nrows >> 3;
  const int n_fa = with_filter ? (8192 / 4 + (l == 0 ? 256 / 4 : 0)) : 0;
  const float* gsrc = p.in[which == 1 ? I_N1G : I_N2G] + l * 1024;
  u16* H = (u16*)(p.ws + OFF_H);
  for (int it = blockIdx.x; it < n_norm + n_fa; it += gridDim.x) {
    if (it < n_norm) {
      int row = it * 8 + wid * 2;
      const float* src;
      int cond;
      if (row < TLAT) { src = (first ? p.in[I_X] : p.out) + (size_t)row * 1024; cond = row >> 13; }
      else { src = (first ? p.in[I_CTX] : (const float*)(p.ws + OFF_XC)) + (size_t)(row - TLAT) * 1024; cond = 4; }
      const float* m = (const float*)(p.ws + OFF_MOD) + (size_t)(l * 5 + cond) * 6144 + (which == 1 ? 0 : 3072);
      float4 v[8];
      float ssq0 = 0.f, ssq1 = 0.f;
#pragma unroll
      for (int i = 0; i < 4; i++) {
        v[i] = *(const float4*)(src + i * 256 + lane * 4);
        v[4 + i] = *(const float4*)(src + 1024 + i * 256 + lane * 4);
      }
#pragma unroll
      for (int i = 0; i < 4; i++) {
        ssq0 += v[i].x * v[i].x + v[i].y * v[i].y + v[i].z * v[i].z + v[i].w * v[i].w;
        ssq1 += v[4 + i].x * v[4 + i].x + v[4 + i].y * v[4 + i].y + v[4 + i].z * v[4 + i].z + v[4 + i].w * v[4 + i].w;
      }
      ssq0 = wave_sum(ssq0); ssq1 = wave_sum(ssq1);
      float rstd0 = rsqrtf(ssq0 * (1.f / 1024.f) + 1e-6f), rstd1 = rsqrtf(ssq1 * (1.f / 1024.f) + 1e-6f);
#pragma unroll
      for (int i = 0; i < 4; i++) {
        int col = i * 256 + lane * 4;
        float4 g = *(const float4*)(gsrc + col), sh = *(const float4*)(m + col), sc = *(const float4*)(m + 1024 + col);
        float gx = g.x * (1.f + sc.x), gy = g.y * (1.f + sc.y), gz = g.z * (1.f + sc.z), gw = g.w * (1.f + sc.w);
        *(uint2*)(H + (size_t)row * 1024 + col) = make_uint2(pack2(v[i].x * rstd0 * gx + sh.x, v[i].y * rstd0 * gy + sh.y),
                                                             pack2(v[i].z * rstd0 * gz + sh.z, v[i].w * rstd0 * gw + sh.w));
        *(uint2*)(H + (size_t)(row + 1) * 1024 + col) = make_uint2(pack2(v[4 + i].x * rstd1 * gx + sh.x, v[4 + i].y * rstd1 * gy + sh.y),
                                                                   pack2(v[4 + i].z * rstd1 * gz + sh.z, v[4 + i].w * rstd1 * gw + sh.w));
      }
    } else {
      int q = it - n_norm;
      if (q < 2048) filt_a_item(p, l, 8192, (float*)(p.ws + OFF_H2F), q * 4 + wid);
      else filt_a_item(p, l, 256, (float*)(p.ws + OFF_H2C), (q - 2048) * 4 + wid);
    }
  }
}

constexpr int GLD = 40;
constexpr int GBUF = (256 + 128) * GLD;
template <bool ROWNORM, bool TR0, bool TR1, class Epi>
DI void gemm_tile(const u16* __restrict__ A, int lda, const u16* __restrict__ Bt, int ldb, int K, int m0, int n0,
                  const u16* __restrict__ at_src, int at_kt, char* smem, Epi epi) {
  u16* Ls = (u16*)smem;
  float* rs = (float*)(Ls + 2 * GBUF);
  int tid_o = tidx();
  const int tid = tid_o, lane = tid & 63, wid = tid >> 6, wm = wid >> 1, wn = wid & 1, r = lane & 31, h = lane >> 5;
  const bool trans = (TR0 == TR1) ? TR0 : (wn ? TR1 : TR0);
  f32x16 acc[4][2];
#pragma unroll
  for (int mi = 0; mi < 4; mi++)
#pragma unroll
    for (int ni = 0; ni < 2; ni++)
#pragma unroll
      for (int e = 0; e < 16; e++) acc[mi][ni][e] = 0.f;
  u32x4 ra0[4], rb0[2], ra1[4], rb1[2];
  float ssq[4];
#pragma unroll
  for (int i = 0; i < 4; i++) ssq[i] = 0.f;
  const int nk = K >> 5;
  const int lrow = tid >> 2, lkc = tid & 3;
  const int tch = tid & 31, ttc = tid >> 5;
  const bool has_at = at_src != nullptr;
#define GEMM_GLOAD(KT, RA, RB)                                                                                              \
  {                                                                                                                         \
    const int kt_ = (KT);                                                                                                   \
    if (has_at && kt_ < at_kt) {                                                                                            \
      _Pragma("unroll") for (int i = 0; i < 4; i++) RA[i] = *(const u32x4*)(at_src + (size_t)(kt_ * 32 + tch) * 8192 + (ttc + 8 * i) * 8); \
    } else {                                                                                                                \
      _Pragma("unroll") for (int i = 0; i < 4; i++) RA[i] = *(const u32x4*)(A + (size_t)(m0 + lrow + 64 * i) * lda + kt_ * 32 + lkc * 8);  \
    }                                                                                                                       \
    _Pragma("unroll") for (int i = 0; i < 2; i++) RB[i] = *(const u32x4*)(Bt + (size_t)(n0 + lrow + 64 * i) * ldb + kt_ * 32 + lkc * 8);   \
  }
#define GEMM_LWRITE(KT, RA, RB)                                                                                             \
  {                                                                                                                         \
    const int kt_ = (KT);                                                                                                   \
    u16* As_ = Ls + (kt_ & 1) * GBUF;                                                                                       \
    u16* Bs_ = As_ + 256 * GLD;                                                                                             \
    if (has_at && kt_ < at_kt) {                                                                                            \
      _Pragma("unroll") for (int i = 0; i < 4; i++)                                                                         \
        _Pragma("unroll") for (int j = 0; j < 8; j++) As_[((ttc + 8 * i) * 8 + j) * GLD + tch] = bfu(RA[i], j);             \
    } else {                                                                                                                \
      _Pragma("unroll") for (int i = 0; i < 4; i++) *(u32x4*)(As_ + (lrow + 64 * i) * GLD + lkc * 8) = RA[i];               \
    }                                                                                                                       \
    _Pragma("unroll") for (int i = 0; i < 2; i++) *(u32x4*)(Bs_ + (lrow + 64 * i) * GLD + lkc * 8) = RB[i];                 \
    if (ROWNORM) {                                                                                                          \
      _Pragma("unroll") for (int i = 0; i < 4; i++)                                                                         \
        _Pragma("unroll") for (int j = 0; j < 8; j++) { float x = bfe(RA[i], j); ssq[i] += x * x; }                         \
    }                                                                                                                       \
  }
#define GEMM_COMPUTE(KT)                                                                                                    \
  {                                                                                                                         \
    const u16* As = Ls + ((KT) & 1) * GBUF;                                                                                 \
    const u16* Bs = As + 256 * GLD;                                                                                         \
    _Pragma("unroll") for (int ks = 0; ks < 2; ks++) {                                                                      \
      __builtin_amdgcn_sched_barrier(0);                                                                                    \
      bf16x8 a[4], b[2];                                                                                                    \
      _Pragma("unroll") for (int mi = 0; mi < 4; mi++) a[mi] = *(const bf16x8*)(As + (wm * 128 + mi * 32 + r) * GLD + ks * 16 + h * 8); \
      _Pragma("unroll") for (int ni = 0; ni < 2; ni++) b[ni] = *(const bf16x8*)(Bs + (wn * 64 + ni * 32 + r) * GLD + ks * 16 + h * 8);  \
      if (!trans) {                                                                                                         \
        _Pragma("unroll") for (int mi = 0; mi < 4; mi++)                                                                    \
          _Pragma("unroll") for (int ni = 0; ni < 2; ni++) acc[mi][ni] = MFMA32(a[mi], b[ni], acc[mi][ni]);                 \
      } else {                                                                                                              \
        _Pragma("unroll") for (int mi = 0; mi < 4; mi++)                                                                    \
          _Pragma("unroll") for (int ni = 0; ni < 2; ni++) acc[mi][ni] = MFMA32(b[ni], a[mi], acc[mi][ni]);                 \
      }                                                                                                                     \
    }                                                                                                                       \
  }
  GEMM_GLOAD(0, ra0, rb0)
  GEMM_GLOAD(1, ra1, rb1)
  GEMM_LWRITE(0, ra0, rb0)
  __syncthreads();
  for (int kt = 0; kt < nk; kt += 2) {
    GEMM_LWRITE(kt + 1, ra1, rb1)
    if (kt + 2 < nk) { GEMM_GLOAD(kt + 2, ra0, rb0) GEMM_GLOAD(kt + 3, ra1, rb1) }
    GEMM_COMPUTE(kt)
    __syncthreads();
    if (kt + 2 < nk) GEMM_LWRITE(kt + 2, ra0, rb0)
    GEMM_COMPUTE(kt + 1)
    __syncthreads();
  }
#undef GEMM_COMPUTE
#undef GEMM_GLOAD
#undef GEMM_LWRITE
  if (ROWNORM) {
    float* rsp = rs + 256;
    {
      const int t2 = tidx();
#pragma unroll
      for (int i = 0; i < 4; i++) rsp[((t2 >> 2) + 64 * i) * 4 + (t2 & 3)] = ssq[i];
    }
    __syncthreads();
    {
      const int t3 = tidx();
      float4 q = *(const float4*)(rsp + t3 * 4);
      rs[t3] = rsqrtf((q.x + q.y + q.z + q.w) / (float)K + 1e-6f);
    }
    __syncthreads();
  }
#define EPI_CALL(mi, ni) epi(m0 + wm * 128 + (mi) * 32, n0 + wn * 64 + (ni) * 32, acc[mi][ni], rs);
  EPI_CALL(0, 0) EPI_CALL(0, 1) EPI_CALL(1, 0) EPI_CALL(1, 1) EPI_CALL(2, 0) EPI_CALL(2, 1) EPI_CALL(3, 0) EPI_CALL(3, 1)
#undef EPI_CALL
  __syncthreads();
}

DI void phase_win(const Params& p, int l, char* smem) {
  const u16* H = (const u16*)(p.ws + OFF_H);
  const u16* W = (const u16*)(p.ws + OFF_W + (size_t)l * WL_SIZE + WL_WIN);
  u16* UT = (u16*)(p.ws + OFF_UT);
  u16* UTC = (u16*)(p.ws + OFF_UTC);
  u16* RET = (u16*)(p.ws + OFF_RET);
  u16* CQ = (u16*)(p.ws + OFF_CQ);
  u16* CKV = (u16*)(p.ws + OFF_CKV);
  u16* KF = (u16*)(p.ws + OFF_KF);
  const int lane = tidx() & 63, r = lane & 31, h = lane >> 5;
  const int total = 132 * 18;
  for (int it = blockIdx.x; it < total; it += gridDim.x) {
    int mt = it / 18, nt = it - mt * 18;
    int m0 = mt * 256, n0 = nt * 128;
    if (nt < 6) {
      gemm_tile<false, true, true>(H, 1024, W, 1024, 1024, m0, n0, nullptr, 0, smem,
        [&](int bm, int bn, const f32x16& acc, const float*) __attribute__((always_inline)) {
        const int lz_ = tidx() & 63, r = lz_ & 31, h = lz_ >> 5;
          int row = bm + r, b, t, key, cond;
          row_info(row, b, t, key, cond);
          u16* dstp = row < TLAT ? UT + ((size_t)(b * 768)) * SEQ + t : UTC + ((size_t)(b * 768)) * LCTX + t;
          int strd = row < TLAT ? SEQ : LCTX;
#pragma unroll
          for (int reg = 0; reg < 16; reg++) dstp[(size_t)(bn + crow(reg, h)) * strd] = f2bf(acc[reg]);
        });
    } else {
      gemm_tile<false, false, false>(H, 1024, W, 1024, 1024, m0, n0, nullptr, 0, smem,
        [&](int bm, int bn, const f32x16& acc, const float*) __attribute__((always_inline)) {
        const int lz_ = tidx() & 63, r = lz_ & 31, h = lz_ >> 5;
        if (nt < 14) {

          int col = bn + r - 768;
          float sc = (col >= 256 && col < 512) ? 0.125f : 1.f;
#pragma unroll
          for (int reg = 0; reg < 16; reg++) RET[(size_t)(bm + crow(reg, h)) * 1024 + col] = f2bf(acc[reg] * sc);
        } else if (nt < 16) {
          int col = bn + r - 1792;
#pragma unroll
          for (int reg = 0; reg < 16; reg++) CQ[(size_t)(bm + crow(reg, h)) * 256 + col] = f2bf(acc[reg]);
        } else if (nt == 16) {
          int col = bn + r - 2048;
#pragma unroll
          for (int reg = 0; reg < 16; reg++) CKV[(size_t)(bm + crow(reg, h)) * 128 + col] = f2bf(acc[reg]);
        } else if (bn == 2176) {
#pragma unroll
          for (int reg = 0; reg < 16; reg++) {
            int row = bm + crow(reg, h), b, t, key, cond;
            row_info(row, b, t, key, cond);
            float v = acc[reg];
            float vr = rope_apply((const float2*)(p.ws + OFF_ROPE), v, r, t);
            if (row < TLAT) v = vr;
            u16 o = f2bf(v);
#pragma unroll
            for (int hh = 0; hh < 8; hh++) KF[((size_t)(b * 8 + hh) * LKEY + key) * 96 + 64 + r] = o;
          }
        }
      });
    }
  }
}

DI void ret_gammas(const Params& p, int l, int hh, float& lgf, float& lgb) {
  lgf = log1pf(-expf(p.in[I_RLD][l * 8 + hh]));
  lgb = log1pf(-expf(p.in[I_RLD][l * 8 + 4 + hh]));
}
DI void ret_kv_item(const Params& p, int l, int b, int hh, int ci, char* smem) {
  const u16* RET = (const u16*)(p.ws + OFF_RET);
  float* ST = (float*)(p.ws + OFF_ST);
  u16* KfT = (u16*)smem;
  u16* KbT = KfT + 64 * 136;
  u16* VsT = KbT + 64 * 136;
  int tid_o = tidx();
  asm volatile("" : "+v"(tid_o));
  const int tid = tid_o, lane = tid & 63, wid = tid >> 6, r = lane & 31, h = lane >> 5;
  float lgf, lgb;
  ret_gammas(p, l, hh, lgf, lgb);
  const int row0 = chunk_row0(b, ci);
#pragma unroll
  for (int i = 0; i < 4; i++) {
    int id = tid + 256 * i, m = id >> 3, dc = id & 7;
    u32x4 kv = *(const u32x4*)(RET + (size_t)(row0 + m) * 1024 + 256 + hh * 64 + dc * 8);
    u32x4 vv = *(const u32x4*)(RET + (size_t)(row0 + m) * 1024 + 512 + hh * 64 + dc * 8);
    float zf = __expf(lgf * (float)(127 - m)), zb = __expf(lgb * (float)m);
#pragma unroll
    for (int j = 0; j < 8; j++) {
      float kval = bfe(kv, j);
      KfT[(dc * 8 + j) * 136 + m] = f2bf(kval * zf);
      KbT[(dc * 8 + j) * 136 + m] = f2bf(kval * zb);
      VsT[(dc * 8 + j) * 136 + m] = bfu(vv, j);
    }
  }
  __syncthreads();
  const int dir = wid >> 1, dh = wid & 1;
  const u16* Asrc = dir ? KbT : KfT;
  f32x16 c0, c1;
#pragma unroll
  for (int e = 0; e < 16; e++) { c0[e] = 0.f; c1[e] = 0.f; }
#pragma unroll
  for (int ks = 0; ks < 8; ks++) {
    bf16x8 a = *(const bf16x8*)(Asrc + (dh * 32 + r) * 136 + ks * 16 + h * 8);
    bf16x8 b0 = *(const bf16x8*)(VsT + (r) * 136 + ks * 16 + h * 8);
    bf16x8 b1 = *(const bf16x8*)(VsT + (32 + r) * 136 + ks * 16 + h * 8);
    c0 = MFMA32(a, b0, c0);
    c1 = MFMA32(a, b1, c1);
  }
  float* dst = ST + ((size_t)((dir * 4 + b) * 4 + hh) * NCH + ci) * 4096;
#pragma unroll
  for (int reg = 0; reg < 16; reg++) {
    int d = dh * 32 + crow(reg, h);
    dst[d * 64 + r] = c0[reg];
    dst[d * 64 + 32 + r] = c1[reg];
  }
  __syncthreads();
}

#define PX(i) ((i) + ((i) >> 4))
typedef float cf2 __attribute__((ext_vector_type(2)));
DI cf2 mk2(float x, float y) { cf2 r; r.x = x; r.y = y; return r; }
DI cf2 cmul(cf2 a, cf2 b) { return mk2(a.x * b.x - a.y * b.y, a.x * b.y + a.y * b.x); }
DI cf2 cmulc(cf2 a, cf2 b) { return mk2(a.x * b.x + a.y * b.y, a.y * b.x - a.x * b.y); }
DI cf2 cadd(cf2 a, cf2 b) { return mk2(a.x + b.x, a.y + b.y); }
DI cf2 csub(cf2 a, cf2 b) { return mk2(a.x - b.x, a.y - b.y); }
DI cf2 twid_rev(float rev) { return mk2(__builtin_amdgcn_cosf(rev), -__builtin_amdgcn_sinf(rev)); }

template <int S, bool INV>
DI void fft_pass8(float2* Xf2, int tid) {
  cf2* X = (cf2*)Xf2;
  constexpr int span = 8192 >> S, q = span >> 3, lq = 10 - S;
  const float R = 0.70710678118654752f;
#pragma unroll 2
  for (int gi = 0; gi < 4; gi++) {
    int g = tid + 256 * gi;
    int j = g & (q - 1), blk = g >> lq, base = blk * span + j;
    cf2 v[8];
#pragma unroll
    for (int k = 0; k < 8; k++) v[k] = X[PX(base + k * q)];
    cf2 W = twid_rev((float)j * (1.f / (float)span));
    cf2 W2 = cmul(W, W), W4 = cmul(W2, W2);
    cf2 w1 = cmul(W, mk2(R, -R)), w2 = mk2(W.y, -W.x), w3 = cmul(W, mk2(-R, -R));
    cf2 w2b = mk2(W2.y, -W2.x);
    if (!INV) {
      { cf2 a, d;
        a = v[0]; d = csub(a, v[4]); v[0] = cadd(a, v[4]); v[4] = cmul(d, W);
        a = v[1]; d = csub(a, v[5]); v[1] = cadd(a, v[5]); v[5] = cmul(d, w1);
        a = v[2]; d = csub(a, v[6]); v[2] = cadd(a, v[6]); v[6] = cmul(d, w2);
        a = v[3]; d = csub(a, v[7]); v[3] = cadd(a, v[7]); v[7] = cmul(d, w3); }
#pragma unroll
      for (int b4 = 0; b4 < 8; b4 += 4) { cf2 a, d;
        a = v[b4]; d = csub(a, v[b4 + 2]); v[b4] = cadd(a, v[b4 + 2]); v[b4 + 2] = cmul(d, W2);
        a = v[b4 + 1]; d = csub(a, v[b4 + 3]); v[b4 + 1] = cadd(a, v[b4 + 3]); v[b4 + 3] = cmul(d, w2b); }
#pragma unroll
      for (int k = 0; k < 8; k += 2) { cf2 a = v[k], d = csub(a, v[k + 1]); v[k] = cadd(a, v[k + 1]); v[k + 1] = cmul(d, W4); }
    } else {
#pragma unroll
      for (int k = 0; k < 8; k += 2) { cf2 a = v[k], bb = cmulc(v[k + 1], W4); v[k] = cadd(a, bb); v[k + 1] = csub(a, bb); }
#pragma unroll
      for (int b4 = 0; b4 < 8; b4 += 4) { cf2 a, bb;
        a = v[b4]; bb = cmulc(v[b4 + 2], W2); v[b4] = cadd(a, bb); v[b4 + 2] = csub(a, bb);
        a = v[b4 + 1]; bb = cmulc(v[b4 + 3], w2b); v[b4 + 1] = cadd(a, bb); v[b4 + 3] = csub(a, bb); }
      { cf2 a, bb;
        a = v[0]; bb = cmulc(v[4], W); v[0] = cadd(a, bb); v[4] = csub(a, bb);
        a = v[1]; bb = cmulc(v[5], w1); v[1] = cadd(a, bb); v[5] = csub(a, bb);
        a = v[2]; bb = cmulc(v[6], w2); v[2] = cadd(a, bb); v[6] = csub(a, bb);
        a = v[3]; bb = cmulc(v[7], w3); v[3] = cadd(a, bb); v[7] = csub(a, bb); }
    }
#pragma unroll
    for (int k = 0; k < 8; k++) X[PX(base + k * q)] = v[k];
  }
  __syncthreads();
}

DI cf2 t16f(int k) {
  const float C1 = 0.92387953251128674f, S1 = 0.38268343236508977f, R = 0.70710678118654752f;
  return k == 0 ? mk2(1.f, 0.f) : k == 1 ? mk2(C1, -S1) : k == 2 ? mk2(R, -R) : k == 3 ? mk2(S1, -C1) : k == 4 ? mk2(0.f, -1.f)
       : k == 5 ? mk2(-S1, -C1) : k == 6 ? mk2(-R, -R) : mk2(-C1, -S1);
}
template <bool INV>
DI void fft_pass16(float2* Xf2, int tid) {
  cf2* X = (cf2*)Xf2;
#pragma unroll 1
  for (int gi = 0; gi < 2; gi++) {
    int g = tid + 256 * gi;
    cf2* xp = X + 17 * g;
    cf2 v[16];
#pragma unroll
    for (int k = 0; k < 16; k++) v[k] = xp[k];
    if (!INV) {
#pragma unroll
      for (int k = 0; k < 8; k++) { cf2 a = v[k], d = csub(a, v[k + 8]); v[k] = cadd(a, v[k + 8]); v[k + 8] = cmul(d, t16f(k)); }
#pragma unroll
      for (int b8 = 0; b8 < 16; b8 += 8)
#pragma unroll
        for (int k = 0; k < 4; k++) { cf2 a = v[b8 + k], d = csub(a, v[b8 + k + 4]); v[b8 + k] = cadd(a, v[b8 + k + 4]); v[b8 + k + 4] = cmul(d, t16f(2 * k)); }
#pragma unroll
      for (int b4 = 0; b4 < 16; b4 += 4)
#pragma unroll
        for (int k = 0; k < 2; k++) { cf2 a = v[b4 + k], d = csub(a, v[b4 + k + 2]); v[b4 + k] = cadd(a, v[b4 + k + 2]); v[b4 + k + 2] = cmul(d, t16f(4 * k)); }
#pragma unroll
      for (int k = 0; k < 16; k += 2) { cf2 a = v[k], bb = v[k + 1]; v[k] = cadd(a, bb); v[k + 1] = csub(a, bb); }
    } else {
#pragma unroll
      for (int k = 0; k < 16; k += 2) { cf2 a = v[k], bb = v[k + 1]; v[k] = cadd(a, bb); v[k + 1] = csub(a, bb); }
#pragma unroll
      for (int b4 = 0; b4 < 16; b4 += 4)
#pragma unroll
        for (int k = 0; k < 2; k++) { cf2 a = v[b4 + k], bb = cmulc(v[b4 + k + 2], t16f(4 * k)); v[b4 + k] = cadd(a, bb); v[b4 + k + 2] = csub(a, bb); }
#pragma unroll
      for (int b8 = 0; b8 < 16; b8 += 8)
#pragma unroll
        for (int k = 0; k < 4; k++) { cf2 a = v[b8 + k], bb = cmulc(v[b8 + k + 4], t16f(2 * k)); v[b8 + k] = cadd(a, bb); v[b8 + k + 4] = csub(a, bb); }
#pragma unroll
      for (int k = 0; k < 8; k++) { cf2 a = v[k], bb = cmulc(v[k + 8], t16f(k)); v[k] = cadd(a, bb); v[k + 8] = csub(a, bb); }
    }
#pragma unroll
    for (int k = 0; k < 16; k++) xp[k] = v[k];
  }
  __syncthreads();
}
DI void fft_dif(float2* X, const float2* __restrict__, int tid) {
  fft_pass8<0, false>(X, tid); fft_pass8<3, false>(X, tid); fft_pass8<6, false>(X, tid); fft_pass16<false>(X, tid);
}
DI void fft_dit(float2* X, const float2* __restrict__, int tid) {
  fft_pass16<true>(X, tid); fft_pass8<6, true>(X, tid); fft_pass8<3, true>(X, tid); fft_pass8<0, true>(X, tid);
}

DI void filt_fft_item(const Params& p, int l, int o, int c, char* smem) {
  float2* X = (float2*)smem;
  float* Xf = (float*)smem;
  float* w3s = (float*)(smem + 69632);
  float* red = w3s + 128;
  const float2* TW = (const float2*)(p.ws + OFF_TW);
  const float* H2 = (const float*)(p.ws + OFF_H2F);
  float2* KS = (float2*)(p.ws + OFF_KSPEC) + (size_t)(o * 256 + c) * 2 * 8192;
  int tid_o = tidx();
  asm volatile("" : "+v"(tid_o));
  const int tid = tid_o;
  if (tid < 128) { int j = tid & 63, side = tid >> 6; w3s[tid] = p.in[I_HW3][((size_t)l * 64 + j) * 1024 + side * 512 + o * 256 + c]; }
  __syncthreads();
  const float min_decay = -3.0701134573253944f, max_decay = -15.350567286626972f;
  const float delta = fabsf(min_decay + (float)c * ((max_decay - min_decay) / 255.f));
  float* Ff = Xf;
  float* Fb = Xf + 8192;
#pragma unroll 1
  for (int i = 0; i < 32; i++) {
    int n = tid + 256 * i;
    const float4* hp = (const float4*)(H2 + (size_t)n * 64);
    float f = 0.f, bsum = 0.f;
#pragma unroll
    for (int q = 0; q < 16; q++) {
      float4 hv = hp[q];
      f += hv.x * w3s[q * 4] + hv.y * w3s[q * 4 + 1] + hv.z * w3s[q * 4 + 2] + hv.w * w3s[q * 4 + 3];
      bsum += hv.x * w3s[64 + q * 4] + hv.y * w3s[64 + q * 4 + 1] + hv.z * w3s[64 + q * 4 + 2] + hv.w * w3s[64 + q * 4 + 3];
    }
    float win = expf(-((float)n / 8191.f) * delta);
    Ff[n] = f * win; Fb[n] = bsum * win;
  }
  __syncthreads();
  float part = 0.f;
#pragma unroll 2
  for (int i = 0; i < 32; i++) {
    int n = tid + 256 * i;
    float k1 = Ff[n], k2 = 0.f;
    if (n == 0) k1 += Fb[0]; else k2 = Fb[8192 - n];
    part += fabsf(k1) + fabsf(k2);
    KS[8192 + n] = make_float2(k1, k2);
  }
  part = wave_sum(part);
  if ((tid & 63) == 0) red[tid >> 6] = part;
  __syncthreads();
  const float inv = 1.f / (red[0] + red[1] + red[2] + red[3]);
#pragma unroll 2
  for (int i = 0; i < 32; i++) { int n = tidx() + 256 * i; float2 kp = KS[8192 + n]; X[PX(n)] = make_float2((kp.x + kp.y) * inv, 0.f); }
  __syncthreads();
  fft_dif(X, TW, tid);
#pragma unroll 2
  for (int i = 0; i < 32; i++) { int n = tidx() + 256 * i; KS[n] = X[PX(n)]; }
  __syncthreads();
#pragma unroll 2
  for (int i = 0; i < 32; i++) { int n = tidx() + 256 * i; float2 w = TW[n]; float2 kp = KS[8192 + n]; float d = (kp.x - kp.y) * inv; X[PX(n)] = make_float2(d * w.x, d * w.y); }
  __syncthreads();
  fft_dif(X, TW, tid);
#pragma unroll 2
  for (int i = 0; i < 32; i++) { int n = tidx() + 256 * i; KS[8192 + n] = X[PX(n)]; }
  __syncthreads();
}

DI void filt_ctx_item(const Params& p, int l, int o, int c, char* smem) {
  float* red = (float*)smem;
  const float* H2 = (const float*)(p.ws + OFF_H2C);
  float* KC = (float*)(p.ws + OFF_KC) + (size_t)(o * 256 + c) * 512;
  int tid_o = tidx();
  asm volatile("" : "+v"(tid_o));
  const int n = tid_o;
  const float min_decay = -3.0701134573253944f, max_decay = -15.350567286626972f;
  const float delta = fabsf(min_decay + (float)c * ((max_decay - min_decay) / 255.f));
  float f = 0.f, bsum = 0.f;
  for (int j = 0; j < 64; j++) {
    float hv = H2[n * 64 + j];
    f += hv * p.in[I_HW3][((size_t)l * 64 + j) * 1024 + o * 256 + c];
    bsum += hv * p.in[I_HW3][((size_t)l * 64 + j) * 1024 + 512 + o * 256 + c];
  }
  float win = expf(-((float)n / 255.f) * delta);
  f *= win; bsum *= win;
  float part = n == 0 ? fabsf(f + bsum) : fabsf(f) + fabsf(bsum);
  part = wave_sum(part);
  __syncthreads();
  if ((n & 63) == 0) red[n >> 6] = part;
  __syncthreads();
  float inv = 1.f / (red[0] + red[1] + red[2] + red[3]);
  if (n == 0) { KC[256] = (f + bsum) * inv; KC[0] = 0.f; }
  else { KC[256 + n] = f * inv; KC[256 - n] = bsum * inv; }
  __syncthreads();
}

DI void phase_p3(const Params& p, int l, char* smem) {
  const int lane = tidx() & 63, r = lane & 31, h = lane >> 5;
  const int n_uq = (l == 0 ? 132 : 128) * 6, n_ukv = 132 * 8, n_r1 = 16 * NCH, n_ff = 512, n_fc = (l == 0 ? 512 : 0);
  const int total = n_uq + n_ukv + n_r1 + n_ff + n_fc;
  const char* wl = p.ws + OFF_W + (size_t)l * WL_SIZE;
  u16* Q = (u16*)(p.ws + OFF_Q);
  u16* KF = (u16*)(p.ws + OFF_KF);
  u16* VT = (u16*)(p.ws + OFF_VT);
  for (int it = blockIdx.x; it < total; it += gridDim.x) {
    int q = it;
    if (q < n_uq) {
      int mt = q / 6, nt = q - mt * 6;
      if (SUB_ON(0)) gemm_tile<true, false, false>((const u16*)(p.ws + OFF_CQ), 256, (const u16*)(wl + WL_WUQ), 256, 256, mt * 256, nt * 128, nullptr, 0, smem,
        [&](int bm, int bn, const f32x16& acc, const float* rs) __attribute__((always_inline)) {
        const int lz_ = tidx() & 63, r = lz_ & 31, h = lz_ >> 5;
          int col = bn + r;
          int j = col % 96;
          const float qscale = 0.10206207261596577f * 1.4426950408889634f;
#pragma unroll
          for (int reg = 0; reg < 16; reg++) {
            int row = bm + crow(reg, h);
            float v = acc[reg] * rs[row - mt * 256];
            if (j >= 64) {
              int b, t, key, cond;
              row_info(row, b, t, key, cond);
              float vr = rope_apply((const float2*)(p.ws + OFF_ROPE), v, r, t);
              if (row < TLAT) v = vr;
            }
            Q[(size_t)row * 768 + col] = f2bf(v * qscale);
          }
        });
    } else if ((q -= n_uq) < n_ukv) {
      int mt = q >> 3, nt = q & 7;
      if (nt < 4) {
        if (SUB_ON(1)) gemm_tile<true, false, false>((const u16*)(p.ws + OFF_CKV), 128, (const u16*)(wl + WL_WUKV), 128, 128, mt * 256, nt * 128, nullptr, 0, smem,
          [&](int bm, int bn, const f32x16& acc, const float* rs) __attribute__((always_inline)) {
        const int lz_ = tidx() & 63, r = lz_ & 31, h = lz_ >> 5;
            int hd = bn >> 6, j = (bn & 63) + r;
#pragma unroll
            for (int reg = 0; reg < 16; reg++) {
              int row = bm + crow(reg, h), b, t, key, cond;
              row_info(row, b, t, key, cond);
              KF[((size_t)(b * 8 + hd) * LKEY + key) * 96 + j] = f2bf(acc[reg] * rs[row - mt * 256]);
            }
          });
      } else {
        if (SUB_ON(1)) gemm_tile<true, true, true>((const u16*)(p.ws + OFF_CKV), 128, (const u16*)(wl + WL_WUKV), 128, 128, mt * 256, nt * 128, nullptr, 0, smem,
          [&](int bm, int bn, const f32x16& acc, const float* rs) __attribute__((always_inline)) {
        const int lz_ = tidx() & 63, r = lz_ & 31, h = lz_ >> 5;
            int row = bm + r, b, t, key, cond;
            row_info(row, b, t, key, cond);
            float rr = rs[row - mt * 256];
            int hd = (bn - 512) >> 6, e0 = (bn - 512) & 63;
            u16* dstp = VT + ((size_t)(b * 8 + hd) * 64 + e0) * LKEY + key;
#pragma unroll
            for (int reg = 0; reg < 16; reg++) dstp[(size_t)crow(reg, h) * LKEY] = f2bf(acc[reg] * rr);
          });
      }
    } else if ((q -= n_ukv) < n_r1) {
      int bh = q / NCH, ci = q - bh * NCH;
      if (SUB_ON(2)) ret_kv_item(p, l, bh >> 2, bh & 3, ci, smem);
    } else if ((q -= n_r1) < n_ff) {
      if (SUB_ON(3)) filt_fft_item(p, l, q >> 8, q & 255, smem);
    } else {
      q -= n_ff;
      if (SUB_ON(4)) filt_ctx_item(p, l, q >> 8, q & 255, smem);
    }
  }
}

DI void phase_scan(const Params& p, int l) {
  float* ST = (float*)(p.ws + OFF_ST);
  for (int idx = blockIdx.x * 256 + tidx(); idx < 2 * 16 * 4096; idx += gridDim.x * 256) {
    int dir = idx >> 16, bh = (idx >> 12) & 15, el = idx & 4095, hh = bh & 3;
    float* base = ST + (size_t)((dir * 16 + bh) * NCH) * 4096 + el;
    float lg = log1pf(-expf(p.in[I_RLD][l * 8 + dir * 4 + hh]));
    float gC = expf(lg * 128.f);
    float s = 0.f;
    if (dir == 0) {
      for (int ci = 0; ci < NCH; ci++) { float tmp = base[(size_t)ci * 4096]; base[(size_t)ci * 4096] = s; s = gC * s + tmp; }
    } else {
      for (int ci = 1; ci >= 0; ci--) { float tmp = base[(size_t)ci * 4096]; base[(size_t)ci * 4096] = s; s = gC * s + tmp; }
      for (int ci = NCH - 1; ci >= 2; ci--) { float tmp = base[(size_t)ci * 4096]; base[(size_t)ci * 4096] = s; s = gC * s + tmp; }
    }
  }
}

DI void attn_item(const Params& p, int b, int hh, int qrow0, int key0, int nkeys, char* smem) {
  u16* Ks = (u16*)smem;
  u16* Vs = Ks + 64 * 104;
  const u16* Q = (const u16*)(p.ws + OFF_Q);
  const u16* KF = (const u16*)(p.ws + OFF_KF);
  const u16* VT = (const u16*)(p.ws + OFF_VT);
  u16* MIX = (u16*)(p.ws + OFF_H);
  int tid_o = tidx();
  asm volatile("" : "+v"(tid_o));
  const int tid = tid_o, lane = tid & 63, wid = tid >> 6, r = lane & 31, h = lane >> 5;
  const int qrow = qrow0 + wid * 32 + r;
  bf16x8 qf[6];
#pragma unroll
  for (int ks = 0; ks < 6; ks++) qf[ks] = *(const bf16x8*)(Q + (size_t)qrow * 768 + hh * 96 + ks * 16 + h * 8);
  f32x16 o0, o1;
#pragma unroll
  for (int e = 0; e < 16; e++) { o0[e] = 0.f; o1[e] = 0.f; }
  float m = -1e30f, lsum = 0.f;
  const u32x4* kbase = (const u32x4*)(KF + ((size_t)(b * 8 + hh) * LKEY + key0) * 96);
  const u16* vbase = VT + (size_t)(b * 8 + hh) * 64 * LKEY + key0;
  u32x4 rk[3], rv[2];
  const int nt = nkeys >> 6;
#define ATT_GLOAD(T)                                                                                                        \
  {                                                                                                                         \
    const int t_ = (T);                                                                                                     \
    _Pragma("unroll") for (int i = 0; i < 3; i++) rk[i] = kbase[(size_t)t_ * 768 + tid + 256 * i];                          \
    _Pragma("unroll") for (int i = 0; i < 2; i++) { int id = tid + 256 * i; rv[i] = *(const u32x4*)(vbase + (size_t)(id >> 3) * LKEY + t_ * 64 + (id & 7) * 8); } \
  }
  ATT_GLOAD(0)
  for (int t = 0; t < nt; t++) {
    __syncthreads();
#pragma unroll
    for (int i = 0; i < 3; i++) { int id = tid + 256 * i; int kr = id / 12, c = id - kr * 12; *(u32x4*)(Ks + kr * 104 + c * 8) = rk[i]; }
#pragma unroll
    for (int i = 0; i < 2; i++) { int id = tid + 256 * i; *(u32x4*)(Vs + (id >> 3) * 72 + (id & 7) * 8) = rv[i]; }
    __syncthreads();
    if (t + 1 < nt) ATT_GLOAD(t + 1)
    f32x16 s0, s1;
#pragma unroll
    for (int e = 0; e < 16; e++) { s0[e] = 0.f; s1[e] = 0.f; }
#pragma unroll
    for (int ks = 0; ks < 6; ks++) {
      bf16x8 k0 = *(const bf16x8*)(Ks + (r) * 104 + ks * 16 + h * 8);
      bf16x8 k1 = *(const bf16x8*)(Ks + (32 + r) * 104 + ks * 16 + h * 8);
      s0 = MFMA32(k0, qf[ks], s0);
      s1 = MFMA32(k1, qf[ks], s1);
    }
    float mx = s0[0];
#pragma unroll
    for (int e = 0; e < 16; e++) { mx = fmaxf(mx, s0[e]); mx = fmaxf(mx, s1[e]); }
    mx = fmaxf(mx, __shfl_xor(mx, 32));
    float mnew = fmaxf(m, mx);
    float alpha = __builtin_amdgcn_exp2f(m - mnew);
    float ps = 0.f;
#pragma unroll
    for (int e = 0; e < 16; e++) {
      s0[e] = __builtin_amdgcn_exp2f(s0[e] - mnew); ps += s0[e];
      s1[e] = __builtin_amdgcn_exp2f(s1[e] - mnew); ps += s1[e];
    }
    ps += __shfl_xor(ps, 32);
    lsum = lsum * alpha + ps;
    m = mnew;
#pragma unroll
    for (int e = 0; e < 16; e++) { o0[e] *= alpha; o1[e] *= alpha; }
#pragma unroll
    for (int kt2 = 0; kt2 < 2; kt2++) {
#pragma unroll
      for (int sx = 0; sx < 2; sx++) {
        u32x4 pw;
        if (kt2 == 0) {
          pw.x = pack2(s0[8 * sx + 0], s0[8 * sx + 1]); pw.y = pack2(s0[8 * sx + 2], s0[8 * sx + 3]);
          pw.z = pack2(s0[8 * sx + 4], s0[8 * sx + 5]); pw.w = pack2(s0[8 * sx + 6], s0[8 * sx + 7]);
        } else {
          pw.x = pack2(s1[8 * sx + 0], s1[8 * sx + 1]); pw.y = pack2(s1[8 * sx + 2], s1[8 * sx + 3]);
          pw.z = pack2(s1[8 * sx + 4], s1[8 * sx + 5]); pw.w = pack2(s1[8 * sx + 6], s1[8 * sx + 7]);
        }
        bf16x8 pb = __builtin_bit_cast(bf16x8, pw);
        int kb = kt2 * 32 + 16 * sx + 4 * h;
        {
          const u16* vp = Vs + (r) * 72 + kb;
          uint2 lo = *(const uint2*)vp, hi = *(const uint2*)(vp + 8);
          u32x4 vw = {lo.x, lo.y, hi.x, hi.y};
          o0 = MFMA32(__builtin_bit_cast(bf16x8, vw), pb, o0);
        }
        {
          const u16* vp = Vs + (32 + r) * 72 + kb;
          uint2 lo = *(const uint2*)vp, hi = *(const uint2*)(vp + 8);
          u32x4 vw = {lo.x, lo.y, hi.x, hi.y};
          o1 = MFMA32(__builtin_bit_cast(bf16x8, vw), pb, o1);
        }
      }
    }
  }
  const float inv = 1.f / lsum;
  u16* dst = MIX + (size_t)qrow * 1024 + 512 + hh * 64;
#pragma unroll
  for (int g = 0; g < 4; g++) {
    int e = 8 * g + 4 * h;
    *(uint2*)(dst + e) = make_uint2(pack2(o0[4 * g] * inv, o0[4 * g + 1] * inv), pack2(o0[4 * g + 2] * inv, o0[4 * g + 3] * inv));
    *(uint2*)(dst + 32 + e) = make_uint2(pack2(o1[4 * g] * inv, o1[4 * g + 1] * inv), pack2(o1[4 * g + 2] * inv, o1[4 * g + 3] * inv));
  }
  __syncthreads();
}

DI void ret_out_item(const Params& p, int l, int b, int hh, int ci, char* smem) {
  const u16* RET = (const u16*)(p.ws + OFF_RET);
  const float* ST = (const float*)(p.ws + OFF_ST);
  u16* MIX = (u16*)(p.ws + OFF_H);
  u16* Qs = (u16*)smem;
  u16* Ks = Qs + 128 * 72;
  u16* Ps = Qs;
  u16* VsT = Ks + 128 * 72;
  u16* SfT = VsT + 64 * 136;
  u16* SbT = SfT + 64 * 72;
  float* dmk = (float*)(SbT + 64 * 72);
  int tid_o = tidx();
  asm volatile("" : "+v"(tid_o));
  const int tid = tid_o, lane = tid & 63, wid = tid >> 6, r = lane & 31, h = lane >> 5;
  float lgf, lgb;
  ret_gammas(p, l, hh, lgf, lgb);
  const int row0 = chunk_row0(b, ci);
  { int d = tid - 128; dmk[tid] = d > 0 ? __expf(lgf * (float)d) : (d < 0 ? __expf(lgb * (float)(-d)) : 2.f); }
#pragma unroll 2
  for (int i = 0; i < 4; i++) {
    int id = tid + 256 * i, m = id >> 3, dc = id & 7;
    const u16* rp = RET + (size_t)(row0 + m) * 1024 + hh * 64 + dc * 8;
    *(uint4*)(Qs + m * 72 + dc * 8) = *(const uint4*)(rp);
    *(uint4*)(Ks + m * 72 + dc * 8) = *(const uint4*)(rp + 256);
    u32x4 vv = *(const u32x4*)(rp + 512);
#pragma unroll
    for (int j = 0; j < 8; j++) VsT[(dc * 8 + j) * 136 + m] = bfu(vv, j);
  }
  const float* Sf = ST + ((size_t)((0 * 4 + b) * 4 + hh) * NCH + ci) * 4096;
  const float* Sb = ST + ((size_t)((1 * 4 + b) * 4 + hh) * NCH + ci) * 4096;
#pragma unroll 2
  for (int i = 0; i < 16; i++) {
    int id = tid + 256 * i, d = id >> 6, e = id & 63;
    SfT[e * 72 + d] = f2bf(Sf[id]);
    SbT[e * 72 + d] = f2bf(Sb[id]);
  }
  __syncthreads();
  const int cw = wid * 32;
  f32x16 in0, in1, sc[4];
  {
    f32x16 cf0, cf1, cb0, cb1;
#pragma unroll
    for (int e = 0; e < 16; e++) { cf0[e] = cf1[e] = cb0[e] = cb1[e] = 0.f; }
#pragma unroll
    for (int ks = 0; ks < 4; ks++) {
      bf16x8 qa = *(const bf16x8*)(Qs + (cw + r) * 72 + ks * 16 + h * 8);
      cf0 = MFMA32(qa, *(const bf16x8*)(SfT + (r) * 72 + ks * 16 + h * 8), cf0);
      cf1 = MFMA32(qa, *(const bf16x8*)(SfT + (32 + r) * 72 + ks * 16 + h * 8), cf1);
      cb0 = MFMA32(qa, *(const bf16x8*)(SbT + (r) * 72 + ks * 16 + h * 8), cb0);
      cb1 = MFMA32(qa, *(const bf16x8*)(SbT + (32 + r) * 72 + ks * 16 + h * 8), cb1);
    }
#pragma unroll
    for (int reg = 0; reg < 16; reg++) {
      int c = cw + crow(reg, h);
      float xf = __expf(lgf * (float)(c + 1)), xb = __expf(lgb * (float)(128 - c));
      in0[reg] = xf * cf0[reg] + xb * cb0[reg];
      in1[reg] = xf * cf1[reg] + xb * cb1[reg];
    }
  }
#pragma unroll
  for (int e = 0; e < 16; e++) { sc[0][e] = sc[1][e] = sc[2][e] = sc[3][e] = 0.f; }
#pragma unroll
  for (int ks = 0; ks < 4; ks++) {
    bf16x8 qa = *(const bf16x8*)(Qs + (cw + r) * 72 + ks * 16 + h * 8);
#pragma unroll
    for (int mt = 0; mt < 4; mt++) sc[mt] = MFMA32(qa, *(const bf16x8*)(Ks + (mt * 32 + r) * 72 + ks * 16 + h * 8), sc[mt]);
  }
  __syncthreads();
#pragma unroll
  for (int mt = 0; mt < 4; mt++)
#pragma unroll
    for (int reg = 0; reg < 16; reg++) {
      int c = cw + crow(reg, h), mm = mt * 32 + r;
      Ps[c * 136 + mm] = f2bf(sc[mt][reg] * dmk[c - mm + 128]);
      if ((reg & 3) == 3) __builtin_amdgcn_sched_barrier(0);
    }
  __syncthreads();
#pragma unroll
  for (int ks = 0; ks < 8; ks++) {
    bf16x8 pa = *(const bf16x8*)(Ps + (cw + r) * 136 + ks * 16 + h * 8);
    in0 = MFMA32(pa, *(const bf16x8*)(VsT + (r) * 136 + ks * 16 + h * 8), in0);
    in1 = MFMA32(pa, *(const bf16x8*)(VsT + (32 + r) * 136 + ks * 16 + h * 8), in1);
  }
#pragma unroll
  for (int reg = 0; reg < 16; reg++) {
    int c = cw + crow(reg, h);
    float oa = in0[reg], ob = in1[reg];
    float ss = oa * oa + ob * ob;
    ss += __shfl_xor(ss, 1); ss += __shfl_xor(ss, 2); ss += __shfl_xor(ss, 4); ss += __shfl_xor(ss, 8); ss += __shfl_xor(ss, 16);
    float rstd = rsqrtf(ss * (1.f / 64.f) + 1e-6f);
    int rowi = row0 + c;
    asm volatile("" : "+v"(rowi));
    size_t row = (size_t)rowi;
    float g0 = bf2f(RET[row * 1024 + 768 + hh * 64 + r]), g1 = bf2f(RET[row * 1024 + 768 + hh * 64 + 32 + r]);
    MIX[row * 1024 + 256 + hh * 64 + r] = f2bf(silu_f(g0) * oa * rstd);
    MIX[row * 1024 + 256 + hh * 64 + 32 + r] = f2bf(silu_f(g1) * ob * rstd);
    if ((reg & 3) == 3) __builtin_amdgcn_sched_barrier(0);
  }
  __syncthreads();
}

typedef _Float16 h2_t __attribute__((ext_vector_type(2)));
DI unsigned packh(float a, float b) { h2_t v; v[0] = (_Float16)a; v[1] = (_Float16)b; return __builtin_bit_cast(unsigned, v); }
template <class ZF, class CF>
DI void hy_conv(float2* X, const float2* __restrict__ TW, const float2* __restrict__ Ke, const float2* __restrict__ Ko,
                ZF zf4, CF consume4, int tid) {
  const float scl = 0.5f / 8192.f;
#pragma unroll 2
  for (int g = 0; g < 8; g++) {
    int j = tidx() + 256 * g;
    float zr[4], zi[4];
    zf4(j, zr, zi);
#pragma unroll
    for (int e = 0; e < 4; e++) X[PX(4 * j + e)] = make_float2(zr[e], zi[e]);
  }
  __syncthreads();
  fft_dif(X, TW, tid);
#pragma unroll 2
  for (int g = 0; g < 8; g++) {
    int j = tidx() + 256 * g;
    const float4* kp = (const float4*)(Ke + 4 * j);
    float4 k01 = kp[0], k23 = kp[1];
    float2 a;
    a = X[PX(4 * j + 0)]; X[PX(4 * j + 0)] = make_float2(a.x * k01.x - a.y * k01.y, a.x * k01.y + a.y * k01.x);
    a = X[PX(4 * j + 1)]; X[PX(4 * j + 1)] = make_float2(a.x * k01.z - a.y * k01.w, a.x * k01.w + a.y * k01.z);
    a = X[PX(4 * j + 2)]; X[PX(4 * j + 2)] = make_float2(a.x * k23.x - a.y * k23.y, a.x * k23.y + a.y * k23.x);
    a = X[PX(4 * j + 3)]; X[PX(4 * j + 3)] = make_float2(a.x * k23.z - a.y * k23.w, a.x * k23.w + a.y * k23.z);
  }
  __syncthreads();
  fft_dit(X, TW, tid);
  unsigned ye[32];
#pragma unroll
  for (int g = 0; g < 8; g++) {
    int j = tid + 256 * g;
    asm volatile("" : "+v"(j));
#pragma unroll
    for (int e = 0; e < 4; e++) {
      float2 ev = X[PX(4 * j + e)];
      unsigned pk = packh(ev.x * scl, ev.y * scl);
      asm volatile("" : "+v"(pk));
      ye[g * 4 + e] = pk;
    }
    if (g & 1) __builtin_amdgcn_sched_barrier(0);
  }
  __syncthreads();
#pragma unroll 2
  for (int g = 0; g < 8; g++) {
    int j = tidx() + 256 * g;
    float zr[4], zi[4];
    zf4(j, zr, zi);
    const float4* tp = (const float4*)(TW + 4 * j);
    float4 t01 = tp[0], t23 = tp[1];
    X[PX(4 * j + 0)] = make_float2(zr[0] * t01.x - zi[0] * t01.y, zr[0] * t01.y + zi[0] * t01.x);
    X[PX(4 * j + 1)] = make_float2(zr[1] * t01.z - zi[1] * t01.w, zr[1] * t01.w + zi[1] * t01.z);
    X[PX(4 * j + 2)] = make_float2(zr[2] * t23.x - zi[2] * t23.y, zr[2] * t23.y + zi[2] * t23.x);
    X[PX(4 * j + 3)] = make_float2(zr[3] * t23.z - zi[3] * t23.w, zr[3] * t23.w + zi[3] * t23.z);
  }
  __syncthreads();
  fft_dif(X, TW, tid);
#pragma unroll 2
  for (int g = 0; g < 8; g++) {
    int j = tidx() + 256 * g;
    const float4* kp = (const float4*)(Ko + 4 * j);
    float4 k01 = kp[0], k23 = kp[1];
    float2 a;
    a = X[PX(4 * j + 0)]; X[PX(4 * j + 0)] = make_float2(a.x * k01.x - a.y * k01.y, a.x * k01.y + a.y * k01.x);
    a = X[PX(4 * j + 1)]; X[PX(4 * j + 1)] = make_float2(a.x * k01.z - a.y * k01.w, a.x * k01.w + a.y * k01.z);
    a = X[PX(4 * j + 2)]; X[PX(4 * j + 2)] = make_float2(a.x * k23.x - a.y * k23.y, a.x * k23.y + a.y * k23.x);
    a = X[PX(4 * j + 3)]; X[PX(4 * j + 3)] = make_float2(a.x * k23.z - a.y * k23.w, a.x * k23.w + a.y * k23.z);
  }
  __syncthreads();
  fft_dit(X, TW, tid);
#pragma unroll
  for (int g = 0; g < 8; g++) {
    int j = tid + 256 * g;
    asm volatile("" : "+v"(j));
    const float4* tp = (const float4*)(TW + 4 * j);
    float4 t01 = tp[0], t23 = tp[1];
    float ya[4], yb[4];
    float2 o;
    h2_t ev;
    o = X[PX(4 * j + 0)]; ev = __builtin_bit_cast(h2_t, ye[g * 4 + 0]);
    ya[0] = (float)ev[0] + (o.x * t01.x + o.y * t01.y) * scl; yb[0] = (float)ev[1] + (o.y * t01.x - o.x * t01.y) * scl;
    o = X[PX(4 * j + 1)]; ev = __builtin_bit_cast(h2_t, ye[g * 4 + 1]);
    ya[1] = (float)ev[0] + (o.x * t01.z + o.y * t01.w) * scl; yb[1] = (float)ev[1] + (o.y * t01.z - o.x * t01.w) * scl;
    o = X[PX(4 * j + 2)]; ev = __builtin_bit_cast(h2_t, ye[g * 4 + 2]);
    ya[2] = (float)ev[0] + (o.x * t23.x + o.y * t23.y) * scl; yb[2] = (float)ev[1] + (o.y * t23.x - o.x * t23.y) * scl;
    o = X[PX(4 * j + 3)]; ev = __builtin_bit_cast(h2_t, ye[g * 4 + 3]);
    ya[3] = (float)ev[0] + (o.x * t23.z + o.y * t23.w) * scl; yb[3] = (float)ev[1] + (o.y * t23.z - o.x * t23.w) * scl;
    consume4(j, ya, yb);
    __builtin_amdgcn_sched_barrier(0);
  }
  __syncthreads();
}

DI float sconv_at(const u16* __restrict__ u, int n, int Ls, float w0, float w1, float w2, float bias) {
  float um = n > 0 ? bf2f(u[n - 1]) : 0.f, uc = bf2f(u[n]), up = n < Ls - 1 ? bf2f(u[n + 1]) : 0.f;
  return bias + w0 * um + w1 * uc + w2 * up;
}
DI void sconv4(const u16* __restrict__ u, int j, float w0, float w1, float w2, float bias, float (&o)[4]) {
  uint2 c = *(const uint2*)(u + 4 * j);
  float x0 = __uint_as_float(c.x << 16), x1 = __uint_as_float(c.x & 0xffff0000u);
  float x2 = __uint_as_float(c.y << 16), x3 = __uint_as_float(c.y & 0xffff0000u);
  float xm = j > 0 ? bf2f(u[4 * j - 1]) : 0.f, xp = j < 2047 ? bf2f(u[4 * j + 4]) : 0.f;
  o[0] = bias + w0 * xm + w1 * x0 + w2 * x1;
  o[1] = bias + w0 * x0 + w1 * x1 + w2 * x2;
  o[2] = bias + w0 * x1 + w1 * x2 + w2 * x3;
  o[3] = bias + w0 * x2 + w1 * x3 + w2 * xp;
}
DI void unpack4(const u16* __restrict__ p, float (&o)[4]) {
  uint2 c = *(const uint2*)p;
  o[0] = __uint_as_float(c.x << 16); o[1] = __uint_as_float(c.x & 0xffff0000u);
  o[2] = __uint_as_float(c.y << 16); o[3] = __uint_as_float(c.y & 0xffff0000u);
}

DI void hyena_item(const Params& p, int l, int c, int pair, char* smem) {
  float2* X = (float2*)smem;
  const float2* TW = (const float2*)(p.ws + OFF_TW);
  const float2* KS = (const float2*)(p.ws + OFF_KSPEC);
  const u16* UT = (const u16*)(p.ws + OFF_UT);
  u16* YT = (u16*)(p.ws + OFF_CQ);
  int tid_o = tidx();
  const int tid = tid_o;
  const float* cw = p.in[I_HCW] + l * 3 * 768;
  const float* cb = p.in[I_HCB] + l * 768;
  const int b0 = 2 * pair, b1 = b0 + 1;
  u16* y0 = YT + (size_t)(b0 * 256 + c) * SEQ;
  u16* y1 = YT + (size_t)(b1 * 256 + c) * SEQ;
  const float vw0 = cw[512 + c], vw1 = cw[768 + 512 + c], vw2 = cw[1536 + 512 + c], vbs = cb[512 + c];
  const u16* v0p = UT + (size_t)(b0 * 768 + 512 + c) * SEQ;
  const u16* v1p = UT + (size_t)(b1 * 768 + 512 + c) * SEQ;
  {
    const float w0 = cw[c], w1 = cw[768 + c], w2 = cw[1536 + c], bs = cb[c];
    const float bias0 = p.in[I_HBIAS][(l * 2 + 0) * 256 + c];
    const u16* u0 = UT + (size_t)(b0 * 768 + c) * SEQ;
    const u16* u1 = UT + (size_t)(b1 * 768 + c) * SEQ;
    hy_conv(X, TW, KS + (size_t)(0 * 256 + c) * 2 * 8192, KS + (size_t)(0 * 256 + c) * 2 * 8192 + 8192,
            [&](int j, float (&zr)[4], float (&zi)[4]) __attribute__((always_inline)) {
              sconv4(v0p, j, vw0, vw1, vw2, vbs, zr); sconv4(v1p, j, vw0, vw1, vw2, vbs, zi);
            },
            [&](int j, const float (&ya)[4], const float (&yb)[4]) __attribute__((always_inline)) {
              float va[4], vb[4], xa[4], xb[4];
              sconv4(v0p, j, vw0, vw1, vw2, vbs, va); sconv4(v1p, j, vw0, vw1, vw2, vbs, vb);
              sconv4(u0, j, w0, w1, w2, bs, xa); sconv4(u1, j, w0, w1, w2, bs, xb);
              *(uint2*)(y0 + 4 * j) = make_uint2(pack2(xa[0] * (ya[0] + va[0] * bias0), xa[1] * (ya[1] + va[1] * bias0)),
                                                 pack2(xa[2] * (ya[2] + va[2] * bias0), xa[3] * (ya[3] + va[3] * bias0)));
              *(uint2*)(y1 + 4 * j) = make_uint2(pack2(xb[0] * (yb[0] + vb[0] * bias0), xb[1] * (yb[1] + vb[1] * bias0)),
                                                 pack2(xb[2] * (yb[2] + vb[2] * bias0), xb[3] * (yb[3] + vb[3] * bias0)));
            }, tid);
  }
  {
    const int col = 256 + c;
    const float w0 = cw[col], w1 = cw[768 + col], w2 = cw[1536 + col], bs = cb[col];
    const float bias1 = p.in[I_HBIAS][(l * 2 + 1) * 256 + c];
    const u16* u0 = UT + (size_t)(b0 * 768 + col) * SEQ;
    const u16* u1 = UT + (size_t)(b1 * 768 + col) * SEQ;
    hy_conv(X, TW, KS + (size_t)(1 * 256 + c) * 2 * 8192, KS + (size_t)(1 * 256 + c) * 2 * 8192 + 8192,
            [&](int j, float (&zr)[4], float (&zi)[4]) __attribute__((always_inline)) { unpack4(y0 + 4 * j, zr); unpack4(y1 + 4 * j, zi); },
            [&](int j, const float (&ya)[4], const float (&yb)[4]) __attribute__((always_inline)) {
              float za[4], zb[4], xa[4], xb[4];
              unpack4(y0 + 4 * j, za); unpack4(y1 + 4 * j, zb);
              sconv4(u0, j, w0, w1, w2, bs, xa); sconv4(u1, j, w0, w1, w2, bs, xb);
              *(uint2*)(y0 + 4 * j) = make_uint2(pack2(xa[0] * (ya[0] + za[0] * bias1), xa[1] * (ya[1] + za[1] * bias1)),
                                                 pack2(xa[2] * (ya[2] + za[2] * bias1), xa[3] * (ya[3] + za[3] * bias1)));
              *(uint2*)(y1 + 4 * j) = make_uint2(pack2(xb[0] * (yb[0] + zb[0] * bias1), xb[1] * (yb[1] + zb[1] * bias1)),
                                                 pack2(xb[2] * (yb[2] + zb[2] * bias1), xb[3] * (yb[3] + zb[3] * bias1)));
            }, tid);
  }
}

DI void hyena_ctx_item(const Params& p, int l, int b, int c, char* smem) {
  float* k0s = (float*)smem;
  float* k1s = k0s + 512;
  float* vs = k1s + 512;
  float* zs = vs + 256;
  const float* KC = (const float*)(p.ws + OFF_KC);
  const u16* UTC = (const u16*)(p.ws + OFF_UTC);
  u16* MIX = (u16*)(p.ws + OFF_H);
  int tid_o = tidx();
  asm volatile("" : "+v"(tid_o));
  const int n = tid_o;
  const float* cw = p.in[I_HCW] + l * 3 * 768;
  const float* cb = p.in[I_HCB] + l * 768;
  k0s[n] = KC[(size_t)(0 * 256 + c) * 512 + n]; k0s[256 + n] = KC[(size_t)(0 * 256 + c) * 512 + 256 + n];
  k1s[n] = KC[(size_t)(1 * 256 + c) * 512 + n]; k1s[256 + n] = KC[(size_t)(1 * 256 + c) * 512 + 256 + n];
  float v = sconv_at(UTC + (size_t)(b * 768 + 512 + c) * LCTX, n, LCTX, cw[512 + c], cw[768 + 512 + c], cw[1536 + 512 + c], cb[512 + c]);
  float x1 = sconv_at(UTC + (size_t)(b * 768 + c) * LCTX, n, LCTX, cw[c], cw[768 + c], cw[1536 + c], cb[c]);
  float x2 = sconv_at(UTC + (size_t)(b * 768 + 256 + c) * LCTX, n, LCTX, cw[256 + c], cw[768 + 256 + c], cw[1536 + 256 + c], cb[256 + c]);
  vs[n] = v;
  __syncthreads();
  float a = 0.f;
  for (int s = 0; s < 256; s++) a += k0s[n - s + 256] * vs[s];
  float z = x1 * (a + v * p.in[I_HBIAS][(l * 2 + 0) * 256 + c]);
  zs[n] = z;
  __syncthreads();
  float a2 = 0.f;
  for (int s = 0; s < 256; s++) a2 += k1s[n - s + 256] * zs[s];
  float y = x2 * (a2 + z * p.in[I_HBIAS][(l * 2 + 1) * 256 + c]);
  MIX[(size_t)(TLAT + b * LCTX + n) * 1024 + c] = f2bf(y);
  __syncthreads();
}

DI void phase_p4(const Params& p, int l, char* smem, int submask = 15) {
  const int n_al = 2048, n_ac = (l == 0 ? 64 : 0), n_hy = 512, n_r3 = (l == 0 ? 16 * NCH : 16 * 64), n_hc = (l == 0 ? 1024 : 0);
  const int total = n_al + n_ac + n_hy + n_r3 + n_hc;
  for (int it = blockIdx.x; it < total; it += gridDim.x) {
    int q = it;
    if (q < n_al) {
      int b = q >> 9, hh = (q >> 6) & 7, qb = q & 63;
      if (SUB_ON(0) && (submask & 1)) attn_item(p, b, hh, b * SEQ + qb * 128, 0, LKEY, smem);
    } else if ((q -= n_al) < n_ac) {
      int b = q >> 4, hh = (q >> 1) & 7, qb = q & 1;
      if (SUB_ON(0) && (submask & 1)) attn_item(p, b, hh, TLAT + b * LCTX + qb * 128, SEQ, LCTX, smem);
    } else if ((q -= n_ac) < n_hy) {
      if (SUB_ON(1) && (submask & 2)) hyena_item(p, l, q >> 1, q & 1, smem);
    } else if ((q -= n_hy) < n_r3) {
      int bh, ci;
      if (l == 0) { bh = q / NCH; ci = q - bh * NCH; } else { bh = q >> 6; ci = 2 + (q & 63); }
      if (SUB_ON(2) && (submask & 4)) ret_out_item(p, l, bh >> 2, bh & 3, ci, smem);
    } else {
      q -= n_r3;
      if (SUB_ON(3) && (submask & 8)) hyena_ctx_item(p, l, q >> 8, q & 255, smem);
    }
  }
}

DI void phase_res_gemm(const Params& p, int l, int which  , char* smem) {
  const int lane = tidx() & 63, r = lane & 31, h = lane >> 5;
  const int nmt = (l == 0 ? 132 : 128);
  const char* wl = p.ws + OFF_W + (size_t)l * WL_SIZE;
  const u16* A = (const u16*)(p.ws + (which == 1 ? OFF_H : OFF_ACT));
  const int K = which == 1 ? 1024 : 4096;
  const u16* Bt = (const u16*)(wl + (which == 1 ? WL_WOUT : WL_W2));
  const bool first = (l == 0 && which == 1);
  const float* mod = (const float*)(p.ws + OFF_MOD);
  float* XC = (float*)(p.ws + OFF_XC);
  const int total = nmt * 8;
  for (int it = blockIdx.x; it < total; it += gridDim.x) {
    int mt = it >> 3, nt = it & 7;
    int m0 = mt * 256;
    const u16* at = nullptr;
    if (which == 1 && m0 < TLAT) at = (const u16*)(p.ws + OFF_CQ) + (size_t)((m0 >> 13) * 256) * SEQ + (m0 & 8191);
    int cond = m0 < TLAT ? (m0 >> 13) : 4;
    const float* ga = mod + (size_t)(l * 5 + cond) * 6144 + (which == 1 ? 2048 : 5120);
    const float* src; float* dst;
    if (m0 < TLAT) { src = first ? p.in[I_X] : p.out; dst = p.out; }
    else { src = (first ? p.in[I_CTX] : XC) - (size_t)TLAT * 1024; dst = XC - (size_t)TLAT * 1024; }
    gemm_tile<false, false, false>(A, K, Bt, K, K, m0, nt * 128, at, 8, smem,
      [&](int bm, int bn, const f32x16& acc, const float*) __attribute__((always_inline)) {
        const int lz_ = tidx() & 63, r = lz_ & 31, h = lz_ >> 5;
        int col = bn + r;
        float g = ga[col];
#pragma unroll
        for (int reg = 0; reg < 16; reg++) {
          size_t idx = (size_t)(bm + crow(reg, h)) * 1024 + col;
          dst[idx] = src[idx] + g * acc[reg];
        }
      });
  }
}

DI void phase_mlp1(const Params& p, int l, char* smem) {
  const int lane = tidx() & 63, r = lane & 31, h = lane >> 5;
  const int nmt = (l == 0 ? 132 : 128);
  const u16* A = (const u16*)(p.ws + OFF_H);
  const u16* Bt = (const u16*)(p.ws + OFF_W + (size_t)l * WL_SIZE + WL_W1);
  u16* ACT = (u16*)(p.ws + OFF_ACT);
  const int total = nmt * 32;
  for (int it = blockIdx.x; it < total; it += gridDim.x) {
    int mt = it >> 5, nt = it & 31;
    gemm_tile<false, false, false>(A, 1024, Bt, 1024, 1024, mt * 256, nt * 128, nullptr, 0, smem,
      [&](int bm, int bn, const f32x16& acc, const float*) __attribute__((always_inline)) {
        const int lz_ = tidx() & 63, r = lz_ & 31, h = lz_ >> 5;
        int col = bn + r;
#pragma unroll
        for (int reg = 0; reg < 16; reg++) {
          float v = fmaxf(acc[reg], 0.f);
          ACT[(size_t)(bm + crow(reg, h)) * 4096 + col] = f2bf(v * v);
        }
      });
  }
}

DI void phase_final(const Params& p) {
  const int lane = tidx() & 63, wid = tidx() >> 6;
  const float* g = p.in[I_FNG];
  for (int it = blockIdx.x; it < TLAT / 8; it += gridDim.x) {
    float* row = p.out + (size_t)(it * 8 + wid * 2) * 1024;
    float4 v[8];
    float ssq0 = 0.f, ssq1 = 0.f;
#pragma unroll
    for (int i = 0; i < 4; i++) { v[i] = *(const float4*)(row + i * 256 + lane * 4); v[4 + i] = *(const float4*)(row + 1024 + i * 256 + lane * 4); }
#pragma unroll
    for (int i = 0; i < 4; i++) {
      ssq0 += v[i].x * v[i].x + v[i].y * v[i].y + v[i].z * v[i].z + v[i].w * v[i].w;
      ssq1 += v[4 + i].x * v[4 + i].x + v[4 + i].y * v[4 + i].y + v[4 + i].z * v[4 + i].z + v[4 + i].w * v[4 + i].w;
    }
    ssq0 = wave_sum(ssq0); ssq1 = wave_sum(ssq1);
    float r0 = rsqrtf(ssq0 * (1.f / 1024.f) + 1e-6f), r1 = rsqrtf(ssq1 * (1.f / 1024.f) + 1e-6f);
#pragma unroll
    for (int i = 0; i < 4; i++) {
      float4 gg = *(const float4*)(g + i * 256 + lane * 4);
      *(float4*)(row + i * 256 + lane * 4) = make_float4(v[i].x * r0 * gg.x, v[i].y * r0 * gg.y, v[i].z * r0 * gg.z, v[i].w * r0 * gg.w);
      *(float4*)(row + 1024 + i * 256 + lane * 4) = make_float4(v[4 + i].x * r1 * gg.x, v[4 + i].y * r1 * gg.y, v[4 + i].z * r1 * gg.z, v[4 + i].w * r1 * gg.w);
    }
  }
}


#define XB_TMO      128
#define XB_XCNT(j)  (256  + 64 * (j))
#define XB_XSUB(j)  (1280 + 64 * (j))
#define XB_XGEN(j)  (2304 + 64 * (j))
#define XB_TOP      3328
#define XB_TOPGEN   3392
#define XCD_BAR_WORDS 3456
#define XB_SPIN_CAP (1u << 22)
#define LAS __attribute__((address_space(3)))
DI unsigned xb_ld(unsigned* p) { return __hip_atomic_load(p, __ATOMIC_RELAXED, __HIP_MEMORY_SCOPE_AGENT); }
DI unsigned xb_add(unsigned* p, unsigned v) { return __hip_atomic_fetch_add(p, v, __ATOMIC_RELAXED, __HIP_MEMORY_SCOPE_AGENT); }
DI unsigned xb_xcc_id() { return (unsigned)__builtin_amdgcn_s_getreg((3 << 11) | 20) & 0xFu; }
#define XB_SPIN(cond, bar) do { unsigned _sp = 0; while (cond) { __builtin_amdgcn_s_sleep(1); \
    if ((++_sp & 255u) == 0u) { if (xb_ld(&(bar)[XB_TMO])) break; if (_sp > XB_SPIN_CAP) { atomicAdd(&(bar)[XB_TMO], 1u); break; } } } } while (0)
struct XcdBarrier { unsigned* bar; unsigned x; volatile LAS unsigned* st; };
DI XcdBarrier xcd_barrier_post(unsigned* bar, volatile LAS unsigned* st) {
  XcdBarrier b; b.bar = bar; b.x = xb_xcc_id(); b.st = st;
  if (threadIdx.x == 0) (void)xb_add(&bar[XB_XCNT(b.x)], 1u);
  return b;
}
DI void xcd_barrier_complete(unsigned* bar, unsigned x, unsigned& nloc, unsigned& nx) {
  const unsigned G = gridDim.x * gridDim.y * gridDim.z;
  unsigned sum, cnt, mine, sp = 0u;
  for (;;) {
    sum = 0u; cnt = 0u; mine = 0u;
#pragma unroll
    for (unsigned j = 0; j < 16; ++j) { const unsigned c = xb_ld(&bar[XB_XCNT(j)]); sum += c; cnt += (c > 0u) ? 1u : 0u; mine = (j == x) ? c : mine; }
    if (sum == G) break;
    __builtin_amdgcn_s_sleep(1);
    if ((++sp & 255u) == 0u) { if (xb_ld(&bar[XB_TMO])) break; if (sp > XB_SPIN_CAP) { atomicAdd(&bar[XB_TMO], 1u); break; } }
  }
  nloc = mine > 0u ? mine : 1u; nx = cnt > 0u ? cnt : 1u;
}
DI void xcd_barrier(const XcdBarrier& b) {
  asm volatile("s_waitcnt vmcnt(0)" ::: "memory");
  __syncthreads();
  if (threadIdx.x == 0) {
    unsigned* bar = b.bar;
    __builtin_amdgcn_s_waitcnt(0);
    unsigned nloc = b.st[0], nx = b.st[1];
    if (nloc == 0u) { xcd_barrier_complete(bar, b.x, nloc, nx); b.st[0] = nloc; b.st[1] = nx; }
    const unsigned old = xb_add(&bar[XB_XSUB(b.x)], 1u);
    const unsigned gen = old / nloc;
    if (old + 1u == (gen + 1u) * nloc) {
      __builtin_amdgcn_fence(__ATOMIC_RELEASE, "agent");
      asm volatile("s_waitcnt vmcnt(0)" ::: "memory");
      const unsigned og = xb_add(&bar[XB_TOP], 1u);
      const unsigned tg = og / nx;
      if (og + 1u == (tg + 1u) * nx) xb_add(&bar[XB_TOPGEN], 1u);
      else XB_SPIN(xb_ld(&bar[XB_TOPGEN]) == tg, bar);
      __builtin_amdgcn_fence(__ATOMIC_ACQUIRE, "agent");
      xb_add(&bar[XB_XGEN(b.x)], 1u);
      asm volatile("s_waitcnt vmcnt(0)" ::: "memory");
    } else {
      XB_SPIN(xb_ld(&bar[XB_XGEN(b.x)]) == gen, bar);
      __builtin_amdgcn_fence(__ATOMIC_ACQUIRE, "agent");
      asm volatile("s_waitcnt vmcnt(0)" ::: "memory");
    }
  }
  __syncthreads();
}

constexpr int NPHASE = 20;
#ifndef ONLY_PHASE
#define ONLY_PHASE -1
#endif
#define PH_ON(k) (ONLY_PHASE < 0 || ONLY_PHASE == (k))
DI void run_phase(const Params& p, int ph, char* smem, int submask = 15) {
  if (ph == 0) { if (PH_ON(0)) phase_s0(p, smem); return; }
  if (ph == NPHASE - 1) { if (PH_ON(8)) phase_final(p); return; }
  int l = (ph - 1) / 9, s = (ph - 1) % 9;
  switch (s) {
    case 0: if (PH_ON(1)) phase_norm(p, l, 1, TALL, true); break;
    case 1: if (PH_ON(2)) phase_win(p, l, smem); break;
    case 2: if (PH_ON(3)) phase_p3(p, l, smem); break;
    case 3: if (PH_ON(4)) phase_scan(p, l); break;
    case 4: if (PH_ON(5)) phase_p4(p, l, smem, submask); break;
    case 5: if (PH_ON(6)) phase_res_gemm(p, l, 1, smem); break;
    case 6: if (PH_ON(1)) phase_norm(p, l, 2, l == 0 ? TALL : TLAT, false); break;
    case 7: if (PH_ON(7)) phase_mlp1(p, l, smem); break;
    default: if (PH_ON(6)) phase_res_gemm(p, l, 2, smem); break;
  }
}

#if !MULTI_LAUNCH
extern "C" __global__ void __launch_bounds__(256, 2) mk_all(Params p) {
  extern __shared__ __attribute__((aligned(16))) char smem[];
  cg::grid_group grid = cg::this_grid();
  __shared__ uint4 xb_words;
  if (threadIdx.x == 0) xb_words = make_uint4(0u, 0u, 0u, 0u);
  __syncthreads();
  XcdBarrier xb = xcd_barrier_post((unsigned*)(p.ws + OFF_BAR), (volatile LAS unsigned*)&xb_words);
  if (p.ws == nullptr) grid.sync();
  for (int ph = 0; ph < NPHASE; ph++) {
    run_phase(p, ph, smem);
#ifdef PROBE_DUP
    if (ph == PROBE_DUP || ph == PROBE_DUP2) { xcd_barrier(xb); run_phase(p, ph, smem, PROBE_MASK); }
#endif
    if (ph + 1 < NPHASE) xcd_barrier(xb);
  }
}
#define MK_KERNEL mk_all
#else
#define MK_KERNEL mk_phase
extern "C" __global__ void __launch_bounds__(256, 2) mk_phase(Params p, int ph) {
  extern __shared__ __attribute__((aligned(16))) char smem[];
  run_phase(p, ph, smem);
}
#endif

extern "C" void kernel_launch(void* const* d_in, const int* in_sizes, int n_in, void* d_out, int out_size, void* d_ws, size_t ws_size,
                              hipStream_t stream) {
  Params p{};
  for (int i = 0; i < 27; i++) p.in[i] = (const float*)d_in[i];
  p.out = (float*)d_out;
  p.ws = (char*)d_ws;
  static int grid_blocks = 0;
  if (!grid_blocks) {
    int dev = 0, cus = 0, per_cu = 0;
    (void)hipGetDevice(&dev);
    (void)hipDeviceGetAttribute(&cus, hipDeviceAttributeMultiprocessorCount, dev);
    (void)hipFuncSetAttribute((const void*)MK_KERNEL, hipFuncAttributeMaxDynamicSharedMemorySize, SMEM_BYTES);
    (void)hipOccupancyMaxActiveBlocksPerMultiprocessor(&per_cu, MK_KERNEL, 256, SMEM_BYTES);
    if (per_cu < 1) per_cu = 1;
    if (per_cu > 2) per_cu = 2;
    grid_blocks = cus * per_cu;
  }
#if MULTI_LAUNCH
  for (int ph = 0; ph < NPHASE; ph++) hipLaunchKernelGGL(mk_phase, dim3(grid_blocks), dim3(256), SMEM_BYTES, stream, p, ph);
#else
  (void)hipMemsetAsync(p.ws + OFF_BAR, 0, XCD_BAR_WORDS * 4, stream);
  void* args[] = {&p};
  (void)hipLaunchCooperativeKernel((void*)mk_all, dim3(grid_blocks), dim3(256), args, SMEM_BYTES, stream);
#endif
}
```

```cpp
#include <hip/hip_runtime.h>
#include <hip/hip_cooperative_groups.h>
namespace cg = cooperative_groups;

#ifndef MULTI_LAUNCH
#define MULTI_LAUNCH 0
#endif

#define DI __device__ __forceinline__
#define NI __device__ __noinline__
typedef unsigned short u16;
typedef short bf16x8 __attribute__((ext_vector_type(8)));
typedef float f32x16 __attribute__((ext_vector_type(16)));
typedef __bf16 bf2_t __attribute__((ext_vector_type(2)));
typedef unsigned u32x4 __attribute__((ext_vector_type(4)));
#define MFMA32(a, b, c) __builtin_amdgcn_mfma_f32_32x32x16_bf16((a), (b), (c), 0, 0, 0)

constexpr int NB = 4, SEQ = 8192, LCTX = 256, DM = 1024, DFF = 4096;
constexpr int TLAT = NB * SEQ;
constexpr int TALL = TLAT + NB * LCTX;
constexpr int NIN = 2208, NINP = 2304;
constexpr int LKEY = SEQ + LCTX;
constexpr int NCH = 66;
constexpr int SMEM_BYTES = 73728;
#ifndef SUBSEL
#define SUBSEL -1
#endif
#define SUB_ON(k) (SUBSEL < 0 || SUBSEL == (k))

constexpr size_t WL_WIN = 0;
constexpr size_t WL_WOUT = WL_WIN + (size_t)NINP * 1024 * 2;
constexpr size_t WL_W1 = WL_WOUT + (size_t)1024 * 1024 * 2;
constexpr size_t WL_W2 = WL_W1 + (size_t)4096 * 1024 * 2;
constexpr size_t WL_WUQ = WL_W2 + (size_t)1024 * 4096 * 2;
constexpr size_t WL_WUKV = WL_WUQ + (size_t)768 * 256 * 2;
constexpr size_t WL_SIZE = WL_WUKV + (size_t)1024 * 128 * 2;
constexpr size_t OFF_W = 0;
constexpr size_t OFF_MOD = OFF_W + 2 * WL_SIZE;
constexpr size_t OFF_TW = OFF_MOD + (size_t)2 * 5 * 6144 * 4;
constexpr size_t OFF_ROPE = OFF_TW + 65536;
constexpr size_t OFF_XC = OFF_ROPE + 192 * 8 * 8 + 4096;
constexpr size_t OFF_H = OFF_XC + (size_t)1024 * 1024 * 4;
constexpr size_t OFF_H2F = OFF_H + (size_t)TALL * 1024 * 2;
constexpr size_t OFF_H2C = OFF_H2F + (size_t)8192 * 64 * 4;
constexpr size_t OFF_KC = OFF_H2C + (size_t)256 * 64 * 4;
constexpr size_t OFF_BIG = OFF_KC + (size_t)2 * 256 * 512 * 4;
constexpr size_t OFF_UT = OFF_BIG;
constexpr size_t OFF_UTC = OFF_UT + (size_t)NB * 768 * SEQ * 2;
constexpr size_t OFF_RET = OFF_UTC + (size_t)NB * 768 * LCTX * 2;
constexpr size_t OFF_CQ = OFF_RET + (size_t)TALL * 1024 * 2;
constexpr size_t OFF_CKV = OFF_CQ + (size_t)TALL * 256 * 2;
constexpr size_t OFF_Q = OFF_CKV + (size_t)TALL * 128 * 2;
constexpr size_t OFF_KF = OFF_Q + (size_t)TALL * 768 * 2;
constexpr size_t OFF_VT = OFF_KF + (size_t)NB * 8 * LKEY * 96 * 2;
constexpr size_t OFF_ST = OFF_VT + (size_t)NB * 8 * 64 * LKEY * 2;
constexpr size_t OFF_KSPEC = OFF_ST + (size_t)2 * 16 * NCH * 4096 * 4;
constexpr size_t OFF_END = OFF_KSPEC + (size_t)2 * 256 * 2 * 8192 * 8;
constexpr size_t OFF_BAR = OFF_END;
constexpr size_t OFF_ACT = OFF_BIG;
static_assert(OFF_ACT + (size_t)TALL * 4096 * 2 <= OFF_END, "act fits");
static_assert(OFF_END + 16384 <= (size_t)536870912, "workspace");

struct Params {
  const float* in[27];
  float* out;
  char* ws;
};
enum { I_X = 0, I_C, I_CTX, I_CCTX, I_WADA, I_BADA, I_N1G, I_N2G, I_WIN, I_WOUT, I_HCW, I_HCB, I_HW1, I_HB1, I_HSF, I_HW2,
       I_HB2, I_HW3, I_HBIAS, I_RLD, I_QNG, I_WUQ, I_KVNG, I_WUKV, I_W1, I_W2, I_FNG };

DI int tidx() { int t = __builtin_amdgcn_workitem_id_x(); asm volatile("" : "+v"(t)); return t; }
DI u16 f2bf(float x) { return __builtin_bit_cast(u16, (__bf16)x); }
DI float bf2f(u16 v) { return __uint_as_float(((unsigned)v) << 16); }
DI unsigned pack2(float a, float b) { bf2_t v; v[0] = (__bf16)a; v[1] = (__bf16)b; return __builtin_bit_cast(unsigned, v); }
DI float wave_sum(float v) {
#pragma unroll
  for (int o = 32; o > 0; o >>= 1) v += __shfl_xor(v, o);
  return v;
}
DI int crow(int reg, int h) { return (reg & 3) + 8 * (reg >> 2) + 4 * h; }
DI float bfe(u32x4 v, int j) {
  unsigned w = v[j >> 1];
  return __uint_as_float((j & 1) ? (w & 0xffff0000u) : (w << 16));
}
DI u16 bfu(u32x4 v, int j) {
  unsigned w = v[j >> 1];
  return (u16)((j & 1) ? (w >> 16) : (w & 0xffffu));
}
DI float silu_f(float x) { return x / (1.f + __expf(-x)); }
DI void row_info(int row, int& b, int& t, int& key, int& cond) {
  if (row < TLAT) { b = row >> 13; t = row & 8191; key = t; cond = b; }
  else { int rc = row - TLAT; b = rc >> 8; t = rc & 255; key = SEQ + t; cond = 4; }
}
DI int chunk_row0(int b, int ci) { return ci < 2 ? TLAT + b * LCTX + ci * 128 : b * SEQ + (ci - 2) * 128; }
DI float rope_apply(const float2* __restrict__ tab, float val, int jj, int t) {
  float partner = __shfl_xor(val, 8);
  int pos = (jj & 16) ? 128 + (t & 63) : (t >> 6);
  float2 cs = tab[pos * 8 + (jj & 7)];
  return (jj & 8) ? (val * cs.x + partner * cs.y) : (val * cs.x - partner * cs.y);
}

DI void convT_item(const float* __restrict__ src, u16* __restrict__ dst, int K, int N, int Npad, const float* __restrict__ gain,
                   int item, float* tile, bool perm = false) {
  int ntn = Npad >> 6;
  int kt = item / ntn, nt = item - kt * ntn;
  int k0 = kt * 64, n0 = nt * 64;
  int c = tidx() & 63, q = tidx() >> 6;
#pragma unroll 4
  for (int i = 0; i < 16; i++) {
    int kk = i * 4 + q, n = n0 + c;
    float v = 0.f;
    if (n < N) { int sn = perm ? ((n & 511) >> 6) * 128 + (n >> 9) * 64 + (n & 63) : n; v = src[(size_t)(k0 + kk) * N + sn]; if (gain) v *= gain[k0 + kk]; }
    tile[kk * 65 + c] = v;
  }
  __syncthreads();
#pragma unroll 4
  for (int i = 0; i < 16; i++) {
    int nn = i * 4 + q;
    dst[(size_t)(n0 + nn) * K + k0 + c] = f2bf(tile[c * 65 + nn]);
  }
  __syncthreads();
}

DI void phase_s0(const Params& p, char* smem) {
  const int per_layer = 576 + 256 + 1024 + 1024 + 48 + 32;
  const int n_conv = 2 * per_layer, n_mod = 2 * 96, n_tw = 32 + 6, n_cp = 1024;
  const int total = n_conv + n_mod + n_tw + n_cp;
  for (int it = blockIdx.x; it < total; it += gridDim.x) {
    if (it < n_conv) {
      int l = it / per_layer, r = it - l * per_layer;
      char* wl = p.ws + OFF_W + (size_t)l * WL_SIZE;
      float* tile = (float*)smem;
      if (r < 576) convT_item(p.in[I_WIN] + (size_t)l * 1024 * NIN, (u16*)(wl + WL_WIN), 1024, NIN, NINP, nullptr, r, tile);
      else if ((r -= 576) < 256) convT_item(p.in[I_WOUT] + (size_t)l * 1024 * 1024, (u16*)(wl + WL_WOUT), 1024, 1024, 1024, nullptr, r, tile);
      else if ((r -= 256) < 1024) convT_item(p.in[I_W1] + (size_t)l * 1024 * 4096, (u16*)(wl + WL_W1), 1024, 4096, 4096, nullptr, r, tile);
      else if ((r -= 1024) < 1024) convT_item(p.in[I_W2] + (size_t)l * 4096 * 1024, (u16*)(wl + WL_W2), 4096, 1024, 1024, nullptr, r, tile);
      else if ((r -= 1024) < 48) convT_item(p.in[I_WUQ] + (size_t)l * 256 * 768, (u16*)(wl + WL_WUQ), 256, 768, 768, p.in[I_QNG] + l * 256, r, tile);
      else { r -= 48; convT_item(p.in[I_WUKV] + (size_t)l * 128 * 1024, (u16*)(wl + WL_WUKV), 128, 1024, 1024, p.in[I_KVNG] + l * 128, r, tile, true); }
    } else if (it < n_conv + n_mod) {
      int r = it - n_conv;
      int l = r / 96, n0 = (r - l * 96) * 64;
      float* sc = (float*)smem;
      float* red = sc + 5120;
      for (int i = tidx(); i < 5120; i += 256) {
        int rr = i >> 10, k = i & 1023;
        float cv = rr < 4 ? p.in[I_C][rr * 1024 + k] : p.in[I_CCTX][k];
        sc[i] = cv / (1.f + expf(-cv));
      }
      __syncthreads();
      int nn = tidx() & 63, kq = tidx() >> 6;
      float a0 = 0, a1 = 0, a2 = 0, a3 = 0, a4 = 0;
      const float* w = p.in[I_WADA] + ((size_t)l * 1024 + kq * 256) * 6144 + n0 + nn;
#pragma unroll 8
      for (int k = 0; k < 256; k++) {
        float wv = w[(size_t)k * 6144];
        int kk = kq * 256 + k;
        a0 += sc[kk] * wv; a1 += sc[1024 + kk] * wv; a2 += sc[2048 + kk] * wv; a3 += sc[3072 + kk] * wv; a4 += sc[4096 + kk] * wv;
      }
      red[(kq * 5 + 0) * 64 + nn] = a0; red[(kq * 5 + 1) * 64 + nn] = a1; red[(kq * 5 + 2) * 64 + nn] = a2;
      red[(kq * 5 + 3) * 64 + nn] = a3; red[(kq * 5 + 4) * 64 + nn] = a4;
      __syncthreads();
      if (tidx() < 64) {
        float* mod = (float*)(p.ws + OFF_MOD);
        float bb = p.in[I_BADA][l * 6144 + n0 + nn];
        for (int rr = 0; rr < 5; rr++) {
          float s = red[(0 * 5 + rr) * 64 + nn] + red[(1 * 5 + rr) * 64 + nn] + red[(2 * 5 + rr) * 64 + nn] + red[(3 * 5 + rr) * 64 + nn];
          mod[(size_t)(l * 5 + rr) * 6144 + n0 + nn] = s + bb;
        }
      }
      __syncthreads();
    } else if (it >= n_conv + n_mod + n_tw) {
      int e = (it - n_conv - n_mod - n_tw) * 256 + tidx();
      ((float4*)(p.ws + OFF_XC))[e] = ((const float4*)p.in[I_CTX])[e];
    } else {
      int q = it - n_conv - n_mod;
      if (q < 32) {
        int n = q * 256 + tidx();
        float sn, cs;
        sincospif((float)n / 8192.f, &sn, &cs);
        ((float2*)(p.ws + OFF_TW))[n] = make_float2(cs, -sn);
      } else {
        int e = (q - 32) * 256 + tidx();
        int pos = e >> 3, f = e & 7;
        float pv = pos < 128 ? (float)pos : (float)(pos - 128);
        float inv = powf(10000.f, -(float)f / 8.f);
        float sn, cs;
        sincosf(pv * inv, &sn, &cs);
        ((float2*)(p.ws + OFF_ROPE))[e] = make_float2(cs, sn);
      }
    }
  }
}

DI void filt_a_item(const Params& p, int l, int Lf, float* h2out, int pos) {
  int lane = tidx() & 63;
  float tpos = (float)pos / (float)(Lf - 1);
  float zval = 0.f;
  if (lane == 0) zval = tpos;
  else if (lane < 33) {
    int jj = (lane - 1) & 15;
    float band = 1e-4f + (float)jj * ((15.f - 1e-4f) / 15.f);
    float ang = ((float)(6.283185307179586 / (double)Lf)) * (float)pos * band;
    zval = lane < 17 ? cosf(ang) : -sinf(ang);
  }
  const float* w1 = p.in[I_HW1] + l * 33 * 64;
  const float* w2 = p.in[I_HW2] + l * 64 * 64;
  float acc = p.in[I_HB1][l * 64 + lane];
  for (int i = 0; i < 33; i++) acc += __shfl(zval, i) * w1[i * 64 + lane];
  float h1 = sinf(p.in[I_HSF][l * 128 + lane] * acc);
  float acc2 = p.in[I_HB2][l * 64 + lane];
  for (int i = 0; i < 64; i++) acc2 += __shfl(h1, i) * w2[i * 64 + lane];
  h2out[(size_t)pos * 64 + lane] = sinf(p.in[I_HSF][l * 128 + 64 + lane] * acc2);
}

DI void phase_norm(const Params& p, int l, int which, int nrows, bool with_filter) {
  const int lane = tidx() & 63, wid = tidx() >> 6;
  const bool first = (l == 0 && which == 1);
  const int n_norm = nrows >> 3;
  const int n_fa = with_filter ? (8192 / 4 + (l == 0 ? 256 / 4 : 0)) : 0;
  const float* gsrc = p.in[which == 1 ? I_N1G : I_N2G] + l * 1024;
  u16* H = (u16*)(p.ws + OFF_H);
  for (int it = blockIdx.x; it < n_norm + n_fa; it += gridDim.x) {
    if (it < n_norm) {
      int row = it * 8 + wid * 2;
      const float* src;
      int cond;
      if (row < TLAT) { src = (first ? p.in[I_X] : p.out) + (size_t)row * 1024; cond = row >> 13; }
      else { src = (first ? p.in[I_CTX] : (const float*)(p.ws + OFF_XC)) + (size_t)(row - TLAT) * 1024; cond = 4; }
      const float* m = (const float*)(p.ws + OFF_MOD) + (size_t)(l * 5 + cond) * 6144 + (which == 1 ? 0 : 3072);
      float4 v[8];
      float ssq0 = 0.f, ssq1 = 0.f;
#pragma unroll
      for (int i = 0; i < 4; i++) {
        v[i] = *(const float4*)(src + i * 256 + lane * 4);
        v[4 + i] = *(const float4*)(src + 1024 + i * 256 + lane * 4);
      }
#pragma unroll
      for (int i = 0; i < 4; i++) {
        ssq0 += v[i].x * v[i].x + v[i].y * v[i].y + v[i].z * v[i].z + v[i].w * v[i].w;
        ssq1 += v[4 + i].x * v[4 + i].x + v[4 + i].y * v[4 + i].y + v[4 + i].z * v[4 + i].z + v[4 + i].w * v[4 + i].w;
      }
      ssq0 = wave_sum(ssq0); ssq1 = wave_sum(ssq1);
      float rstd0 = rsqrtf(ssq0 * (1.f / 1024.f) + 1e-6f), rstd1 = rsqrtf(ssq1 * (1.f / 1024.f) + 1e-6f);
#pragma unroll
      for (int i = 0; i < 4; i++) {
        int col = i * 256 + lane * 4;
        float4 g = *(const float4*)(gsrc + col), sh = *(const float4*)(m + col), sc = *(const float4*)(m + 1024 + col);
        float gx = g.x * (1.f + sc.x), gy = g.y * (1.f + sc.y), gz = g.z * (1.f + sc.z), gw = g.w * (1.f + sc.w);
        *(uint2*)(H + (size_t)row * 1024 + col) = make_uint2(pack2(v[i].x * rstd0 * gx + sh.x, v[i].y * rstd0 * gy + sh.y),
                                                             pack2(v[i].z * rstd0 * gz + sh.z, v[i].w * rstd0 * gw + sh.w));
        *(uint2*)(H + (size_t)(row + 1) * 1024 + col) = make_uint2(pack2(v[4 + i].x * rstd1 * gx + sh.x, v[4 + i].y * rstd1 * gy + sh.y),
                                                                   pack2(v[4 + i].z * rstd1 * gz + sh.z, v[4 + i].w * rstd1 * gw + sh.w));
      }
    } else {
      int q = it - n_norm;
      if (q < 2048) filt_a_item(p, l, 8192, (float*)(p.ws + OFF_H2F), q * 4 + wid);
      else filt_a_item(p, l, 256, (float*)(p.ws + OFF_H2C), (q - 2048) * 4 + wid);
    }
  }
}

constexpr int GLD = 40;
constexpr int GBUF = (256 + 128) * GLD;
template <bool ROWNORM, bool TR0, bool TR1, class Epi>
DI void gemm_tile(const u16* __restrict__ A, int lda, const u16* __restrict__ Bt, int ldb, int K, int m0, int n0,
                  const u16* __restrict__ at_src, int at_kt, char* smem, Epi epi) {
  u16* Ls = (u16*)smem;
  float* rs = (float*)(Ls + 2 * GBUF);
  int tid_o = tidx();
  const int tid = tid_o, lane = tid & 63, wid = tid >> 6, wm = wid >> 1, wn = wid & 1, r = lane & 31, h = lane >> 5;
  const bool trans = (TR0 == TR1) ? TR0 : (wn ? TR1 : TR0);
  f32x16 acc[4][2];
#pragma unroll
  for (int mi = 0; mi < 4; mi++)
#pragma unroll
    for (int ni = 0; ni < 2; ni++)
#pragma unroll
      for (int e = 0; e < 16; e++) acc[mi][ni][e] = 0.f;
  u32x4 ra0[4], rb0[2], ra1[4], rb1[2];
  float ssq[4];
#pragma unroll
  for (int i = 0; i < 4; i++) ssq[i] = 0.f;
  const int nk = K >> 5;
  const int lrow = tid >> 2, lkc = tid & 3;
  const int tch = tid & 31, ttc = tid >> 5;
  const bool has_at = at_src != nullptr;
#define GEMM_GLOAD(KT, RA, RB)                                                                                              \
  {                                                                                                                         \
    const int kt_ = (KT);                                                                                                   \
    if (has_at && kt_ < at_kt) {                                                                                            \
      _Pragma("unroll") for (int i = 0; i < 4; i++) RA[i] = *(const u32x4*)(at_src + (size_t)(kt_ * 32 + tch) * 8192 + (ttc + 8 * i) * 8); \
    } else {                                                                                                                \
      _Pragma("unroll") for (int i = 0; i < 4; i++) RA[i] = *(const u32x4*)(A + (size_t)(m0 + lrow + 64 * i) * lda + kt_ * 32 + lkc * 8);  \
    }                                                                                                                       \
    _Pragma("unroll") for (int i = 0; i < 2; i++) RB[i] = *(const u32x4*)(Bt + (size_t)(n0 + lrow + 64 * i) * ldb + kt_ * 32 + lkc * 8);   \
  }
#define GEMM_LWRITE(KT, RA, RB)                                                                                             \
  {                                                                                                                         \
    const int kt_ = (KT);                                                                                                   \
    u16* As_ = Ls + (kt_ & 1) * GBUF;                                                                                       \
    u16* Bs_ = As_ + 256 * GLD;                                                                                             \
    if (has_at && kt_ < at_kt) {                                                                                            \
      _Pragma("unroll") for (int i = 0; i < 4; i++)                                                                         \
        _Pragma("unroll") for (int j = 0; j < 8; j++) As_[((ttc + 8 * i) * 8 + j) * GLD + tch] = bfu(RA[i], j);             \
    } else {                                                                                                                \
      _Pragma("unroll") for (int i = 0; i < 4; i++) *(u32x4*)(As_ + (lrow + 64 * i) * GLD + lkc * 8) = RA[i];               \
    }                                                                                                                       \
    _Pragma("unroll") for (int i = 0; i < 2; i++) *(u32x4*)(Bs_ + (lrow + 64 * i) * GLD + lkc * 8) = RB[i];                 \
    if (ROWNORM) {                                                                                                          \
      _Pragma("unroll") for (int i = 0; i < 4; i++)                                                                         \
        _Pragma("unroll") for (int j = 0; j < 8; j++) { float x = bfe(RA[i], j); ssq[i] += x * x; }                         \
    }                                                                                                                       \
  }
#define GEMM_COMPUTE(KT)                                                                                                    \
  {                                                                                                                         \
    const u16* As = Ls + ((KT) & 1) * GBUF;                                                                                 \
    const u16* Bs = As + 256 * GLD;                                                                                         \
    _Pragma("unroll") for (int ks = 0; ks < 2; ks++) {                                                                      \
      __builtin_amdgcn_sched_barrier(0);                                                                                    \
      bf16x8 a[4], b[2];                                                                                                    \
      _Pragma("unroll") for (int mi = 0; mi < 4; mi++) a[mi] = *(const bf16x8*)(As + (wm * 128 + mi * 32 + r) * GLD + ks * 16 + h * 8); \
      _Pragma("unroll") for (int ni = 0; ni < 2; ni++) b[ni] = *(const bf16x8*)(Bs + (wn * 64 + ni * 32 + r) * GLD + ks * 16 + h * 8);  \
      if (!trans) {                                                                                                         \
        _Pragma("unroll") for (int mi = 0; mi < 4; mi++)                                                                    \
          _Pragma("unroll") for (int ni = 0; ni < 2; ni++) acc[mi][ni] = MFMA32(a[mi], b[ni], acc[mi][ni]);                 \
      } else {                                                                                                              \
        _Pragma("unroll") for (int mi = 0; mi < 4; mi++)                                                                    \
          _Pragma("unroll") for (int ni = 0; ni < 2; ni++) acc[mi][ni] = MFMA32(b[ni], a[mi], acc[mi][ni]);                 \
      }                                                                                                                     \
    }                                                                                                                       \
  }
  GEMM_GLOAD(0, ra0, rb0)
  GEMM_GLOAD(1, ra1, rb1)
  GEMM_LWRITE(0, ra0, rb0)
  __syncthreads();
  for (int kt = 0; kt < nk; kt += 2) {
    GEMM_LWRITE(kt + 1, ra1, rb1)
    if (kt + 2 < nk) { GEMM_GLOAD(kt + 2, ra0, rb0) GEMM_GLOAD(kt + 3, ra1, rb1) }
    GEMM_COMPUTE(kt)
    __syncthreads();
    if (kt + 2 < nk) GEMM_LWRITE(kt + 2, ra0, rb0)
    GEMM_COMPUTE(kt + 1)
    __syncthreads();
  }
#undef GEMM_COMPUTE
#undef GEMM_GLOAD
#undef GEMM_LWRITE
  if (ROWNORM) {
    float* rsp = rs + 256;
    {
      const int t2 = tidx();
#pragma unroll
      for (int i = 0; i < 4; i++) rsp[((t2 >> 2) + 64 * i) * 4 + (t2 & 3)] = ssq[i];
    }
    __syncthreads();
    {
      const int t3 = tidx();
      float4 q = *(const float4*)(rsp + t3 * 4);
      rs[t3] = rsqrtf((q.x + q.y + q.z + q.w) / (float)K + 1e-6f);
    }
    __syncthreads();
  }
#define EPI_CALL(mi, ni) epi(m0 + wm * 128 + (mi) * 32, n0 + wn * 64 + (ni) * 32, acc[mi][ni], rs);
  EPI_CALL(0, 0) EPI_CALL(0, 1) EPI_CALL(1, 0) EPI_CALL(1, 1) EPI_CALL(2, 0) EPI_CALL(2, 1) EPI_CALL(3, 0) EPI_CALL(3, 1)
#undef EPI_CALL
  __syncthreads();
}

DI void phase_win(const Params& p, int l, char* smem) {
  const u16* H = (const u16*)(p.ws + OFF_H);
  const u16* W = (const u16*)(p.ws + OFF_W + (size_t)l * WL_SIZE + WL_WIN);
  u16* UT = (u16*)(p.ws + OFF_UT);
  u16* UTC = (u16*)(p.ws + OFF_UTC);
  u16* RET = (u16*)(p.ws + OFF_RET);
  u16* CQ = (u16*)(p.ws + OFF_CQ);
  u16* CKV = (u16*)(p.ws + OFF_CKV);
  u16* KF = (u16*)(p.ws + OFF_KF);
  const int lane = tidx() & 63, r = lane & 31, h = lane >> 5;
  const int total = 132 * 18;
  for (int it = blockIdx.x; it < total; it += gridDim.x) {
    int mt = it / 18, nt = it - mt * 18;
    int m0 = mt * 256, n0 = nt * 128;
    if (nt < 6) {
      gemm_tile<false, true, true>(H, 1024, W, 1024, 1024, m0, n0, nullptr, 0, smem,
        [&](int bm, int bn, const f32x16& acc, const float*) __attribute__((always_inline)) {
        const int lz_ = tidx() & 63, r = lz_ & 31, h = lz_ >> 5;
          int row = bm + r, b, t, key, cond;
          row_info(row, b, t, key, cond);
          u16* dstp = row < TLAT ? UT + ((size_t)(b * 768)) * SEQ + t : UTC + ((size_t)(b * 768)) * LCTX + t;
          int strd = row < TLAT ? SEQ : LCTX;
#pragma unroll
          for (int reg = 0; reg < 16; reg++) dstp[(size_t)(bn + crow(reg, h)) * strd] = f2bf(acc[reg]);
        });
    } else {
      gemm_tile<false, false, false>(H, 1024, W, 1024, 1024, m0, n0, nullptr, 0, smem,
        [&](int bm, int bn, const f32x16& acc, const float*) __attribute__((always_inline)) {
        const int lz_ = tidx() & 63, r = lz_ & 31, h = lz_ >> 5;
        if (nt < 14) {

          int col = bn + r - 768;
          float sc = (col >= 256 && col < 512) ? 0.125f : 1.f;
#pragma unroll
          for (int reg = 0; reg < 16; reg++) RET[(size_t)(bm + crow(reg, h)) * 1024 + col] = f2bf(acc[reg] * sc);
        } else if (nt < 16) {
          int col = bn + r - 1792;
#pragma unroll
          for (int reg = 0; reg < 16; reg++) CQ[(size_t)(bm + crow(reg, h)) * 256 + col] = f2bf(acc[reg]);
        } else if (nt == 16) {
          int col = bn + r - 2048;
#pragma unroll
          for (int reg = 0; reg < 16; reg++) CKV[(size_t)(bm + crow(reg, h)) * 128 + col] = f2bf(acc[reg]);
        } else if (bn == 2176) {
#pragma unroll
          for (int reg = 0; reg < 16; reg++) {
            int row = bm + crow(reg, h), b, t, key, cond;
            row_info(row, b, t, key, cond);
            float v = acc[reg];
            float vr = rope_apply((const float2*)(p.ws + OFF_ROPE), v, r, t);
            if (row < TLAT) v = vr;
            u16 o = f2bf(v);
#pragma unroll
            for (int hh = 0; hh < 8; hh++) KF[((size_t)(b * 8 + hh) * LKEY + key) * 96 + 64 + r] = o;
          }
        }
      });
    }
  }
}

DI void ret_gammas(const Params& p, int l, int hh, float& lgf, float& lgb) {
  lgf = log1pf(-expf(p.in[I_RLD][l * 8 + hh]));
  lgb = log1pf(-expf(p.in[I_RLD][l * 8 + 4 + hh]));
}
DI void ret_kv_item(const Params& p, int l, int b, int hh, int ci, char* smem) {
  const u16* RET = (const u16*)(p.ws + OFF_RET);
  float* ST = (float*)(p.ws + OFF_ST);
  u16* KfT = (u16*)smem;
  u16* KbT = KfT + 64 * 136;
  u16* VsT = KbT + 64 * 136;
  int tid_o = tidx();
  asm volatile("" : "+v"(tid_o));
  const int tid = tid_o, lane = tid & 63, wid = tid >> 6, r = lane & 31, h = lane >> 5;
  float lgf, lgb;
  ret_gammas(p, l, hh, lgf, lgb);
  const int row0 = chunk_row0(b, ci);
#pragma unroll
  for (int i = 0; i < 4; i++) {
    int id = tid + 256 * i, m = id >> 3, dc = id & 7;
    u32x4 kv = *(const u32x4*)(RET + (size_t)(row0 + m) * 1024 + 256 + hh * 64 + dc * 8);
    u32x4 vv = *(const u32x4*)(RET + (size_t)(row0 + m) * 1024 + 512 + hh * 64 + dc * 8);
    float zf = __expf(lgf * (float)(127 - m)), zb = __expf(lgb * (float)m);
#pragma unroll
    for (int j = 0; j < 8; j++) {
      float kval = bfe(kv, j);
      KfT[(dc * 8 + j) * 136 + m] = f2bf(kval * zf);
      KbT[(dc * 8 + j) * 136 + m] = f2bf(kval * zb);
      VsT[(dc * 8 + j) * 136 + m] = bfu(vv, j);
    }
  }
  __syncthreads();
  const int dir = wid >> 1, dh = wid & 1;
  const u16* Asrc = dir ? KbT : KfT;
  f32x16 c0, c1;
#pragma unroll
  for (int e = 0; e < 16; e++) { c0[e] = 0.f; c1[e] = 0.f; }
#pragma unroll
  for (int ks = 0; ks < 8; ks++) {
    bf16x8 a = *(const bf16x8*)(Asrc + (dh * 32 + r) * 136 + ks * 16 + h * 8);
    bf16x8 b0 = *(const bf16x8*)(VsT + (r) * 136 + ks * 16 + h * 8);
    bf16x8 b1 = *(const bf16x8*)(VsT + (32 + r) * 136 + ks * 16 + h * 8);
    c0 = MFMA32(a, b0, c0);
    c1 = MFMA32(a, b1, c1);
  }
  float* dst = ST + ((size_t)((dir * 4 + b) * 4 + hh) * NCH + ci) * 4096;
#pragma unroll
  for (int reg = 0; reg < 16; reg++) {
    int d = dh * 32 + crow(reg, h);
    dst[d * 64 + r] = c0[reg];
    dst[d * 64 + 32 + r] = c1[reg];
  }
  __syncthreads();
}

#define PX(i) ((i) + ((i) >> 4))
typedef float cf2 __attribute__((ext_vector_type(2)));
DI cf2 mk2(float x, float y) { cf2 r; r.x = x; r.y = y; return r; }
DI cf2 cmul(cf2 a, cf2 b) { return mk2(a.x * b.x - a.y * b.y, a.x * b.y + a.y * b.x); }
DI cf2 cmulc(cf2 a, cf2 b) { return mk2(a.x * b.x + a.y * b.y, a.y * b.x - a.x * b.y); }
DI cf2 cadd(cf2 a, cf2 b) { return mk2(a.x + b.x, a.y + b.y); }
DI cf2 csub(cf2 a, cf2 b) { return mk2(a.x - b.x, a.y - b.y); }
DI cf2 twid_rev(float rev) { return mk2(__builtin_amdgcn_cosf(rev), -__builtin_amdgcn_sinf(rev)); }

template <int S, bool INV>
DI void fft_pass8(float2* Xf2, int tid) {
  cf2* X = (cf2*)Xf2;
  constexpr int span = 8192 >> S, q = span >> 3, lq = 10 - S;
  const float R = 0.70710678118654752f;
#pragma unroll 2
  for (int gi = 0; gi < 4; gi++) {
    int g = tid + 256 * gi;
    int j = g & (q - 1), blk = g >> lq, base = blk * span + j;
    cf2 v[8];
#pragma unroll
    for (int k = 0; k < 8; k++) v[k] = X[PX(base + k * q)];
    cf2 W = twid_rev((float)j * (1.f / (float)span));
    cf2 W2 = cmul(W, W), W4 = cmul(W2, W2);
    cf2 w1 = cmul(W, mk2(R, -R)), w2 = mk2(W.y, -W.x), w3 = cmul(W, mk2(-R, -R));
    cf2 w2b = mk2(W2.y, -W2.x);
    if (!INV) {
      { cf2 a, d;
        a = v[0]; d = csub(a, v[4]); v[0] = cadd(a, v[4]); v[4] = cmul(d, W);
        a = v[1]; d = csub(a, v[5]); v[1] = cadd(a, v[5]); v[5] = cmul(d, w1);
        a = v[2]; d = csub(a, v[6]); v[2] = cadd(a, v[6]); v[6] = cmul(d, w2);
        a = v[3]; d = csub(a, v[7]); v[3] = cadd(a, v[7]); v[7] = cmul(d, w3); }
#pragma unroll
      for (int b4 = 0; b4 < 8; b4 += 4) { cf2 a, d;
        a = v[b4]; d = csub(a, v[b4 + 2]); v[b4] = cadd(a, v[b4 + 2]); v[b4 + 2] = cmul(d, W2);
        a = v[b4 + 1]; d = csub(a, v[b4 + 3]); v[b4 + 1] = cadd(a, v[b4 + 3]); v[b4 + 3] = cmul(d, w2b); }
#pragma unroll
      for (int k = 0; k < 8; k += 2) { cf2 a = v[k], d = csub(a, v[k + 1]); v[k] = cadd(a, v[k + 1]); v[k + 1] = cmul(d, W4); }
    } else {
#pragma unroll
      for (int k = 0; k < 8; k += 2) { cf2 a = v[k], bb = cmulc(v[k + 1], W4); v[k] = cadd(a, bb); v[k + 1] = csub(a, bb); }
#pragma unroll
      for (int b4 = 0; b4 < 8; b4 += 4) { cf2 a, bb;
        a = v[b4]; bb = cmulc(v[b4 + 2], W2); v[b4] = cadd(a, bb); v[b4 + 2] = csub(a, bb);
        a = v[b4 + 1]; bb = cmulc(v[b4 + 3], w2b); v[b4 + 1] = cadd(a, bb); v[b4 + 3] = csub(a, bb); }
      { cf2 a, bb;
        a = v[0]; bb = cmulc(v[4], W); v[0] = cadd(a, bb); v[4] = csub(a, bb);
        a = v[1]; bb = cmulc(v[5], w1); v[1] = cadd(a, bb); v[5] = csub(a, bb);
        a = v[2]; bb = cmulc(v[6], w2); v[2] = cadd(a, bb); v[6] = csub(a, bb);
        a = v[3]; bb = cmulc(v[7], w3); v[3] = cadd(a, bb); v[7] = csub(a, bb); }
    }
#pragma unroll
    for (int k = 0; k < 8; k++) X[PX(base + k * q)] = v[k];
  }
  __syncthreads();
}

DI cf2 t16f(int k) {
  const float C1 = 0.92387953251128674f, S1 = 0.38268343236508977f, R = 0.70710678118654752f;
  return k == 0 ? mk2(1.f, 0.f) : k == 1 ? mk2(C1, -S1) : k == 2 ? mk2(R, -R) : k == 3 ? mk2(S1, -C1) : k == 4 ? mk2(0.f, -1.f)
       : k == 5 ? mk2(-S1, -C1) : k == 6 ? mk2(-R, -R) : mk2(-C1, -S1);
}
template <bool INV>
DI void fft_pass16(float2* Xf2, int tid) {
  cf2* X = (cf2*)Xf2;
#pragma unroll 1
  for (int gi = 0; gi < 2; gi++) {
    int g = tid + 256 * gi;
    cf2* xp = X + 17 * g;
    cf2 v[16];
#pragma unroll
    for (int k = 0; k < 16; k++) v[k] = xp[k];
    if (!INV) {
#pragma unroll
      for (int k = 0; k < 8; k++) { cf2 a = v[k], d = csub(a, v[k + 8]); v[k] = cadd(a, v[k + 8]); v[k + 8] = cmul(d, t16f(k)); }
#pragma unroll
      for (int b8 = 0; b8 < 16; b8 += 8)
#pragma unroll
        for (int k = 0; k < 4; k++) { cf2 a = v[b8 + k], d = csub(a, v[b8 + k + 4]); v[b8 + k] = cadd(a, v[b8 + k + 4]); v[b8 + k + 4] = cmul(d, t16f(2 * k)); }
#pragma unroll
      for (int b4 = 0; b4 < 16; b4 += 4)
#pragma unroll
        for (int k = 0; k < 2; k++) { cf2 a = v[b4 + k], d = csub(a, v[b4 + k + 2]); v[b4 + k] = cadd(a, v[b4 + k + 2]); v[b4 + k + 2] = cmul(d, t16f(4 * k)); }
#pragma unroll
      for (int k = 0; k < 16; k += 2) { cf2 a = v[k], bb = v[k + 1]; v[k] = cadd(a, bb); v[k + 1] = csub(a, bb); }
    } else {
#pragma unroll
      for (int k = 0; k < 16; k += 2) { cf2 a = v[k], bb = v[k + 1]; v[k] = cadd(a, bb); v[k + 1] = csub(a, bb); }
#pragma unroll
      for (int b4 = 0; b4 < 16; b4 += 4)
#pragma unroll
        for (int k = 0; k < 2; k++) { cf2 a = v[b4 + k], bb = cmulc(v[b4 + k + 2], t16f(4 * k)); v[b4 + k] = cadd(a, bb); v[b4 + k + 2] = csub(a, bb); }
#pragma unroll
      for (int b8 = 0; b8 < 16; b8 += 8)
#pragma unroll
        for (int k = 0; k < 4; k++) { cf2 a = v[b8 + k], bb = cmulc(v[b8 + k + 4], t16f(2 * k)); v[b8 + k] = cadd(a, bb); v[b8 + k + 4] = csub(a, bb); }
#pragma unroll
      for (int k = 0; k < 8; k++) { cf2 a = v[k], bb = cmulc(v[k + 8], t16f(k)); v[k] = cadd(a, bb); v[k + 8] = csub(a, bb); }
    }
#pragma unroll
    for (int k = 0; k < 16; k++) xp[k] = v[k];
  }
  __syncthreads();
}
DI void fft_dif(float2* X, const float2* __restrict__, int tid) {
  fft_pass8<0, false>(X, tid); fft_pass8<3, false>(X, tid); fft_pass8<6, false>(X, tid); fft_pass16<false>(X, tid);
}
DI void fft_dit(float2* X, const float2* __restrict__, int tid) {
  fft_pass16<true>(X, tid); fft_pass8<6, true>(X, tid); fft_pass8<3, true>(X, tid); fft_pass8<0, true>(X, tid);
}

DI void filt_fft_item(const Params& p, int l, int o, int c, char* smem) {
  float2* X = (float2*)smem;
  float* Xf = (float*)smem;
  float* w3s = (float*)(smem + 69632);
  float* red = w3s + 128;
  const float2* TW = (const float2*)(p.ws + OFF_TW);
  const float* H2 = (const float*)(p.ws + OFF_H2F);
  float2* KS = (float2*)(p.ws + OFF_KSPEC) + (size_t)(o * 256 + c) * 2 * 8192;
  int tid_o = tidx();
  asm volatile("" : "+v"(tid_o));
  const int tid = tid_o;
  if (tid < 128) { int j = tid & 63, side = tid >> 6; w3s[tid] = p.in[I_HW3][((size_t)l * 64 + j) * 1024 + side * 512 + o * 256 + c]; }
  __syncthreads();
  const float min_decay = -3.0701134573253944f, max_decay = -15.350567286626972f;
  const float delta = fabsf(min_decay + (float)c * ((max_decay - min_decay) / 255.f));
  float* Ff = Xf;
  float* Fb = Xf + 8192;
#pragma unroll 1
  for (int i = 0; i < 32; i++) {
    int n = tid + 256 * i;
    const float4* hp = (const float4*)(H2 + (size_t)n * 64);
    float f = 0.f, bsum = 0.f;
#pragma unroll
    for (int q = 0; q < 16; q++) {
      float4 hv = hp[q];
      f += hv.x * w3s[q * 4] + hv.y * w3s[q * 4 + 1] + hv.z * w3s[q * 4 + 2] + hv.w * w3s[q * 4 + 3];
      bsum += hv.x * w3s[64 + q * 4] + hv.y * w3s[64 + q * 4 + 1] + hv.z * w3s[64 + q * 4 + 2] + hv.w * w3s[64 + q * 4 + 3];
    }
    float win = expf(-((float)n / 8191.f) * delta);
    Ff[n] = f * win; Fb[n] = bsum * win;
  }
  __syncthreads();
  float part = 0.f;
#pragma unroll 2
  for (int i = 0; i < 32; i++) {
    int n = tid + 256 * i;
    float k1 = Ff[n], k2 = 0.f;
    if (n == 0) k1 += Fb[0]; else k2 = Fb[8192 - n];
    part += fabsf(k1) + fabsf(k2);
    KS[8192 + n] = make_float2(k1, k2);
  }
  part = wave_sum(part);
  if ((tid & 63) == 0) red[tid >> 6] = part;
  __syncthreads();
  const float inv = 1.f / (red[0] + red[1] + red[2] + red[3]);
#pragma unroll 2
  for (int i = 0; i < 32; i++) { int n = tidx() + 256 * i; float2 kp = KS[8192 + n]; X[PX(n)] = make_float2((kp.x + kp.y) * inv, 0.f); }
  __syncthreads();
  fft_dif(X, TW, tid);
#pragma unroll 2
  for (int i = 0; i < 32; i++) { int n = tidx() + 256 * i; KS[n] = X[PX(n)]; }
  __syncthreads();
#pragma unroll 2
  for (int i = 0; i < 32; i++) { int n = tidx() + 256 * i; float2 w = TW[n]; float2 kp = KS[8192 + n]; float d = (kp.x - kp.y) * inv; X[PX(n)] = make_float2(d * w.x, d * w.y); }
  __syncthreads();
  fft_dif(X, TW, tid);
#pragma unroll 2
  for (int i = 0; i < 32; i++) { int n = tidx() + 256 * i; KS[8192 + n] = X[PX(n)]; }
  __syncthreads();
}

DI void filt_ctx_item(const Params& p, int l, int o, int c, char* smem) {
  float* red = (float*)smem;
  const float* H2 = (const float*)(p.ws + OFF_H2C);
  float* KC = (float*)(p.ws + OFF_KC) + (size_t)(o * 256 + c) * 512;
  int tid_o = tidx();
  asm volatile("" : "+v"(tid_o));
  const int n = tid_o;
  const float min_decay = -3.0701134573253944f, max_decay = -15.350567286626972f;
  const float delta = fabsf(min_decay + (float)c * ((max_decay - min_decay) / 255.f));
  float f = 0.f, bsum = 0.f;
  for (int j = 0; j < 64; j++) {
    float hv = H2[n * 64 + j];
    f += hv * p.in[I_HW3][((size_t)l * 64 + j) * 1024 + o * 256 + c];
    bsum += hv * p.in[I_HW3][((size_t)l * 64 + j) * 1024 + 512 + o * 256 + c];
  }
  float win = expf(-((float)n / 255.f) * delta);
  f *= win; bsum *= win;
  float part = n == 0 ? fabsf(f + bsum) : fabsf(f) + fabsf(bsum);
  part = wave_sum(part);
  __syncthreads();
  if ((n & 63) == 0) red[n >> 6] = part;
  __syncthreads();
  float inv = 1.f / (red[0] + red[1] + red[2] + red[3]);
  if (n == 0) { KC[256] = (f + bsum) * inv; KC[0] = 0.f; }
  else { KC[256 + n] = f * inv; KC[256 - n] = bsum * inv; }
  __syncthreads();
}

DI void phase_p3(const Params& p, int l, char* smem) {
  const int lane = tidx() & 63, r = lane & 31, h = lane >> 5;
  const int n_uq = (l == 0 ? 132 : 128) * 6, n_ukv = 132 * 8, n_r1 = 16 * NCH, n_ff = 512, n_fc = (l == 0 ? 512 : 0);
  const int total = n_uq + n_ukv + n_r1 + n_ff + n_fc;
  const char* wl = p.ws + OFF_W + (size_t)l * WL_SIZE;
  u16* Q = (u16*)(p.ws + OFF_Q);
  u16* KF = (u16*)(p.ws + OFF_KF);
  u16* VT = (u16*)(p.ws + OFF_VT);
  for (int it = blockIdx.x; it < total; it += gridDim.x) {
    int q = it;
    if (q < n_uq) {
      int mt = q / 6, nt = q - mt * 6;
      if (SUB_ON(0)) gemm_tile<true, false, false>((const u16*)(p.ws + OFF_CQ), 256, (const u16*)(wl + WL_WUQ), 256, 256, mt * 256, nt * 128, nullptr, 0, smem,
        [&](int bm, int bn, const f32x16& acc, const float* rs) __attribute__((always_inline)) {
        const int lz_ = tidx() & 63, r = lz_ & 31, h = lz_ >> 5;
          int col = bn + r;
          int j = col % 96;
          const float qscale = 0.10206207261596577f * 1.4426950408889634f;
#pragma unroll
          for (int reg = 0; reg < 16; reg++) {
            int row = bm + crow(reg, h);
            float v = acc[reg] * rs[row - mt * 256];
            if (j >= 64) {
              int b, t, key, cond;
              row_info(row, b, t, key, cond);
              float vr = rope_apply((const float2*)(p.ws + OFF_ROPE), v, r, t);
              if (row < TLAT) v = vr;
            }
            Q[(size_t)row * 768 + col] = f2bf(v * qscale);
          }
        });
    } else if ((q -= n_uq) < n_ukv) {
      int mt = q >> 3, nt = q & 7;
      if (nt < 4) {
        if (SUB_ON(1)) gemm_tile<true, false, false>((const u16*)(p.ws + OFF_CKV), 128, (const u16*)(wl + WL_WUKV), 128, 128, mt * 256, nt * 128, nullptr, 0, smem,
          [&](int bm, int bn, const f32x16& acc, const float* rs) __attribute__((always_inline)) {
        const int lz_ = tidx() & 63, r = lz_ & 31, h = lz_ >> 5;
            int hd = bn >> 6, j = (bn & 63) + r;
#pragma unroll
            for (int reg = 0; reg < 16; reg++) {
              int row = bm + crow(reg, h), b, t, key, cond;
              row_info(row, b, t, key, cond);
              KF[((size_t)(b * 8 + hd) * LKEY + key) * 96 + j] = f2bf(acc[reg] * rs[row - mt * 256]);
            }
          });
      } else {
        if (SUB_ON(1)) gemm_tile<true, true, true>((const u16*)(p.ws + OFF_CKV), 128, (const u16*)(wl + WL_WUKV), 128, 128, mt * 256, nt * 128, nullptr, 0, smem,
          [&](int bm, int bn, const f32x16& acc, const float* rs) __attribute__((always_inline)) {
        const int lz_ = tidx() & 63, r = lz_ & 31, h = lz_ >> 5;
            int row = bm + r, b, t, key, cond;
            row_info(row, b, t, key, cond);
            float rr = rs[row - mt * 256];
            int hd = (bn - 512) >> 6, e0 = (bn - 512) & 63;
            u16* dstp = VT + ((size_t)(b * 8 + hd) * 64 + e0) * LKEY + key;
#pragma unroll
            for (int reg = 0; reg < 16; reg++) dstp[(size_t)crow(reg, h) * LKEY] = f2bf(acc[reg] * rr);
          });
      }
    } else if ((q -= n_ukv) < n_r1) {
      int bh = q / NCH, ci = q - bh * NCH;
      if (SUB_ON(2)) ret_kv_item(p, l, bh >> 2, bh & 3, ci, smem);
    } else if ((q -= n_r1) < n_ff) {
      if (SUB_ON(3)) filt_fft_item(p, l, q >> 8, q & 255, smem);
    } else {
      q -= n_ff;
      if (SUB_ON(4)) filt_ctx_item(p, l, q >> 8, q & 255, smem);
    }
  }
}

DI void phase_scan(const Params& p, int l) {
  float* ST = (float*)(p.ws + OFF_ST);
  for (int idx = blockIdx.x * 256 + tidx(); idx < 2 * 16 * 4096; idx += gridDim.x * 256) {
    int dir = idx >> 16, bh = (idx >> 12) & 15, el = idx & 4095, hh = bh & 3;
    float* base = ST + (size_t)((dir * 16 + bh) * NCH) * 4096 + el;
    float lg = log1pf(-expf(p.in[I_RLD][l * 8 + dir * 4 + hh]));
    float gC = expf(lg * 128.f);
    float s = 0.f;
    if (dir == 0) {
      for (int ci = 0; ci < NCH; ci++) { float tmp = base[(size_t)ci * 4096]; base[(size_t)ci * 4096] = s; s = gC * s + tmp; }
    } else {
      for (int ci = 1; ci >= 0; ci--) { float tmp = base[(size_t)ci * 4096]; base[(size_t)ci * 4096] = s; s = gC * s + tmp; }
      for (int ci = NCH - 1; ci >= 2; ci--) { float tmp = base[(size_t)ci * 4096]; base[(size_t)ci * 4096] = s; s = gC * s + tmp; }
    }
  }
}

DI void attn_item(const Params& p, int b, int hh, int qrow0, int key0, int nkeys, char* smem) {
  u16* Ks = (u16*)smem;
  u16* Vs = Ks + 64 * 104;
  const u16* Q = (const u16*)(p.ws + OFF_Q);
  const u16* KF = (const u16*)(p.ws + OFF_KF);
  const u16* VT = (const u16*)(p.ws + OFF_VT);
  u16* MIX = (u16*)(p.ws + OFF_H);
  int tid_o = tidx();
  asm volatile("" : "+v"(tid_o));
  const int tid = tid_o, lane = tid & 63, wid = tid >> 6, r = lane & 31, h = lane >> 5;
  const int qrow = qrow0 + wid * 32 + r;
  bf16x8 qf[6];
#pragma unroll
  for (int ks = 0; ks < 6; ks++) qf[ks] = *(const bf16x8*)(Q + (size_t)qrow * 768 + hh * 96 + ks * 16 + h * 8);
  f32x16 o0, o1;
#pragma unroll
  for (int e = 0; e < 16; e++) { o0[e] = 0.f; o1[e] = 0.f; }
  float m = 0.f, lsum = 0.f;
  const u32x4* kbase = (const u32x4*)(KF + ((size_t)(b * 8 + hh) * LKEY + key0) * 96);
  const u16* vbase = VT + (size_t)(b * 8 + hh) * 64 * LKEY + key0;
  u32x4 rk[3], rv[2];
  const int nt = nkeys >> 6;
#define ATT_GLOAD(T)                                                                                                        \
  {                                                                                                                         \
    const int t_ = (T);                                                                                                     \
    _Pragma("unroll") for (int i = 0; i < 3; i++) rk[i] = kbase[(size_t)t_ * 768 + tid + 256 * i];                          \
    _Pragma("unroll") for (int i = 0; i < 2; i++) { int id = tid + 256 * i; rv[i] = *(const u32x4*)(vbase + (size_t)(id >> 3) * LKEY + t_ * 64 + (id & 7) * 8); } \
  }
#define ATT_LWRITE(T)                                                                                                       \
  {                                                                                                                         \
    u16* Kd = Ks + ((T) & 1) * (64 * 104 + 64 * 72);                                                                        \
    u16* Vd = Kd + 64 * 104;                                                                                                \
    _Pragma("unroll") for (int i = 0; i < 3; i++) { int id = tid + 256 * i; int kr = id / 12, c = id - kr * 12; *(u32x4*)(Kd + kr * 104 + c * 8) = rk[i]; } \
    _Pragma("unroll") for (int i = 0; i < 2; i++) { int id = tid + 256 * i; *(u32x4*)(Vd + (id >> 3) * 72 + (id & 7) * 8) = rv[i]; } \
  }
  ATT_GLOAD(0)
  ATT_LWRITE(0)
  if (nt > 1) ATT_GLOAD(1)
  __syncthreads();
  for (int t = 0; t < nt; t++) {
    if (t + 1 < nt) {
      ATT_LWRITE(t + 1)
      if (t + 2 < nt) ATT_GLOAD(t + 2)
    }
    __builtin_amdgcn_sched_barrier(0);
    const u16* Kc = Ks + (t & 1) * (64 * 104 + 64 * 72);
    const u16* Vc = Kc + 64 * 104;
    f32x16 s0, s1;
#pragma unroll
    for (int e = 0; e < 16; e++) { s0[e] = 0.f; s1[e] = 0.f; }
#pragma unroll
    for (int ks = 0; ks < 6; ks++) {
      bf16x8 k0 = *(const bf16x8*)(Kc + (r) * 104 + ks * 16 + h * 8);
      bf16x8 k1 = *(const bf16x8*)(Kc + (32 + r) * 104 + ks * 16 + h * 8);
      s0 = MFMA32(k0, qf[ks], s0);
      s1 = MFMA32(k1, qf[ks], s1);
    }
    float mx = s0[0];
#pragma unroll
    for (int e = 0; e < 16; e++) { mx = fmaxf(mx, s0[e]); mx = fmaxf(mx, s1[e]); }
    mx = fmaxf(mx, __shfl_xor(mx, 32));
    float d = (t == 0 || mx - m > 8.f) ? (mx - m) : 0.f;
    if (__any(d != 0.f)) {
      float alpha = __builtin_amdgcn_exp2f(-d);
      lsum *= alpha;
#pragma unroll
      for (int e = 0; e < 16; e++) { o0[e] *= alpha; o1[e] *= alpha; }
      m += d;
    }
    float ps = 0.f;
#pragma unroll
    for (int e = 0; e < 16; e++) {
      s0[e] = __builtin_amdgcn_exp2f(s0[e] - m); ps += s0[e];
      s1[e] = __builtin_amdgcn_exp2f(s1[e] - m); ps += s1[e];
    }
    lsum += ps;
#pragma unroll
    for (int kt2 = 0; kt2 < 2; kt2++) {
#pragma unroll
      for (int sx = 0; sx < 2; sx++) {
        u32x4 pw;
        if (kt2 == 0) {
          pw.x = pack2(s0[8 * sx + 0], s0[8 * sx + 1]); pw.y = pack2(s0[8 * sx + 2], s0[8 * sx + 3]);
          pw.z = pack2(s0[8 * sx + 4], s0[8 * sx + 5]); pw.w = pack2(s0[8 * sx + 6], s0[8 * sx + 7]);
        } else {
          pw.x = pack2(s1[8 * sx + 0], s1[8 * sx + 1]); pw.y = pack2(s1[8 * sx + 2], s1[8 * sx + 3]);
          pw.z = pack2(s1[8 * sx + 4], s1[8 * sx + 5]); pw.w = pack2(s1[8 * sx + 6], s1[8 * sx + 7]);
        }
        bf16x8 pb = __builtin_bit_cast(bf16x8, pw);
        int kb = kt2 * 32 + 16 * sx + 4 * h;
        {
          const u16* vp = Vc + (r) * 72 + kb;
          uint2 lo = *(const uint2*)vp, hi = *(const uint2*)(vp + 8);
          u32x4 vw = {lo.x, lo.y, hi.x, hi.y};
          o0 = MFMA32(__builtin_bit_cast(bf16x8, vw), pb, o0);
        }
        {
          const u16* vp = Vc + (32 + r) * 72 + kb;
          uint2 lo = *(const uint2*)vp, hi = *(const uint2*)(vp + 8);
          u32x4 vw = {lo.x, lo.y, hi.x, hi.y};
          o1 = MFMA32(__builtin_bit_cast(bf16x8, vw), pb, o1);
        }
      }
    }
    __syncthreads();
  }
#undef ATT_LWRITE
#undef ATT_GLOAD
  lsum += __shfl_xor(lsum, 32);
  const float inv = 1.f / lsum;
  u16* dst = MIX + (size_t)qrow * 1024 + 512 + hh * 64;
#pragma unroll
  for (int g = 0; g < 4; g++) {
    int e = 8 * g + 4 * h;
    *(uint2*)(dst + e) = make_uint2(pack2(o0[4 * g] * inv, o0[4 * g + 1] * inv), pack2(o0[4 * g + 2] * inv, o0[4 * g + 3] * inv));
    *(uint2*)(dst + 32 + e) = make_uint2(pack2(o1[4 * g] * inv, o1[4 * g + 1] * inv), pack2(o1[4 * g + 2] * inv, o1[4 * g + 3] * inv));
  }
  __syncthreads();
}

DI void ret_out_item(const Params& p, int l, int b, int hh, int ci, char* smem) {
  const u16* RET = (const u16*)(p.ws + OFF_RET);
  const float* ST = (const float*)(p.ws + OFF_ST);
  u16* MIX = (u16*)(p.ws + OFF_H);
  u16* Qs = (u16*)smem;
  u16* Ks = Qs + 128 * 72;
  u16* Ps = Qs;
  u16* VsT = Ks + 128 * 72;
  u16* SfT = VsT + 64 * 136;
  u16* SbT = SfT + 64 * 72;
  float* dmk = (float*)(SbT + 64 * 72);
  int tid_o = tidx();
  asm volatile("" : "+v"(tid_o));
  const int tid = tid_o, lane = tid & 63, wid = tid >> 6, r = lane & 31, h = lane >> 5;
  float lgf, lgb;
  ret_gammas(p, l, hh, lgf, lgb);
  const int row0 = chunk_row0(b, ci);
  { int d = tid - 128; dmk[tid] = d > 0 ? __expf(lgf * (float)d) : (d < 0 ? __expf(lgb * (float)(-d)) : 2.f); }
#pragma unroll 2
  for (int i = 0; i < 4; i++) {
    int id = tid + 256 * i, m = id >> 3, dc = id & 7;
    const u16* rp = RET + (size_t)(row0 + m) * 1024 + hh * 64 + dc * 8;
    *(uint4*)(Qs + m * 72 + dc * 8) = *(const uint4*)(rp);
    *(uint4*)(Ks + m * 72 + dc * 8) = *(const uint4*)(rp + 256);
    u32x4 vv = *(const u32x4*)(rp + 512);
#pragma unroll
    for (int j = 0; j < 8; j++) VsT[(dc * 8 + j) * 136 + m] = bfu(vv, j);
  }
  const float* Sf = ST + ((size_t)((0 * 4 + b) * 4 + hh) * NCH + ci) * 4096;
  const float* Sb = ST + ((size_t)((1 * 4 + b) * 4 + hh) * NCH + ci) * 4096;
#pragma unroll 2
  for (int i = 0; i < 16; i++) {
    int id = tid + 256 * i, d = id >> 6, e = id & 63;
    SfT[e * 72 + d] = f2bf(Sf[id]);
    SbT[e * 72 + d] = f2bf(Sb[id]);
  }
  __syncthreads();
  const int cw = wid * 32;
  f32x16 in0, in1, sc[4];
  {
    f32x16 cf0, cf1, cb0, cb1;
#pragma unroll
    for (int e = 0; e < 16; e++) { cf0[e] = cf1[e] = cb0[e] = cb1[e] = 0.f; }
#pragma unroll
    for (int ks = 0; ks < 4; ks++) {
      bf16x8 qa = *(const bf16x8*)(Qs + (cw + r) * 72 + ks * 16 + h * 8);
      cf0 = MFMA32(qa, *(const bf16x8*)(SfT + (r) * 72 + ks * 16 + h * 8), cf0);
      cf1 = MFMA32(qa, *(const bf16x8*)(SfT + (32 + r) * 72 + ks * 16 + h * 8), cf1);
      cb0 = MFMA32(qa, *(const bf16x8*)(SbT + (r) * 72 + ks * 16 + h * 8), cb0);
      cb1 = MFMA32(qa, *(const bf16x8*)(SbT + (32 + r) * 72 + ks * 16 + h * 8), cb1);
    }
#pragma unroll
    for (int reg = 0; reg < 16; reg++) {
      int c = cw + crow(reg, h);
      float xf = __expf(lgf * (float)(c + 1)), xb = __expf(lgb * (float)(128 - c));
      in0[reg] = xf * cf0[reg] + xb * cb0[reg];
      in1[reg] = xf * cf1[reg] + xb * cb1[reg];
    }
  }
#pragma unroll
  for (int e = 0; e < 16; e++) { sc[0][e] = sc[1][e] = sc[2][e] = sc[3][e] = 0.f; }
#pragma unroll
  for (int ks = 0; ks < 4; ks++) {
    bf16x8 qa = *(const bf16x8*)(Qs + (cw + r) * 72 + ks * 16 + h * 8);
#pragma unroll
    for (int mt = 0; mt < 4; mt++) sc[mt] = MFMA32(qa, *(const bf16x8*)(Ks + (mt * 32 + r) * 72 + ks * 16 + h * 8), sc[mt]);
  }
  __syncthreads();
#pragma unroll
  for (int mt = 0; mt < 4; mt++)
#pragma unroll
    for (int reg = 0; reg < 16; reg++) {
      int c = cw + crow(reg, h), mm = mt * 32 + r;
      Ps[c * 136 + mm] = f2bf(sc[mt][reg] * dmk[c - mm + 128]);
      if ((reg & 3) == 3) __builtin_amdgcn_sched_barrier(0);
    }
  __syncthreads();
#pragma unroll
  for (int ks = 0; ks < 8; ks++) {
    bf16x8 pa = *(const bf16x8*)(Ps + (cw + r) * 136 + ks * 16 + h * 8);
    in0 = MFMA32(pa, *(const bf16x8*)(VsT + (r) * 136 + ks * 16 + h * 8), in0);
    in1 = MFMA32(pa, *(const bf16x8*)(VsT + (32 + r) * 136 + ks * 16 + h * 8), in1);
  }
#pragma unroll
  for (int reg = 0; reg < 16; reg++) {
    int c = cw + crow(reg, h);
    float oa = in0[reg], ob = in1[reg];
    float ss = oa * oa + ob * ob;
    ss += __shfl_xor(ss, 1); ss += __shfl_xor(ss, 2); ss += __shfl_xor(ss, 4); ss += __shfl_xor(ss, 8); ss += __shfl_xor(ss, 16);
    float rstd = rsqrtf(ss * (1.f / 64.f) + 1e-6f);
    int rowi = row0 + c;
    asm volatile("" : "+v"(rowi));
    size_t row = (size_t)rowi;
    float g0 = bf2f(RET[row * 1024 + 768 + hh * 64 + r]), g1 = bf2f(RET[row * 1024 + 768 + hh * 64 + 32 + r]);
    MIX[row * 1024 + 256 + hh * 64 + r] = f2bf(silu_f(g0) * oa * rstd);
    MIX[row * 1024 + 256 + hh * 64 + 32 + r] = f2bf(silu_f(g1) * ob * rstd);
    if ((reg & 3) == 3) __builtin_amdgcn_sched_barrier(0);
  }
  __syncthreads();
}

typedef _Float16 h2_t __attribute__((ext_vector_type(2)));
DI unsigned packh(float a, float b) { h2_t v; v[0] = (_Float16)a; v[1] = (_Float16)b; return __builtin_bit_cast(unsigned, v); }
template <class ZF, class CF>
DI void hy_conv(float2* X, const float2* __restrict__ TW, const float2* __restrict__ Ke, const float2* __restrict__ Ko,
                ZF zf4, CF consume4, int tid) {
  const float scl = 0.5f / 8192.f;
#pragma unroll 2
  for (int g = 0; g < 8; g++) {
    int j = tidx() + 256 * g;
    float zr[4], zi[4];
    zf4(j, zr, zi);
#pragma unroll
    for (int e = 0; e < 4; e++) X[PX(4 * j + e)] = make_float2(zr[e], zi[e]);
  }
  __syncthreads();
  fft_dif(X, TW, tid);
#pragma unroll 2
  for (int g = 0; g < 8; g++) {
    int j = tidx() + 256 * g;
    const float4* kp = (const float4*)(Ke + 4 * j);
    float4 k01 = kp[0], k23 = kp[1];
    float2 a;
    a = X[PX(4 * j + 0)]; X[PX(4 * j + 0)] = make_float2(a.x * k01.x - a.y * k01.y, a.x * k01.y + a.y * k01.x);
    a = X[PX(4 * j + 1)]; X[PX(4 * j + 1)] = make_float2(a.x * k01.z - a.y * k01.w, a.x * k01.w + a.y * k01.z);
    a = X[PX(4 * j + 2)]; X[PX(4 * j + 2)] = make_float2(a.x * k23.x - a.y * k23.y, a.x * k23.y + a.y * k23.x);
    a = X[PX(4 * j + 3)]; X[PX(4 * j + 3)] = make_float2(a.x * k23.z - a.y * k23.w, a.x * k23.w + a.y * k23.z);
  }
  __syncthreads();
  fft_dit(X, TW, tid);
  unsigned ye[32];
#pragma unroll
  for (int g = 0; g < 8; g++) {
    int j = tid + 256 * g;
    asm volatile("" : "+v"(j));
#pragma unroll
    for (int e = 0; e < 4; e++) {
      float2 ev = X[PX(4 * j + e)];
      unsigned pk = packh(ev.x * scl, ev.y * scl);
      asm volatile("" : "+v"(pk));
      ye[g * 4 + e] = pk;
    }
    if (g & 1) __builtin_amdgcn_sched_barrier(0);
  }
  __syncthreads();
#pragma unroll 2
  for (int g = 0; g < 8; g++) {
    int j = tidx() + 256 * g;
    float zr[4], zi[4];
    zf4(j, zr, zi);
    const float4* tp = (const float4*)(TW + 4 * j);
    float4 t01 = tp[0], t23 = tp[1];
    X[PX(4 * j + 0)] = make_float2(zr[0] * t01.x - zi[0] * t01.y, zr[0] * t01.y + zi[0] * t01.x);
    X[PX(4 * j + 1)] = make_float2(zr[1] * t01.z - zi[1] * t01.w, zr[1] * t01.w + zi[1] * t01.z);
    X[PX(4 * j + 2)] = make_float2(zr[2] * t23.x - zi[2] * t23.y, zr[2] * t23.y + zi[2] * t23.x);
    X[PX(4 * j + 3)] = make_float2(zr[3] * t23.z - zi[3] * t23.w, zr[3] * t23.w + zi[3] * t23.z);
  }
  __syncthreads();
  fft_dif(X, TW, tid);
#pragma unroll 2
  for (int g = 0; g < 8; g++) {
    int j = tidx() + 256 * g;
    const float4* kp = (const float4*)(Ko + 4 * j);
    float4 k01 = kp[0], k23 = kp[1];
    float2 a;
    a = X[PX(4 * j + 0)]; X[PX(4 * j + 0)] = make_float2(a.x * k01.x - a.y * k01.y, a.x * k01.y + a.y * k01.x);
    a = X[PX(4 * j + 1)]; X[PX(4 * j + 1)] = make_float2(a.x * k01.z - a.y * k01.w, a.x * k01.w + a.y * k01.z);
    a = X[PX(4 * j + 2)]; X[PX(4 * j + 2)] = make_float2(a.x * k23.x - a.y * k23.y, a.x * k23.y + a.y * k23.x);
    a = X[PX(4 * j + 3)]; X[PX(4 * j + 3)] = make_float2(a.x * k23.z - a.y * k23.w, a.x * k23.w + a.y * k23.z);
  }
  __syncthreads();
  fft_dit(X, TW, tid);
#pragma unroll
  for (int g = 0; g < 8; g++) {
    int j = tid + 256 * g;
    asm volatile("" : "+v"(j));
    const float4* tp = (const float4*)(TW + 4 * j);
    float4 t01 = tp[0], t23 = tp[1];
    float ya[4], yb[4];
    float2 o;
    h2_t ev;
    o = X[PX(4 * j + 0)]; ev = __builtin_bit_cast(h2_t, ye[g * 4 + 0]);
    ya[0] = (float)ev[0] + (o.x * t01.x + o.y * t01.y) * scl; yb[0] = (float)ev[1] + (o.y * t01.x - o.x * t01.y) * scl;
    o = X[PX(4 * j + 1)]; ev = __builtin_bit_cast(h2_t, ye[g * 4 + 1]);
    ya[1] = (float)ev[0] + (o.x * t01.z + o.y * t01.w) * scl; yb[1] = (float)ev[1] + (o.y * t01.z - o.x * t01.w) * scl;
    o = X[PX(4 * j + 2)]; ev = __builtin_bit_cast(h2_t, ye[g * 4 + 2]);
    ya[2] = (float)ev[0] + (o.x * t23.x + o.y * t23.y) * scl; yb[2] = (float)ev[1] + (o.y * t23.x - o.x * t23.y) * scl;
    o = X[PX(4 * j + 3)]; ev = __builtin_bit_cast(h2_t, ye[g * 4 + 3]);
    ya[3] = (float)ev[0] + (o.x * t23.z + o.y * t23.w) * scl; yb[3] = (float)ev[1] + (o.y * t23.z - o.x * t23.w) * scl;
    consume4(j, ya, yb);
    __builtin_amdgcn_sched_barrier(0);
  }
  __syncthreads();
}

DI float sconv_at(const u16* __restrict__ u, int n, int Ls, float w0, float w1, float w2, float bias) {
  float um = n > 0 ? bf2f(u[n - 1]) : 0.f, uc = bf2f(u[n]), up = n < Ls - 1 ? bf2f(u[n + 1]) : 0.f;
  return bias + w0 * um + w1 * uc + w2 * up;
}
DI void sconv4(const u16* __restrict__ u, int j, float w0, float w1, float w2, float bias, float (&o)[4]) {
  uint2 c = *(const uint2*)(u + 4 * j);
  float x0 = __uint_as_float(c.x << 16), x1 = __uint_as_float(c.x & 0xffff0000u);
  float x2 = __uint_as_float(c.y << 16), x3 = __uint_as_float(c.y & 0xffff0000u);
  float xm = j > 0 ? bf2f(u[4 * j - 1]) : 0.f, xp = j < 2047 ? bf2f(u[4 * j + 4]) : 0.f;
  o[0] = bias + w0 * xm + w1 * x0 + w2 * x1;
  o[1] = bias + w0 * x0 + w1 * x1 + w2 * x2;
  o[2] = bias + w0 * x1 + w1 * x2 + w2 * x3;
  o[3] = bias + w0 * x2 + w1 * x3 + w2 * xp;
}
DI void unpack4(const u16* __restrict__ p, float (&o)[4]) {
  uint2 c = *(const uint2*)p;
  o[0] = __uint_as_float(c.x << 16); o[1] = __uint_as_float(c.x & 0xffff0000u);
  o[2] = __uint_as_float(c.y << 16); o[3] = __uint_as_float(c.y & 0xffff0000u);
}

DI void hyena_item(const Params& p, int l, int c, int pair, char* smem) {
  float2* X = (float2*)smem;
  const float2* TW = (const float2*)(p.ws + OFF_TW);
  const float2* KS = (const float2*)(p.ws + OFF_KSPEC);
  const u16* UT = (const u16*)(p.ws + OFF_UT);
  u16* YT = (u16*)(p.ws + OFF_CQ);
  int tid_o = tidx();
  const int tid = tid_o;
  const float* cw = p.in[I_HCW] + l * 3 * 768;
  const float* cb = p.in[I_HCB] + l * 768;
  const int b0 = 2 * pair, b1 = b0 + 1;
  u16* y0 = YT + (size_t)(b0 * 256 + c) * SEQ;
  u16* y1 = YT + (size_t)(b1 * 256 + c) * SEQ;
  const float vw0 = cw[512 + c], vw1 = cw[768 + 512 + c], vw2 = cw[1536 + 512 + c], vbs = cb[512 + c];
  const u16* v0p = UT + (size_t)(b0 * 768 + 512 + c) * SEQ;
  const u16* v1p = UT + (size_t)(b1 * 768 + 512 + c) * SEQ;
  {
    const float w0 = cw[c], w1 = cw[768 + c], w2 = cw[1536 + c], bs = cb[c];
    const float bias0 = p.in[I_HBIAS][(l * 2 + 0) * 256 + c];
    const u16* u0 = UT + (size_t)(b0 * 768 + c) * SEQ;
    const u16* u1 = UT + (size_t)(b1 * 768 + c) * SEQ;
    hy_conv(X, TW, KS + (size_t)(0 * 256 + c) * 2 * 8192, KS + (size_t)(0 * 256 + c) * 2 * 8192 + 8192,
            [&](int j, float (&zr)[4], float (&zi)[4]) __attribute__((always_inline)) {
              sconv4(v0p, j, vw0, vw1, vw2, vbs, zr); sconv4(v1p, j, vw0, vw1, vw2, vbs, zi);
            },
            [&](int j, const float (&ya)[4], const float (&yb)[4]) __attribute__((always_inline)) {
              float va[4], vb[4], xa[4], xb[4];
              sconv4(v0p, j, vw0, vw1, vw2, vbs, va); sconv4(v1p, j, vw0, vw1, vw2, vbs, vb);
              sconv4(u0, j, w0, w1, w2, bs, xa); sconv4(u1, j, w0, w1, w2, bs, xb);
              *(uint2*)(y0 + 4 * j) = make_uint2(pack2(xa[0] * (ya[0] + va[0] * bias0), xa[1] * (ya[1] + va[1] * bias0)),
                                                 pack2(xa[2] * (ya[2] + va[2] * bias0), xa[3] * (ya[3] + va[3] * bias0)));
              *(uint2*)(y1 + 4 * j) = make_uint2(pack2(xb[0] * (yb[0] + vb[0] * bias0), xb[1] * (yb[1] + vb[1] * bias0)),
                                                 pack2(xb[2] * (yb[2] + vb[2] * bias0), xb[3] * (yb[3] + vb[3] * bias0)));
            }, tid);
  }
  {
    const int col = 256 + c;
    const float w0 = cw[col], w1 = cw[768 + col], w2 = cw[1536 + col], bs = cb[col];
    const float bias1 = p.in[I_HBIAS][(l * 2 + 1) * 256 + c];
    const u16* u0 = UT + (size_t)(b0 * 768 + col) * SEQ;
    const u16* u1 = UT + (size_t)(b1 * 768 + col) * SEQ;
    hy_conv(X, TW, KS + (size_t)(1 * 256 + c) * 2 * 8192, KS + (size_t)(1 * 256 + c) * 2 * 8192 + 8192,
            [&](int j, float (&zr)[4], float (&zi)[4]) __attribute__((always_inline)) { unpack4(y0 + 4 * j, zr); unpack4(y1 + 4 * j, zi); },
            [&](int j, const float (&ya)[4], const float (&yb)[4]) __attribute__((always_inline)) {
              float za[4], zb[4], xa[4], xb[4];
              unpack4(y0 + 4 * j, za); unpack4(y1 + 4 * j, zb);
              sconv4(u0, j, w0, w1, w2, bs, xa); sconv4(u1, j, w0, w1, w2, bs, xb);
              *(uint2*)(y0 + 4 * j) = make_uint2(pack2(xa[0] * (ya[0] + za[0] * bias1), xa[1] * (ya[1] + za[1] * bias1)),
                                                 pack2(xa[2] * (ya[2] + za[2] * bias1), xa[3] * (ya[3] + za[3] * bias1)));
              *(uint2*)(y1 + 4 * j) = make_uint2(pack2(xb[0] * (yb[0] + zb[0] * bias1), xb[1] * (yb[1] + zb[1] * bias1)),
                                                 pack2(xb[2] * (yb[2] + zb[2] * bias1), xb[3] * (yb[3] + zb[3] * bias1)));
            }, tid);
  }
}

DI void hyena_ctx_item(const Params& p, int l, int b, int c, char* smem) {
  float* k0s = (float*)smem;
  float* k1s = k0s + 512;
  float* vs = k1s + 512;
  float* zs = vs + 256;
  const float* KC = (const float*)(p.ws + OFF_KC);
  const u16* UTC = (const u16*)(p.ws + OFF_UTC);
  u16* MIX = (u16*)(p.ws + OFF_H);
  int tid_o = tidx();
  asm volatile("" : "+v"(tid_o));
  const int n = tid_o;
  const float* cw = p.in[I_HCW] + l * 3 * 768;
  const float* cb = p.in[I_HCB] + l * 768;
  k0s[n] = KC[(size_t)(0 * 256 + c) * 512 + n]; k0s[256 + n] = KC[(size_t)(0 * 256 + c) * 512 + 256 + n];
  k1s[n] = KC[(size_t)(1 * 256 + c) * 512 + n]; k1s[256 + n] = KC[(size_t)(1 * 256 + c) * 512 + 256 + n];
  float v = sconv_at(UTC + (size_t)(b * 768 + 512 + c) * LCTX, n, LCTX, cw[512 + c], cw[768 + 512 + c], cw[1536 + 512 + c], cb[512 + c]);
  float x1 = sconv_at(UTC + (size_t)(b * 768 + c) * LCTX, n, LCTX, cw[c], cw[768 + c], cw[1536 + c], cb[c]);
  float x2 = sconv_at(UTC + (size_t)(b * 768 + 256 + c) * LCTX, n, LCTX, cw[256 + c], cw[768 + 256 + c], cw[1536 + 256 + c], cb[256 + c]);
  vs[n] = v;
  __syncthreads();
  float a = 0.f;
  for (int s = 0; s < 256; s++) a += k0s[n - s + 256] * vs[s];
  float z = x1 * (a + v * p.in[I_HBIAS][(l * 2 + 0) * 256 + c]);
  zs[n] = z;
  __syncthreads();
  float a2 = 0.f;
  for (int s = 0; s < 256; s++) a2 += k1s[n - s + 256] * zs[s];
  float y = x2 * (a2 + z * p.in[I_HBIAS][(l * 2 + 1) * 256 + c]);
  MIX[(size_t)(TLAT + b * LCTX + n) * 1024 + c] = f2bf(y);
  __syncthreads();
}

DI void phase_p4(const Params& p, int l, char* smem, int submask = 15) {
  const int n_al = 2048, n_ac = (l == 0 ? 64 : 0), n_hy = 512, n_r3 = (l == 0 ? 16 * NCH : 16 * 64), n_hc = (l == 0 ? 1024 : 0);
  const int total = n_al + n_ac + n_hy + n_r3 + n_hc;
  for (int it = blockIdx.x; it < total; it += gridDim.x) {
    int q = it;
    if (q < n_al) {
      int b = q >> 9, hh = (q >> 6) & 7, qb = q & 63;
      if (SUB_ON(0) && (submask & 1)) attn_item(p, b, hh, b * SEQ + qb * 128, 0, LKEY, smem);
    } else if ((q -= n_al) < n_ac) {
      int b = q >> 4, hh = (q >> 1) & 7, qb = q & 1;
      if (SUB_ON(0) && (submask & 1)) attn_item(p, b, hh, TLAT + b * LCTX + qb * 128, SEQ, LCTX, smem);
    } else if ((q -= n_ac) < n_hy) {
      if (SUB_ON(1) && (submask & 2)) hyena_item(p, l, q >> 1, q & 1, smem);
    } else if ((q -= n_hy) < n_r3) {
      int bh, ci;
      if (l == 0) { bh = q / NCH; ci = q - bh * NCH; } else { bh = q >> 6; ci = 2 + (q & 63); }
      if (SUB_ON(2) && (submask & 4)) ret_out_item(p, l, bh >> 2, bh & 3, ci, smem);
    } else {
      q -= n_r3;
      if (SUB_ON(3) && (submask & 8)) hyena_ctx_item(p, l, q >> 8, q & 255, smem);
    }
  }
}

DI void phase_res_gemm(const Params& p, int l, int which  , char* smem) {
  const char* wl = p.ws + OFF_W + (size_t)l * WL_SIZE;
  const u16* A = (const u16*)(p.ws + (which == 1 ? OFF_H : OFF_ACT));
  const int K = which == 1 ? 1024 : 4096;
  const u16* Bt = (const u16*)(wl + (which == 1 ? WL_WOUT : WL_W2));
  const bool first = (l == 0 && which == 1);
  const float* mod = (const float*)(p.ws + OFF_MOD);
  float* XC = (float*)(p.ws + OFF_XC);
  const int n_lat = 128 * 8, n_split = (l == 0 ? 32 * 16 : 0);
  for (int it = blockIdx.x; it < n_lat + n_split; it += gridDim.x) {
    if (it < n_lat) {
      int mt = it >> 3, nt = it & 7;
      int m0 = mt * 256;
      const u16* at = nullptr;
      if (which == 1) at = (const u16*)(p.ws + OFF_CQ) + (size_t)((m0 >> 13) * 256) * SEQ + (m0 & 8191);
      const float* ga = mod + (size_t)(l * 5 + (m0 >> 13)) * 6144 + (which == 1 ? 2048 : 5120);
      const float* src = first ? p.in[I_X] : p.out;
      float* dst = p.out;
      gemm_tile<false, false, false>(A, K, Bt, K, K, m0, nt * 128, at, 8, smem,
        [&](int bm, int bn, const f32x16& acc, const float*) __attribute__((always_inline)) {
          const int lz_ = tidx() & 63, r = lz_ & 31, h = lz_ >> 5;
          int col = bn + r;
          float g = ga[col];
#pragma unroll
          for (int reg = 0; reg < 16; reg++) {
            size_t idx = (size_t)(bm + crow(reg, h)) * 1024 + col;
            dst[idx] = src[idx] + g * acc[reg];
          }
        });
    } else {
      int q = it - n_lat;
      int tile = q >> 4, kc = q & 15;
      int mt = 128 + (tile >> 3), nt = tile & 7;
      int kchunk = K >> 4, k0 = kc * kchunk;
      const float* ga = mod + (size_t)(l * 5 + 4) * 6144 + (which == 1 ? 2048 : 5120);
      float* dst = XC - (size_t)TLAT * 1024;
      gemm_tile<false, false, false>(A + k0, K, Bt + k0, K, kchunk, mt * 256, nt * 128, nullptr, 0, smem,
        [&](int bm, int bn, const f32x16& acc, const float*) __attribute__((always_inline)) {
          const int lz_ = tidx() & 63, r = lz_ & 31, h = lz_ >> 5;
          int col = bn + r;
          float g = ga[col];
#pragma unroll
          for (int reg = 0; reg < 16; reg++) unsafeAtomicAdd(dst + (size_t)(bm + crow(reg, h)) * 1024 + col, g * acc[reg]);
        });
    }
  }
}

DI void phase_mlp1(const Params& p, int l, char* smem) {
  const int lane = tidx() & 63, r = lane & 31, h = lane >> 5;
  const int nmt = (l == 0 ? 132 : 128);
  const u16* A = (const u16*)(p.ws + OFF_H);
  const u16* Bt = (const u16*)(p.ws + OFF_W + (size_t)l * WL_SIZE + WL_W1);
  u16* ACT = (u16*)(p.ws + OFF_ACT);
  const int total = nmt * 32;
  for (int it = blockIdx.x; it < total; it += gridDim.x) {
    int mt = it >> 5, nt = it & 31;
    gemm_tile<false, false, false>(A, 1024, Bt, 1024, 1024, mt * 256, nt * 128, nullptr, 0, smem,
      [&](int bm, int bn, const f32x16& acc, const float*) __attribute__((always_inline)) {
        const int lz_ = tidx() & 63, r = lz_ & 31, h = lz_ >> 5;
        int col = bn + r;
#pragma unroll
        for (int reg = 0; reg < 16; reg++) {
          float v = fmaxf(acc[reg], 0.f);
          ACT[(size_t)(bm + crow(reg, h)) * 4096 + col] = f2bf(v * v);
        }
      });
  }
}

DI void phase_final(const Params& p) {
  const int lane = tidx() & 63, wid = tidx() >> 6;
  const float* g = p.in[I_FNG];
  for (int it = blockIdx.x; it < TLAT / 8; it += gridDim.x) {
    float* row = p.out + (size_t)(it * 8 + wid * 2) * 1024;
    float4 v[8];
    float ssq0 = 0.f, ssq1 = 0.f;
#pragma unroll
    for (int i = 0; i < 4; i++) { v[i] = *(const float4*)(row + i * 256 + lane * 4); v[4 + i] = *(const float4*)(row + 1024 + i * 256 + lane * 4); }
#pragma unroll
    for (int i = 0; i < 4; i++) {
      ssq0 += v[i].x * v[i].x + v[i].y * v[i].y + v[i].z * v[i].z + v[i].w * v[i].w;
      ssq1 += v[4 + i].x * v[4 + i].x + v[4 + i].y * v[4 + i].y + v[4 + i].z * v[4 + i].z + v[4 + i].w * v[4 + i].w;
    }
    ssq0 = wave_sum(ssq0); ssq1 = wave_sum(ssq1);
    float r0 = rsqrtf(ssq0 * (1.f / 1024.f) + 1e-6f), r1 = rsqrtf(ssq1 * (1.f / 1024.f) + 1e-6f);
#pragma unroll
    for (int i = 0; i < 4; i++) {
      float4 gg = *(const float4*)(g + i * 256 + lane * 4);
      *(float4*)(row + i * 256 + lane * 4) = make_float4(v[i].x * r0 * gg.x, v[i].y * r0 * gg.y, v[i].z * r0 * gg.z, v[i].w * r0 * gg.w);
      *(float4*)(row + 1024 + i * 256 + lane * 4) = make_float4(v[4 + i].x * r1 * gg.x, v[4 + i].y * r1 * gg.y, v[4 + i].z * r1 * gg.z, v[4 + i].w * r1 * gg.w);
    }
  }
}


#define XB_TMO      128
#define XB_XCNT(j)  (256  + 64 * (j))
#define XB_XSUB(j)  (1280 + 64 * (j))
#define XB_XGEN(j)  (2304 + 64 * (j))
#define XB_TOP      3328
#define XB_TOPGEN   3392
#define XCD_BAR_WORDS 3456
#define XB_SPIN_CAP (1u << 22)
#define LAS __attribute__((address_space(3)))
DI unsigned xb_ld(unsigned* p) { return __hip_atomic_load(p, __ATOMIC_RELAXED, __HIP_MEMORY_SCOPE_AGENT); }
DI unsigned xb_add(unsigned* p, unsigned v) { return __hip_atomic_fetch_add(p, v, __ATOMIC_RELAXED, __HIP_MEMORY_SCOPE_AGENT); }
DI unsigned xb_xcc_id() { return (unsigned)__builtin_amdgcn_s_getreg((3 << 11) | 20) & 0xFu; }
#define XB_SPIN(cond, bar) do { unsigned _sp = 0; while (cond) { __builtin_amdgcn_s_sleep(1); \
    if ((++_sp & 255u) == 0u) { if (xb_ld(&(bar)[XB_TMO])) break; if (_sp > XB_SPIN_CAP) { atomicAdd(&(bar)[XB_TMO], 1u); break; } } } } while (0)
struct XcdBarrier { unsigned* bar; unsigned x; volatile LAS unsigned* st; };
DI XcdBarrier xcd_barrier_post(unsigned* bar, volatile LAS unsigned* st) {
  XcdBarrier b; b.bar = bar; b.x = xb_xcc_id(); b.st = st;
  if (threadIdx.x == 0) (void)xb_add(&bar[XB_XCNT(b.x)], 1u);
  return b;
}
DI void xcd_barrier_complete(unsigned* bar, unsigned x, unsigned& nloc, unsigned& nx) {
  const unsigned G = gridDim.x * gridDim.y * gridDim.z;
  unsigned sum, cnt, mine, sp = 0u;
  for (;;) {
    sum = 0u; cnt = 0u; mine = 0u;
#pragma unroll
    for (unsigned j = 0; j < 16; ++j) { const unsigned c = xb_ld(&bar[XB_XCNT(j)]); sum += c; cnt += (c > 0u) ? 1u : 0u; mine = (j == x) ? c : mine; }
    if (sum == G) break;
    __builtin_amdgcn_s_sleep(1);
    if ((++sp & 255u) == 0u) { if (xb_ld(&bar[XB_TMO])) break; if (sp > XB_SPIN_CAP) { atomicAdd(&bar[XB_TMO], 1u); break; } }
  }
  nloc = mine > 0u ? mine : 1u; nx = cnt > 0u ? cnt : 1u;
}
DI void xcd_barrier(const XcdBarrier& b) {
  asm volatile("s_waitcnt vmcnt(0)" ::: "memory");
  __syncthreads();
  if (threadIdx.x == 0) {
    unsigned* bar = b.bar;
    __builtin_amdgcn_s_waitcnt(0);
    unsigned nloc = b.st[0], nx = b.st[1];
    if (nloc == 0u) { xcd_barrier_complete(bar, b.x, nloc, nx); b.st[0] = nloc; b.st[1] = nx; }
    const unsigned old = xb_add(&bar[XB_XSUB(b.x)], 1u);
    const unsigned gen = old / nloc;
    if (old + 1u == (gen + 1u) * nloc) {
      __builtin_amdgcn_fence(__ATOMIC_RELEASE, "agent");
      asm volatile("s_waitcnt vmcnt(0)" ::: "memory");
      const unsigned og = xb_add(&bar[XB_TOP], 1u);
      const unsigned tg = og / nx;
      if (og + 1u == (tg + 1u) * nx) xb_add(&bar[XB_TOPGEN], 1u);
      else XB_SPIN(xb_ld(&bar[XB_TOPGEN]) == tg, bar);
      __builtin_amdgcn_fence(__ATOMIC_ACQUIRE, "agent");
      xb_add(&bar[XB_XGEN(b.x)], 1u);
      asm volatile("s_waitcnt vmcnt(0)" ::: "memory");
    } else {
      XB_SPIN(xb_ld(&bar[XB_XGEN(b.x)]) == gen, bar);
      __builtin_amdgcn_fence(__ATOMIC_ACQUIRE, "agent");
      asm volatile("s_waitcnt vmcnt(0)" ::: "memory");
    }
  }
  __syncthreads();
}

constexpr int NPHASE = 20;
#ifndef ONLY_PHASE
#define ONLY_PHASE -1
#endif
#define PH_ON(k) (ONLY_PHASE < 0 || ONLY_PHASE == (k))
DI void run_phase(const Params& p, int ph, char* smem, int submask = 15) {
  if (ph == 0) { if (PH_ON(0)) phase_s0(p, smem); return; }
  if (ph == NPHASE - 1) { if (PH_ON(8)) phase_final(p); return; }
  int l = (ph - 1) / 9, s = (ph - 1) % 9;
  switch (s) {
    case 0: if (PH_ON(1)) phase_norm(p, l, 1, TALL, true); break;
    case 1: if (PH_ON(2)) phase_win(p, l, smem); break;
    case 2: if (PH_ON(3)) phase_p3(p, l, smem); break;
    case 3: if (PH_ON(4)) phase_scan(p, l); break;
    case 4: if (PH_ON(5)) phase_p4(p, l, smem, submask); break;
    case 5: if (PH_ON(6)) phase_res_gemm(p, l, 1, smem); break;
    case 6: if (PH_ON(1)) phase_norm(p, l, 2, l == 0 ? TALL : TLAT, false); break;
    case 7: if (PH_ON(7)) phase_mlp1(p, l, smem); break;
    default: if (PH_ON(6)) phase_res_gemm(p, l, 2, smem); break;
  }
}

#if !MULTI_LAUNCH
extern "C" __global__ void __launch_bounds__(256, 2) mk_all(Params p) {
  extern __shared__ __attribute__((aligned(16))) char smem[];
  cg::grid_group grid = cg::this_grid();
  __shared__ uint4 xb_words;
  if (threadIdx.x == 0) xb_words = make_uint4(0u, 0u, 0u, 0u);
  __syncthreads();
  XcdBarrier xb = xcd_barrier_post((unsigned*)(p.ws + OFF_BAR), (volatile LAS unsigned*)&xb_words);
  if (p.ws == nullptr) grid.sync();
  for (int ph = 0; ph < NPHASE; ph++) {
    run_phase(p, ph, smem);
#ifdef PROBE_DUP
    if (ph == PROBE_DUP || ph == PROBE_DUP2) { xcd_barrier(xb); run_phase(p, ph, smem, PROBE_MASK); }
#endif
    if (ph + 1 < NPHASE) xcd_barrier(xb);
  }
}
#define MK_KERNEL mk_all
#else
#define MK_KERNEL mk_phase
extern "C" __global__ void __launch_bounds__(256, 2) mk_phase(Params p, int ph) {
  extern __shared__ __attribute__((aligned(16))) char smem[];
  run_phase(p, ph, smem);
}
#endif

extern "C" void kernel_launch(void* const* d_in, const int* in_sizes, int n_in, void* d_out, int out_size, void* d_ws, size_t ws_size,
                              hipStream_t stream) {
  Params p{};
  for (int i = 0; i < 27; i++) p.in[i] = (const float*)d_in[i];
  p.out = (float*)d_out;
  p.ws = (char*)d_ws;
  static int grid_blocks = 0;
  if (!grid_blocks) {
    int dev = 0, cus = 0, per_cu = 0;
    (void)hipGetDevice(&dev);
    (void)hipDeviceGetAttribute(&cus, hipDeviceAttributeMultiprocessorCount, dev);
    (void)hipFuncSetAttribute((const void*)MK_KERNEL, hipFuncAttributeMaxDynamicSharedMemorySize, SMEM_BYTES);
    (void)hipOccupancyMaxActiveBlocksPerMultiprocessor(&per_cu, MK_KERNEL, 256, SMEM_BYTES);
    if (per_cu < 1) per_cu = 1;
    if (per_cu > 2) per_cu = 2;
    grid_blocks = cus * per_cu;
  }
#if MULTI_LAUNCH
  for (int ph = 0; ph < NPHASE; ph++) hipLaunchKernelGGL(mk_phase, dim3(grid_blocks), dim3(256), SMEM_BYTES, stream, p, ph);
#else
  (void)hipMemsetAsync(p.ws + OFF_BAR, 0, XCD_BAR_WORDS * 4, stream);
  void* args[] = {&p};
  (void)hipLaunchCooperativeKernel((void*)mk_all, dim3(grid_blocks), dim3(256), args, SMEM_BYTES, stream);
#endif
}
```

```cpp
#include <hip/hip_runtime.h>
#include <hip/hip_cooperative_groups.h>
namespace cg = cooperative_groups;

#ifndef MULTI_LAUNCH
#define MULTI_LAUNCH 0
#endif

#define DI __device__ __forceinline__
#define NI __device__ __noinline__
typedef unsigned short u16;
typedef short bf16x8 __attribute__((ext_vector_type(8)));
typedef float f32x16 __attribute__((ext_vector_type(16)));
typedef __bf16 bf2_t __attribute__((ext_vector_type(2)));
typedef unsigned u32x4 __attribute__((ext_vector_type(4)));
#define MFMA32(a, b, c) __builtin_amdgcn_mfma_f32_32x32x16_bf16((a), (b), (c), 0, 0, 0)

constexpr int NB = 4, SEQ = 8192, LCTX = 256, DM = 1024, DFF = 4096;
constexpr int TLAT = NB * SEQ;
constexpr int TALL = TLAT + NB * LCTX;
constexpr int NIN = 2208, NINP = 2304;
constexpr int LKEY = SEQ + LCTX;
constexpr int NCH = 66;
constexpr int SMEM_BYTES = 73728;
#ifndef SUBSEL
#define SUBSEL -1
#endif
#define SUB_ON(k) (SUBSEL < 0 || SUBSEL == (k))

constexpr size_t WL_WIN = 0;
constexpr size_t WL_WOUT = WL_WIN + (size_t)NINP * 1024 * 2;
constexpr size_t WL_W1 = WL_WOUT + (size_t)1024 * 1024 * 2;
constexpr size_t WL_W2 = WL_W1 + (size_t)4096 * 1024 * 2;
constexpr size_t WL_WUQ = WL_W2 + (size_t)1024 * 4096 * 2;
constexpr size_t WL_WUKV = WL_WUQ + (size_t)768 * 256 * 2;
constexpr size_t WL_SIZE = WL_WUKV + (size_t)1024 * 128 * 2;
constexpr size_t OFF_W = 0;
constexpr size_t OFF_MOD = OFF_W + 2 * WL_SIZE;
constexpr size_t OFF_TW = OFF_MOD + (size_t)2 * 5 * 6144 * 4;
constexpr size_t OFF_ROPE = OFF_TW + 65536;
constexpr size_t OFF_XC = OFF_ROPE + 192 * 8 * 8 + 4096;
constexpr size_t OFF_H = OFF_XC + (size_t)1024 * 1024 * 4;
constexpr size_t OFF_H2F = OFF_H + (size_t)TALL * 1024 * 2;
constexpr size_t OFF_H2C = OFF_H2F + (size_t)8192 * 64 * 4;
constexpr size_t OFF_KC = OFF_H2C + (size_t)256 * 64 * 4;
constexpr size_t OFF_BIG = OFF_KC + (size_t)2 * 256 * 512 * 4;
constexpr size_t OFF_UT = OFF_BIG;
constexpr size_t OFF_UTC = OFF_UT + (size_t)NB * 768 * SEQ * 2;
constexpr size_t OFF_RET = OFF_UTC + (size_t)NB * 768 * LCTX * 2;
constexpr size_t OFF_CQ = OFF_RET + (size_t)TALL * 1024 * 2;
constexpr size_t OFF_CKV = OFF_CQ + (size_t)TALL * 256 * 2;
constexpr size_t OFF_Q = OFF_CKV + (size_t)TALL * 128 * 2;
constexpr size_t OFF_KF = OFF_Q + (size_t)TALL * 768 * 2;
constexpr size_t OFF_VT = OFF_KF + (size_t)NB * 8 * LKEY * 96 * 2;
constexpr size_t OFF_ST = OFF_VT + (size_t)NB * 8 * 64 * LKEY * 2;
constexpr size_t OFF_KSPEC = OFF_ST + (size_t)2 * 16 * NCH * 4096 * 4;
constexpr size_t OFF_END = OFF_KSPEC + (size_t)2 * 256 * 2 * 8192 * 8;
constexpr size_t OFF_BAR = OFF_END;
constexpr size_t OFF_ACT = OFF_BIG;
static_assert(OFF_ACT + (size_t)TALL * 4096 * 2 <= OFF_END, "act fits");
static_assert(OFF_END + 16384 <= (size_t)536870912, "workspace");

struct Params {
  const float* in[27];
  float* out;
  char* ws;
};
enum { I_X = 0, I_C, I_CTX, I_CCTX, I_WADA, I_BADA, I_N1G, I_N2G, I_WIN, I_WOUT, I_HCW, I_HCB, I_HW1, I_HB1, I_HSF, I_HW2,
       I_HB2, I_HW3, I_HBIAS, I_RLD, I_QNG, I_WUQ, I_KVNG, I_WUKV, I_W1, I_W2, I_FNG };

DI int tidx() { int t = __builtin_amdgcn_workitem_id_x(); asm volatile("" : "+v"(t)); return t; }
DI u16 f2bf(float x) { return __builtin_bit_cast(u16, (__bf16)x); }
DI float bf2f(u16 v) { return __uint_as_float(((unsigned)v) << 16); }
DI unsigned pack2(float a, float b) { bf2_t v; v[0] = (__bf16)a; v[1] = (__bf16)b; return __builtin_bit_cast(unsigned, v); }
DI float wave_sum(float v) {
#pragma unroll
  for (int o = 32; o > 0; o >>= 1) v += __shfl_xor(v, o);
  return v;
}
DI int crow(int reg, int h) { return (reg & 3) + 8 * (reg >> 2) + 4 * h; }
DI float bfe(u32x4 v, int j) {
  unsigned w = v[j >> 1];
  return __uint_as_float((j & 1) ? (w & 0xffff0000u) : (w << 16));
}
DI u16 bfu(u32x4 v, int j) {
  unsigned w = v[j >> 1];
  return (u16)((j & 1) ? (w >> 16) : (w & 0xffffu));
}
DI float silu_f(float x) { return x / (1.f + __expf(-x)); }
DI void row_info(int row, int& b, int& t, int& key, int& cond) {
  if (row < TLAT) { b = row >> 13; t = row & 8191; key = t; cond = b; }
  else { int rc = row - TLAT; b = rc >> 8; t = rc & 255; key = SEQ + t; cond = 4; }
}
DI int chunk_row0(int b, int ci) { return ci < 2 ? TLAT + b * LCTX + ci * 128 : b * SEQ + (ci - 2) * 128; }
DI float rope_apply(const float2* __restrict__ tab, float val, int jj, int t) {
  float partner = __shfl_xor(val, 8);
  int pos = (jj & 16) ? 128 + (t & 63) : (t >> 6);
  float2 cs = tab[pos * 8 + (jj & 7)];
  return (jj & 8) ? (val * cs.x + partner * cs.y) : (val * cs.x - partner * cs.y);
}

DI void convT_item(const float* __restrict__ src, u16* __restrict__ dst, int K, int N, int Npad, const float* __restrict__ gain,
                   int item, float* tile, bool perm = false) {
  int ntn = Npad >> 6;
  int kt = item / ntn, nt = item - kt * ntn;
  int k0 = kt * 64, n0 = nt * 64;
  int c = tidx() & 63, q = tidx() >> 6;
#pragma unroll 4
  for (int i = 0; i < 16; i++) {
    int kk = i * 4 + q, n = n0 + c;
    float v = 0.f;
    if (n < N) { int sn = perm ? ((n & 511) >> 6) * 128 + (n >> 9) * 64 + (n & 63) : n; v = src[(size_t)(k0 + kk) * N + sn]; if (gain) v *= gain[k0 + kk]; }
    tile[kk * 65 + c] = v;
  }
  __syncthreads();
#pragma unroll 4
  for (int i = 0; i < 16; i++) {
    int nn = i * 4 + q;
    dst[(size_t)(n0 + nn) * K + k0 + c] = f2bf(tile[c * 65 + nn]);
  }
  __syncthreads();
}

DI void phase_s0(const Params& p, char* smem) {
  const int per_layer = 576 + 256 + 1024 + 1024 + 48 + 32;
  const int n_conv = 2 * per_layer, n_mod = 2 * 96, n_tw = 32 + 6, n_cp = 1024;
  const int total = n_conv + n_mod + n_tw + n_cp;
  for (int it = blockIdx.x; it < total; it += gridDim.x) {
    if (it < n_conv) {
      int l = it / per_layer, r = it - l * per_layer;
      char* wl = p.ws + OFF_W + (size_t)l * WL_SIZE;
      float* tile = (float*)smem;
      if (r < 576) convT_item(p.in[I_WIN] + (size_t)l * 1024 * NIN, (u16*)(wl + WL_WIN), 1024, NIN, NINP, nullptr, r, tile);
      else if ((r -= 576) < 256) convT_item(p.in[I_WOUT] + (size_t)l * 1024 * 1024, (u16*)(wl + WL_WOUT), 1024, 1024, 1024, nullptr, r, tile);
      else if ((r -= 256) < 1024) convT_item(p.in[I_W1] + (size_t)l * 1024 * 4096, (u16*)(wl + WL_W1), 1024, 4096, 4096, nullptr, r, tile);
      else if ((r -= 1024) < 1024) convT_item(p.in[I_W2] + (size_t)l * 4096 * 1024, (u16*)(wl + WL_W2), 4096, 1024, 1024, nullptr, r, tile);
      else if ((r -= 1024) < 48) convT_item(p.in[I_WUQ] + (size_t)l * 256 * 768, (u16*)(wl + WL_WUQ), 256, 768, 768, p.in[I_QNG] + l * 256, r, tile);
      else { r -= 48; convT_item(p.in[I_WUKV] + (size_t)l * 128 * 1024, (u16*)(wl + WL_WUKV), 128, 1024, 1024, p.in[I_KVNG] + l * 128, r, tile, true); }
    } else if (it < n_conv + n_mod) {
      int r = it - n_conv;
      int l = r / 96, n0 = (r - l * 96) * 64;
      float* sc = (float*)smem;
      float* red = sc + 5120;
      for (int i = tidx(); i < 5120; i += 256) {
        int rr = i >> 10, k = i & 1023;
        float cv = rr < 4 ? p.in[I_C][rr * 1024 + k] : p.in[I_CCTX][k];
        sc[i] = cv / (1.f + expf(-cv));
      }
      __syncthreads();
      int nn = tidx() & 63, kq = tidx() >> 6;
      float a0 = 0, a1 = 0, a2 = 0, a3 = 0, a4 = 0;
      const float* w = p.in[I_WADA] + ((size_t)l * 1024 + kq * 256) * 6144 + n0 + nn;
#pragma unroll 8
      for (int k = 0; k < 256; k++) {
        float wv = w[(size_t)k * 6144];
        int kk = kq * 256 + k;
        a0 += sc[kk] * wv; a1 += sc[1024 + kk] * wv; a2 += sc[2048 + kk] * wv; a3 += sc[3072 + kk] * wv; a4 += sc[4096 + kk] * wv;
      }
      red[(kq * 5 + 0) * 64 + nn] = a0; red[(kq * 5 + 1) * 64 + nn] = a1; red[(kq * 5 + 2) * 64 + nn] = a2;
      red[(kq * 5 + 3) * 64 + nn] = a3; red[(kq * 5 + 4) * 64 + nn] = a4;
      __syncthreads();
      if (tidx() < 64) {
        float* mod = (float*)(p.ws + OFF_MOD);
        float bb = p.in[I_BADA][l * 6144 + n0 + nn];
        for (int rr = 0; rr < 5; rr++) {
          float s = red[(0 * 5 + rr) * 64 + nn] + red[(1 * 5 + rr) * 64 + nn] + red[(2 * 5 + rr) * 64 + nn] + red[(3 * 5 + rr) * 64 + nn];
          mod[(size_t)(l * 5 + rr) * 6144 + n0 + nn] = s + bb;
        }
      }
      __syncthreads();
    } else if (it >= n_conv + n_mod + n_tw) {
      int e = (it - n_conv - n_mod - n_tw) * 256 + tidx();
      ((float4*)(p.ws + OFF_XC))[e] = ((const float4*)p.in[I_CTX])[e];
    } else {
      int q = it - n_conv - n_mod;
      if (q < 32) {
        int n = q * 256 + tidx();
        float sn, cs;
        sincospif((float)n / 8192.f, &sn, &cs);
        ((float2*)(p.ws + OFF_TW))[n] = make_float2(cs, -sn);
      } else {
        int e = (q - 32) * 256 + tidx();
        int pos = e >> 3, f = e & 7;
        float pv = pos < 128 ? (float)pos : (float)(pos - 128);
        float inv = powf(10000.f, -(float)f / 8.f);
        float sn, cs;
        sincosf(pv * inv, &sn, &cs);
        ((float2*)(p.ws + OFF_ROPE))[e] = make_float2(cs, sn);
      }
    }
  }
}

DI void filt_a_item(const Params& p, int l, int Lf, float* h2out, int pos) {
  int lane = tidx() & 63;
  float tpos = (float)pos / (float)(Lf - 1);
  float zval = 0.f;
  if (lane == 0) zval = tpos;
  else if (lane < 33) {
    int jj = (lane - 1) & 15;
    float band = 1e-4f + (float)jj * ((15.f - 1e-4f) / 15.f);
    float ang = ((float)(6.283185307179586 / (double)Lf)) * (float)pos * band;
    zval = lane < 17 ? cosf(ang) : -sinf(ang);
  }
  const float* w1 = p.in[I_HW1] + l * 33 * 64;
  const float* w2 = p.in[I_HW2] + l * 64 * 64;
  float acc = p.in[I_HB1][l * 64 + lane];
  for (int i = 0; i < 33; i++) acc += __shfl(zval, i) * w1[i * 64 + lane];
  float h1 = sinf(p.in[I_HSF][l * 128 + lane] * acc);
  float acc2 = p.in[I_HB2][l * 64 + lane];
  for (int i = 0; i < 64; i++) acc2 += __shfl(h1, i) * w2[i * 64 + lane];
  h2out[(size_t)pos * 64 + lane] = sinf(p.in[I_HSF][l * 128 + 64 + lane] * acc2);
}

DI void phase_norm(const Params& p, int l, int which, int nrows, bool with_filter) {
  const int lane = tidx() & 63, wid = tidx() >> 6;
  const bool first = (l == 0 && which == 1);
  const int n_norm = nrows >> 3;
  const int n_fa = with_filter ? (8192 / 4 + (l == 0 ? 256 / 4 : 0)) : 0;
  const float* gsrc = p.in[which == 1 ? I_N1G : I_N2G] + l * 1024;
  u16* H = (u16*)(p.ws + OFF_H);
  for (int it = blockIdx.x; it < n_norm + n_fa; it += gridDim.x) {
    if (it < n_norm) {
      int row = it * 8 + wid * 2;
      const float* src;
      int cond;
      if (row < TLAT) { src = (first ? p.in[I_X] : p.out) + (size_t)row * 1024; cond = row >> 13; }
      else { src = (first ? p.in[I_CTX] : (const float*)(p.ws + OFF_XC)) + (size_t)(row - TLAT) * 1024; cond = 4; }
      const float* m = (const float*)(p.ws + OFF_MOD) + (size_t)(l * 5 + cond) * 6144 + (which == 1 ? 0 : 3072);
      float4 v[8];
      float ssq0 = 0.f, ssq1 = 0.f;
#pragma unroll
      for (int i = 0; i < 4; i++) {
        v[i] = *(const float4*)(src + i * 256 + lane * 4);
        v[4 + i] = *(const float4*)(src + 1024 + i * 256 + lane * 4);
      }
#pragma unroll
      for (int i = 0; i < 4; i++) {
        ssq0 += v[i].x * v[i].x + v[i].y * v[i].y + v[i].z * v[i].z + v[i].w * v[i].w;
        ssq1 += v[4 + i].x * v[4 + i].x + v[4 + i].y * v[4 + i].y + v[4 + i].z * v[4 + i].z + v[4 + i].w * v[4 + i].w;
      }
      ssq0 = wave_sum(ssq0); ssq1 = wave_sum(ssq1);
      float rstd0 = rsqrtf(ssq0 * (1.f / 1024.f) + 1e-6f), rstd1 = rsqrtf(ssq1 * (1.f / 1024.f) + 1e-6f);
#pragma unroll
      for (int i = 0; i < 4; i++) {
        int col = i * 256 + lane * 4;
        float4 g = *(const float4*)(gsrc + col), sh = *(const float4*)(m + col), sc = *(const float4*)(m + 1024 + col);
        float gx = g.x * (1.f + sc.x), gy = g.y * (1.f + sc.y), gz = g.z * (1.f + sc.z), gw = g.w * (1.f + sc.w);
        *(uint2*)(H + (size_t)row * 1024 + col) = make_uint2(pack2(v[i].x * rstd0 * gx + sh.x, v[i].y * rstd0 * gy + sh.y),
                                                             pack2(v[i].z * rstd0 * gz + sh.z, v[i].w * rstd0 * gw + sh.w));
        *(uint2*)(H + (size_t)(row + 1) * 1024 + col) = make_uint2(pack2(v[4 + i].x * rstd1 * gx + sh.x, v[4 + i].y * rstd1 * gy + sh.y),
                                                                   pack2(v[4 + i].z * rstd1 * gz + sh.z, v[4 + i].w * rstd1 * gw + sh.w));
      }
    } else {
      int q = it - n_norm;
      if (q < 2048) filt_a_item(p, l, 8192, (float*)(p.ws + OFF_H2F), q * 4 + wid);
      else filt_a_item(p, l, 256, (float*)(p.ws + OFF_H2C), (q - 2048) * 4 + wid);
    }
  }
}

constexpr int GLD = 40;
constexpr int GBUF = (256 + 128) * GLD;
template <bool ROWNORM, bool TR0, bool TR1, int OUT, class Epi, class DF>
DI void gemm_tile(const u16* __restrict__ A, int lda, const u16* __restrict__ Bt, int ldb, int K, int m0, int n0,
                  const u16* __restrict__ at_src, int at_kt, char* smem, Epi epi, DF df) {
  u16* Ls = (u16*)smem;
  float* rs = (float*)(smem + 69632);
  int tid_o = tidx();
  const int tid = tid_o, lane = tid & 63, wid = tid >> 6, wm = wid >> 1, wn = wid & 1, r = lane & 31, h = lane >> 5;
  const bool trans = (TR0 == TR1) ? TR0 : (wn ? TR1 : TR0);
  f32x16 acc[4][2];
#pragma unroll
  for (int mi = 0; mi < 4; mi++)
#pragma unroll
    for (int ni = 0; ni < 2; ni++)
#pragma unroll
      for (int e = 0; e < 16; e++) acc[mi][ni][e] = 0.f;
  u32x4 ra0[4], rb0[2], ra1[4], rb1[2];
  float ssq[4];
#pragma unroll
  for (int i = 0; i < 4; i++) ssq[i] = 0.f;
  const int nk = K >> 5;
  const int lrow = tid >> 2, lkc = tid & 3;
  const int tch = tid & 31, ttc = tid >> 5;
  const bool has_at = at_src != nullptr;
#define GEMM_GLOAD(KT, RA, RB)                                                                                              \
  {                                                                                                                         \
    const int kt_ = (KT);                                                                                                   \
    if (has_at && kt_ < at_kt) {                                                                                            \
      _Pragma("unroll") for (int i = 0; i < 4; i++) RA[i] = *(const u32x4*)(at_src + (size_t)(kt_ * 32 + tch) * 8192 + (ttc + 8 * i) * 8); \
    } else {                                                                                                                \
      _Pragma("unroll") for (int i = 0; i < 4; i++) RA[i] = *(const u32x4*)(A + (size_t)(m0 + lrow + 64 * i) * lda + kt_ * 32 + lkc * 8);  \
    }                                                                                                                       \
    _Pragma("unroll") for (int i = 0; i < 2; i++) RB[i] = *(const u32x4*)(Bt + (size_t)(n0 + lrow + 64 * i) * ldb + kt_ * 32 + lkc * 8);   \
  }
#define GEMM_LWRITE(KT, RA, RB)                                                                                             \
  {                                                                                                                         \
    const int kt_ = (KT);                                                                                                   \
    u16* As_ = Ls + (kt_ & 1) * GBUF;                                                                                       \
    u16* Bs_ = As_ + 256 * GLD;                                                                                             \
    if (has_at && kt_ < at_kt) {                                                                                            \
      _Pragma("unroll") for (int i = 0; i < 4; i++)                                                                         \
        _Pragma("unroll") for (int j = 0; j < 8; j++) As_[((ttc + 8 * i) * 8 + j) * GLD + tch] = bfu(RA[i], j);             \
    } else {                                                                                                                \
      _Pragma("unroll") for (int i = 0; i < 4; i++) *(u32x4*)(As_ + (lrow + 64 * i) * GLD + lkc * 8) = RA[i];               \
    }                                                                                                                       \
    _Pragma("unroll") for (int i = 0; i < 2; i++) *(u32x4*)(Bs_ + (lrow + 64 * i) * GLD + lkc * 8) = RB[i];                 \
    if (ROWNORM) {                                                                                                          \
      _Pragma("unroll") for (int i = 0; i < 4; i++)                                                                         \
        _Pragma("unroll") for (int j = 0; j < 8; j++) { float x = bfe(RA[i], j); ssq[i] += x * x; }                         \
    }                                                                                                                       \
  }
#define GEMM_COMPUTE(KT)                                                                                                    \
  {                                                                                                                         \
    const u16* As = Ls + ((KT) & 1) * GBUF;                                                                                 \
    const u16* Bs = As + 256 * GLD;                                                                                         \
    _Pragma("unroll") for (int ks = 0; ks < 2; ks++) {                                                                      \
      __builtin_amdgcn_sched_barrier(0);                                                                                    \
      bf16x8 a[4], b[2];                                                                                                    \
      _Pragma("unroll") for (int mi = 0; mi < 4; mi++) a[mi] = *(const bf16x8*)(As + (wm * 128 + mi * 32 + r) * GLD + ks * 16 + h * 8); \
      _Pragma("unroll") for (int ni = 0; ni < 2; ni++) b[ni] = *(const bf16x8*)(Bs + (wn * 64 + ni * 32 + r) * GLD + ks * 16 + h * 8);  \
      if (!trans) {                                                                                                         \
        _Pragma("unroll") for (int mi = 0; mi < 4; mi++)                                                                    \
          _Pragma("unroll") for (int ni = 0; ni < 2; ni++) acc[mi][ni] = MFMA32(a[mi], b[ni], acc[mi][ni]);                 \
      } else {                                                                                                              \
        _Pragma("unroll") for (int mi = 0; mi < 4; mi++)                                                                    \
          _Pragma("unroll") for (int ni = 0; ni < 2; ni++) acc[mi][ni] = MFMA32(b[ni], a[mi], acc[mi][ni]);                 \
      }                                                                                                                     \
    }                                                                                                                       \
  }
  GEMM_GLOAD(0, ra0, rb0)
  GEMM_GLOAD(1, ra1, rb1)
  GEMM_LWRITE(0, ra0, rb0)
  __syncthreads();
  for (int kt = 0; kt < nk; kt += 2) {
    GEMM_LWRITE(kt + 1, ra1, rb1)
    if (kt + 2 < nk) { GEMM_GLOAD(kt + 2, ra0, rb0) GEMM_GLOAD(kt + 3, ra1, rb1) }
    GEMM_COMPUTE(kt)
    __syncthreads();
    if (kt + 2 < nk) GEMM_LWRITE(kt + 2, ra0, rb0)
    GEMM_COMPUTE(kt + 1)
    __syncthreads();
  }
#undef GEMM_COMPUTE
#undef GEMM_GLOAD
#undef GEMM_LWRITE
  if (ROWNORM) {
    float* rsp = (float*)smem;
    {
      const int t2 = tidx();
#pragma unroll
      for (int i = 0; i < 4; i++) rsp[((t2 >> 2) + 64 * i) * 4 + (t2 & 3)] = ssq[i];
    }
    __syncthreads();
    {
      const int t3 = tidx();
      float4 q = *(const float4*)(rsp + t3 * 4);
      rs[t3] = rsqrtf((q.x + q.y + q.z + q.w) / (float)K + 1e-6f);
    }
    __syncthreads();
  }
  if constexpr (OUT == 0) {
#define EPI_CALL(mi, ni) epi(m0 + wm * 128 + (mi) * 32, n0 + wn * 64 + (ni) * 32, acc[mi][ni], rs);
    EPI_CALL(0, 0) EPI_CALL(0, 1) EPI_CALL(1, 0) EPI_CALL(1, 1) EPI_CALL(2, 0) EPI_CALL(2, 1) EPI_CALL(3, 0) EPI_CALL(3, 1)
#undef EPI_CALL
    __syncthreads();
  } else if constexpr (OUT == 1) {
    u16* S = (u16*)smem;
#define EPI_STAGE(mi, ni)                                                                                                   \
    _Pragma("unroll") for (int reg = 0; reg < 16; reg++) {                                                                   \
      int lr = wm * 128 + (mi) * 32 + crow(reg, h), lc = wn * 64 + (ni) * 32 + r;                                           \
      S[lr * 136 + lc] = f2bf(epi(m0 + lr, n0 + lc, acc[mi][ni][reg], rs));                                                 \
    }
    EPI_STAGE(0, 0) EPI_STAGE(0, 1) EPI_STAGE(1, 0) EPI_STAGE(1, 1) EPI_STAGE(2, 0) EPI_STAGE(2, 1) EPI_STAGE(3, 0) EPI_STAGE(3, 1)
#undef EPI_STAGE
    __syncthreads();
    {
      const int t2 = tidx();
#pragma unroll 4
      for (int i = 0; i < 16; i++) {
        int id = t2 + 256 * i, lr = id >> 4, c = id & 15;
        u16* d = df(m0 + lr, n0 + c * 8);
        if (d) *(u32x4*)d = *(const u32x4*)(S + lr * 136 + c * 8);
      }
    }
    __syncthreads();
  } else if constexpr (OUT == 2) {
    u16* S = (u16*)smem;
#define EPI_STAGE(mi, ni)                                                                                                   \
    _Pragma("unroll") for (int reg = 0; reg < 16; reg++) {                                                                   \
      int lr = wm * 128 + (mi) * 32 + r, lc = wn * 64 + (ni) * 32 + crow(reg, h);                                           \
      S[lc * 264 + lr] = f2bf(epi(m0 + lr, n0 + lc, acc[mi][ni][reg], rs));                                                 \
    }
    EPI_STAGE(0, 0) EPI_STAGE(0, 1) EPI_STAGE(1, 0) EPI_STAGE(1, 1) EPI_STAGE(2, 0) EPI_STAGE(2, 1) EPI_STAGE(3, 0) EPI_STAGE(3, 1)
#undef EPI_STAGE
    __syncthreads();
    {
      const int t2 = tidx();
#pragma unroll 4
      for (int i = 0; i < 16; i++) {
        int id = t2 + 256 * i, lc = id >> 5, t8 = id & 31;
        u16* d = df(m0 + t8 * 8, n0 + lc);
        if (d) *(u32x4*)d = *(const u32x4*)(S + lc * 264 + t8 * 8);
      }
    }
    __syncthreads();
  } else {
    float* S = (float*)smem;
#pragma unroll
    for (int pass = 0; pass < 2; pass++) {
      if (wm == pass) {
#define EPI_STAGE(mi, ni)                                                                                                   \
        _Pragma("unroll") for (int reg = 0; reg < 16; reg++) S[((mi) * 32 + crow(reg, h)) * 132 + wn * 64 + (ni) * 32 + r] = acc[mi][ni][reg];
        EPI_STAGE(0, 0) EPI_STAGE(0, 1) EPI_STAGE(1, 0) EPI_STAGE(1, 1) EPI_STAGE(2, 0) EPI_STAGE(2, 1) EPI_STAGE(3, 0) EPI_STAGE(3, 1)
#undef EPI_STAGE
      }
      __syncthreads();
      {
        const int t2 = tidx();
#pragma unroll 4
        for (int i = 0; i < 16; i++) {
          int id = t2 + 256 * i, lr = id >> 5, c4 = id & 31;
          float4 a = *(const float4*)(S + lr * 132 + c4 * 4);
          df(m0 + pass * 128 + lr, n0 + c4 * 4, a);
        }
      }
      __syncthreads();
    }
  }
}

DI void phase_win(const Params& p, int l, char* smem) {
  const u16* H = (const u16*)(p.ws + OFF_H);
  const u16* W = (const u16*)(p.ws + OFF_W + (size_t)l * WL_SIZE + WL_WIN);
  u16* UT = (u16*)(p.ws + OFF_UT);
  u16* UTC = (u16*)(p.ws + OFF_UTC);
  u16* RET = (u16*)(p.ws + OFF_RET);
  u16* CQ = (u16*)(p.ws + OFF_CQ);
  u16* CKV = (u16*)(p.ws + OFF_CKV);
  u16* KF = (u16*)(p.ws + OFF_KF);
  const int lane = tidx() & 63, r = lane & 31, h = lane >> 5;
  const int total = 132 * 18;
  for (int it = blockIdx.x; it < total; it += gridDim.x) {
    int mt = it / 18, nt = it - mt * 18;
    int m0 = mt * 256, n0 = nt * 128;
    if (nt < 6) {
      gemm_tile<false, true, true, 2>(H, 1024, W, 1024, 1024, m0, n0, nullptr, 0, smem,
        [&](int row, int col, float v, const float*) __attribute__((always_inline)) { return v; },
        [&](int row, int col) __attribute__((always_inline)) -> u16* {
          int b, t, key, cond;
          row_info(row, b, t, key, cond);
          return row < TLAT ? UT + ((size_t)(b * 768 + col)) * SEQ + t : UTC + ((size_t)(b * 768 + col)) * LCTX + t;
        });
    } else {
      if (nt < 17) {
        gemm_tile<false, false, false, 1>(H, 1024, W, 1024, 1024, m0, n0, nullptr, 0, smem,
          [&](int row, int col, float v, const float*) __attribute__((always_inline)) {
            return (col >= 768 + 256 && col < 768 + 512) ? v * 0.125f : v;
          },
          [&](int row, int col) __attribute__((always_inline)) -> u16* {
            if (nt < 14) return RET + (size_t)row * 1024 + (col - 768);
            if (nt < 16) return CQ + (size_t)row * 256 + (col - 1792);
            return CKV + (size_t)row * 128 + (col - 2048);
          });
      } else {
        gemm_tile<false, false, false, 0>(H, 1024, W, 1024, 1024, m0, n0, nullptr, 0, smem,
          [&](int bm, int bn, const f32x16& acc, const float*) __attribute__((always_inline)) {
            const int lz_ = tidx() & 63, r = lz_ & 31, h = lz_ >> 5;
            if (bn == 2176) {
#pragma unroll
              for (int reg = 0; reg < 16; reg++) {
                int row = bm + crow(reg, h), b, t, key, cond;
                row_info(row, b, t, key, cond);
                float v = acc[reg];
                float vr = rope_apply((const float2*)(p.ws + OFF_ROPE), v, r, t);
                if (row < TLAT) v = vr;
                u16 o = f2bf(v);
#pragma unroll
                for (int hh = 0; hh < 8; hh++) KF[((size_t)(b * 8 + hh) * LKEY + key) * 96 + 64 + r] = o;
              }
            }
          }, [](int, int) __attribute__((always_inline)) -> u16* { return nullptr; });
      }
    }
  }
}

DI void ret_gammas(const Params& p, int l, int hh, float& lgf, float& lgb) {
  lgf = log1pf(-expf(p.in[I_RLD][l * 8 + hh]));
  lgb = log1pf(-expf(p.in[I_RLD][l * 8 + 4 + hh]));
}
DI void ret_kv_item(const Params& p, int l, int b, int hh, int ci, char* smem) {
  const u16* RET = (const u16*)(p.ws + OFF_RET);
  float* ST = (float*)(p.ws + OFF_ST);
  u16* KfT = (u16*)smem;
  u16* KbT = KfT + 64 * 136;
  u16* VsT = KbT + 64 * 136;
  int tid_o = tidx();
  asm volatile("" : "+v"(tid_o));
  const int tid = tid_o, lane = tid & 63, wid = tid >> 6, r = lane & 31, h = lane >> 5;
  float lgf, lgb;
  ret_gammas(p, l, hh, lgf, lgb);
  const int row0 = chunk_row0(b, ci);
#pragma unroll
  for (int i = 0; i < 4; i++) {
    int id = tid + 256 * i, m = id >> 3, dc = id & 7;
    u32x4 kv = *(const u32x4*)(RET + (size_t)(row0 + m) * 1024 + 256 + hh * 64 + dc * 8);
    u32x4 vv = *(const u32x4*)(RET + (size_t)(row0 + m) * 1024 + 512 + hh * 64 + dc * 8);
    float zf = __expf(lgf * (float)(127 - m)), zb = __expf(lgb * (float)m);
#pragma unroll
    for (int j = 0; j < 8; j++) {
      float kval = bfe(kv, j);
      KfT[(dc * 8 + j) * 136 + m] = f2bf(kval * zf);
      KbT[(dc * 8 + j) * 136 + m] = f2bf(kval * zb);
      VsT[(dc * 8 + j) * 136 + m] = bfu(vv, j);
    }
  }
  __syncthreads();
  const int dir = wid >> 1, dh = wid & 1;
  const u16* Asrc = dir ? KbT : KfT;
  f32x16 c0, c1;
#pragma unroll
  for (int e = 0; e < 16; e++) { c0[e] = 0.f; c1[e] = 0.f; }
#pragma unroll
  for (int ks = 0; ks < 8; ks++) {
    bf16x8 a = *(const bf16x8*)(Asrc + (dh * 32 + r) * 136 + ks * 16 + h * 8);
    bf16x8 b0 = *(const bf16x8*)(VsT + (r) * 136 + ks * 16 + h * 8);
    bf16x8 b1 = *(const bf16x8*)(VsT + (32 + r) * 136 + ks * 16 + h * 8);
    c0 = MFMA32(a, b0, c0);
    c1 = MFMA32(a, b1, c1);
  }
  float* dst = ST + ((size_t)((dir * 4 + b) * 4 + hh) * NCH + ci) * 4096;
#pragma unroll
  for (int reg = 0; reg < 16; reg++) {
    int d = dh * 32 + crow(reg, h);
    dst[d * 64 + r] = c0[reg];
    dst[d * 64 + 32 + r] = c1[reg];
  }
  __syncthreads();
}

#define PX(i) ((i) + ((i) >> 4))
typedef float cf2 __attribute__((ext_vector_type(2)));
DI cf2 mk2(float x, float y) { cf2 r; r.x = x; r.y = y; return r; }
DI cf2 cmul(cf2 a, cf2 b) { return mk2(a.x * b.x - a.y * b.y, a.x * b.y + a.y * b.x); }
DI cf2 cmulc(cf2 a, cf2 b) { return mk2(a.x * b.x + a.y * b.y, a.y * b.x - a.x * b.y); }
DI cf2 cadd(cf2 a, cf2 b) { return mk2(a.x + b.x, a.y + b.y); }
DI cf2 csub(cf2 a, cf2 b) { return mk2(a.x - b.x, a.y - b.y); }
DI cf2 twid_rev(float rev) { return mk2(__builtin_amdgcn_cosf(rev), -__builtin_amdgcn_sinf(rev)); }

template <int S, bool INV>
DI void fft_pass8(float2* Xf2, int tid) {
  cf2* X = (cf2*)Xf2;
  constexpr int span = 8192 >> S, q = span >> 3, lq = 10 - S;
  const float R = 0.70710678118654752f;
#pragma unroll 2
  for (int gi = 0; gi < 4; gi++) {
    int g = tid + 256 * gi;
    int j = g & (q - 1), blk = g >> lq, base = blk * span + j;
    cf2 v[8];
#pragma unroll
    for (int k = 0; k < 8; k++) v[k] = X[PX(base + k * q)];
    cf2 W = twid_rev((float)j * (1.f / (float)span));
    cf2 W2 = cmul(W, W), W4 = cmul(W2, W2);
    cf2 w1 = cmul(W, mk2(R, -R)), w2 = mk2(W.y, -W.x), w3 = cmul(W, mk2(-R, -R));
    cf2 w2b = mk2(W2.y, -W2.x);
    if (!INV) {
      { cf2 a, d;
        a = v[0]; d = csub(a, v[4]); v[0] = cadd(a, v[4]); v[4] = cmul(d, W);
        a = v[1]; d = csub(a, v[5]); v[1] = cadd(a, v[5]); v[5] = cmul(d, w1);
        a = v[2]; d = csub(a, v[6]); v[2] = cadd(a, v[6]); v[6] = cmul(d, w2);
        a = v[3]; d = csub(a, v[7]); v[3] = cadd(a, v[7]); v[7] = cmul(d, w3); }
#pragma unroll
      for (int b4 = 0; b4 < 8; b4 += 4) { cf2 a, d;
        a = v[b4]; d = csub(a, v[b4 + 2]); v[b4] = cadd(a, v[b4 + 2]); v[b4 + 2] = cmul(d, W2);
        a = v[b4 + 1]; d = csub(a, v[b4 + 3]); v[b4 + 1] = cadd(a, v[b4 + 3]); v[b4 + 3] = cmul(d, w2b); }
#pragma unroll
      for (int k = 0; k < 8; k += 2) { cf2 a = v[k], d = csub(a, v[k + 1]); v[k] = cadd(a, v[k + 1]); v[k + 1] = cmul(d, W4); }
    } else {
#pragma unroll
      for (int k = 0; k < 8; k += 2) { cf2 a = v[k], bb = cmulc(v[k + 1], W4); v[k] = cadd(a, bb); v[k + 1] = csub(a, bb); }
#pragma unroll
      for (int b4 = 0; b4 < 8; b4 += 4) { cf2 a, bb;
        a = v[b4]; bb = cmulc(v[b4 + 2], W2); v[b4] = cadd(a, bb); v[b4 + 2] = csub(a, bb);
        a = v[b4 + 1]; bb = cmulc(v[b4 + 3], w2b); v[b4 + 1] = cadd(a, bb); v[b4 + 3] = csub(a, bb); }
      { cf2 a, bb;
        a = v[0]; bb = cmulc(v[4], W); v[0] = cadd(a, bb); v[4] = csub(a, bb);
        a = v[1]; bb = cmulc(v[5], w1); v[1] = cadd(a, bb); v[5] = csub(a, bb);
        a = v[2]; bb = cmulc(v[6], w2); v[2] = cadd(a, bb); v[6] = csub(a, bb);
        a = v[3]; bb = cmulc(v[7], w3); v[3] = cadd(a, bb); v[7] = csub(a, bb); }
    }
#pragma unroll
    for (int k = 0; k < 8; k++) X[PX(base + k * q)] = v[k];
  }
  __syncthreads();
}

DI cf2 t16f(int k) {
  const float C1 = 0.92387953251128674f, S1 = 0.38268343236508977f, R = 0.70710678118654752f;
  return k == 0 ? mk2(1.f, 0.f) : k == 1 ? mk2(C1, -S1) : k == 2 ? mk2(R, -R) : k == 3 ? mk2(S1, -C1) : k == 4 ? mk2(0.f, -1.f)
       : k == 5 ? mk2(-S1, -C1) : k == 6 ? mk2(-R, -R) : mk2(-C1, -S1);
}
template <bool INV>
DI void fft_pass16(float2* Xf2, int tid) {
  cf2* X = (cf2*)Xf2;
#pragma unroll 1
  for (int gi = 0; gi < 2; gi++) {
    int g = tid + 256 * gi;
    cf2* xp = X + 17 * g;
    cf2 v[16];
#pragma unroll
    for (int k = 0; k < 16; k++) v[k] = xp[k];
    if (!INV) {
#pragma unroll
      for (int k = 0; k < 8; k++) { cf2 a = v[k], d = csub(a, v[k + 8]); v[k] = cadd(a, v[k + 8]); v[k + 8] = cmul(d, t16f(k)); }
#pragma unroll
      for (int b8 = 0; b8 < 16; b8 += 8)
#pragma unroll
        for (int k = 0; k < 4; k++) { cf2 a = v[b8 + k], d = csub(a, v[b8 + k + 4]); v[b8 + k] = cadd(a, v[b8 + k + 4]); v[b8 + k + 4] = cmul(d, t16f(2 * k)); }
#pragma unroll
      for (int b4 = 0; b4 < 16; b4 += 4)
#pragma unroll
        for (int k = 0; k < 2; k++) { cf2 a = v[b4 + k], d = csub(a, v[b4 + k + 2]); v[b4 + k] = cadd(a, v[b4 + k + 2]); v[b4 + k + 2] = cmul(d, t16f(4 * k)); }
#pragma unroll
      for (int k = 0; k < 16; k += 2) { cf2 a = v[k], bb = v[k + 1]; v[k] = cadd(a, bb); v[k + 1] = csub(a, bb); }
    } else {
#pragma unroll
      for (int k = 0; k < 16; k += 2) { cf2 a = v[k], bb = v[k + 1]; v[k] = cadd(a, bb); v[k + 1] = csub(a, bb); }
#pragma unroll
      for (int b4 = 0; b4 < 16; b4 += 4)
#pragma unroll
        for (int k = 0; k < 2; k++) { cf2 a = v[b4 + k], bb = cmulc(v[b4 + k + 2], t16f(4 * k)); v[b4 + k] = cadd(a, bb); v[b4 + k + 2] = csub(a, bb); }
#pragma unroll
      for (int b8 = 0; b8 < 16; b8 += 8)
#pragma unroll
        for (int k = 0; k < 4; k++) { cf2 a = v[b8 + k], bb = cmulc(v[b8 + k + 4], t16f(2 * k)); v[b8 + k] = cadd(a, bb); v[b8 + k + 4] = csub(a, bb); }
#pragma unroll
      for (int k = 0; k < 8; k++) { cf2 a = v[k], bb = cmulc(v[k + 8], t16f(k)); v[k] = cadd(a, bb); v[k + 8] = csub(a, bb); }
    }
#pragma unroll
    for (int k = 0; k < 16; k++) xp[k] = v[k];
  }
  __syncthreads();
}
DI void fft_dif(float2* X, const float2* __restrict__, int tid) {
  fft_pass8<0, false>(X, tid); fft_pass8<3, false>(X, tid); fft_pass8<6, false>(X, tid); fft_pass16<false>(X, tid);
}
DI void fft_dit(float2* X, const float2* __restrict__, int tid) {
  fft_pass16<true>(X, tid); fft_pass8<6, true>(X, tid); fft_pass8<3, true>(X, tid); fft_pass8<0, true>(X, tid);
}

DI void filt_fft_item(const Params& p, int l, int o, int c, char* smem) {
  float2* X = (float2*)smem;
  float* Xf = (float*)smem;
  float* w3s = (float*)(smem + 69632);
  float* red = w3s + 128;
  const float2* TW = (const float2*)(p.ws + OFF_TW);
  const float* H2 = (const float*)(p.ws + OFF_H2F);
  float2* KS = (float2*)(p.ws + OFF_KSPEC) + (size_t)(o * 256 + c) * 2 * 8192;
  int tid_o = tidx();
  asm volatile("" : "+v"(tid_o));
  const int tid = tid_o;
  if (tid < 128) { int j = tid & 63, side = tid >> 6; w3s[tid] = p.in[I_HW3][((size_t)l * 64 + j) * 1024 + side * 512 + o * 256 + c]; }
  __syncthreads();
  const float min_decay = -3.0701134573253944f, max_decay = -15.350567286626972f;
  const float delta = fabsf(min_decay + (float)c * ((max_decay - min_decay) / 255.f));
  float* Ff = Xf;
  float* Fb = Xf + 8192;
#pragma unroll 1
  for (int i = 0; i < 32; i++) {
    int n = tid + 256 * i;
    const float4* hp = (const float4*)(H2 + (size_t)n * 64);
    float f = 0.f, bsum = 0.f;
#pragma unroll
    for (int q = 0; q < 16; q++) {
      float4 hv = hp[q];
      f += hv.x * w3s[q * 4] + hv.y * w3s[q * 4 + 1] + hv.z * w3s[q * 4 + 2] + hv.w * w3s[q * 4 + 3];
      bsum += hv.x * w3s[64 + q * 4] + hv.y * w3s[64 + q * 4 + 1] + hv.z * w3s[64 + q * 4 + 2] + hv.w * w3s[64 + q * 4 + 3];
    }
    float win = expf(-((float)n / 8191.f) * delta);
    Ff[n] = f * win; Fb[n] = bsum * win;
  }
  __syncthreads();
  float part = 0.f;
#pragma unroll 2
  for (int i = 0; i < 32; i++) {
    int n = tid + 256 * i;
    float k1 = Ff[n], k2 = 0.f;
    if (n == 0) k1 += Fb[0]; else k2 = Fb[8192 - n];
    part += fabsf(k1) + fabsf(k2);
    KS[8192 + n] = make_float2(k1, k2);
  }
  part = wave_sum(part);
  if ((tid & 63) == 0) red[tid >> 6] = part;
  __syncthreads();
  const float inv = 1.f / (red[0] + red[1] + red[2] + red[3]);
#pragma unroll 2
  for (int i = 0; i < 32; i++) { int n = tidx() + 256 * i; float2 kp = KS[8192 + n]; X[PX(n)] = make_float2((kp.x + kp.y) * inv, 0.f); }
  __syncthreads();
  fft_dif(X, TW, tid);
#pragma unroll 2
  for (int i = 0; i < 32; i++) { int n = tidx() + 256 * i; KS[n] = X[PX(n)]; }
  __syncthreads();
#pragma unroll 2
  for (int i = 0; i < 32; i++) { int n = tidx() + 256 * i; float2 w = TW[n]; float2 kp = KS[8192 + n]; float d = (kp.x - kp.y) * inv; X[PX(n)] = make_float2(d * w.x, d * w.y); }
  __syncthreads();
  fft_dif(X, TW, tid);
#pragma unroll 2
  for (int i = 0; i < 32; i++) { int n = tidx() + 256 * i; KS[8192 + n] = X[PX(n)]; }
  __syncthreads();
}

DI void filt_ctx_item(const Params& p, int l, int o, int c, char* smem) {
  float* red = (float*)smem;
  const float* H2 = (const float*)(p.ws + OFF_H2C);
  float* KC = (float*)(p.ws + OFF_KC) + (size_t)(o * 256 + c) * 512;
  int tid_o = tidx();
  asm volatile("" : "+v"(tid_o));
  const int n = tid_o;
  const float min_decay = -3.0701134573253944f, max_decay = -15.350567286626972f;
  const float delta = fabsf(min_decay + (float)c * ((max_decay - min_decay) / 255.f));
  float f = 0.f, bsum = 0.f;
  for (int j = 0; j < 64; j++) {
    float hv = H2[n * 64 + j];
    f += hv * p.in[I_HW3][((size_t)l * 64 + j) * 1024 + o * 256 + c];
    bsum += hv * p.in[I_HW3][((size_t)l * 64 + j) * 1024 + 512 + o * 256 + c];
  }
  float win = expf(-((float)n / 255.f) * delta);
  f *= win; bsum *= win;
  float part = n == 0 ? fabsf(f + bsum) : fabsf(f) + fabsf(bsum);
  part = wave_sum(part);
  __syncthreads();
  if ((n & 63) == 0) red[n >> 6] = part;
  __syncthreads();
  float inv = 1.f / (red[0] + red[1] + red[2] + red[3]);
  if (n == 0) { KC[256] = (f + bsum) * inv; KC[0] = 0.f; }
  else { KC[256 + n] = f * inv; KC[256 - n] = bsum * inv; }
  __syncthreads();
}

DI void phase_p3(const Params& p, int l, char* smem) {
  const int lane = tidx() & 63, r = lane & 31, h = lane >> 5;
  const int n_uq = (l == 0 ? 132 : 128) * 6, n_ukv = 132 * 8, n_r1 = 16 * NCH, n_ff = 512, n_fc = (l == 0 ? 512 : 0);
  const int total = n_uq + n_ukv + n_r1 + n_ff + n_fc;
  const char* wl = p.ws + OFF_W + (size_t)l * WL_SIZE;
  u16* Q = (u16*)(p.ws + OFF_Q);
  u16* KF = (u16*)(p.ws + OFF_KF);
  u16* VT = (u16*)(p.ws + OFF_VT);
  for (int it = blockIdx.x; it < total; it += gridDim.x) {
    int q = it;
    if (q < n_uq) {
      int mt = q / 6, nt = q - mt * 6;
      if (SUB_ON(0)) gemm_tile<true, false, false, 1>((const u16*)(p.ws + OFF_CQ), 256, (const u16*)(wl + WL_WUQ), 256, 256, mt * 256, nt * 128, nullptr, 0, smem,
        [&](int row, int col, float v, const float* rs) __attribute__((always_inline)) {
          const float qscale = 0.10206207261596577f * 1.4426950408889634f;
          v *= rs[row - mt * 256];
          if ((col % 96) >= 64) {
            int b, t, key, cond;
            row_info(row, b, t, key, cond);
            float vr = rope_apply((const float2*)(p.ws + OFF_ROPE), v, col & 31, t);
            if (row < TLAT) v = vr;
          }
          return v * qscale;
        },
        [&](int row, int col) __attribute__((always_inline)) -> u16* { return Q + (size_t)row * 768 + col; });
    } else if ((q -= n_uq) < n_ukv) {
      int mt = q >> 3, nt = q & 7;
      if (nt < 4) {
        if (SUB_ON(1)) gemm_tile<true, false, false, 1>((const u16*)(p.ws + OFF_CKV), 128, (const u16*)(wl + WL_WUKV), 128, 128, mt * 256, nt * 128, nullptr, 0, smem,
          [&](int row, int col, float v, const float* rs) __attribute__((always_inline)) { return v * rs[row - mt * 256]; },
          [&](int row, int col) __attribute__((always_inline)) -> u16* {
            int b, t, key, cond;
            row_info(row, b, t, key, cond);
            return KF + ((size_t)(b * 8 + (col >> 6)) * LKEY + key) * 96 + (col & 63);
          });
      } else {
        if (SUB_ON(1)) gemm_tile<true, true, true, 2>((const u16*)(p.ws + OFF_CKV), 128, (const u16*)(wl + WL_WUKV), 128, 128, mt * 256, nt * 128, nullptr, 0, smem,
          [&](int row, int col, float v, const float* rs) __attribute__((always_inline)) { return v * rs[row - mt * 256]; },
          [&](int row, int col) __attribute__((always_inline)) -> u16* {
            int b, t, key, cond;
            row_info(row, b, t, key, cond);
            return VT + ((size_t)(b * 8 + ((col - 512) >> 6)) * 64 + ((col - 512) & 63)) * LKEY + key;
          });
      }
    } else if ((q -= n_ukv) < n_r1) {
      int bh = q / NCH, ci = q - bh * NCH;
      if (SUB_ON(2)) ret_kv_item(p, l, bh >> 2, bh & 3, ci, smem);
    } else if ((q -= n_r1) < n_ff) {
      if (SUB_ON(3)) filt_fft_item(p, l, q >> 8, q & 255, smem);
    } else {
      q -= n_ff;
      if (SUB_ON(4)) filt_ctx_item(p, l, q >> 8, q & 255, smem);
    }
  }
}

DI void phase_scan(const Params& p, int l) {
  float* ST = (float*)(p.ws + OFF_ST);
  for (int idx = blockIdx.x * 256 + tidx(); idx < 2 * 16 * 4096; idx += gridDim.x * 256) {
    int dir = idx >> 16, bh = (idx >> 12) & 15, el = idx & 4095, hh = bh & 3;
    float* base = ST + (size_t)((dir * 16 + bh) * NCH) * 4096 + el;
    float lg = log1pf(-expf(p.in[I_RLD][l * 8 + dir * 4 + hh]));
    float gC = expf(lg * 128.f);
    float s = 0.f;
    if (dir == 0) {
      for (int ci = 0; ci < NCH; ci++) { float tmp = base[(size_t)ci * 4096]; base[(size_t)ci * 4096] = s; s = gC * s + tmp; }
    } else {
      for (int ci = 1; ci >= 0; ci--) { float tmp = base[(size_t)ci * 4096]; base[(size_t)ci * 4096] = s; s = gC * s + tmp; }
      for (int ci = NCH - 1; ci >= 2; ci--) { float tmp = base[(size_t)ci * 4096]; base[(size_t)ci * 4096] = s; s = gC * s + tmp; }
    }
  }
}

DI void attn_item(const Params& p, int b, int hh, int qrow0, int key0, int nkeys, char* smem) {
  u16* Ks = (u16*)smem;
  u16* Vs = Ks + 64 * 104;
  const u16* Q = (const u16*)(p.ws + OFF_Q);
  const u16* KF = (const u16*)(p.ws + OFF_KF);
  const u16* VT = (const u16*)(p.ws + OFF_VT);
  u16* MIX = (u16*)(p.ws + OFF_H);
  int tid_o = tidx();
  asm volatile("" : "+v"(tid_o));
  const int tid = tid_o, lane = tid & 63, wid = tid >> 6, r = lane & 31, h = lane >> 5;
  const int qrow = qrow0 + wid * 32 + r;
  bf16x8 qf[6];
#pragma unroll
  for (int ks = 0; ks < 6; ks++) qf[ks] = *(const bf16x8*)(Q + (size_t)qrow * 768 + hh * 96 + ks * 16 + h * 8);
  f32x16 o0, o1;
#pragma unroll
  for (int e = 0; e < 16; e++) { o0[e] = 0.f; o1[e] = 0.f; }
  float m = 0.f, lsum = 0.f;
  const u32x4* kbase = (const u32x4*)(KF + ((size_t)(b * 8 + hh) * LKEY + key0) * 96);
  const u16* vbase = VT + (size_t)(b * 8 + hh) * 64 * LKEY + key0;
  u32x4 rk[3], rv[2];
  const int nt = nkeys >> 6;
#define ATT_GLOAD(T)                                                                                                        \
  {                                                                                                                         \
    const int t_ = (T);                                                                                                     \
    _Pragma("unroll") for (int i = 0; i < 3; i++) rk[i] = kbase[(size_t)t_ * 768 + tid + 256 * i];                          \
    _Pragma("unroll") for (int i = 0; i < 2; i++) { int id = tid + 256 * i; rv[i] = *(const u32x4*)(vbase + (size_t)(id >> 3) * LKEY + t_ * 64 + (id & 7) * 8); } \
  }
#define ATT_LWRITE(T)                                                                                                       \
  {                                                                                                                         \
    u16* Kd = Ks + ((T) & 1) * (64 * 104 + 64 * 72);                                                                        \
    u16* Vd = Kd + 64 * 104;                                                                                                \
    _Pragma("unroll") for (int i = 0; i < 3; i++) { int id = tid + 256 * i; int kr = id / 12, c = id - kr * 12; *(u32x4*)(Kd + kr * 104 + c * 8) = rk[i]; } \
    _Pragma("unroll") for (int i = 0; i < 2; i++) { int id = tid + 256 * i; *(u32x4*)(Vd + (id >> 3) * 72 + (id & 7) * 8) = rv[i]; } \
  }
  ATT_GLOAD(0)
  ATT_LWRITE(0)
  if (nt > 1) ATT_GLOAD(1)
  __syncthreads();
  for (int t = 0; t < nt; t++) {
    if (t + 1 < nt) {
      ATT_LWRITE(t + 1)
      if (t + 2 < nt) ATT_GLOAD(t + 2)
    }
    __builtin_amdgcn_sched_barrier(0);
    const u16* Kc = Ks + (t & 1) * (64 * 104 + 64 * 72);
    const u16* Vc = Kc + 64 * 104;
    f32x16 s0, s1;
#pragma unroll
    for (int e = 0; e < 16; e++) { s0[e] = 0.f; s1[e] = 0.f; }
#pragma unroll
    for (int ks = 0; ks < 6; ks++) {
      bf16x8 k0 = *(const bf16x8*)(Kc + (r) * 104 + ks * 16 + h * 8);
      bf16x8 k1 = *(const bf16x8*)(Kc + (32 + r) * 104 + ks * 16 + h * 8);
      s0 = MFMA32(k0, qf[ks], s0);
      s1 = MFMA32(k1, qf[ks], s1);
    }
    float mx = s0[0];
#pragma unroll
    for (int e = 0; e < 16; e++) { mx = fmaxf(mx, s0[e]); mx = fmaxf(mx, s1[e]); }
    mx = fmaxf(mx, __shfl_xor(mx, 32));
    float d = (t == 0 || mx - m > 8.f) ? (mx - m) : 0.f;
    if (__any(d != 0.f)) {
      float alpha = __builtin_amdgcn_exp2f(-d);
      lsum *= alpha;
#pragma unroll
      for (int e = 0; e < 16; e++) { o0[e] *= alpha; o1[e] *= alpha; }
      m += d;
    }
    float ps = 0.f;
#pragma unroll
    for (int e = 0; e < 16; e++) {
      s0[e] = __builtin_amdgcn_exp2f(s0[e] - m); ps += s0[e];
      s1[e] = __builtin_amdgcn_exp2f(s1[e] - m); ps += s1[e];
    }
    lsum += ps;
#pragma unroll
    for (int kt2 = 0; kt2 < 2; kt2++) {
#pragma unroll
      for (int sx = 0; sx < 2; sx++) {
        u32x4 pw;
        if (kt2 == 0) {
          pw.x = pack2(s0[8 * sx + 0], s0[8 * sx + 1]); pw.y = pack2(s0[8 * sx + 2], s0[8 * sx + 3]);
          pw.z = pack2(s0[8 * sx + 4], s0[8 * sx + 5]); pw.w = pack2(s0[8 * sx + 6], s0[8 * sx + 7]);
        } else {
          pw.x = pack2(s1[8 * sx + 0], s1[8 * sx + 1]); pw.y = pack2(s1[8 * sx + 2], s1[8 * sx + 3]);
          pw.z = pack2(s1[8 * sx + 4], s1[8 * sx + 5]); pw.w = pack2(s1[8 * sx + 6], s1[8 * sx + 7]);
        }
        bf16x8 pb = __builtin_bit_cast(bf16x8, pw);
        int kb = kt2 * 32 + 16 * sx + 4 * h;
        {
          const u16* vp = Vc + (r) * 72 + kb;
          uint2 lo = *(const uint2*)vp, hi = *(const uint2*)(vp + 8);
          u32x4 vw = {lo.x, lo.y, hi.x, hi.y};
          o0 = MFMA32(__builtin_bit_cast(bf16x8, vw), pb, o0);
        }
        {
          const u16* vp = Vc + (32 + r) * 72 + kb;
          uint2 lo = *(const uint2*)vp, hi = *(const uint2*)(vp + 8);
          u32x4 vw = {lo.x, lo.y, hi.x, hi.y};
          o1 = MFMA32(__builtin_bit_cast(bf16x8, vw), pb, o1);
        }
      }
    }
    __syncthreads();
  }
#undef ATT_LWRITE
#undef ATT_GLOAD
  lsum += __shfl_xor(lsum, 32);
  const float inv = 1.f / lsum;
  u16* dst = MIX + (size_t)qrow * 1024 + 512 + hh * 64;
#pragma unroll
  for (int g = 0; g < 4; g++) {
    int e = 8 * g + 4 * h;
    *(uint2*)(dst + e) = make_uint2(pack2(o0[4 * g] * inv, o0[4 * g + 1] * inv), pack2(o0[4 * g + 2] * inv, o0[4 * g + 3] * inv));
    *(uint2*)(dst + 32 + e) = make_uint2(pack2(o1[4 * g] * inv, o1[4 * g + 1] * inv), pack2(o1[4 * g + 2] * inv, o1[4 * g + 3] * inv));
  }
  __syncthreads();
}

DI void ret_out_item(const Params& p, int l, int b, int hh, int ci, char* smem) {
  const u16* RET = (const u16*)(p.ws + OFF_RET);
  const float* ST = (const float*)(p.ws + OFF_ST);
  u16* MIX = (u16*)(p.ws + OFF_H);
  u16* Qs = (u16*)smem;
  u16* Ks = Qs + 128 * 72;
  u16* Ps = Qs;
  u16* VsT = Ks + 128 * 72;
  u16* SfT = VsT + 64 * 136;
  u16* SbT = SfT + 64 * 72;
  float* dmk = (float*)(SbT + 64 * 72);
  int tid_o = tidx();
  asm volatile("" : "+v"(tid_o));
  const int tid = tid_o, lane = tid & 63, wid = tid >> 6, r = lane & 31, h = lane >> 5;
  float lgf, lgb;
  ret_gammas(p, l, hh, lgf, lgb);
  const int row0 = chunk_row0(b, ci);
  { int d = tid - 128; dmk[tid] = d > 0 ? __expf(lgf * (float)d) : (d < 0 ? __expf(lgb * (float)(-d)) : 2.f); }
#pragma unroll 2
  for (int i = 0; i < 4; i++) {
    int id = tid + 256 * i, m = id >> 3, dc = id & 7;
    const u16* rp = RET + (size_t)(row0 + m) * 1024 + hh * 64 + dc * 8;
    *(uint4*)(Qs + m * 72 + dc * 8) = *(const uint4*)(rp);
    *(uint4*)(Ks + m * 72 + dc * 8) = *(const uint4*)(rp + 256);
    u32x4 vv = *(const u32x4*)(rp + 512);
#pragma unroll
    for (int j = 0; j < 8; j++) VsT[(dc * 8 + j) * 136 + m] = bfu(vv, j);
  }
  const float* Sf = ST + ((size_t)((0 * 4 + b) * 4 + hh) * NCH + ci) * 4096;
  const float* Sb = ST + ((size_t)((1 * 4 + b) * 4 + hh) * NCH + ci) * 4096;
#pragma unroll 2
  for (int i = 0; i < 16; i++) {
    int id = tid + 256 * i, d = id >> 6, e = id & 63;
    SfT[e * 72 + d] = f2bf(Sf[id]);
    SbT[e * 72 + d] = f2bf(Sb[id]);
  }
  __syncthreads();
  const int cw = wid * 32;
  f32x16 in0, in1, sc[4];
  {
    f32x16 cf0, cf1, cb0, cb1;
#pragma unroll
    for (int e = 0; e < 16; e++) { cf0[e] = cf1[e] = cb0[e] = cb1[e] = 0.f; }
#pragma unroll
    for (int ks = 0; ks < 4; ks++) {
      bf16x8 qa = *(const bf16x8*)(Qs + (cw + r) * 72 + ks * 16 + h * 8);
      cf0 = MFMA32(qa, *(const bf16x8*)(SfT + (r) * 72 + ks * 16 + h * 8), cf0);
      cf1 = MFMA32(qa, *(const bf16x8*)(SfT + (32 + r) * 72 + ks * 16 + h * 8), cf1);
      cb0 = MFMA32(qa, *(const bf16x8*)(SbT + (r) * 72 + ks * 16 + h * 8), cb0);
      cb1 = MFMA32(qa, *(const bf16x8*)(SbT + (32 + r) * 72 + ks * 16 + h * 8), cb1);
    }
#pragma unroll
    for (int reg = 0; reg < 16; reg++) {
      int c = cw + crow(reg, h);
      float xf = __expf(lgf * (float)(c + 1)), xb = __expf(lgb * (float)(128 - c));
      in0[reg] = xf * cf0[reg] + xb * cb0[reg];
      in1[reg] = xf * cf1[reg] + xb * cb1[reg];
    }
  }
#pragma unroll
  for (int e = 0; e < 16; e++) { sc[0][e] = sc[1][e] = sc[2][e] = sc[3][e] = 0.f; }
#pragma unroll
  for (int ks = 0; ks < 4; ks++) {
    bf16x8 qa = *(const bf16x8*)(Qs + (cw + r) * 72 + ks * 16 + h * 8);
#pragma unroll
    for (int mt = 0; mt < 4; mt++) sc[mt] = MFMA32(qa, *(const bf16x8*)(Ks + (mt * 32 + r) * 72 + ks * 16 + h * 8), sc[mt]);
  }
  __syncthreads();
#pragma unroll
  for (int mt = 0; mt < 4; mt++)
#pragma unroll
    for (int reg = 0; reg < 16; reg++) {
      int c = cw + crow(reg, h), mm = mt * 32 + r;
      Ps[c * 136 + mm] = f2bf(sc[mt][reg] * dmk[c - mm + 128]);
      if ((reg & 3) == 3) __builtin_amdgcn_sched_barrier(0);
    }
  __syncthreads();
#pragma unroll
  for (int ks = 0; ks < 8; ks++) {
    bf16x8 pa = *(const bf16x8*)(Ps + (cw + r) * 136 + ks * 16 + h * 8);
    in0 = MFMA32(pa, *(const bf16x8*)(VsT + (r) * 136 + ks * 16 + h * 8), in0);
    in1 = MFMA32(pa, *(const bf16x8*)(VsT + (32 + r) * 136 + ks * 16 + h * 8), in1);
  }
#pragma unroll
  for (int reg = 0; reg < 16; reg++) {
    int c = cw + crow(reg, h);
    float oa = in0[reg], ob = in1[reg];
    float ss = oa * oa + ob * ob;
    ss += __shfl_xor(ss, 1); ss += __shfl_xor(ss, 2); ss += __shfl_xor(ss, 4); ss += __shfl_xor(ss, 8); ss += __shfl_xor(ss, 16);
    float rstd = rsqrtf(ss * (1.f / 64.f) + 1e-6f);
    int rowi = row0 + c;
    asm volatile("" : "+v"(rowi));
    size_t row = (size_t)rowi;
    float g0 = bf2f(RET[row * 1024 + 768 + hh * 64 + r]), g1 = bf2f(RET[row * 1024 + 768 + hh * 64 + 32 + r]);
    MIX[row * 1024 + 256 + hh * 64 + r] = f2bf(silu_f(g0) * oa * rstd);
    MIX[row * 1024 + 256 + hh * 64 + 32 + r] = f2bf(silu_f(g1) * ob * rstd);
    if ((reg & 3) == 3) __builtin_amdgcn_sched_barrier(0);
  }
  __syncthreads();
}

typedef _Float16 h2_t __attribute__((ext_vector_type(2)));
DI unsigned packh(float a, float b) { h2_t v; v[0] = (_Float16)a; v[1] = (_Float16)b; return __builtin_bit_cast(unsigned, v); }
template <class ZF, class CF>
DI void hy_conv(float2* X, const float2* __restrict__ TW, const float2* __restrict__ Ke, const float2* __restrict__ Ko,
                ZF zf4, CF consume4, int tid) {
  const float scl = 0.5f / 8192.f;
#pragma unroll 2
  for (int g = 0; g < 8; g++) {
    int j = tidx() + 256 * g;
    float zr[4], zi[4];
    zf4(j, zr, zi);
#pragma unroll
    for (int e = 0; e < 4; e++) X[PX(4 * j + e)] = make_float2(zr[e], zi[e]);
  }
  __syncthreads();
  fft_dif(X, TW, tid);
#pragma unroll 2
  for (int g = 0; g < 8; g++) {
    int j = tidx() + 256 * g;
    const float4* kp = (const float4*)(Ke + 4 * j);
    float4 k01 = kp[0], k23 = kp[1];
    float2 a;
    a = X[PX(4 * j + 0)]; X[PX(4 * j + 0)] = make_float2(a.x * k01.x - a.y * k01.y, a.x * k01.y + a.y * k01.x);
    a = X[PX(4 * j + 1)]; X[PX(4 * j + 1)] = make_float2(a.x * k01.z - a.y * k01.w, a.x * k01.w + a.y * k01.z);
    a = X[PX(4 * j + 2)]; X[PX(4 * j + 2)] = make_float2(a.x * k23.x - a.y * k23.y, a.x * k23.y + a.y * k23.x);
    a = X[PX(4 * j + 3)]; X[PX(4 * j + 3)] = make_float2(a.x * k23.z - a.y * k23.w, a.x * k23.w + a.y * k23.z);
  }
  __syncthreads();
  fft_dit(X, TW, tid);
  unsigned ye[32];
#pragma unroll
  for (int g = 0; g < 8; g++) {
    int j = tid + 256 * g;
    asm volatile("" : "+v"(j));
#pragma unroll
    for (int e = 0; e < 4; e++) {
      float2 ev = X[PX(4 * j + e)];
      unsigned pk = packh(ev.x * scl, ev.y * scl);
      asm volatile("" : "+v"(pk));
      ye[g * 4 + e] = pk;
    }
    if (g & 1) __builtin_amdgcn_sched_barrier(0);
  }
  __syncthreads();
#pragma unroll 2
  for (int g = 0; g < 8; g++) {
    int j = tidx() + 256 * g;
    float zr[4], zi[4];
    zf4(j, zr, zi);
    const float4* tp = (const float4*)(TW + 4 * j);
    float4 t01 = tp[0], t23 = tp[1];
    X[PX(4 * j + 0)] = make_float2(zr[0] * t01.x - zi[0] * t01.y, zr[0] * t01.y + zi[0] * t01.x);
    X[PX(4 * j + 1)] = make_float2(zr[1] * t01.z - zi[1] * t01.w, zr[1] * t01.w + zi[1] * t01.z);
    X[PX(4 * j + 2)] = make_float2(zr[2] * t23.x - zi[2] * t23.y, zr[2] * t23.y + zi[2] * t23.x);
    X[PX(4 * j + 3)] = make_float2(zr[3] * t23.z - zi[3] * t23.w, zr[3] * t23.w + zi[3] * t23.z);
  }
  __syncthreads();
  fft_dif(X, TW, tid);
#pragma unroll 2
  for (int g = 0; g < 8; g++) {
    int j = tidx() + 256 * g;
    const float4* kp = (const float4*)(Ko + 4 * j);
    float4 k01 = kp[0], k23 = kp[1];
    float2 a;
    a = X[PX(4 * j + 0)]; X[PX(4 * j + 0)] = make_float2(a.x * k01.x - a.y * k01.y, a.x * k01.y + a.y * k01.x);
    a = X[PX(4 * j + 1)]; X[PX(4 * j + 1)] = make_float2(a.x * k01.z - a.y * k01.w, a.x * k01.w + a.y * k01.z);
    a = X[PX(4 * j + 2)]; X[PX(4 * j + 2)] = make_float2(a.x * k23.x - a.y * k23.y, a.x * k23.y + a.y * k23.x);
    a = X[PX(4 * j + 3)]; X[PX(4 * j + 3)] = make_float2(a.x * k23.z - a.y * k23.w, a.x * k23.w + a.y * k23.z);
  }
  __syncthreads();
  fft_dit(X, TW, tid);
#pragma unroll
  for (int g = 0; g < 8; g++) {
    int j = tid + 256 * g;
    asm volatile("" : "+v"(j));
    const float4* tp = (const float4*)(TW + 4 * j);
    float4 t01 = tp[0], t23 = tp[1];
    float ya[4], yb[4];
    float2 o;
    h2_t ev;
    o = X[PX(4 * j + 0)]; ev = __builtin_bit_cast(h2_t, ye[g * 4 + 0]);
    ya[0] = (float)ev[0] + (o.x * t01.x + o.y * t01.y) * scl; yb[0] = (float)ev[1] + (o.y * t01.x - o.x * t01.y) * scl;
    o = X[PX(4 * j + 1)]; ev = __builtin_bit_cast(h2_t, ye[g * 4 + 1]);
    ya[1] = (float)ev[0] + (o.x * t01.z + o.y * t01.w) * scl; yb[1] = (float)ev[1] + (o.y * t01.z - o.x * t01.w) * scl;
    o = X[PX(4 * j + 2)]; ev = __builtin_bit_cast(h2_t, ye[g * 4 + 2]);
    ya[2] = (float)ev[0] + (o.x * t23.x + o.y * t23.y) * scl; yb[2] = (float)ev[1] + (o.y * t23.x - o.x * t23.y) * scl;
    o = X[PX(4 * j + 3)]; ev = __builtin_bit_cast(h2_t, ye[g * 4 + 3]);
    ya[3] = (float)ev[0] + (o.x * t23.z + o.y * t23.w) * scl; yb[3] = (float)ev[1] + (o.y * t23.z - o.x * t23.w) * scl;
    consume4(j, ya, yb);
    __builtin_amdgcn_sched_barrier(0);
  }
  __syncthreads();
}

DI float sconv_at(const u16* __restrict__ u, int n, int Ls, float w0, float w1, float w2, float bias) {
  float um = n > 0 ? bf2f(u[n - 1]) : 0.f, uc = bf2f(u[n]), up = n < Ls - 1 ? bf2f(u[n + 1]) : 0.f;
  return bias + w0 * um + w1 * uc + w2 * up;
}
DI void sconv4(const u16* __restrict__ u, int j, float w0, float w1, float w2, float bias, float (&o)[4]) {
  uint2 c = *(const uint2*)(u + 4 * j);
  float x0 = __uint_as_float(c.x << 16), x1 = __uint_as_float(c.x & 0xffff0000u);
  float x2 = __uint_as_float(c.y << 16), x3 = __uint_as_float(c.y & 0xffff0000u);
  float xm = j > 0 ? bf2f(u[4 * j - 1]) : 0.f, xp = j < 2047 ? bf2f(u[4 * j + 4]) : 0.f;
  o[0] = bias + w0 * xm + w1 * x0 + w2 * x1;
  o[1] = bias + w0 * x0 + w1 * x1 + w2 * x2;
  o[2] = bias + w0 * x1 + w1 * x2 + w2 * x3;
  o[3] = bias + w0 * x2 + w1 * x3 + w2 * xp;
}
DI void unpack4(const u16* __restrict__ p, float (&o)[4]) {
  uint2 c = *(const uint2*)p;
  o[0] = __uint_as_float(c.x << 16); o[1] = __uint_as_float(c.x & 0xffff0000u);
  o[2] = __uint_as_float(c.y << 16); o[3] = __uint_as_float(c.y & 0xffff0000u);
}

DI void hyena_item(const Params& p, int l, int c, int pair, char* smem) {
  float2* X = (float2*)smem;
  const float2* TW = (const float2*)(p.ws + OFF_TW);
  const float2* KS = (const float2*)(p.ws + OFF_KSPEC);
  const u16* UT = (const u16*)(p.ws + OFF_UT);
  u16* YT = (u16*)(p.ws + OFF_CQ);
  int tid_o = tidx();
  const int tid = tid_o;
  const float* cw = p.in[I_HCW] + l * 3 * 768;
  const float* cb = p.in[I_HCB] + l * 768;
  const int b0 = 2 * pair, b1 = b0 + 1;
  u16* y0 = YT + (size_t)(b0 * 256 + c) * SEQ;
  u16* y1 = YT + (size_t)(b1 * 256 + c) * SEQ;
  const float vw0 = cw[512 + c], vw1 = cw[768 + 512 + c], vw2 = cw[1536 + 512 + c], vbs = cb[512 + c];
  const u16* v0p = UT + (size_t)(b0 * 768 + 512 + c) * SEQ;
  const u16* v1p = UT + (size_t)(b1 * 768 + 512 + c) * SEQ;
  {
    const float w0 = cw[c], w1 = cw[768 + c], w2 = cw[1536 + c], bs = cb[c];
    const float bias0 = p.in[I_HBIAS][(l * 2 + 0) * 256 + c];
    const u16* u0 = UT + (size_t)(b0 * 768 + c) * SEQ;
    const u16* u1 = UT + (size_t)(b1 * 768 + c) * SEQ;
    hy_conv(X, TW, KS + (size_t)(0 * 256 + c) * 2 * 8192, KS + (size_t)(0 * 256 + c) * 2 * 8192 + 8192,
            [&](int j, float (&zr)[4], float (&zi)[4]) __attribute__((always_inline)) {
              sconv4(v0p, j, vw0, vw1, vw2, vbs, zr); sconv4(v1p, j, vw0, vw1, vw2, vbs, zi);
            },
            [&](int j, const float (&ya)[4], const float (&yb)[4]) __attribute__((always_inline)) {
              float va[4], vb[4], xa[4], xb[4];
              sconv4(v0p, j, vw0, vw1, vw2, vbs, va); sconv4(v1p, j, vw0, vw1, vw2, vbs, vb);
              sconv4(u0, j, w0, w1, w2, bs, xa); sconv4(u1, j, w0, w1, w2, bs, xb);
              *(uint2*)(y0 + 4 * j) = make_uint2(pack2(xa[0] * (ya[0] + va[0] * bias0), xa[1] * (ya[1] + va[1] * bias0)),
                                                 pack2(xa[2] * (ya[2] + va[2] * bias0), xa[3] * (ya[3] + va[3] * bias0)));
              *(uint2*)(y1 + 4 * j) = make_uint2(pack2(xb[0] * (yb[0] + vb[0] * bias0), xb[1] * (yb[1] + vb[1] * bias0)),
                                                 pack2(xb[2] * (yb[2] + vb[2] * bias0), xb[3] * (yb[3] + vb[3] * bias0)));
            }, tid);
  }
  {
    const int col = 256 + c;
    const float w0 = cw[col], w1 = cw[768 + col], w2 = cw[1536 + col], bs = cb[col];
    const float bias1 = p.in[I_HBIAS][(l * 2 + 1) * 256 + c];
    const u16* u0 = UT + (size_t)(b0 * 768 + col) * SEQ;
    const u16* u1 = UT + (size_t)(b1 * 768 + col) * SEQ;
    hy_conv(X, TW, KS + (size_t)(1 * 256 + c) * 2 * 8192, KS + (size_t)(1 * 256 + c) * 2 * 8192 + 8192,
            [&](int j, float (&zr)[4], float (&zi)[4]) __attribute__((always_inline)) { unpack4(y0 + 4 * j, zr); unpack4(y1 + 4 * j, zi); },
            [&](int j, const float (&ya)[4], const float (&yb)[4]) __attribute__((always_inline)) {
              float za[4], zb[4], xa[4], xb[4];
              unpack4(y0 + 4 * j, za); unpack4(y1 + 4 * j, zb);
              sconv4(u0, j, w0, w1, w2, bs, xa); sconv4(u1, j, w0, w1, w2, bs, xb);
              *(uint2*)(y0 + 4 * j) = make_uint2(pack2(xa[0] * (ya[0] + za[0] * bias1), xa[1] * (ya[1] + za[1] * bias1)),
                                                 pack2(xa[2] * (ya[2] + za[2] * bias1), xa[3] * (ya[3] + za[3] * bias1)));
              *(uint2*)(y1 + 4 * j) = make_uint2(pack2(xb[0] * (yb[0] + zb[0] * bias1), xb[1] * (yb[1] + zb[1] * bias1)),
                                                 pack2(xb[2] * (yb[2] + zb[2] * bias1), xb[3] * (yb[3] + zb[3] * bias1)));
            }, tid);
  }
}

DI void hyena_ctx_item(const Params& p, int l, int b, int c, char* smem) {
  float* k0s = (float*)smem;
  float* k1s = k0s + 512;
  float* vs = k1s + 512;
  float* zs = vs + 256;
  const float* KC = (const float*)(p.ws + OFF_KC);
  const u16* UTC = (const u16*)(p.ws + OFF_UTC);
  u16* MIX = (u16*)(p.ws + OFF_H);
  int tid_o = tidx();
  asm volatile("" : "+v"(tid_o));
  const int n = tid_o;
  const float* cw = p.in[I_HCW] + l * 3 * 768;
  const float* cb = p.in[I_HCB] + l * 768;
  k0s[n] = KC[(size_t)(0 * 256 + c) * 512 + n]; k0s[256 + n] = KC[(size_t)(0 * 256 + c) * 512 + 256 + n];
  k1s[n] = KC[(size_t)(1 * 256 + c) * 512 + n]; k1s[256 + n] = KC[(size_t)(1 * 256 + c) * 512 + 256 + n];
  float v = sconv_at(UTC + (size_t)(b * 768 + 512 + c) * LCTX, n, LCTX, cw[512 + c], cw[768 + 512 + c], cw[1536 + 512 + c], cb[512 + c]);
  float x1 = sconv_at(UTC + (size_t)(b * 768 + c) * LCTX, n, LCTX, cw[c], cw[768 + c], cw[1536 + c], cb[c]);
  float x2 = sconv_at(UTC + (size_t)(b * 768 + 256 + c) * LCTX, n, LCTX, cw[256 + c], cw[768 + 256 + c], cw[1536 + 256 + c], cb[256 + c]);
  vs[n] = v;
  __syncthreads();
  float a = 0.f;
  for (int s = 0; s < 256; s++) a += k0s[n - s + 256] * vs[s];
  float z = x1 * (a + v * p.in[I_HBIAS][(l * 2 + 0) * 256 + c]);
  zs[n] = z;
  __syncthreads();
  float a2 = 0.f;
  for (int s = 0; s < 256; s++) a2 += k1s[n - s + 256] * zs[s];
  float y = x2 * (a2 + z * p.in[I_HBIAS][(l * 2 + 1) * 256 + c]);
  MIX[(size_t)(TLAT + b * LCTX + n) * 1024 + c] = f2bf(y);
  __syncthreads();
}

DI void phase_p4(const Params& p, int l, char* smem, int submask = 15) {
  const int n_al = 2048, n_ac = (l == 0 ? 64 : 0), n_hy = 512, n_r3 = (l == 0 ? 16 * NCH : 16 * 64), n_hc = (l == 0 ? 1024 : 0);
  const int total = n_al + n_ac + n_hy + n_r3 + n_hc;
  for (int it = blockIdx.x; it < total; it += gridDim.x) {
    int q = it;
    if (q < n_al) {
      int b = q >> 9, hh = (q >> 6) & 7, qb = q & 63;
      if (SUB_ON(0) && (submask & 1)) attn_item(p, b, hh, b * SEQ + qb * 128, 0, LKEY, smem);
    } else if ((q -= n_al) < n_ac) {
      int b = q >> 4, hh = (q >> 1) & 7, qb = q & 1;
      if (SUB_ON(0) && (submask & 1)) attn_item(p, b, hh, TLAT + b * LCTX + qb * 128, SEQ, LCTX, smem);
    } else if ((q -= n_ac) < n_hy) {
      if (SUB_ON(1) && (submask & 2)) hyena_item(p, l, q >> 1, q & 1, smem);
    } else if ((q -= n_hy) < n_r3) {
      int bh, ci;
      if (l == 0) { bh = q / NCH; ci = q - bh * NCH; } else { bh = q >> 6; ci = 2 + (q & 63); }
      if (SUB_ON(2) && (submask & 4)) ret_out_item(p, l, bh >> 2, bh & 3, ci, smem);
    } else {
      q -= n_r3;
      if (SUB_ON(3) && (submask & 8)) hyena_ctx_item(p, l, q >> 8, q & 255, smem);
    }
  }
}

DI void phase_res_gemm(const Params& p, int l, int which  , char* smem) {
  const char* wl = p.ws + OFF_W + (size_t)l * WL_SIZE;
  const u16* A = (const u16*)(p.ws + (which == 1 ? OFF_H : OFF_ACT));
  const int K = which == 1 ? 1024 : 4096;
  const u16* Bt = (const u16*)(wl + (which == 1 ? WL_WOUT : WL_W2));
  const bool first = (l == 0 && which == 1);
  const float* mod = (const float*)(p.ws + OFF_MOD);
  float* XC = (float*)(p.ws + OFF_XC);
  const int n_lat = 128 * 8, n_split = (l == 0 ? 32 * 16 : 0);
  for (int it = blockIdx.x; it < n_lat + n_split; it += gridDim.x) {
    if (it < n_lat) {
      int mt = it >> 3, nt = it & 7;
      int m0 = mt * 256;
      const u16* at = nullptr;
      if (which == 1) at = (const u16*)(p.ws + OFF_CQ) + (size_t)((m0 >> 13) * 256) * SEQ + (m0 & 8191);
      const float* ga = mod + (size_t)(l * 5 + (m0 >> 13)) * 6144 + (which == 1 ? 2048 : 5120);
      const float* src = first ? p.in[I_X] : p.out;
      float* dst = p.out;
      gemm_tile<false, false, false, 3>(A, K, Bt, K, K, m0, nt * 128, at, 8, smem,
        [](int, int, float v, const float*) __attribute__((always_inline)) { return v; },
        [&](int row, int col, float4 a) __attribute__((always_inline)) {
          size_t idx = (size_t)row * 1024 + col;
          float4 x = *(const float4*)(src + idx), g = *(const float4*)(ga + col);
          *(float4*)(dst + idx) = make_float4(x.x + g.x * a.x, x.y + g.y * a.y, x.z + g.z * a.z, x.w + g.w * a.w);
        });
    } else {
      int q = it - n_lat;
      int tile = q >> 4, kc = q & 15;
      int mt = 128 + (tile >> 3), nt = tile & 7;
      int kchunk = K >> 4, k0 = kc * kchunk;
      const float* ga = mod + (size_t)(l * 5 + 4) * 6144 + (which == 1 ? 2048 : 5120);
      float* dst = XC - (size_t)TLAT * 1024;
      gemm_tile<false, false, false, 0>(A + k0, K, Bt + k0, K, kchunk, mt * 256, nt * 128, nullptr, 0, smem,
        [&](int bm, int bn, const f32x16& acc, const float*) __attribute__((always_inline)) {
          const int lz_ = tidx() & 63, r = lz_ & 31, h = lz_ >> 5;
          int col = bn + r;
          float g = ga[col];
#pragma unroll
          for (int reg = 0; reg < 16; reg++) unsafeAtomicAdd(dst + (size_t)(bm + crow(reg, h)) * 1024 + col, g * acc[reg]);
        }, [](int, int) __attribute__((always_inline)) -> u16* { return nullptr; });
    }
  }
}

DI void phase_mlp1(const Params& p, int l, char* smem) {
  const int lane = tidx() & 63, r = lane & 31, h = lane >> 5;
  const int nmt = (l == 0 ? 132 : 128);
  const u16* A = (const u16*)(p.ws + OFF_H);
  const u16* Bt = (const u16*)(p.ws + OFF_W + (size_t)l * WL_SIZE + WL_W1);
  u16* ACT = (u16*)(p.ws + OFF_ACT);
  const int total = nmt * 32;
  for (int it = blockIdx.x; it < total; it += gridDim.x) {
    int mt = it >> 5, nt = it & 31;
    gemm_tile<false, false, false, 1>(A, 1024, Bt, 1024, 1024, mt * 256, nt * 128, nullptr, 0, smem,
      [](int, int, float v, const float*) __attribute__((always_inline)) { float x = fmaxf(v, 0.f); return x * x; },
      [&](int row, int col) __attribute__((always_inline)) -> u16* { return ACT + (size_t)row * 4096 + col; });
  }
}

DI void phase_final(const Params& p) {
  const int lane = tidx() & 63, wid = tidx() >> 6;
  const float* g = p.in[I_FNG];
  for (int it = blockIdx.x; it < TLAT / 8; it += gridDim.x) {
    float* row = p.out + (size_t)(it * 8 + wid * 2) * 1024;
    float4 v[8];
    float ssq0 = 0.f, ssq1 = 0.f;
#pragma unroll
    for (int i = 0; i < 4; i++) { v[i] = *(const float4*)(row + i * 256 + lane * 4); v[4 + i] = *(const float4*)(row + 1024 + i * 256 + lane * 4); }
#pragma unroll
    for (int i = 0; i < 4; i++) {
      ssq0 += v[i].x * v[i].x + v[i].y * v[i].y + v[i].z * v[i].z + v[i].w * v[i].w;
      ssq1 += v[4 + i].x * v[4 + i].x + v[4 + i].y * v[4 + i].y + v[4 + i].z * v[4 + i].z + v[4 + i].w * v[4 + i].w;
    }
    ssq0 = wave_sum(ssq0); ssq1 = wave_sum(ssq1);
    float r0 = rsqrtf(ssq0 * (1.f / 1024.f) + 1e-6f), r1 = rsqrtf(ssq1 * (1.f / 1024.f) + 1e-6f);
#pragma unroll
    for (int i = 0; i < 4; i++) {
      float4 gg = *(const float4*)(g + i * 256 + lane * 4);
      *(float4*)(row + i * 256 + lane * 4) = make_float4(v[i].x * r0 * gg.x, v[i].y * r0 * gg.y, v[i].z * r0 * gg.z, v[i].w * r0 * gg.w);
      *(float4*)(row + 1024 + i * 256 + lane * 4) = make_float4(v[4 + i].x * r1 * gg.x, v[4 + i].y * r1 * gg.y, v[4 + i].z * r1 * gg.z, v[4 + i].w * r1 * gg.w);
    }
  }
}


#define XB_TMO      128
#define XB_XCNT(j)  (256  + 64 * (j))
#define XB_XSUB(j)  (1280 + 64 * (j))
#define XB_XGEN(j)  (2304 + 64 * (j))
#define XB_TOP      3328
#define XB_TOPGEN   3392
#define XCD_BAR_WORDS 3456
#define XB_SPIN_CAP (1u << 22)
#define LAS __attribute__((address_space(3)))
DI unsigned xb_ld(unsigned* p) { return __hip_atomic_load(p, __ATOMIC_RELAXED, __HIP_MEMORY_SCOPE_AGENT); }
DI unsigned xb_add(unsigned* p, unsigned v) { return __hip_atomic_fetch_add(p, v, __ATOMIC_RELAXED, __HIP_MEMORY_SCOPE_AGENT); }
DI unsigned xb_xcc_id() { return (unsigned)__builtin_amdgcn_s_getreg((3 << 11) | 20) & 0xFu; }
#define XB_SPIN(cond, bar) do { unsigned _sp = 0; while (cond) { __builtin_amdgcn_s_sleep(1); \
    if ((++_sp & 255u) == 0u) { if (xb_ld(&(bar)[XB_TMO])) break; if (_sp > XB_SPIN_CAP) { atomicAdd(&(bar)[XB_TMO], 1u); break; } } } } while (0)
struct XcdBarrier { unsigned* bar; unsigned x; volatile LAS unsigned* st; };
DI XcdBarrier xcd_barrier_post(unsigned* bar, volatile LAS unsigned* st) {
  XcdBarrier b; b.bar = bar; b.x = xb_xcc_id(); b.st = st;
  if (threadIdx.x == 0) (void)xb_add(&bar[XB_XCNT(b.x)], 1u);
  return b;
}
DI void xcd_barrier_complete(unsigned* bar, unsigned x, unsigned& nloc, unsigned& nx) {
  const unsigned G = gridDim.x * gridDim.y * gridDim.z;
  unsigned sum, cnt, mine, sp = 0u;
  for (;;) {
    sum = 0u; cnt = 0u; mine = 0u;
#pragma unroll
    for (unsigned j = 0; j < 16; ++j) { const unsigned c = xb_ld(&bar[XB_XCNT(j)]); sum += c; cnt += (c > 0u) ? 1u : 0u; mine = (j == x) ? c : mine; }
    if (sum == G) break;
    __builtin_amdgcn_s_sleep(1);
    if ((++sp & 255u) == 0u) { if (xb_ld(&bar[XB_TMO])) break; if (sp > XB_SPIN_CAP) { atomicAdd(&bar[XB_TMO], 1u); break; } }
  }
  nloc = mine > 0u ? mine : 1u; nx = cnt > 0u ? cnt : 1u;
}
DI void xcd_barrier(const XcdBarrier& b) {
  asm volatile("s_waitcnt vmcnt(0)" ::: "memory");
  __syncthreads();
  if (threadIdx.x == 0) {
    unsigned* bar = b.bar;
    __builtin_amdgcn_s_waitcnt(0);
    unsigned nloc = b.st[0], nx = b.st[1];
    if (nloc == 0u) { xcd_barrier_complete(bar, b.x, nloc, nx); b.st[0] = nloc; b.st[1] = nx; }
    const unsigned old = xb_add(&bar[XB_XSUB(b.x)], 1u);
    const unsigned gen = old / nloc;
    if (old + 1u == (gen + 1u) * nloc) {
      __builtin_amdgcn_fence(__ATOMIC_RELEASE, "agent");
      asm volatile("s_waitcnt vmcnt(0)" ::: "memory");
      const unsigned og = xb_add(&bar[XB_TOP], 1u);
      const unsigned tg = og / nx;
      if (og + 1u == (tg + 1u) * nx) xb_add(&bar[XB_TOPGEN], 1u);
      else XB_SPIN(xb_ld(&bar[XB_TOPGEN]) == tg, bar);
      __builtin_amdgcn_fence(__ATOMIC_ACQUIRE, "agent");
      xb_add(&bar[XB_XGEN(b.x)], 1u);
      asm volatile("s_waitcnt vmcnt(0)" ::: "memory");
    } else {
      XB_SPIN(xb_ld(&bar[XB_XGEN(b.x)]) == gen, bar);
      __builtin_amdgcn_fence(__ATOMIC_ACQUIRE, "agent");
      asm volatile("s_waitcnt vmcnt(0)" ::: "memory");
    }
  }
  __syncthreads();
}

constexpr int NPHASE = 20;
#ifndef ONLY_PHASE
#define ONLY_PHASE -1
#endif
#define PH_ON(k) (ONLY_PHASE < 0 || ONLY_PHASE == (k))
DI void run_phase(const Params& p, int ph, char* smem, int submask = 15) {
  if (ph == 0) { if (PH_ON(0)) phase_s0(p, smem); return; }
  if (ph == NPHASE - 1) { if (PH_ON(8)) phase_final(p); return; }
  int l = (ph - 1) / 9, s = (ph - 1) % 9;
  switch (s) {
    case 0: if (PH_ON(1)) phase_norm(p, l, 1, TALL, true); break;
    case 1: if (PH_ON(2)) phase_win(p, l, smem); break;
    case 2: if (PH_ON(3)) phase_p3(p, l, smem); break;
    case 3: if (PH_ON(4)) phase_scan(p, l); break;
    case 4: if (PH_ON(5)) phase_p4(p, l, smem, submask); break;
    case 5: if (PH_ON(6)) phase_res_gemm(p, l, 1, smem); break;
    case 6: if (PH_ON(1)) phase_norm(p, l, 2, l == 0 ? TALL : TLAT, false); break;
    case 7: if (PH_ON(7)) phase_mlp1(p, l, smem); break;
    default: if (PH_ON(6)) phase_res_gemm(p, l, 2, smem); break;
  }
}

#if !MULTI_LAUNCH
extern "C" __global__ void __launch_bounds__(256, 2) mk_all(Params p) {
  extern __shared__ __attribute__((aligned(16))) char smem[];
  cg::grid_group grid = cg::this_grid();
  __shared__ uint4 xb_words;
  if (threadIdx.x == 0) xb_words = make_uint4(0u, 0u, 0u, 0u);
  __syncthreads();
  XcdBarrier xb = xcd_barrier_post((unsigned*)(p.ws + OFF_BAR), (volatile LAS unsigned*)&xb_words);
  if (p.ws == nullptr) grid.sync();
  for (int ph = 0; ph < NPHASE; ph++) {
    run_phase(p, ph, smem);
#ifdef PROBE_DUP
    if (ph == PROBE_DUP || ph == PROBE_DUP2) { xcd_barrier(xb); run_phase(p, ph, smem, PROBE_MASK); }
#endif
    if (ph + 1 < NPHASE) xcd_barrier(xb);
  }
}
#define MK_KERNEL mk_all
#else
#define MK_KERNEL mk_phase
extern "C" __global__ void __launch_bounds__(256, 2) mk_phase(Params p, int ph) {
  extern __shared__ __attribute__((aligned(16))) char smem[];
  run_phase(p, ph, smem);
}
#endif

extern "C" void kernel_launch(void* const* d_in, const int* in_sizes, int n_in, void* d_out, int out_size, void* d_ws, size_t ws_size,
                              hipStream_t stream) {
  Params p{};
  for (int i = 0; i < 27; i++) p.in[i] = (const float*)d_in[i];
  p.out = (float*)d_out;
  p.ws = (char*)d_ws;
  static int grid_blocks = 0;
  if (!grid_blocks) {
    int dev = 0, cus = 0, per_cu = 0;
    (void)hipGetDevice(&dev);
    (void)hipDeviceGetAttribute(&cus, hipDeviceAttributeMultiprocessorCount, dev);
    (void)hipFuncSetAttribute((const void*)MK_KERNEL, hipFuncAttributeMaxDynamicSharedMemorySize, SMEM_BYTES);
    (void)hipOccupancyMaxActiveBlocksPerMultiprocessor(&per_cu, MK_KERNEL, 256, SMEM_BYTES);
    if (per_cu < 1) per_cu = 1;
    if (per_cu > 2) per_cu = 2;
    grid_blocks = cus * per_cu;
  }
#if MULTI_LAUNCH
  for (int ph = 0; ph < NPHASE; ph++) hipLaunchKernelGGL(mk_phase, dim3(grid_blocks), dim3(256), SMEM_BYTES, stream, p, ph);
#else
  (void)hipMemsetAsync(p.ws + OFF_BAR, 0, XCD_BAR_WORDS * 4, stream);
  void* args[] = {&p};
  (void)hipLaunchCooperativeKernel((void*)mk_all, dim3(grid_blocks), dim3(256), args, SMEM_BYTES, stream);
#endif
}
```

```cpp
#include <hip/hip_runtime.h>
#include <hip/hip_cooperative_groups.h>
namespace cg = cooperative_groups;

#ifndef MULTI_LAUNCH
#define MULTI_LAUNCH 0
#endif

#define DI __device__ __forceinline__
#define NI __device__ __noinline__
typedef unsigned short u16;
typedef short bf16x8 __attribute__((ext_vector_type(8)));
typedef float f32x16 __attribute__((ext_vector_type(16)));
typedef __bf16 bf2_t __attribute__((ext_vector_type(2)));
typedef unsigned u32x4 __attribute__((ext_vector_type(4)));
#define MFMA32(a, b, c) __builtin_amdgcn_mfma_f32_32x32x16_bf16((a), (b), (c), 0, 0, 0)

constexpr int NB = 4, SEQ = 8192, LCTX = 256, DM = 1024, DFF = 4096;
constexpr int TLAT = NB * SEQ;
constexpr int TALL = TLAT + NB * LCTX;
constexpr int NIN = 2208, NINP = 2304;
constexpr int LKEY = SEQ + LCTX;
constexpr int NCH = 66;
constexpr int SMEM_BYTES = 73728;
#ifndef SUBSEL
#define SUBSEL -1
#endif
#define SUB_ON(k) (SUBSEL < 0 || SUBSEL == (k))

constexpr size_t WL_WIN = 0;
constexpr size_t WL_WOUT = WL_WIN + (size_t)NINP * 1024 * 2;
constexpr size_t WL_W1 = WL_WOUT + (size_t)1024 * 1024 * 2;
constexpr size_t WL_W2 = WL_W1 + (size_t)4096 * 1024 * 2;
constexpr size_t WL_WUQ = WL_W2 + (size_t)1024 * 4096 * 2;
constexpr size_t WL_WUKV = WL_WUQ + (size_t)768 * 256 * 2;
constexpr size_t WL_SIZE = WL_WUKV + (size_t)1024 * 128 * 2;
constexpr size_t OFF_W = 0;
constexpr size_t OFF_MOD = OFF_W + 2 * WL_SIZE;
constexpr size_t OFF_TW = OFF_MOD + (size_t)2 * 5 * 6144 * 4;
constexpr size_t OFF_ROPE = OFF_TW + 65536;
constexpr size_t OFF_XC = OFF_ROPE + 192 * 8 * 8 + 4096;
constexpr size_t OFF_H = OFF_XC + (size_t)1024 * 1024 * 4;
constexpr size_t OFF_H2F = OFF_H + (size_t)TALL * 1024 * 2;
constexpr size_t OFF_H2C = OFF_H2F + (size_t)8192 * 64 * 4;
constexpr size_t OFF_KC = OFF_H2C + (size_t)256 * 64 * 4;
constexpr size_t OFF_BIG = OFF_KC + (size_t)2 * 256 * 512 * 4;
constexpr size_t OFF_UT = OFF_BIG;
constexpr size_t OFF_UTC = OFF_UT + (size_t)NB * 768 * SEQ * 2;
constexpr size_t OFF_RET = OFF_UTC + (size_t)NB * 768 * LCTX * 2;
constexpr size_t OFF_CQ = OFF_RET + (size_t)TALL * 1024 * 2;
constexpr size_t OFF_CKV = OFF_CQ + (size_t)TALL * 256 * 2;
constexpr size_t OFF_Q = OFF_CKV + (size_t)TALL * 128 * 2;
constexpr size_t OFF_KF = OFF_Q + (size_t)TALL * 768 * 2;
constexpr size_t OFF_VT = OFF_KF + (size_t)NB * 8 * LKEY * 96 * 2;
constexpr size_t OFF_ST = OFF_VT + (size_t)NB * 8 * 64 * LKEY * 2;
constexpr size_t OFF_KSPEC = OFF_ST + (size_t)2 * 16 * NCH * 4096 * 4;
constexpr size_t OFF_END = OFF_KSPEC + (size_t)2 * 256 * 2 * 8192 * 8;
constexpr size_t OFF_BAR = OFF_END;
constexpr size_t OFF_ACT = OFF_BIG;
static_assert(OFF_ACT + (size_t)TALL * 4096 * 2 <= OFF_END, "act fits");
static_assert(OFF_END + 16384 <= (size_t)536870912, "workspace");

struct Params {
  const float* in[27];
  float* out;
  char* ws;
};
enum { I_X = 0, I_C, I_CTX, I_CCTX, I_WADA, I_BADA, I_N1G, I_N2G, I_WIN, I_WOUT, I_HCW, I_HCB, I_HW1, I_HB1, I_HSF, I_HW2,
       I_HB2, I_HW3, I_HBIAS, I_RLD, I_QNG, I_WUQ, I_KVNG, I_WUKV, I_W1, I_W2, I_FNG };

DI int tidx() { int t = __builtin_amdgcn_workitem_id_x(); asm volatile("" : "+v"(t)); return t; }
DI u16 f2bf(float x) { return __builtin_bit_cast(u16, (__bf16)x); }
DI float bf2f(u16 v) { return __uint_as_float(((unsigned)v) << 16); }
DI unsigned pack2(float a, float b) { bf2_t v; v[0] = (__bf16)a; v[1] = (__bf16)b; return __builtin_bit_cast(unsigned, v); }
DI float wave_sum(float v) {
#pragma unroll
  for (int o = 32; o > 0; o >>= 1) v += __shfl_xor(v, o);
  return v;
}
DI int crow(int reg, int h) { return (reg & 3) + 8 * (reg >> 2) + 4 * h; }
DI float bfe(u32x4 v, int j) {
  unsigned w = v[j >> 1];
  return __uint_as_float((j & 1) ? (w & 0xffff0000u) : (w << 16));
}
DI u16 bfu(u32x4 v, int j) {
  unsigned w = v[j >> 1];
  return (u16)((j & 1) ? (w >> 16) : (w & 0xffffu));
}
DI float silu_f(float x) { return x / (1.f + __expf(-x)); }
DI void row_info(int row, int& b, int& t, int& key, int& cond) {
  if (row < TLAT) { b = row >> 13; t = row & 8191; key = t; cond = b; }
  else { int rc = row - TLAT; b = rc >> 8; t = rc & 255; key = SEQ + t; cond = 4; }
}
DI int chunk_row0(int b, int ci) { return ci < 2 ? TLAT + b * LCTX + ci * 128 : b * SEQ + (ci - 2) * 128; }
DI float rope_apply(const float2* __restrict__ tab, float val, int jj, int t) {
  float partner = __shfl_xor(val, 8);
  int pos = (jj & 16) ? 128 + (t & 63) : (t >> 6);
  float2 cs = tab[pos * 8 + (jj & 7)];
  return (jj & 8) ? (val * cs.x + partner * cs.y) : (val * cs.x - partner * cs.y);
}

DI void convT_item(const float* __restrict__ src, u16* __restrict__ dst, int K, int N, int Npad, const float* __restrict__ gain,
                   int item, float* tile, bool perm = false) {
  int ntn = Npad >> 6;
  int kt = item / ntn, nt = item - kt * ntn;
  int k0 = kt * 64, n0 = nt * 64;
  int c = tidx() & 63, q = tidx() >> 6;
#pragma unroll 4
  for (int i = 0; i < 16; i++) {
    int kk = i * 4 + q, n = n0 + c;
    float v = 0.f;
    if (n < N) { int sn = perm ? ((n & 511) >> 6) * 128 + (n >> 9) * 64 + (n & 63) : n; v = src[(size_t)(k0 + kk) * N + sn]; if (gain) v *= gain[k0 + kk]; }
    tile[kk * 65 + c] = v;
  }
  __syncthreads();
#pragma unroll 4
  for (int i = 0; i < 16; i++) {
    int nn = i * 4 + q;
    dst[(size_t)(n0 + nn) * K + k0 + c] = f2bf(tile[c * 65 + nn]);
  }
  __syncthreads();
}

DI void phase_s0(const Params& p, char* smem) {
  const int per_layer = 576 + 256 + 1024 + 1024 + 48 + 32;
  const int n_conv = 2 * per_layer, n_mod = 2 * 96, n_tw = 32 + 6, n_cp = 1024;
  const int total = n_conv + n_mod + n_tw + n_cp;
  for (int it = blockIdx.x; it < total; it += gridDim.x) {
    if (it < n_conv) {
      int l = it / per_layer, r = it - l * per_layer;
      char* wl = p.ws + OFF_W + (size_t)l * WL_SIZE;
      float* tile = (float*)smem;
      if (r < 576) convT_item(p.in[I_WIN] + (size_t)l * 1024 * NIN, (u16*)(wl + WL_WIN), 1024, NIN, NINP, nullptr, r, tile);
      else if ((r -= 576) < 256) convT_item(p.in[I_WOUT] + (size_t)l * 1024 * 1024, (u16*)(wl + WL_WOUT), 1024, 1024, 1024, nullptr, r, tile);
      else if ((r -= 256) < 1024) convT_item(p.in[I_W1] + (size_t)l * 1024 * 4096, (u16*)(wl + WL_W1), 1024, 4096, 4096, nullptr, r, tile);
      else if ((r -= 1024) < 1024) convT_item(p.in[I_W2] + (size_t)l * 4096 * 1024, (u16*)(wl + WL_W2), 4096, 1024, 1024, nullptr, r, tile);
      else if ((r -= 1024) < 48) convT_item(p.in[I_WUQ] + (size_t)l * 256 * 768, (u16*)(wl + WL_WUQ), 256, 768, 768, p.in[I_QNG] + l * 256, r, tile);
      else { r -= 48; convT_item(p.in[I_WUKV] + (size_t)l * 128 * 1024, (u16*)(wl + WL_WUKV), 128, 1024, 1024, p.in[I_KVNG] + l * 128, r, tile, true); }
    } else if (it < n_conv + n_mod) {
      int r = it - n_conv;
      int l = r / 96, n0 = (r - l * 96) * 64;
      float* sc = (float*)smem;
      float* red = sc + 5120;
      for (int i = tidx(); i < 5120; i += 256) {
        int rr = i >> 10, k = i & 1023;
        float cv = rr < 4 ? p.in[I_C][rr * 1024 + k] : p.in[I_CCTX][k];
        sc[i] = cv / (1.f + expf(-cv));
      }
      __syncthreads();
      int nn = tidx() & 63, kq = tidx() >> 6;
      float a0 = 0, a1 = 0, a2 = 0, a3 = 0, a4 = 0;
      const float* w = p.in[I_WADA] + ((size_t)l * 1024 + kq * 256) * 6144 + n0 + nn;
#pragma unroll 8
      for (int k = 0; k < 256; k++) {
        float wv = w[(size_t)k * 6144];
        int kk = kq * 256 + k;
        a0 += sc[kk] * wv; a1 += sc[1024 + kk] * wv; a2 += sc[2048 + kk] * wv; a3 += sc[3072 + kk] * wv; a4 += sc[4096 + kk] * wv;
      }
      red[(kq * 5 + 0) * 64 + nn] = a0; red[(kq * 5 + 1) * 64 + nn] = a1; red[(kq * 5 + 2) * 64 + nn] = a2;
      red[(kq * 5 + 3) * 64 + nn] = a3; red[(kq * 5 + 4) * 64 + nn] = a4;
      __syncthreads();
      if (tidx() < 64) {
        float* mod = (float*)(p.ws + OFF_MOD);
        float bb = p.in[I_BADA][l * 6144 + n0 + nn];
        for (int rr = 0; rr < 5; rr++) {
          float s = red[(0 * 5 + rr) * 64 + nn] + red[(1 * 5 + rr) * 64 + nn] + red[(2 * 5 + rr) * 64 + nn] + red[(3 * 5 + rr) * 64 + nn];
          mod[(size_t)(l * 5 + rr) * 6144 + n0 + nn] = s + bb;
        }
      }
      __syncthreads();
    } else if (it >= n_conv + n_mod + n_tw) {
      int e = (it - n_conv - n_mod - n_tw) * 256 + tidx();
      ((float4*)(p.ws + OFF_XC))[e] = ((const float4*)p.in[I_CTX])[e];
    } else {
      int q = it - n_conv - n_mod;
      if (q < 32) {
        int n = q * 256 + tidx();
        float sn, cs;
        sincospif((float)n / 8192.f, &sn, &cs);
        ((float2*)(p.ws + OFF_TW))[n] = make_float2(cs, -sn);
      } else {
        int e = (q - 32) * 256 + tidx();
        int pos = e >> 3, f = e & 7;
        float pv = pos < 128 ? (float)pos : (float)(pos - 128);
        float inv = powf(10000.f, -(float)f / 8.f);
        float sn, cs;
        sincosf(pv * inv, &sn, &cs);
        ((float2*)(p.ws + OFF_ROPE))[e] = make_float2(cs, sn);
      }
    }
  }
}

DI void filt_a_item(const Params& p, int l, int Lf, float* h2out, int pos) {
  int lane = tidx() & 63;
  float tpos = (float)pos / (float)(Lf - 1);
  float zval = 0.f;
  if (lane == 0) zval = tpos;
  else if (lane < 33) {
    int jj = (lane - 1) & 15;
    float band = 1e-4f + (float)jj * ((15.f - 1e-4f) / 15.f);
    float ang = ((float)(6.283185307179586 / (double)Lf)) * (float)pos * band;
    zval = lane < 17 ? cosf(ang) : -sinf(ang);
  }
  const float* w1 = p.in[I_HW1] + l * 33 * 64;
  const float* w2 = p.in[I_HW2] + l * 64 * 64;
  float acc = p.in[I_HB1][l * 64 + lane];
  for (int i = 0; i < 33; i++) acc += __shfl(zval, i) * w1[i * 64 + lane];
  float h1 = sinf(p.in[I_HSF][l * 128 + lane] * acc);
  float acc2 = p.in[I_HB2][l * 64 + lane];
  for (int i = 0; i < 64; i++) acc2 += __shfl(h1, i) * w2[i * 64 + lane];
  h2out[(size_t)pos * 64 + lane] = sinf(p.in[I_HSF][l * 128 + 64 + lane] * acc2);
}

DI void phase_norm(const Params& p, int l, int which, int nrows, bool with_filter) {
  const int lane = tidx() & 63, wid = tidx() >> 6;
  const bool first = (l == 0 && which == 1);
  const int n_norm = nrows >> 3;
  const int n_fa = with_filter ? (8192 / 4 + (l == 0 ? 256 / 4 : 0)) : 0;
  const float* gsrc = p.in[which == 1 ? I_N1G : I_N2G] + l * 1024;
  u16* H = (u16*)(p.ws + OFF_H);
  for (int it = blockIdx.x; it < n_norm + n_fa; it += gridDim.x) {
    if (it < n_norm) {
      int row = it * 8 + wid * 2;
      const float* src;
      int cond;
      if (row < TLAT) { src = (first ? p.in[I_X] : p.out) + (size_t)row * 1024; cond = row >> 13; }
      else { src = (first ? p.in[I_CTX] : (const float*)(p.ws + OFF_XC)) + (size_t)(row - TLAT) * 1024; cond = 4; }
      const float* m = (const float*)(p.ws + OFF_MOD) + (size_t)(l * 5 + cond) * 6144 + (which == 1 ? 0 : 3072);
      float4 v[8];
      float ssq0 = 0.f, ssq1 = 0.f;
#pragma unroll
      for (int i = 0; i < 4; i++) {
        v[i] = *(const float4*)(src + i * 256 + lane * 4);
        v[4 + i] = *(const float4*)(src + 1024 + i * 256 + lane * 4);
      }
#pragma unroll
      for (int i = 0; i < 4; i++) {
        ssq0 += v[i].x * v[i].x + v[i].y * v[i].y + v[i].z * v[i].z + v[i].w * v[i].w;
        ssq1 += v[4 + i].x * v[4 + i].x + v[4 + i].y * v[4 + i].y + v[4 + i].z * v[4 + i].z + v[4 + i].w * v[4 + i].w;
      }
      ssq0 = wave_sum(ssq0); ssq1 = wave_sum(ssq1);
      float rstd0 = rsqrtf(ssq0 * (1.f / 1024.f) + 1e-6f), rstd1 = rsqrtf(ssq1 * (1.f / 1024.f) + 1e-6f);
#pragma unroll
      for (int i = 0; i < 4; i++) {
        int col = i * 256 + lane * 4;
        float4 g = *(const float4*)(gsrc + col), sh = *(const float4*)(m + col), sc = *(const float4*)(m + 1024 + col);
        float gx = g.x * (1.f + sc.x), gy = g.y * (1.f + sc.y), gz = g.z * (1.f + sc.z), gw = g.w * (1.f + sc.w);
        *(uint2*)(H + (size_t)row * 1024 + col) = make_uint2(pack2(v[i].x * rstd0 * gx + sh.x, v[i].y * rstd0 * gy + sh.y),
                                                             pack2(v[i].z * rstd0 * gz + sh.z, v[i].w * rstd0 * gw + sh.w));
        *(uint2*)(H + (size_t)(row + 1) * 1024 + col) = make_uint2(pack2(v[4 + i].x * rstd1 * gx + sh.x, v[4 + i].y * rstd1 * gy + sh.y),
                                                                   pack2(v[4 + i].z * rstd1 * gz + sh.z, v[4 + i].w * rstd1 * gw + sh.w));
      }
    } else {
      int q = it - n_norm;
      if (q < 2048) filt_a_item(p, l, 8192, (float*)(p.ws + OFF_H2F), q * 4 + wid);
      else filt_a_item(p, l, 256, (float*)(p.ws + OFF_H2C), (q - 2048) * 4 + wid);
    }
  }
}

constexpr int GLD = 40;
constexpr int GBUF = (256 + 128) * GLD;
template <bool ROWNORM, bool TR0, bool TR1, int OUT, class Epi, class DF>
DI void gemm_tile(const u16* __restrict__ A, int lda, const u16* __restrict__ Bt, int ldb, int K, int m0, int n0,
                  const u16* __restrict__ at_src, int at_kt, char* smem, Epi epi, DF df) {
  u16* Ls = (u16*)smem;
  float* rs = (float*)(smem + 69632);
  int tid_o = tidx();
  const int tid = tid_o, lane = tid & 63, wid = tid >> 6, wm = wid >> 1, wn = wid & 1, r = lane & 31, h = lane >> 5;
  const bool trans = (TR0 == TR1) ? TR0 : (wn ? TR1 : TR0);
  f32x16 acc[4][2];
#pragma unroll
  for (int mi = 0; mi < 4; mi++)
#pragma unroll
    for (int ni = 0; ni < 2; ni++)
#pragma unroll
      for (int e = 0; e < 16; e++) acc[mi][ni][e] = 0.f;
  u32x4 ra0[4], rb0[2], ra1[4], rb1[2];
  float ssq[4];
#pragma unroll
  for (int i = 0; i < 4; i++) ssq[i] = 0.f;
  const int nk = K >> 5;
  const int lrow = tid >> 2, lkc = tid & 3;
  const int tch = tid & 31, ttc = tid >> 5;
  const bool has_at = at_src != nullptr;
#define GEMM_GLOAD(KT, RA, RB)                                                                                              \
  {                                                                                                                         \
    const int kt_ = (KT);                                                                                                   \
    if (has_at && kt_ < at_kt) {                                                                                            \
      _Pragma("unroll") for (int i = 0; i < 4; i++) RA[i] = *(const u32x4*)(at_src + (size_t)(kt_ * 32 + tch) * 8192 + (ttc + 8 * i) * 8); \
    } else {                                                                                                                \
      _Pragma("unroll") for (int i = 0; i < 4; i++) RA[i] = *(const u32x4*)(A + (size_t)(m0 + lrow + 64 * i) * lda + kt_ * 32 + lkc * 8);  \
    }                                                                                                                       \
    _Pragma("unroll") for (int i = 0; i < 2; i++) RB[i] = *(const u32x4*)(Bt + (size_t)(n0 + lrow + 64 * i) * ldb + kt_ * 32 + lkc * 8);   \
  }
#define GEMM_LWRITE(KT, RA, RB)                                                                                             \
  {                                                                                                                         \
    const int kt_ = (KT);                                                                                                   \
    u16* As_ = Ls + (kt_ & 1) * GBUF;                                                                                       \
    u16* Bs_ = As_ + 256 * GLD;                                                                                             \
    if (has_at && kt_ < at_kt) {                                                                                            \
      _Pragma("unroll") for (int i = 0; i < 4; i++)                                                                         \
        _Pragma("unroll") for (int j = 0; j < 8; j++) As_[((ttc + 8 * i) * 8 + j) * GLD + tch] = bfu(RA[i], j);             \
    } else {                                                                                                                \
      _Pragma("unroll") for (int i = 0; i < 4; i++) *(u32x4*)(As_ + (lrow + 64 * i) * GLD + lkc * 8) = RA[i];               \
    }                                                                                                                       \
    _Pragma("unroll") for (int i = 0; i < 2; i++) *(u32x4*)(Bs_ + (lrow + 64 * i) * GLD + lkc * 8) = RB[i];                 \
    if (ROWNORM) {                                                                                                          \
      _Pragma("unroll") for (int i = 0; i < 4; i++)                                                                         \
        _Pragma("unroll") for (int j = 0; j < 8; j++) { float x = bfe(RA[i], j); ssq[i] += x * x; }                         \
    }                                                                                                                       \
  }
#define GEMM_COMPUTE(KT)                                                                                                    \
  {                                                                                                                         \
    const u16* As = Ls + ((KT) & 1) * GBUF;                                                                                 \
    const u16* Bs = As + 256 * GLD;                                                                                         \
    _Pragma("unroll") for (int ks = 0; ks < 2; ks++) {                                                                      \
      __builtin_amdgcn_sched_barrier(0);                                                                                    \
      bf16x8 a[4], b[2];                                                                                                    \
      _Pragma("unroll") for (int mi = 0; mi < 4; mi++) a[mi] = *(const bf16x8*)(As + (wm * 128 + mi * 32 + r) * GLD + ks * 16 + h * 8); \
      _Pragma("unroll") for (int ni = 0; ni < 2; ni++) b[ni] = *(const bf16x8*)(Bs + (wn * 64 + ni * 32 + r) * GLD + ks * 16 + h * 8);  \
      __builtin_amdgcn_s_setprio(1);                                                                                        \
      if (!trans) {                                                                                                         \
        _Pragma("unroll") for (int mi = 0; mi < 4; mi++)                                                                    \
          _Pragma("unroll") for (int ni = 0; ni < 2; ni++) acc[mi][ni] = MFMA32(a[mi], b[ni], acc[mi][ni]);                 \
      } else {                                                                                                              \
        _Pragma("unroll") for (int mi = 0; mi < 4; mi++)                                                                    \
          _Pragma("unroll") for (int ni = 0; ni < 2; ni++) acc[mi][ni] = MFMA32(b[ni], a[mi], acc[mi][ni]);                 \
      }                                                                                                                     \
      __builtin_amdgcn_s_setprio(0);                                                                                        \
    }                                                                                                                       \
  }
  GEMM_GLOAD(0, ra0, rb0)
  GEMM_GLOAD(1, ra1, rb1)
  GEMM_LWRITE(0, ra0, rb0)
  __syncthreads();
  for (int kt = 0; kt < nk; kt += 2) {
    GEMM_LWRITE(kt + 1, ra1, rb1)
    if (kt + 2 < nk) { GEMM_GLOAD(kt + 2, ra0, rb0) GEMM_GLOAD(kt + 3, ra1, rb1) }
    GEMM_COMPUTE(kt)
    __syncthreads();
    if (kt + 2 < nk) GEMM_LWRITE(kt + 2, ra0, rb0)
    GEMM_COMPUTE(kt + 1)
    __syncthreads();
  }
#undef GEMM_COMPUTE
#undef GEMM_GLOAD
#undef GEMM_LWRITE
  if (ROWNORM) {
    float* rsp = (float*)smem;
    {
      const int t2 = tidx();
#pragma unroll
      for (int i = 0; i < 4; i++) rsp[((t2 >> 2) + 64 * i) * 4 + (t2 & 3)] = ssq[i];
    }
    __syncthreads();
    {
      const int t3 = tidx();
      float4 q = *(const float4*)(rsp + t3 * 4);
      rs[t3] = rsqrtf((q.x + q.y + q.z + q.w) / (float)K + 1e-6f);
    }
    __syncthreads();
  }
  if constexpr (OUT == 0) {
#define EPI_CALL(mi, ni) epi(m0 + wm * 128 + (mi) * 32, n0 + wn * 64 + (ni) * 32, acc[mi][ni], rs);
    EPI_CALL(0, 0) EPI_CALL(0, 1) EPI_CALL(1, 0) EPI_CALL(1, 1) EPI_CALL(2, 0) EPI_CALL(2, 1) EPI_CALL(3, 0) EPI_CALL(3, 1)
#undef EPI_CALL
    __syncthreads();
  } else if constexpr (OUT == 1) {
    u16* S = (u16*)smem;
#define EPI_STAGE(mi, ni)                                                                                                   \
    _Pragma("unroll") for (int reg = 0; reg < 16; reg++) {                                                                   \
      int lr = wm * 128 + (mi) * 32 + crow(reg, h), lc = wn * 64 + (ni) * 32 + r;                                           \
      S[lr * 136 + lc] = f2bf(epi(m0 + lr, n0 + lc, acc[mi][ni][reg], rs));                                                 \
    }
    EPI_STAGE(0, 0) EPI_STAGE(0, 1) EPI_STAGE(1, 0) EPI_STAGE(1, 1) EPI_STAGE(2, 0) EPI_STAGE(2, 1) EPI_STAGE(3, 0) EPI_STAGE(3, 1)
#undef EPI_STAGE
    __syncthreads();
    {
      const int t2 = tidx();
#pragma unroll 4
      for (int i = 0; i < 16; i++) {
        int id = t2 + 256 * i, lr = id >> 4, c = id & 15;
        u16* d = df(m0 + lr, n0 + c * 8);
        if (d) *(u32x4*)d = *(const u32x4*)(S + lr * 136 + c * 8);
      }
    }
    __syncthreads();
  } else if constexpr (OUT == 2) {
    u16* S = (u16*)smem;
#define EPI_STAGE(mi, ni)                                                                                                   \
    _Pragma("unroll") for (int reg = 0; reg < 16; reg++) {                                                                   \
      int lr = wm * 128 + (mi) * 32 + r, lc = wn * 64 + (ni) * 32 + crow(reg, h);                                           \
      S[lc * 264 + lr] = f2bf(epi(m0 + lr, n0 + lc, acc[mi][ni][reg], rs));                                                 \
    }
    EPI_STAGE(0, 0) EPI_STAGE(0, 1) EPI_STAGE(1, 0) EPI_STAGE(1, 1) EPI_STAGE(2, 0) EPI_STAGE(2, 1) EPI_STAGE(3, 0) EPI_STAGE(3, 1)
#undef EPI_STAGE
    __syncthreads();
    {
      const int t2 = tidx();
#pragma unroll 4
      for (int i = 0; i < 16; i++) {
        int id = t2 + 256 * i, lc = id >> 5, t8 = id & 31;
        u16* d = df(m0 + t8 * 8, n0 + lc);
        if (d) *(u32x4*)d = *(const u32x4*)(S + lc * 264 + t8 * 8);
      }
    }
    __syncthreads();
  } else {
    float* S = (float*)smem;
#pragma unroll
    for (int pass = 0; pass < 2; pass++) {
      if (wm == pass) {
#define EPI_STAGE(mi, ni)                                                                                                   \
        _Pragma("unroll") for (int reg = 0; reg < 16; reg++) S[((mi) * 32 + crow(reg, h)) * 132 + wn * 64 + (ni) * 32 + r] = acc[mi][ni][reg];
        EPI_STAGE(0, 0) EPI_STAGE(0, 1) EPI_STAGE(1, 0) EPI_STAGE(1, 1) EPI_STAGE(2, 0) EPI_STAGE(2, 1) EPI_STAGE(3, 0) EPI_STAGE(3, 1)
#undef EPI_STAGE
      }
      __syncthreads();
      {
        const int t2 = tidx();
#pragma unroll 4
        for (int i = 0; i < 16; i++) {
          int id = t2 + 256 * i, lr = id >> 5, c4 = id & 31;
          float4 a = *(const float4*)(S + lr * 132 + c4 * 4);
          df(m0 + pass * 128 + lr, n0 + c4 * 4, a);
        }
      }
      __syncthreads();
    }
  }
}

DI void phase_win(const Params& p, int l, char* smem) {
  const u16* H = (const u16*)(p.ws + OFF_H);
  const u16* W = (const u16*)(p.ws + OFF_W + (size_t)l * WL_SIZE + WL_WIN);
  u16* UT = (u16*)(p.ws + OFF_UT);
  u16* UTC = (u16*)(p.ws + OFF_UTC);
  u16* RET = (u16*)(p.ws + OFF_RET);
  u16* CQ = (u16*)(p.ws + OFF_CQ);
  u16* CKV = (u16*)(p.ws + OFF_CKV);
  u16* KF = (u16*)(p.ws + OFF_KF);
  const int lane = tidx() & 63, r = lane & 31, h = lane >> 5;
  const int total = 132 * 18;
  for (int it = blockIdx.x; it < total; it += gridDim.x) {
    int mt = it / 18, nt = it - mt * 18;
    int m0 = mt * 256, n0 = nt * 128;
    if (nt < 6) {
      gemm_tile<false, true, true, 2>(H, 1024, W, 1024, 1024, m0, n0, nullptr, 0, smem,
        [&](int row, int col, float v, const float*) __attribute__((always_inline)) { return v; },
        [&](int row, int col) __attribute__((always_inline)) -> u16* {
          int b, t, key, cond;
          row_info(row, b, t, key, cond);
          return row < TLAT ? UT + ((size_t)(b * 768 + col)) * SEQ + t : UTC + ((size_t)(b * 768 + col)) * LCTX + t;
        });
    } else {
      if (nt < 17) {
        gemm_tile<false, false, false, 1>(H, 1024, W, 1024, 1024, m0, n0, nullptr, 0, smem,
          [&](int row, int col, float v, const float*) __attribute__((always_inline)) {
            return (col >= 768 + 256 && col < 768 + 512) ? v * 0.125f : v;
          },
          [&](int row, int col) __attribute__((always_inline)) -> u16* {
            if (nt < 14) return RET + (size_t)row * 1024 + (col - 768);
            if (nt < 16) return CQ + (size_t)row * 256 + (col - 1792);
            return CKV + (size_t)row * 128 + (col - 2048);
          });
      } else {
        gemm_tile<false, false, false, 0>(H, 1024, W, 1024, 1024, m0, n0, nullptr, 0, smem,
          [&](int bm, int bn, const f32x16& acc, const float*) __attribute__((always_inline)) {
            const int lz_ = tidx() & 63, r = lz_ & 31, h = lz_ >> 5;
            if (bn == 2176) {
#pragma unroll
              for (int reg = 0; reg < 16; reg++) {
                int row = bm + crow(reg, h), b, t, key, cond;
                row_info(row, b, t, key, cond);
                float v = acc[reg];
                float vr = rope_apply((const float2*)(p.ws + OFF_ROPE), v, r, t);
                if (row < TLAT) v = vr;
                u16 o = f2bf(v);
#pragma unroll
                for (int hh = 0; hh < 8; hh++) KF[((size_t)(b * 8 + hh) * LKEY + key) * 96 + 64 + r] = o;
              }
            }
          }, [](int, int) __attribute__((always_inline)) -> u16* { return nullptr; });
      }
    }
  }
}

DI void ret_gammas(const Params& p, int l, int hh, float& lgf, float& lgb) {
  lgf = log1pf(-expf(p.in[I_RLD][l * 8 + hh]));
  lgb = log1pf(-expf(p.in[I_RLD][l * 8 + 4 + hh]));
}
DI void ret_kv_item(const Params& p, int l, int b, int hh, int ci, char* smem) {
  const u16* RET = (const u16*)(p.ws + OFF_RET);
  float* ST = (float*)(p.ws + OFF_ST);
  u16* KfT = (u16*)smem;
  u16* KbT = KfT + 64 * 136;
  u16* VsT = KbT + 64 * 136;
  int tid_o = tidx();
  asm volatile("" : "+v"(tid_o));
  const int tid = tid_o, lane = tid & 63, wid = tid >> 6, r = lane & 31, h = lane >> 5;
  float lgf, lgb;
  ret_gammas(p, l, hh, lgf, lgb);
  const int row0 = chunk_row0(b, ci);
#pragma unroll
  for (int i = 0; i < 4; i++) {
    int id = tid + 256 * i, m = id >> 3, dc = id & 7;
    u32x4 kv = *(const u32x4*)(RET + (size_t)(row0 + m) * 1024 + 256 + hh * 64 + dc * 8);
    u32x4 vv = *(const u32x4*)(RET + (size_t)(row0 + m) * 1024 + 512 + hh * 64 + dc * 8);
    float zf = __expf(lgf * (float)(127 - m)), zb = __expf(lgb * (float)m);
#pragma unroll
    for (int j = 0; j < 8; j++) {
      float kval = bfe(kv, j);
      KfT[(dc * 8 + j) * 136 + m] = f2bf(kval * zf);
      KbT[(dc * 8 + j) * 136 + m] = f2bf(kval * zb);
      VsT[(dc * 8 + j) * 136 + m] = bfu(vv, j);
    }
  }
  __syncthreads();
  const int dir = wid >> 1, dh = wid & 1;
  const u16* Asrc = dir ? KbT : KfT;
  f32x16 c0, c1;
#pragma unroll
  for (int e = 0; e < 16; e++) { c0[e] = 0.f; c1[e] = 0.f; }
#pragma unroll
  for (int ks = 0; ks < 8; ks++) {
    bf16x8 a = *(const bf16x8*)(Asrc + (dh * 32 + r) * 136 + ks * 16 + h * 8);
    bf16x8 b0 = *(const bf16x8*)(VsT + (r) * 136 + ks * 16 + h * 8);
    bf16x8 b1 = *(const bf16x8*)(VsT + (32 + r) * 136 + ks * 16 + h * 8);
    c0 = MFMA32(a, b0, c0);
    c1 = MFMA32(a, b1, c1);
  }
  float* dst = ST + ((size_t)((dir * 4 + b) * 4 + hh) * NCH + ci) * 4096;
#pragma unroll
  for (int reg = 0; reg < 16; reg++) {
    int d = dh * 32 + crow(reg, h);
    dst[d * 64 + r] = c0[reg];
    dst[d * 64 + 32 + r] = c1[reg];
  }
  __syncthreads();
}

#define PX(i) ((i) + ((i) >> 4))
typedef float cf2 __attribute__((ext_vector_type(2)));
DI cf2 mk2(float x, float y) { cf2 r; r.x = x; r.y = y; return r; }
DI cf2 cmul(cf2 a, cf2 b) { return mk2(a.x * b.x - a.y * b.y, a.x * b.y + a.y * b.x); }
DI cf2 cmulc(cf2 a, cf2 b) { return mk2(a.x * b.x + a.y * b.y, a.y * b.x - a.x * b.y); }
DI cf2 cadd(cf2 a, cf2 b) { return mk2(a.x + b.x, a.y + b.y); }
DI cf2 csub(cf2 a, cf2 b) { return mk2(a.x - b.x, a.y - b.y); }
DI cf2 twid_rev(float rev) { return mk2(__builtin_amdgcn_cosf(rev), -__builtin_amdgcn_sinf(rev)); }

template <int S, bool INV>
DI void fft_pass8(float2* Xf2, int tid) {
  cf2* X = (cf2*)Xf2;
  constexpr int span = 8192 >> S, q = span >> 3, lq = 10 - S;
  const float R = 0.70710678118654752f;
#pragma unroll 2
  for (int gi = 0; gi < 4; gi++) {
    int g = tid + 256 * gi;
    int j = g & (q - 1), blk = g >> lq, base = blk * span + j;
    cf2 v[8];
#pragma unroll
    for (int k = 0; k < 8; k++) v[k] = X[PX(base + k * q)];
    cf2 W = twid_rev((float)j * (1.f / (float)span));
    cf2 W2 = cmul(W, W), W4 = cmul(W2, W2);
    cf2 w1 = cmul(W, mk2(R, -R)), w2 = mk2(W.y, -W.x), w3 = cmul(W, mk2(-R, -R));
    cf2 w2b = mk2(W2.y, -W2.x);
    if (!INV) {
      { cf2 a, d;
        a = v[0]; d = csub(a, v[4]); v[0] = cadd(a, v[4]); v[4] = cmul(d, W);
        a = v[1]; d = csub(a, v[5]); v[1] = cadd(a, v[5]); v[5] = cmul(d, w1);
        a = v[2]; d = csub(a, v[6]); v[2] = cadd(a, v[6]); v[6] = cmul(d, w2);
        a = v[3]; d = csub(a, v[7]); v[3] = cadd(a, v[7]); v[7] = cmul(d, w3); }
#pragma unroll
      for (int b4 = 0; b4 < 8; b4 += 4) { cf2 a, d;
        a = v[b4]; d = csub(a, v[b4 + 2]); v[b4] = cadd(a, v[b4 + 2]); v[b4 + 2] = cmul(d, W2);
        a = v[b4 + 1]; d = csub(a, v[b4 + 3]); v[b4 + 1] = cadd(a, v[b4 + 3]); v[b4 + 3] = cmul(d, w2b); }
#pragma unroll
      for (int k = 0; k < 8; k += 2) { cf2 a = v[k], d = csub(a, v[k + 1]); v[k] = cadd(a, v[k + 1]); v[k + 1] = cmul(d, W4); }
    } else {
#pragma unroll
      for (int k = 0; k < 8; k += 2) { cf2 a = v[k], bb = cmulc(v[k + 1], W4); v[k] = cadd(a, bb); v[k + 1] = csub(a, bb); }
#pragma unroll
      for (int b4 = 0; b4 < 8; b4 += 4) { cf2 a, bb;
        a = v[b4]; bb = cmulc(v[b4 + 2], W2); v[b4] = cadd(a, bb); v[b4 + 2] = csub(a, bb);
        a = v[b4 + 1]; bb = cmulc(v[b4 + 3], w2b); v[b4 + 1] = cadd(a, bb); v[b4 + 3] = csub(a, bb); }
      { cf2 a, bb;
        a = v[0]; bb = cmulc(v[4], W); v[0] = cadd(a, bb); v[4] = csub(a, bb);
        a = v[1]; bb = cmulc(v[5], w1); v[1] = cadd(a, bb); v[5] = csub(a, bb);
        a = v[2]; bb = cmulc(v[6], w2); v[2] = cadd(a, bb); v[6] = csub(a, bb);
        a = v[3]; bb = cmulc(v[7], w3); v[3] = cadd(a, bb); v[7] = csub(a, bb); }
    }
#pragma unroll
    for (int k = 0; k < 8; k++) X[PX(base + k * q)] = v[k];
  }
  __syncthreads();
}

DI cf2 t16f(int k) {
  const float C1 = 0.92387953251128674f, S1 = 0.38268343236508977f, R = 0.70710678118654752f;
  return k == 0 ? mk2(1.f, 0.f) : k == 1 ? mk2(C1, -S1) : k == 2 ? mk2(R, -R) : k == 3 ? mk2(S1, -C1) : k == 4 ? mk2(0.f, -1.f)
       : k == 5 ? mk2(-S1, -C1) : k == 6 ? mk2(-R, -R) : mk2(-C1, -S1);
}
template <bool INV>
DI void fft_pass16(float2* Xf2, int tid) {
  cf2* X = (cf2*)Xf2;
#pragma unroll 1
  for (int gi = 0; gi < 2; gi++) {
    int g = tid + 256 * gi;
    cf2* xp = X + 17 * g;
    cf2 v[16];
#pragma unroll
    for (int k = 0; k < 16; k++) v[k] = xp[k];
    if (!INV) {
#pragma unroll
      for (int k = 0; k < 8; k++) { cf2 a = v[k], d = csub(a, v[k + 8]); v[k] = cadd(a, v[k + 8]); v[k + 8] = cmul(d, t16f(k)); }
#pragma unroll
      for (int b8 = 0; b8 < 16; b8 += 8)
#pragma unroll
        for (int k = 0; k < 4; k++) { cf2 a = v[b8 + k], d = csub(a, v[b8 + k + 4]); v[b8 + k] = cadd(a, v[b8 + k + 4]); v[b8 + k + 4] = cmul(d, t16f(2 * k)); }
#pragma unroll
      for (int b4 = 0; b4 < 16; b4 += 4)
#pragma unroll
        for (int k = 0; k < 2; k++) { cf2 a = v[b4 + k], d = csub(a, v[b4 + k + 2]); v[b4 + k] = cadd(a, v[b4 + k + 2]); v[b4 + k + 2] = cmul(d, t16f(4 * k)); }
#pragma unroll
      for (int k = 0; k < 16; k += 2) { cf2 a = v[k], bb = v[k + 1]; v[k] = cadd(a, bb); v[k + 1] = csub(a, bb); }
    } else {
#pragma unroll
      for (int k = 0; k < 16; k += 2) { cf2 a = v[k], bb = v[k + 1]; v[k] = cadd(a, bb); v[k + 1] = csub(a, bb); }
#pragma unroll
      for (int b4 = 0; b4 < 16; b4 += 4)
#pragma unroll
        for (int k = 0; k < 2; k++) { cf2 a = v[b4 + k], bb = cmulc(v[b4 + k + 2], t16f(4 * k)); v[b4 + k] = cadd(a, bb); v[b4 + k + 2] = csub(a, bb); }
#pragma unroll
      for (int b8 = 0; b8 < 16; b8 += 8)
#pragma unroll
        for (int k = 0; k < 4; k++) { cf2 a = v[b8 + k], bb = cmulc(v[b8 + k + 4], t16f(2 * k)); v[b8 + k] = cadd(a, bb); v[b8 + k + 4] = csub(a, bb); }
#pragma unroll
      for (int k = 0; k < 8; k++) { cf2 a = v[k], bb = cmulc(v[k + 8], t16f(k)); v[k] = cadd(a, bb); v[k + 8] = csub(a, bb); }
    }
#pragma unroll
    for (int k = 0; k < 16; k++) xp[k] = v[k];
  }
  __syncthreads();
}
DI void fft_dif(float2* X, const float2* __restrict__, int tid) {
  fft_pass8<0, false>(X, tid); fft_pass8<3, false>(X, tid); fft_pass8<6, false>(X, tid); fft_pass16<false>(X, tid);
}
DI void fft_dit(float2* X, const float2* __restrict__, int tid) {
  fft_pass16<true>(X, tid); fft_pass8<6, true>(X, tid); fft_pass8<3, true>(X, tid); fft_pass8<0, true>(X, tid);
}

DI void filt_fft_item(const Params& p, int l, int o, int c, char* smem) {
  float2* X = (float2*)smem;
  float* Xf = (float*)smem;
  float* w3s = (float*)(smem + 69632);
  float* red = w3s + 128;
  const float2* TW = (const float2*)(p.ws + OFF_TW);
  const float* H2 = (const float*)(p.ws + OFF_H2F);
  float2* KS = (float2*)(p.ws + OFF_KSPEC) + (size_t)(o * 256 + c) * 2 * 8192;
  int tid_o = tidx();
  asm volatile("" : "+v"(tid_o));
  const int tid = tid_o;
  if (tid < 128) { int j = tid & 63, side = tid >> 6; w3s[tid] = p.in[I_HW3][((size_t)l * 64 + j) * 1024 + side * 512 + o * 256 + c]; }
  __syncthreads();
  const float min_decay = -3.0701134573253944f, max_decay = -15.350567286626972f;
  const float delta = fabsf(min_decay + (float)c * ((max_decay - min_decay) / 255.f));
  float* Ff = Xf;
  float* Fb = Xf + 8192;
#pragma unroll 1
  for (int i = 0; i < 32; i++) {
    int n = tid + 256 * i;
    const float4* hp = (const float4*)(H2 + (size_t)n * 64);
    float f = 0.f, bsum = 0.f;
#pragma unroll
    for (int q = 0; q < 16; q++) {
      float4 hv = hp[q];
      f += hv.x * w3s[q * 4] + hv.y * w3s[q * 4 + 1] + hv.z * w3s[q * 4 + 2] + hv.w * w3s[q * 4 + 3];
      bsum += hv.x * w3s[64 + q * 4] + hv.y * w3s[64 + q * 4 + 1] + hv.z * w3s[64 + q * 4 + 2] + hv.w * w3s[64 + q * 4 + 3];
    }
    float win = expf(-((float)n / 8191.f) * delta);
    Ff[n] = f * win; Fb[n] = bsum * win;
  }
  __syncthreads();
  float part = 0.f;
#pragma unroll 2
  for (int i = 0; i < 32; i++) {
    int n = tid + 256 * i;
    float k1 = Ff[n], k2 = 0.f;
    if (n == 0) k1 += Fb[0]; else k2 = Fb[8192 - n];
    part += fabsf(k1) + fabsf(k2);
    KS[8192 + n] = make_float2(k1, k2);
  }
  part = wave_sum(part);
  if ((tid & 63) == 0) red[tid >> 6] = part;
  __syncthreads();
  const float inv = 1.f / (red[0] + red[1] + red[2] + red[3]);
#pragma unroll 2
  for (int i = 0; i < 32; i++) { int n = tidx() + 256 * i; float2 kp = KS[8192 + n]; X[PX(n)] = make_float2((kp.x + kp.y) * inv, 0.f); }
  __syncthreads();
  fft_dif(X, TW, tid);
#pragma unroll 2
  for (int i = 0; i < 32; i++) { int n = tidx() + 256 * i; KS[n] = X[PX(n)]; }
  __syncthreads();
#pragma unroll 2
  for (int i = 0; i < 32; i++) { int n = tidx() + 256 * i; float2 w = TW[n]; float2 kp = KS[8192 + n]; float d = (kp.x - kp.y) * inv; X[PX(n)] = make_float2(d * w.x, d * w.y); }
  __syncthreads();
  fft_dif(X, TW, tid);
#pragma unroll 2
  for (int i = 0; i < 32; i++) { int n = tidx() + 256 * i; KS[8192 + n] = X[PX(n)]; }
  __syncthreads();
}

DI void filt_ctx_item(const Params& p, int l, int o, int c, char* smem) {
  float* red = (float*)smem;
  const float* H2 = (const float*)(p.ws + OFF_H2C);
  float* KC = (float*)(p.ws + OFF_KC) + (size_t)(o * 256 + c) * 512;
  int tid_o = tidx();
  asm volatile("" : "+v"(tid_o));
  const int n = tid_o;
  const float min_decay = -3.0701134573253944f, max_decay = -15.350567286626972f;
  const float delta = fabsf(min_decay + (float)c * ((max_decay - min_decay) / 255.f));
  float f = 0.f, bsum = 0.f;
  for (int j = 0; j < 64; j++) {
    float hv = H2[n * 64 + j];
    f += hv * p.in[I_HW3][((size_t)l * 64 + j) * 1024 + o * 256 + c];
    bsum += hv * p.in[I_HW3][((size_t)l * 64 + j) * 1024 + 512 + o * 256 + c];
  }
  float win = expf(-((float)n / 255.f) * delta);
  f *= win; bsum *= win;
  float part = n == 0 ? fabsf(f + bsum) : fabsf(f) + fabsf(bsum);
  part = wave_sum(part);
  __syncthreads();
  if ((n & 63) == 0) red[n >> 6] = part;
  __syncthreads();
  float inv = 1.f / (red[0] + red[1] + red[2] + red[3]);
  if (n == 0) { KC[256] = (f + bsum) * inv; KC[0] = 0.f; }
  else { KC[256 + n] = f * inv; KC[256 - n] = bsum * inv; }
  __syncthreads();
}

DI void phase_p3(const Params& p, int l, char* smem) {
  const int lane = tidx() & 63, r = lane & 31, h = lane >> 5;
  const int n_uq = (l == 0 ? 132 : 128) * 6, n_ukv = 132 * 8, n_r1 = 16 * NCH, n_ff = 512, n_fc = (l == 0 ? 512 : 0);
  const int total = n_uq + n_ukv + n_r1 + n_ff + n_fc;
  const char* wl = p.ws + OFF_W + (size_t)l * WL_SIZE;
  u16* Q = (u16*)(p.ws + OFF_Q);
  u16* KF = (u16*)(p.ws + OFF_KF);
  u16* VT = (u16*)(p.ws + OFF_VT);
  for (int it = blockIdx.x; it < total; it += gridDim.x) {
    int q = it;
    if (q < n_uq) {
      int mt = q / 6, nt = q - mt * 6;
      if (SUB_ON(0)) gemm_tile<true, false, false, 1>((const u16*)(p.ws + OFF_CQ), 256, (const u16*)(wl + WL_WUQ), 256, 256, mt * 256, nt * 128, nullptr, 0, smem,
        [&](int row, int col, float v, const float* rs) __attribute__((always_inline)) {
          const float qscale = 0.10206207261596577f * 1.4426950408889634f;
          v *= rs[row - mt * 256];
          if ((col % 96) >= 64) {
            int b, t, key, cond;
            row_info(row, b, t, key, cond);
            float vr = rope_apply((const float2*)(p.ws + OFF_ROPE), v, col & 31, t);
            if (row < TLAT) v = vr;
          }
          return v * qscale;
        },
        [&](int row, int col) __attribute__((always_inline)) -> u16* { return Q + (size_t)row * 768 + col; });
    } else if ((q -= n_uq) < n_ukv) {
      int mt = q >> 3, nt = q & 7;
      if (nt < 4) {
        if (SUB_ON(1)) gemm_tile<true, false, false, 1>((const u16*)(p.ws + OFF_CKV), 128, (const u16*)(wl + WL_WUKV), 128, 128, mt * 256, nt * 128, nullptr, 0, smem,
          [&](int row, int col, float v, const float* rs) __attribute__((always_inline)) { return v * rs[row - mt * 256]; },
          [&](int row, int col) __attribute__((always_inline)) -> u16* {
            int b, t, key, cond;
            row_info(row, b, t, key, cond);
            return KF + ((size_t)(b * 8 + (col >> 6)) * LKEY + key) * 96 + (col & 63);
          });
      } else {
        if (SUB_ON(1)) gemm_tile<true, true, true, 2>((const u16*)(p.ws + OFF_CKV), 128, (const u16*)(wl + WL_WUKV), 128, 128, mt * 256, nt * 128, nullptr, 0, smem,
          [&](int row, int col, float v, const float* rs) __attribute__((always_inline)) { return v * rs[row - mt * 256]; },
          [&](int row, int col) __attribute__((always_inline)) -> u16* {
            int b, t, key, cond;
            row_info(row, b, t, key, cond);
            return VT + ((size_t)(b * 8 + ((col - 512) >> 6)) * 64 + ((col - 512) & 63)) * LKEY + key;
          });
      }
    } else if ((q -= n_ukv) < n_r1) {
      int bh = q / NCH, ci = q - bh * NCH;
      if (SUB_ON(2)) ret_kv_item(p, l, bh >> 2, bh & 3, ci, smem);
    } else if ((q -= n_r1) < n_ff) {
      if (SUB_ON(3)) filt_fft_item(p, l, q >> 8, q & 255, smem);
    } else {
      q -= n_ff;
      if (SUB_ON(4)) filt_ctx_item(p, l, q >> 8, q & 255, smem);
    }
  }
}

DI void phase_scan(const Params& p, int l) {
  float* ST = (float*)(p.ws + OFF_ST);
  for (int idx = blockIdx.x * 256 + tidx(); idx < 2 * 16 * 4096; idx += gridDim.x * 256) {
    int dir = idx >> 16, bh = (idx >> 12) & 15, el = idx & 4095, hh = bh & 3;
    float* base = ST + (size_t)((dir * 16 + bh) * NCH) * 4096 + el;
    float lg = log1pf(-expf(p.in[I_RLD][l * 8 + dir * 4 + hh]));
    float gC = expf(lg * 128.f);
    float s = 0.f;
    if (dir == 0) {
      for (int ci = 0; ci < NCH; ci++) { float tmp = base[(size_t)ci * 4096]; base[(size_t)ci * 4096] = s; s = gC * s + tmp; }
    } else {
      for (int ci = 1; ci >= 0; ci--) { float tmp = base[(size_t)ci * 4096]; base[(size_t)ci * 4096] = s; s = gC * s + tmp; }
      for (int ci = NCH - 1; ci >= 2; ci--) { float tmp = base[(size_t)ci * 4096]; base[(size_t)ci * 4096] = s; s = gC * s + tmp; }
    }
  }
}

DI void attn_item(const Params& p, int b, int hh, int qrow0, int key0, int nkeys, char* smem) {
  u16* Ks = (u16*)smem;
  u16* Vs = Ks + 64 * 104;
  const u16* Q = (const u16*)(p.ws + OFF_Q);
  const u16* KF = (const u16*)(p.ws + OFF_KF);
  const u16* VT = (const u16*)(p.ws + OFF_VT);
  u16* MIX = (u16*)(p.ws + OFF_H);
  int tid_o = tidx();
  asm volatile("" : "+v"(tid_o));
  const int tid = tid_o, lane = tid & 63, wid = tid >> 6, r = lane & 31, h = lane >> 5;
  const int qrow = qrow0 + wid * 32 + r;
  bf16x8 qf[6];
#pragma unroll
  for (int ks = 0; ks < 6; ks++) qf[ks] = *(const bf16x8*)(Q + (size_t)qrow * 768 + hh * 96 + ks * 16 + h * 8);
  f32x16 o0, o1;
#pragma unroll
  for (int e = 0; e < 16; e++) { o0[e] = 0.f; o1[e] = 0.f; }
  float m = 0.f, lsum = 0.f;
  const u32x4* kbase = (const u32x4*)(KF + ((size_t)(b * 8 + hh) * LKEY + key0) * 96);
  const u16* vbase = VT + (size_t)(b * 8 + hh) * 64 * LKEY + key0;
  u32x4 rk[3], rv[2];
  const int nt = nkeys >> 6;
#define ATT_GLOAD(T)                                                                                                        \
  {                                                                                                                         \
    const int t_ = (T);                                                                                                     \
    _Pragma("unroll") for (int i = 0; i < 3; i++) rk[i] = kbase[(size_t)t_ * 768 + tid + 256 * i];                          \
    _Pragma("unroll") for (int i = 0; i < 2; i++) { int id = tid + 256 * i; rv[i] = *(const u32x4*)(vbase + (size_t)(id >> 3) * LKEY + t_ * 64 + (id & 7) * 8); } \
  }
#define ATT_LWRITE(T)                                                                                                       \
  {                                                                                                                         \
    u16* Kd = Ks + ((T) & 1) * (64 * 104 + 64 * 72);                                                                        \
    u16* Vd = Kd + 64 * 104;                                                                                                \
    _Pragma("unroll") for (int i = 0; i < 3; i++) { int id = tid + 256 * i; int kr = id / 12, c = id - kr * 12; *(u32x4*)(Kd + kr * 104 + c * 8) = rk[i]; } \
    _Pragma("unroll") for (int i = 0; i < 2; i++) { int id = tid + 256 * i; int c_ = id & 7; u16* vd_ = Vd + (id >> 3) * 72 + (c_ >> 1) * 16 + (c_ & 1) * 4; \
      *(uint2*)(vd_) = make_uint2(rv[i].x, rv[i].y); *(uint2*)(vd_ + 8) = make_uint2(rv[i].z, rv[i].w); } \
  }
  ATT_GLOAD(0)
  ATT_LWRITE(0)
  if (nt > 1) ATT_GLOAD(1)
  __syncthreads();
  for (int t = 0; t < nt; t++) {
    if (t + 1 < nt) {
      ATT_LWRITE(t + 1)
      if (t + 2 < nt) ATT_GLOAD(t + 2)
    }
    __builtin_amdgcn_sched_barrier(0);
    const u16* Kc = Ks + (t & 1) * (64 * 104 + 64 * 72);
    const u16* Vc = Kc + 64 * 104;
    f32x16 s0, s1;
#pragma unroll
    for (int e = 0; e < 16; e++) { s0[e] = 0.f; s1[e] = 0.f; }
    __builtin_amdgcn_s_setprio(1);
#pragma unroll
    for (int ks = 0; ks < 6; ks++) {
      bf16x8 k0 = *(const bf16x8*)(Kc + (r) * 104 + ks * 16 + h * 8);
      bf16x8 k1 = *(const bf16x8*)(Kc + (32 + r) * 104 + ks * 16 + h * 8);
      s0 = MFMA32(k0, qf[ks], s0);
      s1 = MFMA32(k1, qf[ks], s1);
    }
    __builtin_amdgcn_s_setprio(0);
    float mx = s0[0];
#pragma unroll
    for (int e = 0; e < 16; e++) { mx = fmaxf(mx, s0[e]); mx = fmaxf(mx, s1[e]); }
    mx = fmaxf(mx, __shfl_xor(mx, 32));
    float d = (t == 0 || mx - m > 8.f) ? (mx - m) : 0.f;
    if (__any(d != 0.f)) {
      float alpha = __builtin_amdgcn_exp2f(-d);
      lsum *= alpha;
#pragma unroll
      for (int e = 0; e < 16; e++) { o0[e] *= alpha; o1[e] *= alpha; }
      m += d;
    }
    float ps = 0.f;
#pragma unroll
    for (int e = 0; e < 16; e++) {
      s0[e] = __builtin_amdgcn_exp2f(s0[e] - m); ps += s0[e];
      s1[e] = __builtin_amdgcn_exp2f(s1[e] - m); ps += s1[e];
    }
    lsum += ps;
#pragma unroll
    for (int kt2 = 0; kt2 < 2; kt2++) {
#pragma unroll
      for (int sx = 0; sx < 2; sx++) {
        u32x4 pw;
        if (kt2 == 0) {
          pw.x = pack2(s0[8 * sx + 0], s0[8 * sx + 1]); pw.y = pack2(s0[8 * sx + 2], s0[8 * sx + 3]);
          pw.z = pack2(s0[8 * sx + 4], s0[8 * sx + 5]); pw.w = pack2(s0[8 * sx + 6], s0[8 * sx + 7]);
        } else {
          pw.x = pack2(s1[8 * sx + 0], s1[8 * sx + 1]); pw.y = pack2(s1[8 * sx + 2], s1[8 * sx + 3]);
          pw.z = pack2(s1[8 * sx + 4], s1[8 * sx + 5]); pw.w = pack2(s1[8 * sx + 6], s1[8 * sx + 7]);
        }
        bf16x8 pb = __builtin_bit_cast(bf16x8, pw);
        int kb = kt2 * 32 + 16 * sx + 8 * h;
        o0 = MFMA32(*(const bf16x8*)(Vc + (r) * 72 + kb), pb, o0);
        o1 = MFMA32(*(const bf16x8*)(Vc + (32 + r) * 72 + kb), pb, o1);
      }
    }
    __syncthreads();
  }
#undef ATT_LWRITE
#undef ATT_GLOAD
  lsum += __shfl_xor(lsum, 32);
  const float inv = 1.f / lsum;
  u16* dst = MIX + (size_t)qrow * 1024 + 512 + hh * 64;
#pragma unroll
  for (int g = 0; g < 4; g++) {
    int e = 8 * g + 4 * h;
    *(uint2*)(dst + e) = make_uint2(pack2(o0[4 * g] * inv, o0[4 * g + 1] * inv), pack2(o0[4 * g + 2] * inv, o0[4 * g + 3] * inv));
    *(uint2*)(dst + 32 + e) = make_uint2(pack2(o1[4 * g] * inv, o1[4 * g + 1] * inv), pack2(o1[4 * g + 2] * inv, o1[4 * g + 3] * inv));
  }
  __syncthreads();
}

DI void ret_out_item(const Params& p, int l, int b, int hh, int ci, char* smem) {
  const u16* RET = (const u16*)(p.ws + OFF_RET);
  const float* ST = (const float*)(p.ws + OFF_ST);
  u16* MIX = (u16*)(p.ws + OFF_H);
  u16* Qs = (u16*)smem;
  u16* Ks = Qs + 128 * 72;
  u16* Ps = Qs;
  u16* VsT = Ks + 128 * 72;
  u16* SfT = VsT + 64 * 136;
  u16* SbT = SfT + 64 * 72;
  float* dmk = (float*)(SbT + 64 * 72);
  int tid_o = tidx();
  asm volatile("" : "+v"(tid_o));
  const int tid = tid_o, lane = tid & 63, wid = tid >> 6, r = lane & 31, h = lane >> 5;
  float lgf, lgb;
  ret_gammas(p, l, hh, lgf, lgb);
  const int row0 = chunk_row0(b, ci);
  { int d = tid - 128; dmk[tid] = d > 0 ? __expf(lgf * (float)d) : (d < 0 ? __expf(lgb * (float)(-d)) : 2.f); }
#pragma unroll 2
  for (int i = 0; i < 4; i++) {
    int id = tid + 256 * i, m = id >> 3, dc = id & 7;
    const u16* rp = RET + (size_t)(row0 + m) * 1024 + hh * 64 + dc * 8;
    *(uint4*)(Qs + m * 72 + dc * 8) = *(const uint4*)(rp);
    *(uint4*)(Ks + m * 72 + dc * 8) = *(const uint4*)(rp + 256);
    u32x4 vv = *(const u32x4*)(rp + 512);
#pragma unroll
    for (int j = 0; j < 8; j++) VsT[(dc * 8 + j) * 136 + m] = bfu(vv, j);
  }
  const float* Sf = ST + ((size_t)((0 * 4 + b) * 4 + hh) * NCH + ci) * 4096;
  const float* Sb = ST + ((size_t)((1 * 4 + b) * 4 + hh) * NCH + ci) * 4096;
#pragma unroll 2
  for (int i = 0; i < 16; i++) {
    int id = tid + 256 * i, d = id >> 6, e = id & 63;
    SfT[e * 72 + d] = f2bf(Sf[id]);
    SbT[e * 72 + d] = f2bf(Sb[id]);
  }
  __syncthreads();
  const int cw = wid * 32;
  f32x16 in0, in1, sc[4];
  {
    f32x16 cf0, cf1, cb0, cb1;
#pragma unroll
    for (int e = 0; e < 16; e++) { cf0[e] = cf1[e] = cb0[e] = cb1[e] = 0.f; }
#pragma unroll
    for (int ks = 0; ks < 4; ks++) {
      bf16x8 qa = *(const bf16x8*)(Qs + (cw + r) * 72 + ks * 16 + h * 8);
      cf0 = MFMA32(qa, *(const bf16x8*)(SfT + (r) * 72 + ks * 16 + h * 8), cf0);
      cf1 = MFMA32(qa, *(const bf16x8*)(SfT + (32 + r) * 72 + ks * 16 + h * 8), cf1);
      cb0 = MFMA32(qa, *(const bf16x8*)(SbT + (r) * 72 + ks * 16 + h * 8), cb0);
      cb1 = MFMA32(qa, *(const bf16x8*)(SbT + (32 + r) * 72 + ks * 16 + h * 8), cb1);
    }
#pragma unroll
    for (int reg = 0; reg < 16; reg++) {
      int c = cw + crow(reg, h);
      float xf = __expf(lgf * (float)(c + 1)), xb = __expf(lgb * (float)(128 - c));
      in0[reg] = xf * cf0[reg] + xb * cb0[reg];
      in1[reg] = xf * cf1[reg] + xb * cb1[reg];
    }
  }
#pragma unroll
  for (int e = 0; e < 16; e++) { sc[0][e] = sc[1][e] = sc[2][e] = sc[3][e] = 0.f; }
#pragma unroll
  for (int ks = 0; ks < 4; ks++) {
    bf16x8 qa = *(const bf16x8*)(Qs + (cw + r) * 72 + ks * 16 + h * 8);
#pragma unroll
    for (int mt = 0; mt < 4; mt++) sc[mt] = MFMA32(qa, *(const bf16x8*)(Ks + (mt * 32 + r) * 72 + ks * 16 + h * 8), sc[mt]);
  }
  __syncthreads();
#pragma unroll
  for (int mt = 0; mt < 4; mt++)
#pragma unroll
    for (int reg = 0; reg < 16; reg++) {
      int c = cw + crow(reg, h), mm = mt * 32 + r;
      Ps[c * 136 + mm] = f2bf(sc[mt][reg] * dmk[c - mm + 128]);
      if ((reg & 3) == 3) __builtin_amdgcn_sched_barrier(0);
    }
  __syncthreads();
#pragma unroll
  for (int ks = 0; ks < 8; ks++) {
    bf16x8 pa = *(const bf16x8*)(Ps + (cw + r) * 136 + ks * 16 + h * 8);
    in0 = MFMA32(pa, *(const bf16x8*)(VsT + (r) * 136 + ks * 16 + h * 8), in0);
    in1 = MFMA32(pa, *(const bf16x8*)(VsT + (32 + r) * 136 + ks * 16 + h * 8), in1);
  }
#pragma unroll
  for (int reg = 0; reg < 16; reg++) {
    int c = cw + crow(reg, h);
    float oa = in0[reg], ob = in1[reg];
    float ss = oa * oa + ob * ob;
    ss += __shfl_xor(ss, 1); ss += __shfl_xor(ss, 2); ss += __shfl_xor(ss, 4); ss += __shfl_xor(ss, 8); ss += __shfl_xor(ss, 16);
    float rstd = rsqrtf(ss * (1.f / 64.f) + 1e-6f);
    int rowi = row0 + c;
    asm volatile("" : "+v"(rowi));
    size_t row = (size_t)rowi;
    float g0 = bf2f(RET[row * 1024 + 768 + hh * 64 + r]), g1 = bf2f(RET[row * 1024 + 768 + hh * 64 + 32 + r]);
    MIX[row * 1024 + 256 + hh * 64 + r] = f2bf(silu_f(g0) * oa * rstd);
    MIX[row * 1024 + 256 + hh * 64 + 32 + r] = f2bf(silu_f(g1) * ob * rstd);
    if ((reg & 3) == 3) __builtin_amdgcn_sched_barrier(0);
  }
  __syncthreads();
}

typedef _Float16 h2_t __attribute__((ext_vector_type(2)));
DI unsigned packh(float a, float b) { h2_t v; v[0] = (_Float16)a; v[1] = (_Float16)b; return __builtin_bit_cast(unsigned, v); }
template <class ZF, class CF>
DI void hy_conv(float2* X, const float2* __restrict__ TW, const float2* __restrict__ Ke, const float2* __restrict__ Ko,
                ZF zf4, CF consume4, int tid) {
  const float scl = 0.5f / 8192.f;
#pragma unroll 2
  for (int g = 0; g < 8; g++) {
    int j = tidx() + 256 * g;
    float zr[4], zi[4];
    zf4(j, zr, zi);
#pragma unroll
    for (int e = 0; e < 4; e++) X[PX(4 * j + e)] = make_float2(zr[e], zi[e]);
  }
  __syncthreads();
  fft_dif(X, TW, tid);
#pragma unroll 2
  for (int g = 0; g < 8; g++) {
    int j = tidx() + 256 * g;
    const float4* kp = (const float4*)(Ke + 4 * j);
    float4 k01 = kp[0], k23 = kp[1];
    float2 a;
    a = X[PX(4 * j + 0)]; X[PX(4 * j + 0)] = make_float2(a.x * k01.x - a.y * k01.y, a.x * k01.y + a.y * k01.x);
    a = X[PX(4 * j + 1)]; X[PX(4 * j + 1)] = make_float2(a.x * k01.z - a.y * k01.w, a.x * k01.w + a.y * k01.z);
    a = X[PX(4 * j + 2)]; X[PX(4 * j + 2)] = make_float2(a.x * k23.x - a.y * k23.y, a.x * k23.y + a.y * k23.x);
    a = X[PX(4 * j + 3)]; X[PX(4 * j + 3)] = make_float2(a.x * k23.z - a.y * k23.w, a.x * k23.w + a.y * k23.z);
  }
  __syncthreads();
  fft_dit(X, TW, tid);
  unsigned ye[32];
#pragma unroll
  for (int g = 0; g < 8; g++) {
    int j = tid + 256 * g;
    asm volatile("" : "+v"(j));
#pragma unroll
    for (int e = 0; e < 4; e++) {
      float2 ev = X[PX(4 * j + e)];
      unsigned pk = packh(ev.x * scl, ev.y * scl);
      asm volatile("" : "+v"(pk));
      ye[g * 4 + e] = pk;
    }
    if (g & 1) __builtin_amdgcn_sched_barrier(0);
  }
  __syncthreads();
#pragma unroll 2
  for (int g = 0; g < 8; g++) {
    int j = tidx() + 256 * g;
    float zr[4], zi[4];
    zf4(j, zr, zi);
    const float4* tp = (const float4*)(TW + 4 * j);
    float4 t01 = tp[0], t23 = tp[1];
    X[PX(4 * j + 0)] = make_float2(zr[0] * t01.x - zi[0] * t01.y, zr[0] * t01.y + zi[0] * t01.x);
    X[PX(4 * j + 1)] = make_float2(zr[1] * t01.z - zi[1] * t01.w, zr[1] * t01.w + zi[1] * t01.z);
    X[PX(4 * j + 2)] = make_float2(zr[2] * t23.x - zi[2] * t23.y, zr[2] * t23.y + zi[2] * t23.x);
    X[PX(4 * j + 3)] = make_float2(zr[3] * t23.z - zi[3] * t23.w, zr[3] * t23.w + zi[3] * t23.z);
  }
  __syncthreads();
  fft_dif(X, TW, tid);
#pragma unroll 2
  for (int g = 0; g < 8; g++) {
    int j = tidx() + 256 * g;
    const float4* kp = (const float4*)(Ko + 4 * j);
    float4 k01 = kp[0], k23 = kp[1];
    float2 a;
    a = X[PX(4 * j + 0)]; X[PX(4 * j + 0)] = make_float2(a.x * k01.x - a.y * k01.y, a.x * k01.y + a.y * k01.x);
    a = X[PX(4 * j + 1)]; X[PX(4 * j + 1)] = make_float2(a.x * k01.z - a.y * k01.w, a.x * k01.w + a.y * k01.z);
    a = X[PX(4 * j + 2)]; X[PX(4 * j + 2)] = make_float2(a.x * k23.x - a.y * k23.y, a.x * k23.y + a.y * k23.x);
    a = X[PX(4 * j + 3)]; X[PX(4 * j + 3)] = make_float2(a.x * k23.z - a.y * k23.w, a.x * k23.w + a.y * k23.z);
  }
  __syncthreads();
  fft_dit(X, TW, tid);
#pragma unroll
  for (int g = 0; g < 8; g++) {
    int j = tid + 256 * g;
    asm volatile("" : "+v"(j));
    const float4* tp = (const float4*)(TW + 4 * j);
    float4 t01 = tp[0], t23 = tp[1];
    float ya[4], yb[4];
    float2 o;
    h2_t ev;
    o = X[PX(4 * j + 0)]; ev = __builtin_bit_cast(h2_t, ye[g * 4 + 0]);
    ya[0] = (float)ev[0] + (o.x * t01.x + o.y * t01.y) * scl; yb[0] = (float)ev[1] + (o.y * t01.x - o.x * t01.y) * scl;
    o = X[PX(4 * j + 1)]; ev = __builtin_bit_cast(h2_t, ye[g * 4 + 1]);
    ya[1] = (float)ev[0] + (o.x * t01.z + o.y * t01.w) * scl; yb[1] = (float)ev[1] + (o.y * t01.z - o.x * t01.w) * scl;
    o = X[PX(4 * j + 2)]; ev = __builtin_bit_cast(h2_t, ye[g * 4 + 2]);
    ya[2] = (float)ev[0] + (o.x * t23.x + o.y * t23.y) * scl; yb[2] = (float)ev[1] + (o.y * t23.x - o.x * t23.y) * scl;
    o = X[PX(4 * j + 3)]; ev = __builtin_bit_cast(h2_t, ye[g * 4 + 3]);
    ya[3] = (float)ev[0] + (o.x * t23.z + o.y * t23.w) * scl; yb[3] = (float)ev[1] + (o.y * t23.z - o.x * t23.w) * scl;
    consume4(j, ya, yb);
    __builtin_amdgcn_sched_barrier(0);
  }
  __syncthreads();
}

DI float sconv_at(const u16* __restrict__ u, int n, int Ls, float w0, float w1, float w2, float bias) {
  float um = n > 0 ? bf2f(u[n - 1]) : 0.f, uc = bf2f(u[n]), up = n < Ls - 1 ? bf2f(u[n + 1]) : 0.f;
  return bias + w0 * um + w1 * uc + w2 * up;
}
DI void sconv4(const u16* __restrict__ u, int j, float w0, float w1, float w2, float bias, float (&o)[4]) {
  uint2 c = *(const uint2*)(u + 4 * j);
  float x0 = __uint_as_float(c.x << 16), x1 = __uint_as_float(c.x & 0xffff0000u);
  float x2 = __uint_as_float(c.y << 16), x3 = __uint_as_float(c.y & 0xffff0000u);
  float xm = j > 0 ? bf2f(u[4 * j - 1]) : 0.f, xp = j < 2047 ? bf2f(u[4 * j + 4]) : 0.f;
  o[0] = bias + w0 * xm + w1 * x0 + w2 * x1;
  o[1] = bias + w0 * x0 + w1 * x1 + w2 * x2;
  o[2] = bias + w0 * x1 + w1 * x2 + w2 * x3;
  o[3] = bias + w0 * x2 + w1 * x3 + w2 * xp;
}
DI void unpack4(const u16* __restrict__ p, float (&o)[4]) {
  uint2 c = *(const uint2*)p;
  o[0] = __uint_as_float(c.x << 16); o[1] = __uint_as_float(c.x & 0xffff0000u);
  o[2] = __uint_as_float(c.y << 16); o[3] = __uint_as_float(c.y & 0xffff0000u);
}

DI void hyena_item(const Params& p, int l, int c, int pair, char* smem) {
  float2* X = (float2*)smem;
  const float2* TW = (const float2*)(p.ws + OFF_TW);
  const float2* KS = (const float2*)(p.ws + OFF_KSPEC);
  const u16* UT = (const u16*)(p.ws + OFF_UT);
  u16* YT = (u16*)(p.ws + OFF_CQ);
  int tid_o = tidx();
  const int tid = tid_o;
  const float* cw = p.in[I_HCW] + l * 3 * 768;
  const float* cb = p.in[I_HCB] + l * 768;
  const int b0 = 2 * pair, b1 = b0 + 1;
  u16* y0 = YT + (size_t)(b0 * 256 + c) * SEQ;
  u16* y1 = YT + (size_t)(b1 * 256 + c) * SEQ;
  const float vw0 = cw[512 + c], vw1 = cw[768 + 512 + c], vw2 = cw[1536 + 512 + c], vbs = cb[512 + c];
  const u16* v0p = UT + (size_t)(b0 * 768 + 512 + c) * SEQ;
  const u16* v1p = UT + (size_t)(b1 * 768 + 512 + c) * SEQ;
  {
    const float w0 = cw[c], w1 = cw[768 + c], w2 = cw[1536 + c], bs = cb[c];
    const float bias0 = p.in[I_HBIAS][(l * 2 + 0) * 256 + c];
    const u16* u0 = UT + (size_t)(b0 * 768 + c) * SEQ;
    const u16* u1 = UT + (size_t)(b1 * 768 + c) * SEQ;
    hy_conv(X, TW, KS + (size_t)(0 * 256 + c) * 2 * 8192, KS + (size_t)(0 * 256 + c) * 2 * 8192 + 8192,
            [&](int j, float (&zr)[4], float (&zi)[4]) __attribute__((always_inline)) {
              sconv4(v0p, j, vw0, vw1, vw2, vbs, zr); sconv4(v1p, j, vw0, vw1, vw2, vbs, zi);
            },
            [&](int j, const float (&ya)[4], const float (&yb)[4]) __attribute__((always_inline)) {
              float va[4], vb[4], xa[4], xb[4];
              sconv4(v0p, j, vw0, vw1, vw2, vbs, va); sconv4(v1p, j, vw0, vw1, vw2, vbs, vb);
              sconv4(u0, j, w0, w1, w2, bs, xa); sconv4(u1, j, w0, w1, w2, bs, xb);
              *(uint2*)(y0 + 4 * j) = make_uint2(pack2(xa[0] * (ya[0] + va[0] * bias0), xa[1] * (ya[1] + va[1] * bias0)),
                                                 pack2(xa[2] * (ya[2] + va[2] * bias0), xa[3] * (ya[3] + va[3] * bias0)));
              *(uint2*)(y1 + 4 * j) = make_uint2(pack2(xb[0] * (yb[0] + vb[0] * bias0), xb[1] * (yb[1] + vb[1] * bias0)),
                                                 pack2(xb[2] * (yb[2] + vb[2] * bias0), xb[3] * (yb[3] + vb[3] * bias0)));
            }, tid);
  }
  {
    const int col = 256 + c;
    const float w0 = cw[col], w1 = cw[768 + col], w2 = cw[1536 + col], bs = cb[col];
    const float bias1 = p.in[I_HBIAS][(l * 2 + 1) * 256 + c];
    const u16* u0 = UT + (size_t)(b0 * 768 + col) * SEQ;
    const u16* u1 = UT + (size_t)(b1 * 768 + col) * SEQ;
    hy_conv(X, TW, KS + (size_t)(1 * 256 + c) * 2 * 8192, KS + (size_t)(1 * 256 + c) * 2 * 8192 + 8192,
            [&](int j, float (&zr)[4], float (&zi)[4]) __attribute__((always_inline)) { unpack4(y0 + 4 * j, zr); unpack4(y1 + 4 * j, zi); },
            [&](int j, const float (&ya)[4], const float (&yb)[4]) __attribute__((always_inline)) {
              float za[4], zb[4], xa[4], xb[4];
              unpack4(y0 + 4 * j, za); unpack4(y1 + 4 * j, zb);
              sconv4(u0, j, w0, w1, w2, bs, xa); sconv4(u1, j, w0, w1, w2, bs, xb);
              *(uint2*)(y0 + 4 * j) = make_uint2(pack2(xa[0] * (ya[0] + za[0] * bias1), xa[1] * (ya[1] + za[1] * bias1)),
                                                 pack2(xa[2] * (ya[2] + za[2] * bias1), xa[3] * (ya[3] + za[3] * bias1)));
              *(uint2*)(y1 + 4 * j) = make_uint2(pack2(xb[0] * (yb[0] + zb[0] * bias1), xb[1] * (yb[1] + zb[1] * bias1)),
                                                 pack2(xb[2] * (yb[2] + zb[2] * bias1), xb[3] * (yb[3] + zb[3] * bias1)));
            }, tid);
  }
}

DI void hyena_ctx_item(const Params& p, int l, int b, int c, char* smem) {
  float* k0s = (float*)smem;
  float* k1s = k0s + 512;
  float* vs = k1s + 512;
  float* zs = vs + 256;
  const float* KC = (const float*)(p.ws + OFF_KC);
  const u16* UTC = (const u16*)(p.ws + OFF_UTC);
  u16* MIX = (u16*)(p.ws + OFF_H);
  int tid_o = tidx();
  asm volatile("" : "+v"(tid_o));
  const int n = tid_o;
  const float* cw = p.in[I_HCW] + l * 3 * 768;
  const float* cb = p.in[I_HCB] + l * 768;
  k0s[n] = KC[(size_t)(0 * 256 + c) * 512 + n]; k0s[256 + n] = KC[(size_t)(0 * 256 + c) * 512 + 256 + n];
  k1s[n] = KC[(size_t)(1 * 256 + c) * 512 + n]; k1s[256 + n] = KC[(size_t)(1 * 256 + c) * 512 + 256 + n];
  float v = sconv_at(UTC + (size_t)(b * 768 + 512 + c) * LCTX, n, LCTX, cw[512 + c], cw[768 + 512 + c], cw[1536 + 512 + c], cb[512 + c]);
  float x1 = sconv_at(UTC + (size_t)(b * 768 + c) * LCTX, n, LCTX, cw[c], cw[768 + c], cw[1536 + c], cb[c]);
  float x2 = sconv_at(UTC + (size_t)(b * 768 + 256 + c) * LCTX, n, LCTX, cw[256 + c], cw[768 + 256 + c], cw[1536 + 256 + c], cb[256 + c]);
  vs[n] = v;
  __syncthreads();
  float a = 0.f;
  for (int s = 0; s < 256; s++) a += k0s[n - s + 256] * vs[s];
  float z = x1 * (a + v * p.in[I_HBIAS][(l * 2 + 0) * 256 + c]);
  zs[n] = z;
  __syncthreads();
  float a2 = 0.f;
  for (int s = 0; s < 256; s++) a2 += k1s[n - s + 256] * zs[s];
  float y = x2 * (a2 + z * p.in[I_HBIAS][(l * 2 + 1) * 256 + c]);
  MIX[(size_t)(TLAT + b * LCTX + n) * 1024 + c] = f2bf(y);
  __syncthreads();
}

DI void phase_p4(const Params& p, int l, char* smem, int submask = 15) {
  const int n_al = 2048, n_ac = (l == 0 ? 64 : 0), n_hy = 512, n_r3 = (l == 0 ? 16 * NCH : 16 * 64), n_hc = (l == 0 ? 1024 : 0);
  const int total = n_al + n_ac + n_hy + n_r3 + n_hc;
  for (int it = blockIdx.x; it < total; it += gridDim.x) {
    int q = it;
    if (q < n_al) {
      int b = q >> 9, hh = (q >> 6) & 7, qb = q & 63;
      if (SUB_ON(0) && (submask & 1)) attn_item(p, b, hh, b * SEQ + qb * 128, 0, LKEY, smem);
    } else if ((q -= n_al) < n_ac) {
      int b = q >> 4, hh = (q >> 1) & 7, qb = q & 1;
      if (SUB_ON(0) && (submask & 1)) attn_item(p, b, hh, TLAT + b * LCTX + qb * 128, SEQ, LCTX, smem);
    } else if ((q -= n_ac) < n_hy) {
      if (SUB_ON(1) && (submask & 2)) hyena_item(p, l, q >> 1, q & 1, smem);
    } else if ((q -= n_hy) < n_r3) {
      int bh, ci;
      if (l == 0) { bh = q / NCH; ci = q - bh * NCH; } else { bh = q >> 6; ci = 2 + (q & 63); }
      if (SUB_ON(2) && (submask & 4)) ret_out_item(p, l, bh >> 2, bh & 3, ci, smem);
    } else {
      q -= n_r3;
      if (SUB_ON(3) && (submask & 8)) hyena_ctx_item(p, l, q >> 8, q & 255, smem);
    }
  }
}

DI void phase_res_gemm(const Params& p, int l, int which  , char* smem) {
  const char* wl = p.ws + OFF_W + (size_t)l * WL_SIZE;
  const u16* A = (const u16*)(p.ws + (which == 1 ? OFF_H : OFF_ACT));
  const int K = which == 1 ? 1024 : 4096;
  const u16* Bt = (const u16*)(wl + (which == 1 ? WL_WOUT : WL_W2));
  const bool first = (l == 0 && which == 1);
  const float* mod = (const float*)(p.ws + OFF_MOD);
  float* XC = (float*)(p.ws + OFF_XC);
  const int n_lat = 128 * 8, n_split = (l == 0 ? 32 * 16 : 0);
  for (int it = blockIdx.x; it < n_lat + n_split; it += gridDim.x) {
    if (it < n_lat) {
      int mt = it >> 3, nt = it & 7;
      int m0 = mt * 256;
      const u16* at = nullptr;
      if (which == 1) at = (const u16*)(p.ws + OFF_CQ) + (size_t)((m0 >> 13) * 256) * SEQ + (m0 & 8191);
      const float* ga = mod + (size_t)(l * 5 + (m0 >> 13)) * 6144 + (which == 1 ? 2048 : 5120);
      const float* src = first ? p.in[I_X] : p.out;
      float* dst = p.out;
      gemm_tile<false, false, false, 3>(A, K, Bt, K, K, m0, nt * 128, at, 8, smem,
        [](int, int, float v, const float*) __attribute__((always_inline)) { return v; },
        [&](int row, int col, float4 a) __attribute__((always_inline)) {
          size_t idx = (size_t)row * 1024 + col;
          float4 x = *(const float4*)(src + idx), g = *(const float4*)(ga + col);
          *(float4*)(dst + idx) = make_float4(x.x + g.x * a.x, x.y + g.y * a.y, x.z + g.z * a.z, x.w + g.w * a.w);
        });
    } else {
      int q = it - n_lat;
      int tile = q >> 4, kc = q & 15;
      int mt = 128 + (tile >> 3), nt = tile & 7;
      int kchunk = K >> 4, k0 = kc * kchunk;
      const float* ga = mod + (size_t)(l * 5 + 4) * 6144 + (which == 1 ? 2048 : 5120);
      float* dst = XC - (size_t)TLAT * 1024;
      gemm_tile<false, false, false, 0>(A + k0, K, Bt + k0, K, kchunk, mt * 256, nt * 128, nullptr, 0, smem,
        [&](int bm, int bn, const f32x16& acc, const float*) __attribute__((always_inline)) {
          const int lz_ = tidx() & 63, r = lz_ & 31, h = lz_ >> 5;
          int col = bn + r;
          float g = ga[col];
#pragma unroll
          for (int reg = 0; reg < 16; reg++) unsafeAtomicAdd(dst + (size_t)(bm + crow(reg, h)) * 1024 + col, g * acc[reg]);
        }, [](int, int) __attribute__((always_inline)) -> u16* { return nullptr; });
    }
  }
}

DI void phase_mlp1(const Params& p, int l, char* smem) {
  const int lane = tidx() & 63, r = lane & 31, h = lane >> 5;
  const int nmt = (l == 0 ? 132 : 128);
  const u16* A = (const u16*)(p.ws + OFF_H);
  const u16* Bt = (const u16*)(p.ws + OFF_W + (size_t)l * WL_SIZE + WL_W1);
  u16* ACT = (u16*)(p.ws + OFF_ACT);
  const int total = nmt * 32;
  for (int it = blockIdx.x; it < total; it += gridDim.x) {
    int mt = it >> 5, nt = it & 31;
    gemm_tile<false, false, false, 1>(A, 1024, Bt, 1024, 1024, mt * 256, nt * 128, nullptr, 0, smem,
      [](int, int, float v, const float*) __attribute__((always_inline)) { float x = fmaxf(v, 0.f); return x * x; },
      [&](int row, int col) __attribute__((always_inline)) -> u16* { return ACT + (size_t)row * 4096 + col; });
  }
}

DI void phase_final(const Params& p) {
  const int lane = tidx() & 63, wid = tidx() >> 6;
  const float* g = p.in[I_FNG];
  for (int it = blockIdx.x; it < TLAT / 8; it += gridDim.x) {
    float* row = p.out + (size_t)(it * 8 + wid * 2) * 1024;
    float4 v[8];
    float ssq0 = 0.f, ssq1 = 0.f;
#pragma unroll
    for (int i = 0; i < 4; i++) { v[i] = *(const float4*)(row + i * 256 + lane * 4); v[4 + i] = *(const float4*)(row + 1024 + i * 256 + lane * 4); }
#pragma unroll
    for (int i = 0; i < 4; i++) {
      ssq0 += v[i].x * v[i].x + v[i].y * v[i].y + v[i].z * v[i].z + v[i].w * v[i].w;
      ssq1 += v[4 + i].x * v[4 + i].x + v[4 + i].y * v[4 + i].y + v[4 + i].z * v[4 + i].z + v[4 + i].w * v[4 + i].w;
    }
    ssq0 = wave_sum(ssq0); ssq1 = wave_sum(ssq1);
    float r0 = rsqrtf(ssq0 * (1.f / 1024.f) + 1e-6f), r1 = rsqrtf(ssq1 * (1.f / 1024.f) + 1e-6f);
#pragma unroll
    for (int i = 0; i < 4; i++) {
      float4 gg = *(const float4*)(g + i * 256 + lane * 4);
      *(float4*)(row + i * 256 + lane * 4) = make_float4(v[i].x * r0 * gg.x, v[i].y * r0 * gg.y, v[i].z * r0 * gg.z, v[i].w * r0 * gg.w);
      *(float4*)(row + 1024 + i * 256 + lane * 4) = make_float4(v[4 + i].x * r1 * gg.x, v[4 + i].y * r1 * gg.y, v[4 + i].z * r1 * gg.z, v[4 + i].w * r1 * gg.w);
    }
  }
}


#define XB_TMO      128
#define XB_XCNT(j)  (256  + 64 * (j))
#define XB_XSUB(j)  (1280 + 64 * (j))
#define XB_XGEN(j)  (2304 + 64 * (j))
#define XB_TOP      3328
#define XB_TOPGEN   3392
#define XCD_BAR_WORDS 3456
#define XB_SPIN_CAP (1u << 22)
#define LAS __attribute__((address_space(3)))
DI unsigned xb_ld(unsigned* p) { return __hip_atomic_load(p, __ATOMIC_RELAXED, __HIP_MEMORY_SCOPE_AGENT); }
DI unsigned xb_add(unsigned* p, unsigned v) { return __hip_atomic_fetch_add(p, v, __ATOMIC_RELAXED, __HIP_MEMORY_SCOPE_AGENT); }
DI unsigned xb_xcc_id() { return (unsigned)__builtin_amdgcn_s_getreg((3 << 11) | 20) & 0xFu; }
#define XB_SPIN(cond, bar) do { unsigned _sp = 0; while (cond) { __builtin_amdgcn_s_sleep(1); \
    if ((++_sp & 255u) == 0u) { if (xb_ld(&(bar)[XB_TMO])) break; if (_sp > XB_SPIN_CAP) { atomicAdd(&(bar)[XB_TMO], 1u); break; } } } } while (0)
struct XcdBarrier { unsigned* bar; unsigned x; volatile LAS unsigned* st; };
DI XcdBarrier xcd_barrier_post(unsigned* bar, volatile LAS unsigned* st) {
  XcdBarrier b; b.bar = bar; b.x = xb_xcc_id(); b.st = st;
  if (threadIdx.x == 0) (void)xb_add(&bar[XB_XCNT(b.x)], 1u);
  return b;
}
DI void xcd_barrier_complete(unsigned* bar, unsigned x, unsigned& nloc, unsigned& nx) {
  const unsigned G = gridDim.x * gridDim.y * gridDim.z;
  unsigned sum, cnt, mine, sp = 0u;
  for (;;) {
    sum = 0u; cnt = 0u; mine = 0u;
#pragma unroll
    for (unsigned j = 0; j < 16; ++j) { const unsigned c = xb_ld(&bar[XB_XCNT(j)]); sum += c; cnt += (c > 0u) ? 1u : 0u; mine = (j == x) ? c : mine; }
    if (sum == G) break;
    __builtin_amdgcn_s_sleep(1);
    if ((++sp & 255u) == 0u) { if (xb_ld(&bar[XB_TMO])) break; if (sp > XB_SPIN_CAP) { atomicAdd(&bar[XB_TMO], 1u); break; } }
  }
  nloc = mine > 0u ? mine : 1u; nx = cnt > 0u ? cnt : 1u;
}
DI void xcd_barrier(const XcdBarrier& b) {
  asm volatile("s_waitcnt vmcnt(0)" ::: "memory");
  __syncthreads();
  if (threadIdx.x == 0) {
    unsigned* bar = b.bar;
    __builtin_amdgcn_s_waitcnt(0);
    unsigned nloc = b.st[0], nx = b.st[1];
    if (nloc == 0u) { xcd_barrier_complete(bar, b.x, nloc, nx); b.st[0] = nloc; b.st[1] = nx; }
    const unsigned old = xb_add(&bar[XB_XSUB(b.x)], 1u);
    const unsigned gen = old / nloc;
    if (old + 1u == (gen + 1u) * nloc) {
      __builtin_amdgcn_fence(__ATOMIC_RELEASE, "agent");
      asm volatile("s_waitcnt vmcnt(0)" ::: "memory");
      const unsigned og = xb_add(&bar[XB_TOP], 1u);
      const unsigned tg = og / nx;
      if (og + 1u == (tg + 1u) * nx) xb_add(&bar[XB_TOPGEN], 1u);
      else XB_SPIN(xb_ld(&bar[XB_TOPGEN]) == tg, bar);
      __builtin_amdgcn_fence(__ATOMIC_ACQUIRE, "agent");
      xb_add(&bar[XB_XGEN(b.x)], 1u);
      asm volatile("s_waitcnt vmcnt(0)" ::: "memory");
    } else {
      XB_SPIN(xb_ld(&bar[XB_XGEN(b.x)]) == gen, bar);
      __builtin_amdgcn_fence(__ATOMIC_ACQUIRE, "agent");
      asm volatile("s_waitcnt vmcnt(0)" ::: "memory");
    }
  }
  __syncthreads();
}

constexpr int NPHASE = 20;
#ifndef ONLY_PHASE
#define ONLY_PHASE -1
#endif
#define PH_ON(k) (ONLY_PHASE < 0 || ONLY_PHASE == (k))
DI void run_phase(const Params& p, int ph, char* smem, int submask = 15) {
  if (ph == 0) { if (PH_ON(0)) phase_s0(p, smem); return; }
  if (ph == NPHASE - 1) { if (PH_ON(8)) phase_final(p); return; }
  int l = (ph - 1) / 9, s = (ph - 1) % 9;
  switch (s) {
    case 0: if (PH_ON(1)) phase_norm(p, l, 1, TALL, true); break;
    case 1: if (PH_ON(2)) phase_win(p, l, smem); break;
    case 2: if (PH_ON(3)) phase_p3(p, l, smem); break;
    case 3: if (PH_ON(4)) phase_scan(p, l); break;
    case 4: if (PH_ON(5)) phase_p4(p, l, smem, submask); break;
    case 5: if (PH_ON(6)) phase_res_gemm(p, l, 1, smem); break;
    case 6: if (PH_ON(1)) phase_norm(p, l, 2, l == 0 ? TALL : TLAT, false); break;
    case 7: if (PH_ON(7)) phase_mlp1(p, l, smem); break;
    default: if (PH_ON(6)) phase_res_gemm(p, l, 2, smem); break;
  }
}

#if !MULTI_LAUNCH
extern "C" __global__ void __launch_bounds__(256, 2) mk_all(Params p) {
  extern __shared__ __attribute__((aligned(16))) char smem[];
  cg::grid_group grid = cg::this_grid();
  __shared__ uint4 xb_words;
  if (threadIdx.x == 0) xb_words = make_uint4(0u, 0u, 0u, 0u);
  __syncthreads();
  XcdBarrier xb = xcd_barrier_post((unsigned*)(p.ws + OFF_BAR), (volatile LAS unsigned*)&xb_words);
  if (p.ws == nullptr) grid.sync();
  for (int ph = 0; ph < NPHASE; ph++) {
    run_phase(p, ph, smem);
#ifdef PROBE_DUP
    if (ph == PROBE_DUP || ph == PROBE_DUP2) { xcd_barrier(xb); run_phase(p, ph, smem, PROBE_MASK); }
#endif
    if (ph + 1 < NPHASE) xcd_barrier(xb);
  }
}
#define MK_KERNEL mk_all
#else
#define MK_KERNEL mk_phase
extern "C" __global__ void __launch_bounds__(256, 2) mk_phase(Params p, int ph) {
  extern __shared__ __attribute__((aligned(16))) char smem[];
  run_phase(p, ph, smem);
}
#endif

extern "C" void kernel_launch(void* const* d_in, const int* in_sizes, int n_in, void* d_out, int out_size, void* d_ws, size_t ws_size,
                              hipStream_t stream) {
  Params p{};
  for (int i = 0; i < 27; i++) p.in[i] = (const float*)d_in[i];
  p.out = (float*)d_out;
  p.ws = (char*)d_ws;
  static int grid_blocks = 0;
  if (!grid_blocks) {
    int dev = 0, cus = 0, per_cu = 0;
    (void)hipGetDevice(&dev);
    (void)hipDeviceGetAttribute(&cus, hipDeviceAttributeMultiprocessorCount, dev);
    (void)hipFuncSetAttribute((const void*)MK_KERNEL, hipFuncAttributeMaxDynamicSharedMemorySize, SMEM_BYTES);
    (void)hipOccupancyMaxActiveBlocksPerMultiprocessor(&per_cu, MK_KERNEL, 256, SMEM_BYTES);
    if (per_cu < 1) per_cu = 1;
    if (per_cu > 2) per_cu = 2;
    grid_blocks = cus * per_cu;
  }
#if MULTI_LAUNCH
  for (int ph = 0; ph < NPHASE; ph++) hipLaunchKernelGGL(mk_phase, dim3(grid_blocks), dim3(256), SMEM_BYTES, stream, p, ph);
#else
  (void)hipMemsetAsync(p.ws + OFF_BAR, 0, XCD_BAR_WORDS * 4, stream);
  void* args[] = {&p};
  (void)hipLaunchCooperativeKernel((void*)mk_all, dim3(grid_blocks), dim3(256), args, SMEM_BYTES, stream);
#endif
}
```

```cpp
#include <hip/hip_runtime.h>
#include <hip/hip_cooperative_groups.h>
namespace cg = cooperative_groups;

#ifndef MULTI_LAUNCH
#define MULTI_LAUNCH 0
#endif

#define DI __device__ __forceinline__
#define NI __device__ __noinline__
typedef unsigned short u16;
typedef short bf16x8 __attribute__((ext_vector_type(8)));
typedef float f32x16 __attribute__((ext_vector_type(16)));
typedef __bf16 bf2_t __attribute__((ext_vector_type(2)));
typedef unsigned u32x4 __attribute__((ext_vector_type(4)));
#define MFMA32(a, b, c) __builtin_amdgcn_mfma_f32_32x32x16_bf16((a), (b), (c), 0, 0, 0)

constexpr int NB = 4, SEQ = 8192, LCTX = 256, DM = 1024, DFF = 4096;
constexpr int TLAT = NB * SEQ;
constexpr int TALL = TLAT + NB * LCTX;
constexpr int NIN = 2208, NINP = 2304;
constexpr int LKEY = SEQ + LCTX;
constexpr int NCH = 66;
constexpr int SMEM_BYTES = 73728;
#ifndef SUBSEL
#define SUBSEL -1
#endif
#define SUB_ON(k) (SUBSEL < 0 || SUBSEL == (k))

constexpr size_t WL_WIN = 0;
constexpr size_t WL_WOUT = WL_WIN + (size_t)NINP * 1024 * 2;
constexpr size_t WL_W1 = WL_WOUT + (size_t)1024 * 1024 * 2;
constexpr size_t WL_W2 = WL_W1 + (size_t)4096 * 1024 * 2;
constexpr size_t WL_WUQ = WL_W2 + (size_t)1024 * 4096 * 2;
constexpr size_t WL_WUKV = WL_WUQ + (size_t)768 * 256 * 2;
constexpr size_t WL_SIZE = WL_WUKV + (size_t)1024 * 128 * 2;
constexpr size_t OFF_W = 0;
constexpr size_t OFF_MOD = OFF_W + 2 * WL_SIZE;
constexpr size_t OFF_TW = OFF_MOD + (size_t)2 * 5 * 6144 * 4;
constexpr size_t OFF_ROPE = OFF_TW + 65536;
constexpr size_t OFF_XC = OFF_ROPE + 192 * 8 * 8 + 4096;
constexpr size_t OFF_H = OFF_XC + (size_t)1024 * 1024 * 4;
constexpr size_t OFF_H2F = OFF_H + (size_t)TALL * 1024 * 2;
constexpr size_t OFF_H2C = OFF_H2F + (size_t)8192 * 64 * 4;
constexpr size_t OFF_KC = OFF_H2C + (size_t)256 * 64 * 4;
constexpr size_t OFF_BIG = OFF_KC + (size_t)2 * 256 * 512 * 4;
constexpr size_t OFF_UT = OFF_BIG;
constexpr size_t OFF_UTC = OFF_UT + (size_t)NB * 768 * SEQ * 2;
constexpr size_t OFF_RET = OFF_UTC + (size_t)NB * 768 * LCTX * 2;
constexpr size_t OFF_CQ = OFF_RET + (size_t)TALL * 1024 * 2;
constexpr size_t OFF_CKV = OFF_CQ + (size_t)TALL * 256 * 2;
constexpr size_t OFF_Q = OFF_CKV + (size_t)TALL * 128 * 2;
constexpr size_t OFF_KF = OFF_Q + (size_t)TALL * 768 * 2;
constexpr size_t OFF_VT = OFF_KF + (size_t)NB * 8 * LKEY * 96 * 2;
constexpr size_t OFF_ST = OFF_VT + (size_t)NB * 8 * 64 * LKEY * 2;
constexpr size_t OFF_KSPEC = OFF_ST + (size_t)2 * 16 * NCH * 4096 * 4;
constexpr size_t OFF_END = OFF_KSPEC + (size_t)2 * 256 * 2 * 8192 * 8;
constexpr size_t OFF_BAR = OFF_END;
constexpr size_t OFF_ACT = OFF_BIG;
static_assert(OFF_ACT + (size_t)TALL * 4096 * 2 <= OFF_END, "act fits");
static_assert(OFF_END + 16384 <= (size_t)536870912, "workspace");

struct Params {
  const float* in[27];
  float* out;
  char* ws;
};
enum { I_X = 0, I_C, I_CTX, I_CCTX, I_WADA, I_BADA, I_N1G, I_N2G, I_WIN, I_WOUT, I_HCW, I_HCB, I_HW1, I_HB1, I_HSF, I_HW2,
       I_HB2, I_HW3, I_HBIAS, I_RLD, I_QNG, I_WUQ, I_KVNG, I_WUKV, I_W1, I_W2, I_FNG };

DI int tidx() { int t = __builtin_amdgcn_workitem_id_x(); asm volatile("" : "+v"(t)); return t; }
DI u16 f2bf(float x) { return __builtin_bit_cast(u16, (__bf16)x); }
DI float bf2f(u16 v) { return __uint_as_float(((unsigned)v) << 16); }
DI unsigned pack2(float a, float b) { bf2_t v; v[0] = (__bf16)a; v[1] = (__bf16)b; return __builtin_bit_cast(unsigned, v); }
DI float wave_sum(float v) {
#pragma unroll
  for (int o = 32; o > 0; o >>= 1) v += __shfl_xor(v, o);
  return v;
}
DI int crow(int reg, int h) { return (reg & 3) + 8 * (reg >> 2) + 4 * h; }
DI float bfe(u32x4 v, int j) {
  unsigned w = v[j >> 1];
  return __uint_as_float((j & 1) ? (w & 0xffff0000u) : (w << 16));
}
DI u16 bfu(u32x4 v, int j) {
  unsigned w = v[j >> 1];
  return (u16)((j & 1) ? (w >> 16) : (w & 0xffffu));
}
DI float silu_f(float x) { return x / (1.f + __expf(-x)); }
DI void row_info(int row, int& b, int& t, int& key, int& cond) {
  if (row < TLAT) { b = row >> 13; t = row & 8191; key = t; cond = b; }
  else { int rc = row - TLAT; b = rc >> 8; t = rc & 255; key = SEQ + t; cond = 4; }
}
DI int chunk_row0(int b, int ci) { return ci < 2 ? TLAT + b * LCTX + ci * 128 : b * SEQ + (ci - 2) * 128; }
DI float rope_apply(const float2* __restrict__ tab, float val, int jj, int t) {
  float partner = __shfl_xor(val, 8);
  int pos = (jj & 16) ? 128 + (t & 63) : (t >> 6);
  float2 cs = tab[pos * 8 + (jj & 7)];
  return (jj & 8) ? (val * cs.x + partner * cs.y) : (val * cs.x - partner * cs.y);
}

DI void convT_item(const float* __restrict__ src, u16* __restrict__ dst, int K, int N, int Npad, const float* __restrict__ gain,
                   int item, float* tile, bool perm = false) {
  int ntn = Npad >> 6;
  int kt = item / ntn, nt = item - kt * ntn;
  int k0 = kt * 64, n0 = nt * 64;
  int c = tidx() & 63, q = tidx() >> 6;
#pragma unroll 4
  for (int i = 0; i < 16; i++) {
    int kk = i * 4 + q, n = n0 + c;
    float v = 0.f;
    if (n < N) { int sn = perm ? ((n & 511) >> 6) * 128 + (n >> 9) * 64 + (n & 63) : n; v = src[(size_t)(k0 + kk) * N + sn]; if (gain) v *= gain[k0 + kk]; }
    tile[kk * 65 + c] = v;
  }
  __syncthreads();
#pragma unroll 4
  for (int i = 0; i < 16; i++) {
    int nn = i * 4 + q;
    dst[(size_t)(n0 + nn) * K + k0 + c] = f2bf(tile[c * 65 + nn]);
  }
  __syncthreads();
}

DI void phase_s0(const Params& p, char* smem) {
  const int per_layer = 576 + 256 + 1024 + 1024 + 48 + 32;
  const int n_conv = 2 * per_layer, n_mod = 2 * 96, n_tw = 32 + 6, n_cp = 1024;
  const int total = n_conv + n_mod + n_tw + n_cp;
  for (int it = blockIdx.x; it < total; it += gridDim.x) {
    if (it < n_conv) {
      int l = it / per_layer, r = it - l * per_layer;
      char* wl = p.ws + OFF_W + (size_t)l * WL_SIZE;
      float* tile = (float*)smem;
      if (r < 576) convT_item(p.in[I_WIN] + (size_t)l * 1024 * NIN, (u16*)(wl + WL_WIN), 1024, NIN, NINP, nullptr, r, tile);
      else if ((r -= 576) < 256) convT_item(p.in[I_WOUT] + (size_t)l * 1024 * 1024, (u16*)(wl + WL_WOUT), 1024, 1024, 1024, nullptr, r, tile);
      else if ((r -= 256) < 1024) convT_item(p.in[I_W1] + (size_t)l * 1024 * 4096, (u16*)(wl + WL_W1), 1024, 4096, 4096, nullptr, r, tile);
      else if ((r -= 1024) < 1024) convT_item(p.in[I_W2] + (size_t)l * 4096 * 1024, (u16*)(wl + WL_W2), 4096, 1024, 1024, nullptr, r, tile);
      else if ((r -= 1024) < 48) convT_item(p.in[I_WUQ] + (size_t)l * 256 * 768, (u16*)(wl + WL_WUQ), 256, 768, 768, p.in[I_QNG] + l * 256, r, tile);
      else { r -= 48; convT_item(p.in[I_WUKV] + (size_t)l * 128 * 1024, (u16*)(wl + WL_WUKV), 128, 1024, 1024, p.in[I_KVNG] + l * 128, r, tile, true); }
    } else if (it < n_conv + n_mod) {
      int r = it - n_conv;
      int l = r / 96, n0 = (r - l * 96) * 64;
      float* sc = (float*)smem;
      float* red = sc + 5120;
      for (int i = tidx(); i < 5120; i += 256) {
        int rr = i >> 10, k = i & 1023;
        float cv = rr < 4 ? p.in[I_C][rr * 1024 + k] : p.in[I_CCTX][k];
        sc[i] = cv / (1.f + expf(-cv));
      }
      __syncthreads();
      int nn = tidx() & 63, kq = tidx() >> 6;
      float a0 = 0, a1 = 0, a2 = 0, a3 = 0, a4 = 0;
      const float* w = p.in[I_WADA] + ((size_t)l * 1024 + kq * 256) * 6144 + n0 + nn;
#pragma unroll 8
      for (int k = 0; k < 256; k++) {
        float wv = w[(size_t)k * 6144];
        int kk = kq * 256 + k;
        a0 += sc[kk] * wv; a1 += sc[1024 + kk] * wv; a2 += sc[2048 + kk] * wv; a3 += sc[3072 + kk] * wv; a4 += sc[4096 + kk] * wv;
      }
      red[(kq * 5 + 0) * 64 + nn] = a0; red[(kq * 5 + 1) * 64 + nn] = a1; red[(kq * 5 + 2) * 64 + nn] = a2;
      red[(kq * 5 + 3) * 64 + nn] = a3; red[(kq * 5 + 4) * 64 + nn] = a4;
      __syncthreads();
      if (tidx() < 64) {
        float* mod = (float*)(p.ws + OFF_MOD);
        float bb = p.in[I_BADA][l * 6144 + n0 + nn];
        for (int rr = 0; rr < 5; rr++) {
          float s = red[(0 * 5 + rr) * 64 + nn] + red[(1 * 5 + rr) * 64 + nn] + red[(2 * 5 + rr) * 64 + nn] + red[(3 * 5 + rr) * 64 + nn];
          mod[(size_t)(l * 5 + rr) * 6144 + n0 + nn] = s + bb;
        }
      }
      __syncthreads();
    } else if (it >= n_conv + n_mod + n_tw) {
      int e = (it - n_conv - n_mod - n_tw) * 256 + tidx();
      ((float4*)(p.ws + OFF_XC))[e] = ((const float4*)p.in[I_CTX])[e];
    } else {
      int q = it - n_conv - n_mod;
      if (q < 32) {
        int n = q * 256 + tidx();
        float sn, cs;
        sincospif((float)n / 8192.f, &sn, &cs);
        ((float2*)(p.ws + OFF_TW))[n] = make_float2(cs, -sn);
      } else {
        int e = (q - 32) * 256 + tidx();
        int pos = e >> 3, f = e & 7;
        float pv = pos < 128 ? (float)pos : (float)(pos - 128);
        float inv = powf(10000.f, -(float)f / 8.f);
        float sn, cs;
        sincosf(pv * inv, &sn, &cs);
        ((float2*)(p.ws + OFF_ROPE))[e] = make_float2(cs, sn);
      }
    }
  }
}

DI void filt_a_item(const Params& p, int l, int Lf, float* h2out, int pos) {
  int lane = tidx() & 63;
  float tpos = (float)pos / (float)(Lf - 1);
  float zval = 0.f;
  if (lane == 0) zval = tpos;
  else if (lane < 33) {
    int jj = (lane - 1) & 15;
    float band = 1e-4f + (float)jj * ((15.f - 1e-4f) / 15.f);
    float ang = ((float)(6.283185307179586 / (double)Lf)) * (float)pos * band;
    zval = lane < 17 ? cosf(ang) : -sinf(ang);
  }
  const float* w1 = p.in[I_HW1] + l * 33 * 64;
  const float* w2 = p.in[I_HW2] + l * 64 * 64;
  float acc = p.in[I_HB1][l * 64 + lane];
  for (int i = 0; i < 33; i++) acc += __shfl(zval, i) * w1[i * 64 + lane];
  float h1 = sinf(p.in[I_HSF][l * 128 + lane] * acc);
  float acc2 = p.in[I_HB2][l * 64 + lane];
  for (int i = 0; i < 64; i++) acc2 += __shfl(h1, i) * w2[i * 64 + lane];
  h2out[(size_t)pos * 64 + lane] = sinf(p.in[I_HSF][l * 128 + 64 + lane] * acc2);
}

DI void phase_norm(const Params& p, int l, int which, int nrows, bool with_filter) {
  const int lane = tidx() & 63, wid = tidx() >> 6;
  const bool first = (l == 0 && which == 1);
  const int n_norm = nrows >> 3;
  const int n_fa = with_filter ? (8192 / 4 + (l == 0 ? 256 / 4 : 0)) : 0;
  const float* gsrc = p.in[which == 1 ? I_N1G : I_N2G] + l * 1024;
  u16* H = (u16*)(p.ws + OFF_H);
  for (int it = blockIdx.x; it < n_norm + n_fa; it += gridDim.x) {
    if (it < n_norm) {
      int row = it * 8 + wid * 2;
      const float* src;
      int cond;
      if (row < TLAT) { src = (first ? p.in[I_X] : p.out) + (size_t)row * 1024; cond = row >> 13; }
      else { src = (first ? p.in[I_CTX] : (const float*)(p.ws + OFF_XC)) + (size_t)(row - TLAT) * 1024; cond = 4; }
      const float* m = (const float*)(p.ws + OFF_MOD) + (size_t)(l * 5 + cond) * 6144 + (which == 1 ? 0 : 3072);
      float4 v[8];
      float ssq0 = 0.f, ssq1 = 0.f;
#pragma unroll
      for (int i = 0; i < 4; i++) {
        v[i] = *(const float4*)(src + i * 256 + lane * 4);
        v[4 + i] = *(const float4*)(src + 1024 + i * 256 + lane * 4);
      }
#pragma unroll
      for (int i = 0; i < 4; i++) {
        ssq0 += v[i].x * v[i].x + v[i].y * v[i].y + v[i].z * v[i].z + v[i].w * v[i].w;
        ssq1 += v[4 + i].x * v[4 + i].x + v[4 + i].y * v[4 + i].y + v[4 + i].z * v[4 + i].z + v[4 + i].w * v[4 + i].w;
      }
      ssq0 = wave_sum(ssq0); ssq1 = wave_sum(ssq1);
      float rstd0 = rsqrtf(ssq0 * (1.f / 1024.f) + 1e-6f), rstd1 = rsqrtf(ssq1 * (1.f / 1024.f) + 1e-6f);
#pragma unroll
      for (int i = 0; i < 4; i++) {
        int col = i * 256 + lane * 4;
        float4 g = *(const float4*)(gsrc + col), sh = *(const float4*)(m + col), sc = *(const float4*)(m + 1024 + col);
        float gx = g.x * (1.f + sc.x), gy = g.y * (1.f + sc.y), gz = g.z * (1.f + sc.z), gw = g.w * (1.f + sc.w);
        *(uint2*)(H + (size_t)row * 1024 + col) = make_uint2(pack2(v[i].x * rstd0 * gx + sh.x, v[i].y * rstd0 * gy + sh.y),
                                                             pack2(v[i].z * rstd0 * gz + sh.z, v[i].w * rstd0 * gw + sh.w));
        *(uint2*)(H + (size_t)(row + 1) * 1024 + col) = make_uint2(pack2(v[4 + i].x * rstd1 * gx + sh.x, v[4 + i].y * rstd1 * gy + sh.y),
                                                                   pack2(v[4 + i].z * rstd1 * gz + sh.z, v[4 + i].w * rstd1 * gw + sh.w));
      }
    } else {
      int q = it - n_norm;
      if (q < 2048) filt_a_item(p, l, 8192, (float*)(p.ws + OFF_H2F), q * 4 + wid);
      else filt_a_item(p, l, 256, (float*)(p.ws + OFF_H2C), (q - 2048) * 4 + wid);
    }
  }
}

constexpr int GLD = 40;
constexpr int GBUF = (256 + 128) * GLD;
template <bool ROWNORM, bool TR0, bool TR1, int OUT, class Epi, class DF>
DI void gemm_tile(const u16* __restrict__ A, int lda, const u16* __restrict__ Bt, int ldb, int K, int m0, int n0,
                  const u16* __restrict__ at_src, int at_kt, char* smem, Epi epi, DF df) {
  u16* Ls = (u16*)smem;
  float* rs = (float*)(smem + 69632);
  int tid_o = tidx();
  const int tid = tid_o, lane = tid & 63, wid = tid >> 6, wm = wid >> 1, wn = wid & 1, r = lane & 31, h = lane >> 5;
  const bool trans = (TR0 == TR1) ? TR0 : (wn ? TR1 : TR0);
  f32x16 acc[4][2];
#pragma unroll
  for (int mi = 0; mi < 4; mi++)
#pragma unroll
    for (int ni = 0; ni < 2; ni++)
#pragma unroll
      for (int e = 0; e < 16; e++) acc[mi][ni][e] = 0.f;
  u32x4 ra0[4], rb0[2], ra1[4], rb1[2];
  float ssq[4];
#pragma unroll
  for (int i = 0; i < 4; i++) ssq[i] = 0.f;
  const int nk = K >> 5;
  const int lrow = tid >> 2, lkc = tid & 3;
  const int tch = tid & 31, ttc = tid >> 5;
  const bool has_at = at_src != nullptr;
#define GEMM_GLOAD(KT, RA, RB)                                                                                              \
  {                                                                                                                         \
    const int kt_ = (KT);                                                                                                   \
    if (has_at && kt_ < at_kt) {                                                                                            \
      _Pragma("unroll") for (int i = 0; i < 4; i++) RA[i] = *(const u32x4*)(at_src + (size_t)(kt_ * 32 + tch) * 8192 + (ttc + 8 * i) * 8); \
    } else {                                                                                                                \
      _Pragma("unroll") for (int i = 0; i < 4; i++) RA[i] = *(const u32x4*)(A + (size_t)(m0 + lrow + 64 * i) * lda + kt_ * 32 + lkc * 8);  \
    }                                                                                                                       \
    _Pragma("unroll") for (int i = 0; i < 2; i++) RB[i] = *(const u32x4*)(Bt + (size_t)(n0 + lrow + 64 * i) * ldb + kt_ * 32 + lkc * 8);   \
  }
#define GEMM_LWRITE(KT, RA, RB)                                                                                             \
  {                                                                                                                         \
    const int kt_ = (KT);                                                                                                   \
    u16* As_ = Ls + (kt_ & 1) * GBUF;                                                                                       \
    u16* Bs_ = As_ + 256 * GLD;                                                                                             \
    if (has_at && kt_ < at_kt) {                                                                                            \
      _Pragma("unroll") for (int i = 0; i < 4; i++)                                                                         \
        _Pragma("unroll") for (int j = 0; j < 8; j++) As_[((ttc + 8 * i) * 8 + j) * GLD + tch] = bfu(RA[i], j);             \
    } else {                                                                                                                \
      _Pragma("unroll") for (int i = 0; i < 4; i++) *(u32x4*)(As_ + (lrow + 64 * i) * GLD + lkc * 8) = RA[i];               \
    }                                                                                                                       \
    _Pragma("unroll") for (int i = 0; i < 2; i++) *(u32x4*)(Bs_ + (lrow + 64 * i) * GLD + lkc * 8) = RB[i];                 \
    if (ROWNORM) {                                                                                                          \
      _Pragma("unroll") for (int i = 0; i < 4; i++)                                                                         \
        _Pragma("unroll") for (int j = 0; j < 8; j++) { float x = bfe(RA[i], j); ssq[i] += x * x; }                         \
    }                                                                                                                       \
  }
#define GEMM_COMPUTE(KT)                                                                                                    \
  {                                                                                                                         \
    const u16* As = Ls + ((KT) & 1) * GBUF;                                                                                 \
    const u16* Bs = As + 256 * GLD;                                                                                         \
    _Pragma("unroll") for (int ks = 0; ks < 2; ks++) {                                                                      \
      __builtin_amdgcn_sched_barrier(0);                                                                                    \
      bf16x8 a[4], b[2];                                                                                                    \
      _Pragma("unroll") for (int mi = 0; mi < 4; mi++) a[mi] = *(const bf16x8*)(As + (wm * 128 + mi * 32 + r) * GLD + ks * 16 + h * 8); \
      _Pragma("unroll") for (int ni = 0; ni < 2; ni++) b[ni] = *(const bf16x8*)(Bs + (wn * 64 + ni * 32 + r) * GLD + ks * 16 + h * 8);  \
      __builtin_amdgcn_s_setprio(1);                                                                                        \
      if (!trans) {                                                                                                         \
        _Pragma("unroll") for (int mi = 0; mi < 4; mi++)                                                                    \
          _Pragma("unroll") for (int ni = 0; ni < 2; ni++) acc[mi][ni] = MFMA32(a[mi], b[ni], acc[mi][ni]);                 \
      } else {                                                                                                              \
        _Pragma("unroll") for (int mi = 0; mi < 4; mi++)                                                                    \
          _Pragma("unroll") for (int ni = 0; ni < 2; ni++) acc[mi][ni] = MFMA32(b[ni], a[mi], acc[mi][ni]);                 \
      }                                                                                                                     \
      __builtin_amdgcn_s_setprio(0);                                                                                        \
    }                                                                                                                       \
  }
  GEMM_GLOAD(0, ra0, rb0)
  GEMM_GLOAD(1, ra1, rb1)
  GEMM_LWRITE(0, ra0, rb0)
  __syncthreads();
  for (int kt = 0; kt < nk; kt += 2) {
    GEMM_LWRITE(kt + 1, ra1, rb1)
    if (kt + 2 < nk) { GEMM_GLOAD(kt + 2, ra0, rb0) GEMM_GLOAD(kt + 3, ra1, rb1) }
    GEMM_COMPUTE(kt)
    __syncthreads();
    if (kt + 2 < nk) GEMM_LWRITE(kt + 2, ra0, rb0)
    GEMM_COMPUTE(kt + 1)
    __syncthreads();
  }
#undef GEMM_COMPUTE
#undef GEMM_GLOAD
#undef GEMM_LWRITE
  if (ROWNORM) {
    float* rsp = (float*)smem;
    {
      const int t2 = tidx();
#pragma unroll
      for (int i = 0; i < 4; i++) rsp[((t2 >> 2) + 64 * i) * 4 + (t2 & 3)] = ssq[i];
    }
    __syncthreads();
    {
      const int t3 = tidx();
      float4 q = *(const float4*)(rsp + t3 * 4);
      rs[t3] = rsqrtf((q.x + q.y + q.z + q.w) / (float)K + 1e-6f);
    }
    __syncthreads();
  }
  if constexpr (OUT == 0) {
#define EPI_CALL(mi, ni) epi(m0 + wm * 128 + (mi) * 32, n0 + wn * 64 + (ni) * 32, acc[mi][ni], rs);
    EPI_CALL(0, 0) EPI_CALL(0, 1) EPI_CALL(1, 0) EPI_CALL(1, 1) EPI_CALL(2, 0) EPI_CALL(2, 1) EPI_CALL(3, 0) EPI_CALL(3, 1)
#undef EPI_CALL
    __syncthreads();
  } else if constexpr (OUT == 1) {
    u16* S = (u16*)smem;
#define EPI_STAGE(mi, ni)                                                                                                   \
    _Pragma("unroll") for (int reg = 0; reg < 16; reg++) {                                                                   \
      int lr = wm * 128 + (mi) * 32 + crow(reg, h), lc = wn * 64 + (ni) * 32 + r;                                           \
      S[lr * 136 + lc] = f2bf(epi(m0 + lr, n0 + lc, acc[mi][ni][reg], rs));                                                 \
    }
    EPI_STAGE(0, 0) EPI_STAGE(0, 1) EPI_STAGE(1, 0) EPI_STAGE(1, 1) EPI_STAGE(2, 0) EPI_STAGE(2, 1) EPI_STAGE(3, 0) EPI_STAGE(3, 1)
#undef EPI_STAGE
    __syncthreads();
    {
      const int t2 = tidx();
#pragma unroll 4
      for (int i = 0; i < 16; i++) {
        int id = t2 + 256 * i, lr = id >> 4, c = id & 15;
        u16* d = df(m0 + lr, n0 + c * 8);
        if (d) *(u32x4*)d = *(const u32x4*)(S + lr * 136 + c * 8);
      }
    }
    __syncthreads();
  } else if constexpr (OUT == 2) {
    u16* S = (u16*)smem;
#define EPI_STAGE(mi, ni)                                                                                                   \
    _Pragma("unroll") for (int reg = 0; reg < 16; reg++) {                                                                   \
      int lr = wm * 128 + (mi) * 32 + r, lc = wn * 64 + (ni) * 32 + crow(reg, h);                                           \
      S[lc * 264 + lr] = f2bf(epi(m0 + lr, n0 + lc, acc[mi][ni][reg], rs));                                                 \
    }
    EPI_STAGE(0, 0) EPI_STAGE(0, 1) EPI_STAGE(1, 0) EPI_STAGE(1, 1) EPI_STAGE(2, 0) EPI_STAGE(2, 1) EPI_STAGE(3, 0) EPI_STAGE(3, 1)
#undef EPI_STAGE
    __syncthreads();
    {
      const int t2 = tidx();
#pragma unroll 4
      for (int i = 0; i < 16; i++) {
        int id = t2 + 256 * i, lc = id >> 5, t8 = id & 31;
        u16* d = df(m0 + t8 * 8, n0 + lc);
        if (d) *(u32x4*)d = *(const u32x4*)(S + lc * 264 + t8 * 8);
      }
    }
    __syncthreads();
  } else {
    float* S = (float*)smem;
#pragma unroll
    for (int pass = 0; pass < 2; pass++) {
      if (wm == pass) {
#define EPI_STAGE(mi, ni)                                                                                                   \
        _Pragma("unroll") for (int reg = 0; reg < 16; reg++) S[((mi) * 32 + crow(reg, h)) * 132 + wn * 64 + (ni) * 32 + r] = acc[mi][ni][reg];
        EPI_STAGE(0, 0) EPI_STAGE(0, 1) EPI_STAGE(1, 0) EPI_STAGE(1, 1) EPI_STAGE(2, 0) EPI_STAGE(2, 1) EPI_STAGE(3, 0) EPI_STAGE(3, 1)
#undef EPI_STAGE
      }
      __syncthreads();
      {
        const int t2 = tidx();
#pragma unroll 4
        for (int i = 0; i < 16; i++) {
          int id = t2 + 256 * i, lr = id >> 5, c4 = id & 31;
          float4 a = *(const float4*)(S + lr * 132 + c4 * 4);
          df(m0 + pass * 128 + lr, n0 + c4 * 4, a);
        }
      }
      __syncthreads();
    }
  }
}

DI void phase_win(const Params& p, int l, char* smem) {
  const u16* H = (const u16*)(p.ws + OFF_H);
  const u16* W = (const u16*)(p.ws + OFF_W + (size_t)l * WL_SIZE + WL_WIN);
  u16* UT = (u16*)(p.ws + OFF_UT);
  u16* UTC = (u16*)(p.ws + OFF_UTC);
  u16* RET = (u16*)(p.ws + OFF_RET);
  u16* CQ = (u16*)(p.ws + OFF_CQ);
  u16* CKV = (u16*)(p.ws + OFF_CKV);
  u16* KF = (u16*)(p.ws + OFF_KF);
  const int lane = tidx() & 63, r = lane & 31, h = lane >> 5;
  const int total = 132 * 18;
  for (int it = blockIdx.x; it < total; it += gridDim.x) {
    int mt = it / 18, nt = it - mt * 18;
    int m0 = mt * 256, n0 = nt * 128;
    if (nt < 6) {
      gemm_tile<false, true, true, 2>(H, 1024, W, 1024, 1024, m0, n0, nullptr, 0, smem,
        [&](int row, int col, float v, const float*) __attribute__((always_inline)) { return v; },
        [&](int row, int col) __attribute__((always_inline)) -> u16* {
          int b, t, key, cond;
          row_info(row, b, t, key, cond);
          return row < TLAT ? UT + ((size_t)(b * 768 + col)) * SEQ + t : UTC + ((size_t)(b * 768 + col)) * LCTX + t;
        });
    } else {
      if (nt < 17) {
        gemm_tile<false, false, false, 1>(H, 1024, W, 1024, 1024, m0, n0, nullptr, 0, smem,
          [&](int row, int col, float v, const float*) __attribute__((always_inline)) {
            return (col >= 768 + 256 && col < 768 + 512) ? v * 0.125f : v;
          },
          [&](int row, int col) __attribute__((always_inline)) -> u16* {
            if (nt < 14) return RET + (size_t)row * 1024 + (col - 768);
            if (nt < 16) return CQ + (size_t)row * 256 + (col - 1792);
            return CKV + (size_t)row * 128 + (col - 2048);
          });
      } else {
        gemm_tile<false, false, false, 0>(H, 1024, W, 1024, 1024, m0, n0, nullptr, 0, smem,
          [&](int bm, int bn, const f32x16& acc, const float*) __attribute__((always_inline)) {
            const int lz_ = tidx() & 63, r = lz_ & 31, h = lz_ >> 5;
            if (bn == 2176) {
#pragma unroll
              for (int reg = 0; reg < 16; reg++) {
                int row = bm + crow(reg, h), b, t, key, cond;
                row_info(row, b, t, key, cond);
                float v = acc[reg];
                float vr = rope_apply((const float2*)(p.ws + OFF_ROPE), v, r, t);
                if (row < TLAT) v = vr;
                u16 o = f2bf(v);
#pragma unroll
                for (int hh = 0; hh < 8; hh++) KF[((size_t)(b * 8 + hh) * LKEY + key) * 96 + 64 + r] = o;
              }
            }
          }, [](int, int) __attribute__((always_inline)) -> u16* { return nullptr; });
      }
    }
  }
}

DI void ret_gammas(const Params& p, int l, int hh, float& lgf, float& lgb) {
  lgf = log1pf(-expf(p.in[I_RLD][l * 8 + hh]));
  lgb = log1pf(-expf(p.in[I_RLD][l * 8 + 4 + hh]));
}
DI void ret_kv_item(const Params& p, int l, int b, int hh, int ci, char* smem) {
  const u16* RET = (const u16*)(p.ws + OFF_RET);
  float* ST = (float*)(p.ws + OFF_ST);
  u16* KfT = (u16*)smem;
  u16* KbT = KfT + 64 * 136;
  u16* VsT = KbT + 64 * 136;
  int tid_o = tidx();
  asm volatile("" : "+v"(tid_o));
  const int tid = tid_o, lane = tid & 63, wid = tid >> 6, r = lane & 31, h = lane >> 5;
  float lgf, lgb;
  ret_gammas(p, l, hh, lgf, lgb);
  const int row0 = chunk_row0(b, ci);
#pragma unroll
  for (int i = 0; i < 4; i++) {
    int id = tid + 256 * i, m = id >> 3, dc = id & 7;
    u32x4 kv = *(const u32x4*)(RET + (size_t)(row0 + m) * 1024 + 256 + hh * 64 + dc * 8);
    u32x4 vv = *(const u32x4*)(RET + (size_t)(row0 + m) * 1024 + 512 + hh * 64 + dc * 8);
    float zf = __expf(lgf * (float)(127 - m)), zb = __expf(lgb * (float)m);
#pragma unroll
    for (int j = 0; j < 8; j++) {
      float kval = bfe(kv, j);
      KfT[(dc * 8 + j) * 136 + m] = f2bf(kval * zf);
      KbT[(dc * 8 + j) * 136 + m] = f2bf(kval * zb);
      VsT[(dc * 8 + j) * 136 + m] = bfu(vv, j);
    }
  }
  __syncthreads();
  const int dir = wid >> 1, dh = wid & 1;
  const u16* Asrc = dir ? KbT : KfT;
  f32x16 c0, c1;
#pragma unroll
  for (int e = 0; e < 16; e++) { c0[e] = 0.f; c1[e] = 0.f; }
#pragma unroll
  for (int ks = 0; ks < 8; ks++) {
    bf16x8 a = *(const bf16x8*)(Asrc + (dh * 32 + r) * 136 + ks * 16 + h * 8);
    bf16x8 b0 = *(const bf16x8*)(VsT + (r) * 136 + ks * 16 + h * 8);
    bf16x8 b1 = *(const bf16x8*)(VsT + (32 + r) * 136 + ks * 16 + h * 8);
    c0 = MFMA32(a, b0, c0);
    c1 = MFMA32(a, b1, c1);
  }
  float* dst = ST + ((size_t)((dir * 4 + b) * 4 + hh) * NCH + ci) * 4096;
#pragma unroll
  for (int reg = 0; reg < 16; reg++) {
    int d = dh * 32 + crow(reg, h);
    dst[d * 64 + r] = c0[reg];
    dst[d * 64 + 32 + r] = c1[reg];
  }
  __syncthreads();
}

#define PX(i) ((i) + ((i) >> 4))
typedef float cf2 __attribute__((ext_vector_type(2)));
DI cf2 mk2(float x, float y) { cf2 r; r.x = x; r.y = y; return r; }
DI cf2 cmul(cf2 a, cf2 b) { return mk2(a.x * b.x - a.y * b.y, a.x * b.y + a.y * b.x); }
DI cf2 cmulc(cf2 a, cf2 b) { return mk2(a.x * b.x + a.y * b.y, a.y * b.x - a.x * b.y); }
DI cf2 cadd(cf2 a, cf2 b) { return mk2(a.x + b.x, a.y + b.y); }
DI cf2 csub(cf2 a, cf2 b) { return mk2(a.x - b.x, a.y - b.y); }
DI cf2 twid_rev(float rev) { return mk2(__builtin_amdgcn_cosf(rev), -__builtin_amdgcn_sinf(rev)); }

template <int S, bool INV>
DI void fft_pass8(float2* Xf2, int tid) {
  cf2* X = (cf2*)Xf2;
  constexpr int span = 8192 >> S, q = span >> 3, lq = 10 - S;
  const float R = 0.70710678118654752f;
#pragma unroll 2
  for (int gi = 0; gi < 4; gi++) {
    int g = tid + 256 * gi;
    int j = g & (q - 1), blk = g >> lq, base = blk * span + j;
    cf2 v[8];
#pragma unroll
    for (int k = 0; k < 8; k++) v[k] = X[PX(base + k * q)];
    cf2 W = twid_rev((float)j * (1.f / (float)span));
    cf2 W2 = cmul(W, W), W4 = cmul(W2, W2);
    cf2 w1 = cmul(W, mk2(R, -R)), w2 = mk2(W.y, -W.x), w3 = cmul(W, mk2(-R, -R));
    cf2 w2b = mk2(W2.y, -W2.x);
    if (!INV) {
      { cf2 a, d;
        a = v[0]; d = csub(a, v[4]); v[0] = cadd(a, v[4]); v[4] = cmul(d, W);
        a = v[1]; d = csub(a, v[5]); v[1] = cadd(a, v[5]); v[5] = cmul(d, w1);
        a = v[2]; d = csub(a, v[6]); v[2] = cadd(a, v[6]); v[6] = cmul(d, w2);
        a = v[3]; d = csub(a, v[7]); v[3] = cadd(a, v[7]); v[7] = cmul(d, w3); }
#pragma unroll
      for (int b4 = 0; b4 < 8; b4 += 4) { cf2 a, d;
        a = v[b4]; d = csub(a, v[b4 + 2]); v[b4] = cadd(a, v[b4 + 2]); v[b4 + 2] = cmul(d, W2);
        a = v[b4 + 1]; d = csub(a, v[b4 + 3]); v[b4 + 1] = cadd(a, v[b4 + 3]); v[b4 + 3] = cmul(d, w2b); }
#pragma unroll
      for (int k = 0; k < 8; k += 2) { cf2 a = v[k], d = csub(a, v[k + 1]); v[k] = cadd(a, v[k + 1]); v[k + 1] = cmul(d, W4); }
    } else {
#pragma unroll
      for (int k = 0; k < 8; k += 2) { cf2 a = v[k], bb = cmulc(v[k + 1], W4); v[k] = cadd(a, bb); v[k + 1] = csub(a, bb); }
#pragma unroll
      for (int b4 = 0; b4 < 8; b4 += 4) { cf2 a, bb;
        a = v[b4]; bb = cmulc(v[b4 + 2], W2); v[b4] = cadd(a, bb); v[b4 + 2] = csub(a, bb);
        a = v[b4 + 1]; bb = cmulc(v[b4 + 3], w2b); v[b4 + 1] = cadd(a, bb); v[b4 + 3] = csub(a, bb); }
      { cf2 a, bb;
        a = v[0]; bb = cmulc(v[4], W); v[0] = cadd(a, bb); v[4] = csub(a, bb);
        a = v[1]; bb = cmulc(v[5], w1); v[1] = cadd(a, bb); v[5] = csub(a, bb);
        a = v[2]; bb = cmulc(v[6], w2); v[2] = cadd(a, bb); v[6] = csub(a, bb);
        a = v[3]; bb = cmulc(v[7], w3); v[3] = cadd(a, bb); v[7] = csub(a, bb); }
    }
#pragma unroll
    for (int k = 0; k < 8; k++) X[PX(base + k * q)] = v[k];
  }
  __syncthreads();
}

DI cf2 t16f(int k) {
  const float C1 = 0.92387953251128674f, S1 = 0.38268343236508977f, R = 0.70710678118654752f;
  return k == 0 ? mk2(1.f, 0.f) : k == 1 ? mk2(C1, -S1) : k == 2 ? mk2(R, -R) : k == 3 ? mk2(S1, -C1) : k == 4 ? mk2(0.f, -1.f)
       : k == 5 ? mk2(-S1, -C1) : k == 6 ? mk2(-R, -R) : mk2(-C1, -S1);
}
template <bool INV>
DI void fft_pass16(float2* Xf2, int tid) {
  cf2* X = (cf2*)Xf2;
#pragma unroll 1
  for (int gi = 0; gi < 2; gi++) {
    int g = tid + 256 * gi;
    cf2* xp = X + 17 * g;
    cf2 v[16];
#pragma unroll
    for (int k = 0; k < 16; k++) v[k] = xp[k];
    if (!INV) {
#pragma unroll
      for (int k = 0; k < 8; k++) { cf2 a = v[k], d = csub(a, v[k + 8]); v[k] = cadd(a, v[k + 8]); v[k + 8] = cmul(d, t16f(k)); }
#pragma unroll
      for (int b8 = 0; b8 < 16; b8 += 8)
#pragma unroll
        for (int k = 0; k < 4; k++) { cf2 a = v[b8 + k], d = csub(a, v[b8 + k + 4]); v[b8 + k] = cadd(a, v[b8 + k + 4]); v[b8 + k + 4] = cmul(d, t16f(2 * k)); }
#pragma unroll
      for (int b4 = 0; b4 < 16; b4 += 4)
#pragma unroll
        for (int k = 0; k < 2; k++) { cf2 a = v[b4 + k], d = csub(a, v[b4 + k + 2]); v[b4 + k] = cadd(a, v[b4 + k + 2]); v[b4 + k + 2] = cmul(d, t16f(4 * k)); }
#pragma unroll
      for (int k = 0; k < 16; k += 2) { cf2 a = v[k], bb = v[k + 1]; v[k] = cadd(a, bb); v[k + 1] = csub(a, bb); }
    } else {
#pragma unroll
      for (int k = 0; k < 16; k += 2) { cf2 a = v[k], bb = v[k + 1]; v[k] = cadd(a, bb); v[k + 1] = csub(a, bb); }
#pragma unroll
      for (int b4 = 0; b4 < 16; b4 += 4)
#pragma unroll
        for (int k = 0; k < 2; k++) { cf2 a = v[b4 + k], bb = cmulc(v[b4 + k + 2], t16f(4 * k)); v[b4 + k] = cadd(a, bb); v[b4 + k + 2] = csub(a, bb); }
#pragma unroll
      for (int b8 = 0; b8 < 16; b8 += 8)
#pragma unroll
        for (int k = 0; k < 4; k++) { cf2 a = v[b8 + k], bb = cmulc(v[b8 + k + 4], t16f(2 * k)); v[b8 + k] = cadd(a, bb); v[b8 + k + 4] = csub(a, bb); }
#pragma unroll
      for (int k = 0; k < 8; k++) { cf2 a = v[k], bb = cmulc(v[k + 8], t16f(k)); v[k] = cadd(a, bb); v[k + 8] = csub(a, bb); }
    }
#pragma unroll
    for (int k = 0; k < 16; k++) xp[k] = v[k];
  }
  __syncthreads();
}
DI void fft_dif(float2* X, const float2* __restrict__, int tid) {
  fft_pass8<0, false>(X, tid); fft_pass8<3, false>(X, tid); fft_pass8<6, false>(X, tid); fft_pass16<false>(X, tid);
}
DI void fft_dit(float2* X, const float2* __restrict__, int tid) {
  fft_pass16<true>(X, tid); fft_pass8<6, true>(X, tid); fft_pass8<3, true>(X, tid); fft_pass8<0, true>(X, tid);
}

DI void filt_fft_item(const Params& p, int l, int o, int c, char* smem) {
  float2* X = (float2*)smem;
  float* Xf = (float*)smem;
  float* w3s = (float*)(smem + 69632);
  float* red = w3s + 128;
  const float2* TW = (const float2*)(p.ws + OFF_TW);
  const float* H2 = (const float*)(p.ws + OFF_H2F);
  float2* KS = (float2*)(p.ws + OFF_KSPEC) + (size_t)(o * 256 + c) * 2 * 8192;
  int tid_o = tidx();
  asm volatile("" : "+v"(tid_o));
  const int tid = tid_o;
  if (tid < 128) { int j = tid & 63, side = tid >> 6; w3s[tid] = p.in[I_HW3][((size_t)l * 64 + j) * 1024 + side * 512 + o * 256 + c]; }
  __syncthreads();
  const float min_decay = -3.0701134573253944f, max_decay = -15.350567286626972f;
  const float delta = fabsf(min_decay + (float)c * ((max_decay - min_decay) / 255.f));
  float* Ff = Xf;
  float* Fb = Xf + 8192;
#pragma unroll 1
  for (int i = 0; i < 32; i++) {
    int n = tid + 256 * i;
    const float4* hp = (const float4*)(H2 + (size_t)n * 64);
    float f = 0.f, bsum = 0.f;
#pragma unroll
    for (int q = 0; q < 16; q++) {
      float4 hv = hp[q];
      f += hv.x * w3s[q * 4] + hv.y * w3s[q * 4 + 1] + hv.z * w3s[q * 4 + 2] + hv.w * w3s[q * 4 + 3];
      bsum += hv.x * w3s[64 + q * 4] + hv.y * w3s[64 + q * 4 + 1] + hv.z * w3s[64 + q * 4 + 2] + hv.w * w3s[64 + q * 4 + 3];
    }
    float win = expf(-((float)n / 8191.f) * delta);
    Ff[n] = f * win; Fb[n] = bsum * win;
  }
  __syncthreads();
  float part = 0.f;
#pragma unroll 2
  for (int i = 0; i < 32; i++) {
    int n = tid + 256 * i;
    float k1 = Ff[n], k2 = 0.f;
    if (n == 0) k1 += Fb[0]; else k2 = Fb[8192 - n];
    part += fabsf(k1) + fabsf(k2);
    KS[8192 + n] = make_float2(k1, k2);
  }
  part = wave_sum(part);
  if ((tid & 63) == 0) red[tid >> 6] = part;
  __syncthreads();
  const float inv = 1.f / (red[0] + red[1] + red[2] + red[3]);
#pragma unroll 2
  for (int i = 0; i < 32; i++) { int n = tidx() + 256 * i; float2 kp = KS[8192 + n]; X[PX(n)] = make_float2((kp.x + kp.y) * inv, 0.f); }
  __syncthreads();
  fft_dif(X, TW, tid);
#pragma unroll 2
  for (int i = 0; i < 32; i++) { int n = tidx() + 256 * i; KS[n] = X[PX(n)]; }
  __syncthreads();
#pragma unroll 2
  for (int i = 0; i < 32; i++) { int n = tidx() + 256 * i; float2 w = TW[n]; float2 kp = KS[8192 + n]; float d = (kp.x - kp.y) * inv; X[PX(n)] = make_float2(d * w.x, d * w.y); }
  __syncthreads();
  fft_dif(X, TW, tid);
#pragma unroll 2
  for (int i = 0; i < 32; i++) { int n = tidx() + 256 * i; KS[8192 + n] = X[PX(n)]; }
  __syncthreads();
}

DI void filt_ctx_item(const Params& p, int l, int o, int c, char* smem) {
  float* red = (float*)smem;
  const float* H2 = (const float*)(p.ws + OFF_H2C);
  float* KC = (float*)(p.ws + OFF_KC) + (size_t)(o * 256 + c) * 512;
  int tid_o = tidx();
  asm volatile("" : "+v"(tid_o));
  const int n = tid_o;
  const float min_decay = -3.0701134573253944f, max_decay = -15.350567286626972f;
  const float delta = fabsf(min_decay + (float)c * ((max_decay - min_decay) / 255.f));
  float f = 0.f, bsum = 0.f;
  for (int j = 0; j < 64; j++) {
    float hv = H2[n * 64 + j];
    f += hv * p.in[I_HW3][((size_t)l * 64 + j) * 1024 + o * 256 + c];
    bsum += hv * p.in[I_HW3][((size_t)l * 64 + j) * 1024 + 512 + o * 256 + c];
  }
  float win = expf(-((float)n / 255.f) * delta);
  f *= win; bsum *= win;
  float part = n == 0 ? fabsf(f + bsum) : fabsf(f) + fabsf(bsum);
  part = wave_sum(part);
  __syncthreads();
  if ((n & 63) == 0) red[n >> 6] = part;
  __syncthreads();
  float inv = 1.f / (red[0] + red[1] + red[2] + red[3]);
  if (n == 0) { KC[256] = (f + bsum) * inv; KC[0] = 0.f; }
  else { KC[256 + n] = f * inv; KC[256 - n] = bsum * inv; }
  __syncthreads();
}

DI void phase_p3(const Params& p, int l, char* smem) {
  const int lane = tidx() & 63, r = lane & 31, h = lane >> 5;
  const int n_uq = (l == 0 ? 132 : 128) * 6, n_ukv = 132 * 8, n_r1 = 16 * NCH, n_ff = 512, n_fc = (l == 0 ? 512 : 0);
  const int total = n_uq + n_ukv + n_r1 + n_ff + n_fc;
  const char* wl = p.ws + OFF_W + (size_t)l * WL_SIZE;
  u16* Q = (u16*)(p.ws + OFF_Q);
  u16* KF = (u16*)(p.ws + OFF_KF);
  u16* VT = (u16*)(p.ws + OFF_VT);
  for (int it = blockIdx.x; it < total; it += gridDim.x) {
    int q = it;
    if (q < n_uq) {
      int mt = q / 6, nt = q - mt * 6;
      if (SUB_ON(0)) gemm_tile<true, false, false, 1>((const u16*)(p.ws + OFF_CQ), 256, (const u16*)(wl + WL_WUQ), 256, 256, mt * 256, nt * 128, nullptr, 0, smem,
        [&](int row, int col, float v, const float* rs) __attribute__((always_inline)) {
          const float qscale = 0.10206207261596577f * 1.4426950408889634f;
          v *= rs[row - mt * 256];
          if ((col % 96) >= 64) {
            int b, t, key, cond;
            row_info(row, b, t, key, cond);
            float vr = rope_apply((const float2*)(p.ws + OFF_ROPE), v, col & 31, t);
            if (row < TLAT) v = vr;
          }
          return v * qscale;
        },
        [&](int row, int col) __attribute__((always_inline)) -> u16* { return Q + (size_t)row * 768 + col; });
    } else if ((q -= n_uq) < n_ukv) {
      int mt = q >> 3, nt = q & 7;
      if (nt < 4) {
        if (SUB_ON(1)) gemm_tile<true, false, false, 1>((const u16*)(p.ws + OFF_CKV), 128, (const u16*)(wl + WL_WUKV), 128, 128, mt * 256, nt * 128, nullptr, 0, smem,
          [&](int row, int col, float v, const float* rs) __attribute__((always_inline)) { return v * rs[row - mt * 256]; },
          [&](int row, int col) __attribute__((always_inline)) -> u16* {
            int b, t, key, cond;
            row_info(row, b, t, key, cond);
            return KF + ((size_t)(b * 8 + (col >> 6)) * LKEY + key) * 96 + (col & 63);
          });
      } else {
        if (SUB_ON(1)) gemm_tile<true, true, true, 2>((const u16*)(p.ws + OFF_CKV), 128, (const u16*)(wl + WL_WUKV), 128, 128, mt * 256, nt * 128, nullptr, 0, smem,
          [&](int row, int col, float v, const float* rs) __attribute__((always_inline)) { return v * rs[row - mt * 256]; },
          [&](int row, int col) __attribute__((always_inline)) -> u16* {
            int b, t, key, cond;
            row_info(row, b, t, key, cond);
            return VT + ((size_t)(b * 8 + ((col - 512) >> 6)) * 64 + ((col - 512) & 63)) * LKEY + key;
          });
      }
    } else if ((q -= n_ukv) < n_r1) {
      int bh = q / NCH, ci = q - bh * NCH;
      if (SUB_ON(2)) ret_kv_item(p, l, bh >> 2, bh & 3, ci, smem);
    } else if ((q -= n_r1) < n_ff) {
      if (SUB_ON(3)) filt_fft_item(p, l, q >> 8, q & 255, smem);
    } else {
      q -= n_ff;
      if (SUB_ON(4)) filt_ctx_item(p, l, q >> 8, q & 255, smem);
    }
  }
}

DI void phase_scan(const Params& p, int l) {
  float* ST = (float*)(p.ws + OFF_ST);
  for (int idx = blockIdx.x * 256 + tidx(); idx < 2 * 16 * 4096; idx += gridDim.x * 256) {
    int dir = idx >> 16, bh = (idx >> 12) & 15, el = idx & 4095, hh = bh & 3;
    float* base = ST + (size_t)((dir * 16 + bh) * NCH) * 4096 + el;
    float lg = log1pf(-expf(p.in[I_RLD][l * 8 + dir * 4 + hh]));
    float gC = expf(lg * 128.f);
    float s = 0.f;
    if (dir == 0) {
      for (int ci = 0; ci < NCH; ci++) { float tmp = base[(size_t)ci * 4096]; base[(size_t)ci * 4096] = s; s = gC * s + tmp; }
    } else {
      for (int ci = 1; ci >= 0; ci--) { float tmp = base[(size_t)ci * 4096]; base[(size_t)ci * 4096] = s; s = gC * s + tmp; }
      for (int ci = NCH - 1; ci >= 2; ci--) { float tmp = base[(size_t)ci * 4096]; base[(size_t)ci * 4096] = s; s = gC * s + tmp; }
    }
  }
}

#define ATT_SOFTMAX(S0, S1, O0, O1, M, LS)                                                                                  \
  {                                                                                                                         \
    float mx = S0[0];                                                                                                       \
    _Pragma("unroll") for (int e = 0; e < 16; e++) { mx = fmaxf(mx, S0[e]); mx = fmaxf(mx, S1[e]); }                        \
    mx = fmaxf(mx, __shfl_xor(mx, 32));                                                                                     \
    float d = (t == 0 || mx - M > 8.f) ? (mx - M) : 0.f;                                                                    \
    if (__any(d != 0.f)) {                                                                                                  \
      float alpha = __builtin_amdgcn_exp2f(-d);                                                                             \
      LS *= alpha;                                                                                                          \
      _Pragma("unroll") for (int e = 0; e < 16; e++) { O0[e] *= alpha; O1[e] *= alpha; }                                    \
      M += d;                                                                                                               \
    }                                                                                                                       \
    float ps = 0.f;                                                                                                         \
    _Pragma("unroll") for (int e = 0; e < 16; e++) {                                                                        \
      S0[e] = __builtin_amdgcn_exp2f(S0[e] - M); ps += S0[e];                                                               \
      S1[e] = __builtin_amdgcn_exp2f(S1[e] - M); ps += S1[e];                                                               \
    }                                                                                                                       \
    LS += ps;                                                                                                               \
  }
#define ATT_PACK(SV, SX, PB)                                                                                                \
  {                                                                                                                         \
    u32x4 pw_;                                                                                                              \
    pw_.x = pack2(SV[8 * (SX) + 0], SV[8 * (SX) + 1]); pw_.y = pack2(SV[8 * (SX) + 2], SV[8 * (SX) + 3]);                   \
    pw_.z = pack2(SV[8 * (SX) + 4], SV[8 * (SX) + 5]); pw_.w = pack2(SV[8 * (SX) + 6], SV[8 * (SX) + 7]);                   \
    PB = __builtin_bit_cast(bf16x8, pw_);                                                                                   \
  }
DI void attn_item(const Params& p, int b, int hh, int qrow0, int key0, int nkeys, char* smem) {
  u16* Ks = (u16*)smem;
  const u16* Q = (const u16*)(p.ws + OFF_Q);
  const u16* KF = (const u16*)(p.ws + OFF_KF);
  const u16* VT = (const u16*)(p.ws + OFF_VT);
  u16* MIX = (u16*)(p.ws + OFF_H);
  int tid_o = tidx();
  asm volatile("" : "+v"(tid_o));
  const int tid = tid_o, lane = tid & 63, wid = tid >> 6, r = lane & 31, h = lane >> 5;
  const int qrowA = qrow0 + wid * 64 + r, qrowB = qrowA + 32;
  bf16x8 qa[6], qb[6];
#pragma unroll
  for (int ks = 0; ks < 6; ks++) {
    qa[ks] = *(const bf16x8*)(Q + (size_t)qrowA * 768 + hh * 96 + ks * 16 + h * 8);
    qb[ks] = *(const bf16x8*)(Q + (size_t)qrowB * 768 + hh * 96 + ks * 16 + h * 8);
  }
  f32x16 oa0, oa1, ob0, ob1;
#pragma unroll
  for (int e = 0; e < 16; e++) { oa0[e] = 0.f; oa1[e] = 0.f; ob0[e] = 0.f; ob1[e] = 0.f; }
  float ma = 0.f, la = 0.f, mb = 0.f, lb = 0.f;
  const u32x4* kbase = (const u32x4*)(KF + ((size_t)(b * 8 + hh) * LKEY + key0) * 96);
  const u16* vbase = VT + (size_t)(b * 8 + hh) * 64 * LKEY + key0;
  u32x4 rk[3], rv[2];
  const int nt = nkeys >> 6;
#define ATT_GLOAD(T)                                                                                                        \
  {                                                                                                                         \
    const int t_ = (T);                                                                                                     \
    const int tg_ = tidx();                                                                                                 \
    _Pragma("unroll") for (int i = 0; i < 3; i++) rk[i] = kbase[(size_t)t_ * 768 + tg_ + 256 * i];                          \
    _Pragma("unroll") for (int i = 0; i < 2; i++) { int id = tg_ + 256 * i; rv[i] = *(const u32x4*)(vbase + (size_t)(id >> 3) * LKEY + t_ * 64 + (id & 7) * 8); } \
  }
#define ATT_LWRITE(T)                                                                                                       \
  {                                                                                                                         \
    u16* Kd = Ks + ((T) & 1) * (64 * 104 + 64 * 72);                                                                        \
    u16* Vd = Kd + 64 * 104;                                                                                                \
    const int tw_ = tidx();                                                                                                 \
    _Pragma("unroll") for (int i = 0; i < 3; i++) { int id = tw_ + 256 * i; int kr = id / 12, c = id - kr * 12; *(u32x4*)(Kd + kr * 104 + c * 8) = rk[i]; } \
    _Pragma("unroll") for (int i = 0; i < 2; i++) { int id = tw_ + 256 * i; int c_ = id & 7; u16* vd_ = Vd + (id >> 3) * 72 + (c_ >> 1) * 16 + (c_ & 1) * 4; \
      *(uint2*)(vd_) = make_uint2(rv[i].x, rv[i].y); *(uint2*)(vd_ + 8) = make_uint2(rv[i].z, rv[i].w); } \
  }
  ATT_GLOAD(0)
  ATT_LWRITE(0)
  if (nt > 1) ATT_GLOAD(1)
  __syncthreads();
  for (int t = 0; t < nt; t++) {
    if (t + 1 < nt) {
      ATT_LWRITE(t + 1)
      if (t + 2 < nt) ATT_GLOAD(t + 2)
    }
    __builtin_amdgcn_sched_barrier(0);
    const u16* Kc = Ks + (t & 1) * (64 * 104 + 64 * 72);
    const u16* Vc = Kc + 64 * 104;
    f32x16 sa0, sa1, sb0, sb1;
#pragma unroll
    for (int e = 0; e < 16; e++) { sa0[e] = 0.f; sa1[e] = 0.f; sb0[e] = 0.f; sb1[e] = 0.f; }
    __builtin_amdgcn_s_setprio(1);
#pragma unroll
    for (int ks = 0; ks < 6; ks++) {
      bf16x8 k0 = *(const bf16x8*)(Kc + (r) * 104 + ks * 16 + h * 8);
      bf16x8 k1 = *(const bf16x8*)(Kc + (32 + r) * 104 + ks * 16 + h * 8);
      sa0 = MFMA32(k0, qa[ks], sa0);
      sa1 = MFMA32(k1, qa[ks], sa1);
      sb0 = MFMA32(k0, qb[ks], sb0);
      sb1 = MFMA32(k1, qb[ks], sb1);
    }
    __builtin_amdgcn_s_setprio(0);
    ATT_SOFTMAX(sa0, sa1, oa0, oa1, ma, la)
    ATT_SOFTMAX(sb0, sb1, ob0, ob1, mb, lb)
#pragma unroll
    for (int kt2 = 0; kt2 < 2; kt2++) {
#pragma unroll
      for (int sx = 0; sx < 2; sx++) {
        bf16x8 pa, pb;
        if (kt2 == 0) { ATT_PACK(sa0, sx, pa) ATT_PACK(sb0, sx, pb) } else { ATT_PACK(sa1, sx, pa) ATT_PACK(sb1, sx, pb) }
        int kb = kt2 * 32 + 16 * sx + 8 * h;
        bf16x8 v0 = *(const bf16x8*)(Vc + (r) * 72 + kb);
        bf16x8 v1 = *(const bf16x8*)(Vc + (32 + r) * 72 + kb);
        oa0 = MFMA32(v0, pa, oa0);
        oa1 = MFMA32(v1, pa, oa1);
        ob0 = MFMA32(v0, pb, ob0);
        ob1 = MFMA32(v1, pb, ob1);
      }
    }
    __syncthreads();
  }
#undef ATT_LWRITE
#undef ATT_GLOAD
  la += __shfl_xor(la, 32);
  lb += __shfl_xor(lb, 32);
  {
    const float inv = 1.f / la;
    u16* dst = MIX + (size_t)qrowA * 1024 + 512 + hh * 64;
#pragma unroll
    for (int g = 0; g < 4; g++) {
      int e = 8 * g + 4 * h;
      *(uint2*)(dst + e) = make_uint2(pack2(oa0[4 * g] * inv, oa0[4 * g + 1] * inv), pack2(oa0[4 * g + 2] * inv, oa0[4 * g + 3] * inv));
      *(uint2*)(dst + 32 + e) = make_uint2(pack2(oa1[4 * g] * inv, oa1[4 * g + 1] * inv), pack2(oa1[4 * g + 2] * inv, oa1[4 * g + 3] * inv));
    }
  }
  {
    const float inv = 1.f / lb;
    u16* dst = MIX + (size_t)qrowB * 1024 + 512 + hh * 64;
#pragma unroll
    for (int g = 0; g < 4; g++) {
      int e = 8 * g + 4 * h;
      *(uint2*)(dst + e) = make_uint2(pack2(ob0[4 * g] * inv, ob0[4 * g + 1] * inv), pack2(ob0[4 * g + 2] * inv, ob0[4 * g + 3] * inv));
      *(uint2*)(dst + 32 + e) = make_uint2(pack2(ob1[4 * g] * inv, ob1[4 * g + 1] * inv), pack2(ob1[4 * g + 2] * inv, ob1[4 * g + 3] * inv));
    }
  }
  __syncthreads();
}

DI void ret_out_item(const Params& p, int l, int b, int hh, int ci, char* smem) {
  const u16* RET = (const u16*)(p.ws + OFF_RET);
  const float* ST = (const float*)(p.ws + OFF_ST);
  u16* MIX = (u16*)(p.ws + OFF_H);
  u16* Qs = (u16*)smem;
  u16* Ks = Qs + 128 * 72;
  u16* Ps = Qs;
  u16* VsT = Ks + 128 * 72;
  u16* SfT = VsT + 64 * 136;
  u16* SbT = SfT + 64 * 72;
  float* dmk = (float*)(SbT + 64 * 72);
  int tid_o = tidx();
  asm volatile("" : "+v"(tid_o));
  const int tid = tid_o, lane = tid & 63, wid = tid >> 6, r = lane & 31, h = lane >> 5;
  float lgf, lgb;
  ret_gammas(p, l, hh, lgf, lgb);
  const int row0 = chunk_row0(b, ci);
  { int d = tid - 128; dmk[tid] = d > 0 ? __expf(lgf * (float)d) : (d < 0 ? __expf(lgb * (float)(-d)) : 2.f); }
#pragma unroll 2
  for (int i = 0; i < 4; i++) {
    int id = tid + 256 * i, m = id >> 3, dc = id & 7;
    const u16* rp = RET + (size_t)(row0 + m) * 1024 + hh * 64 + dc * 8;
    *(uint4*)(Qs + m * 72 + dc * 8) = *(const uint4*)(rp);
    *(uint4*)(Ks + m * 72 + dc * 8) = *(const uint4*)(rp + 256);
    u32x4 vv = *(const u32x4*)(rp + 512);
#pragma unroll
    for (int j = 0; j < 8; j++) VsT[(dc * 8 + j) * 136 + m] = bfu(vv, j);
  }
  const float* Sf = ST + ((size_t)((0 * 4 + b) * 4 + hh) * NCH + ci) * 4096;
  const float* Sb = ST + ((size_t)((1 * 4 + b) * 4 + hh) * NCH + ci) * 4096;
#pragma unroll 2
  for (int i = 0; i < 16; i++) {
    int id = tid + 256 * i, d = id >> 6, e = id & 63;
    SfT[e * 72 + d] = f2bf(Sf[id]);
    SbT[e * 72 + d] = f2bf(Sb[id]);
  }
  __syncthreads();
  const int cw = wid * 32;
  f32x16 in0, in1, sc[4];
  {
    f32x16 cf0, cf1, cb0, cb1;
#pragma unroll
    for (int e = 0; e < 16; e++) { cf0[e] = cf1[e] = cb0[e] = cb1[e] = 0.f; }
#pragma unroll
    for (int ks = 0; ks < 4; ks++) {
      bf16x8 qa = *(const bf16x8*)(Qs + (cw + r) * 72 + ks * 16 + h * 8);
      cf0 = MFMA32(qa, *(const bf16x8*)(SfT + (r) * 72 + ks * 16 + h * 8), cf0);
      cf1 = MFMA32(qa, *(const bf16x8*)(SfT + (32 + r) * 72 + ks * 16 + h * 8), cf1);
      cb0 = MFMA32(qa, *(const bf16x8*)(SbT + (r) * 72 + ks * 16 + h * 8), cb0);
      cb1 = MFMA32(qa, *(const bf16x8*)(SbT + (32 + r) * 72 + ks * 16 + h * 8), cb1);
    }
#pragma unroll
    for (int reg = 0; reg < 16; reg++) {
      int c = cw + crow(reg, h);
      float xf = __expf(lgf * (float)(c + 1)), xb = __expf(lgb * (float)(128 - c));
      in0[reg] = xf * cf0[reg] + xb * cb0[reg];
      in1[reg] = xf * cf1[reg] + xb * cb1[reg];
    }
  }
#pragma unroll
  for (int e = 0; e < 16; e++) { sc[0][e] = sc[1][e] = sc[2][e] = sc[3][e] = 0.f; }
#pragma unroll
  for (int ks = 0; ks < 4; ks++) {
    bf16x8 qa = *(const bf16x8*)(Qs + (cw + r) * 72 + ks * 16 + h * 8);
#pragma unroll
    for (int mt = 0; mt < 4; mt++) sc[mt] = MFMA32(qa, *(const bf16x8*)(Ks + (mt * 32 + r) * 72 + ks * 16 + h * 8), sc[mt]);
  }
  __syncthreads();
#pragma unroll
  for (int mt = 0; mt < 4; mt++)
#pragma unroll
    for (int reg = 0; reg < 16; reg++) {
      int c = cw + crow(reg, h), mm = mt * 32 + r;
      Ps[c * 136 + mm] = f2bf(sc[mt][reg] * dmk[c - mm + 128]);
      if ((reg & 3) == 3) __builtin_amdgcn_sched_barrier(0);
    }
  __syncthreads();
#pragma unroll
  for (int ks = 0; ks < 8; ks++) {
    bf16x8 pa = *(const bf16x8*)(Ps + (cw + r) * 136 + ks * 16 + h * 8);
    in0 = MFMA32(pa, *(const bf16x8*)(VsT + (r) * 136 + ks * 16 + h * 8), in0);
    in1 = MFMA32(pa, *(const bf16x8*)(VsT + (32 + r) * 136 + ks * 16 + h * 8), in1);
  }
#pragma unroll
  for (int reg = 0; reg < 16; reg++) {
    int c = cw + crow(reg, h);
    float oa = in0[reg], ob = in1[reg];
    float ss = oa * oa + ob * ob;
    ss += __shfl_xor(ss, 1); ss += __shfl_xor(ss, 2); ss += __shfl_xor(ss, 4); ss += __shfl_xor(ss, 8); ss += __shfl_xor(ss, 16);
    float rstd = rsqrtf(ss * (1.f / 64.f) + 1e-6f);
    int rowi = row0 + c;
    asm volatile("" : "+v"(rowi));
    size_t row = (size_t)rowi;
    float g0 = bf2f(RET[row * 1024 + 768 + hh * 64 + r]), g1 = bf2f(RET[row * 1024 + 768 + hh * 64 + 32 + r]);
    MIX[row * 1024 + 256 + hh * 64 + r] = f2bf(silu_f(g0) * oa * rstd);
    MIX[row * 1024 + 256 + hh * 64 + 32 + r] = f2bf(silu_f(g1) * ob * rstd);
    if ((reg & 3) == 3) __builtin_amdgcn_sched_barrier(0);
  }
  __syncthreads();
}

typedef _Float16 h2_t __attribute__((ext_vector_type(2)));
DI unsigned packh(float a, float b) { h2_t v; v[0] = (_Float16)a; v[1] = (_Float16)b; return __builtin_bit_cast(unsigned, v); }
template <class ZF, class CF>
DI void hy_conv(float2* X, const float2* __restrict__ TW, const float2* __restrict__ Ke, const float2* __restrict__ Ko,
                ZF zf4, CF consume4, int tid) {
  const float scl = 0.5f / 8192.f;
#pragma unroll 2
  for (int g = 0; g < 8; g++) {
    int j = tidx() + 256 * g;
    float zr[4], zi[4];
    zf4(j, zr, zi);
#pragma unroll
    for (int e = 0; e < 4; e++) X[PX(4 * j + e)] = make_float2(zr[e], zi[e]);
  }
  __syncthreads();
  fft_dif(X, TW, tid);
#pragma unroll 2
  for (int g = 0; g < 8; g++) {
    int j = tidx() + 256 * g;
    const float4* kp = (const float4*)(Ke + 4 * j);
    float4 k01 = kp[0], k23 = kp[1];
    float2 a;
    a = X[PX(4 * j + 0)]; X[PX(4 * j + 0)] = make_float2(a.x * k01.x - a.y * k01.y, a.x * k01.y + a.y * k01.x);
    a = X[PX(4 * j + 1)]; X[PX(4 * j + 1)] = make_float2(a.x * k01.z - a.y * k01.w, a.x * k01.w + a.y * k01.z);
    a = X[PX(4 * j + 2)]; X[PX(4 * j + 2)] = make_float2(a.x * k23.x - a.y * k23.y, a.x * k23.y + a.y * k23.x);
    a = X[PX(4 * j + 3)]; X[PX(4 * j + 3)] = make_float2(a.x * k23.z - a.y * k23.w, a.x * k23.w + a.y * k23.z);
  }
  __syncthreads();
  fft_dit(X, TW, tid);
  unsigned ye[32];
#pragma unroll
  for (int g = 0; g < 8; g++) {
    int j = tid + 256 * g;
    asm volatile("" : "+v"(j));
#pragma unroll
    for (int e = 0; e < 4; e++) {
      float2 ev = X[PX(4 * j + e)];
      unsigned pk = packh(ev.x * scl, ev.y * scl);
      asm volatile("" : "+v"(pk));
      ye[g * 4 + e] = pk;
    }
    if (g & 1) __builtin_amdgcn_sched_barrier(0);
  }
  __syncthreads();
#pragma unroll 2
  for (int g = 0; g < 8; g++) {
    int j = tidx() + 256 * g;
    float zr[4], zi[4];
    zf4(j, zr, zi);
    const float4* tp = (const float4*)(TW + 4 * j);
    float4 t01 = tp[0], t23 = tp[1];
    X[PX(4 * j + 0)] = make_float2(zr[0] * t01.x - zi[0] * t01.y, zr[0] * t01.y + zi[0] * t01.x);
    X[PX(4 * j + 1)] = make_float2(zr[1] * t01.z - zi[1] * t01.w, zr[1] * t01.w + zi[1] * t01.z);
    X[PX(4 * j + 2)] = make_float2(zr[2] * t23.x - zi[2] * t23.y, zr[2] * t23.y + zi[2] * t23.x);
    X[PX(4 * j + 3)] = make_float2(zr[3] * t23.z - zi[3] * t23.w, zr[3] * t23.w + zi[3] * t23.z);
  }
  __syncthreads();
  fft_dif(X, TW, tid);
#pragma unroll 2
  for (int g = 0; g < 8; g++) {
    int j = tidx() + 256 * g;
    const float4* kp = (const float4*)(Ko + 4 * j);
    float4 k01 = kp[0], k23 = kp[1];
    float2 a;
    a = X[PX(4 * j + 0)]; X[PX(4 * j + 0)] = make_float2(a.x * k01.x - a.y * k01.y, a.x * k01.y + a.y * k01.x);
    a = X[PX(4 * j + 1)]; X[PX(4 * j + 1)] = make_float2(a.x * k01.z - a.y * k01.w, a.x * k01.w + a.y * k01.z);
    a = X[PX(4 * j + 2)]; X[PX(4 * j + 2)] = make_float2(a.x * k23.x - a.y * k23.y, a.x * k23.y + a.y * k23.x);
    a = X[PX(4 * j + 3)]; X[PX(4 * j + 3)] = make_float2(a.x * k23.z - a.y * k23.w, a.x * k23.w + a.y * k23.z);
  }
  __syncthreads();
  fft_dit(X, TW, tid);
#pragma unroll
  for (int g = 0; g < 8; g++) {
    int j = tid + 256 * g;
    asm volatile("" : "+v"(j));
    const float4* tp = (const float4*)(TW + 4 * j);
    float4 t01 = tp[0], t23 = tp[1];
    float ya[4], yb[4];
    float2 o;
    h2_t ev;
    o = X[PX(4 * j + 0)]; ev = __builtin_bit_cast(h2_t, ye[g * 4 + 0]);
    ya[0] = (float)ev[0] + (o.x * t01.x + o.y * t01.y) * scl; yb[0] = (float)ev[1] + (o.y * t01.x - o.x * t01.y) * scl;
    o = X[PX(4 * j + 1)]; ev = __builtin_bit_cast(h2_t, ye[g * 4 + 1]);
    ya[1] = (float)ev[0] + (o.x * t01.z + o.y * t01.w) * scl; yb[1] = (float)ev[1] + (o.y * t01.z - o.x * t01.w) * scl;
    o = X[PX(4 * j + 2)]; ev = __builtin_bit_cast(h2_t, ye[g * 4 + 2]);
    ya[2] = (float)ev[0] + (o.x * t23.x + o.y * t23.y) * scl; yb[2] = (float)ev[1] + (o.y * t23.x - o.x * t23.y) * scl;
    o = X[PX(4 * j + 3)]; ev = __builtin_bit_cast(h2_t, ye[g * 4 + 3]);
    ya[3] = (float)ev[0] + (o.x * t23.z + o.y * t23.w) * scl; yb[3] = (float)ev[1] + (o.y * t23.z - o.x * t23.w) * scl;
    consume4(j, ya, yb);
    __builtin_amdgcn_sched_barrier(0);
  }
  __syncthreads();
}

DI float sconv_at(const u16* __restrict__ u, int n, int Ls, float w0, float w1, float w2, float bias) {
  float um = n > 0 ? bf2f(u[n - 1]) : 0.f, uc = bf2f(u[n]), up = n < Ls - 1 ? bf2f(u[n + 1]) : 0.f;
  return bias + w0 * um + w1 * uc + w2 * up;
}
DI void sconv4(const u16* __restrict__ u, int j, float w0, float w1, float w2, float bias, float (&o)[4]) {
  uint2 c = *(const uint2*)(u + 4 * j);
  float x0 = __uint_as_float(c.x << 16), x1 = __uint_as_float(c.x & 0xffff0000u);
  float x2 = __uint_as_float(c.y << 16), x3 = __uint_as_float(c.y & 0xffff0000u);
  float xm = j > 0 ? bf2f(u[4 * j - 1]) : 0.f, xp = j < 2047 ? bf2f(u[4 * j + 4]) : 0.f;
  o[0] = bias + w0 * xm + w1 * x0 + w2 * x1;
  o[1] = bias + w0 * x0 + w1 * x1 + w2 * x2;
  o[2] = bias + w0 * x1 + w1 * x2 + w2 * x3;
  o[3] = bias + w0 * x2 + w1 * x3 + w2 * xp;
}
DI void unpack4(const u16* __restrict__ p, float (&o)[4]) {
  uint2 c = *(const uint2*)p;
  o[0] = __uint_as_float(c.x << 16); o[1] = __uint_as_float(c.x & 0xffff0000u);
  o[2] = __uint_as_float(c.y << 16); o[3] = __uint_as_float(c.y & 0xffff0000u);
}

DI void hyena_item(const Params& p, int l, int c, int pair, char* smem) {
  float2* X = (float2*)smem;
  const float2* TW = (const float2*)(p.ws + OFF_TW);
  const float2* KS = (const float2*)(p.ws + OFF_KSPEC);
  const u16* UT = (const u16*)(p.ws + OFF_UT);
  u16* YT = (u16*)(p.ws + OFF_CQ);
  int tid_o = tidx();
  const int tid = tid_o;
  const float* cw = p.in[I_HCW] + l * 3 * 768;
  const float* cb = p.in[I_HCB] + l * 768;
  const int b0 = 2 * pair, b1 = b0 + 1;
  u16* y0 = YT + (size_t)(b0 * 256 + c) * SEQ;
  u16* y1 = YT + (size_t)(b1 * 256 + c) * SEQ;
  const float vw0 = cw[512 + c], vw1 = cw[768 + 512 + c], vw2 = cw[1536 + 512 + c], vbs = cb[512 + c];
  const u16* v0p = UT + (size_t)(b0 * 768 + 512 + c) * SEQ;
  const u16* v1p = UT + (size_t)(b1 * 768 + 512 + c) * SEQ;
  {
    const float w0 = cw[c], w1 = cw[768 + c], w2 = cw[1536 + c], bs = cb[c];
    const float bias0 = p.in[I_HBIAS][(l * 2 + 0) * 256 + c];
    const u16* u0 = UT + (size_t)(b0 * 768 + c) * SEQ;
    const u16* u1 = UT + (size_t)(b1 * 768 + c) * SEQ;
    hy_conv(X, TW, KS + (size_t)(0 * 256 + c) * 2 * 8192, KS + (size_t)(0 * 256 + c) * 2 * 8192 + 8192,
            [&](int j, float (&zr)[4], float (&zi)[4]) __attribute__((always_inline)) {
              sconv4(v0p, j, vw0, vw1, vw2, vbs, zr); sconv4(v1p, j, vw0, vw1, vw2, vbs, zi);
            },
            [&](int j, const float (&ya)[4], const float (&yb)[4]) __attribute__((always_inline)) {
              float va[4], vb[4], xa[4], xb[4];
              sconv4(v0p, j, vw0, vw1, vw2, vbs, va); sconv4(v1p, j, vw0, vw1, vw2, vbs, vb);
              sconv4(u0, j, w0, w1, w2, bs, xa); sconv4(u1, j, w0, w1, w2, bs, xb);
              *(uint2*)(y0 + 4 * j) = make_uint2(pack2(xa[0] * (ya[0] + va[0] * bias0), xa[1] * (ya[1] + va[1] * bias0)),
                                                 pack2(xa[2] * (ya[2] + va[2] * bias0), xa[3] * (ya[3] + va[3] * bias0)));
              *(uint2*)(y1 + 4 * j) = make_uint2(pack2(xb[0] * (yb[0] + vb[0] * bias0), xb[1] * (yb[1] + vb[1] * bias0)),
                                                 pack2(xb[2] * (yb[2] + vb[2] * bias0), xb[3] * (yb[3] + vb[3] * bias0)));
            }, tid);
  }
  {
    const int col = 256 + c;
    const float w0 = cw[col], w1 = cw[768 + col], w2 = cw[1536 + col], bs = cb[col];
    const float bias1 = p.in[I_HBIAS][(l * 2 + 1) * 256 + c];
    const u16* u0 = UT + (size_t)(b0 * 768 + col) * SEQ;
    const u16* u1 = UT + (size_t)(b1 * 768 + col) * SEQ;
    hy_conv(X, TW, KS + (size_t)(1 * 256 + c) * 2 * 8192, KS + (size_t)(1 * 256 + c) * 2 * 8192 + 8192,
            [&](int j, float (&zr)[4], float (&zi)[4]) __attribute__((always_inline)) { unpack4(y0 + 4 * j, zr); unpack4(y1 + 4 * j, zi); },
            [&](int j, const float (&ya)[4], const float (&yb)[4]) __attribute__((always_inline)) {
              float za[4], zb[4], xa[4], xb[4];
              unpack4(y0 + 4 * j, za); unpack4(y1 + 4 * j, zb);
              sconv4(u0, j, w0, w1, w2, bs, xa); sconv4(u1, j, w0, w1, w2, bs, xb);
              *(uint2*)(y0 + 4 * j) = make_uint2(pack2(xa[0] * (ya[0] + za[0] * bias1), xa[1] * (ya[1] + za[1] * bias1)),
                                                 pack2(xa[2] * (ya[2] + za[2] * bias1), xa[3] * (ya[3] + za[3] * bias1)));
              *(uint2*)(y1 + 4 * j) = make_uint2(pack2(xb[0] * (yb[0] + zb[0] * bias1), xb[1] * (yb[1] + zb[1] * bias1)),
                                                 pack2(xb[2] * (yb[2] + zb[2] * bias1), xb[3] * (yb[3] + zb[3] * bias1)));
            }, tid);
  }
}

DI void hyena_ctx_item(const Params& p, int l, int b, int c, char* smem) {
  float* k0s = (float*)smem;
  float* k1s = k0s + 512;
  float* vs = k1s + 512;
  float* zs = vs + 256;
  const float* KC = (const float*)(p.ws + OFF_KC);
  const u16* UTC = (const u16*)(p.ws + OFF_UTC);
  u16* MIX = (u16*)(p.ws + OFF_H);
  int tid_o = tidx();
  asm volatile("" : "+v"(tid_o));
  const int n = tid_o;
  const float* cw = p.in[I_HCW] + l * 3 * 768;
  const float* cb = p.in[I_HCB] + l * 768;
  k0s[n] = KC[(size_t)(0 * 256 + c) * 512 + n]; k0s[256 + n] = KC[(size_t)(0 * 256 + c) * 512 + 256 + n];
  k1s[n] = KC[(size_t)(1 * 256 + c) * 512 + n]; k1s[256 + n] = KC[(size_t)(1 * 256 + c) * 512 + 256 + n];
  float v = sconv_at(UTC + (size_t)(b * 768 + 512 + c) * LCTX, n, LCTX, cw[512 + c], cw[768 + 512 + c], cw[1536 + 512 + c], cb[512 + c]);
  float x1 = sconv_at(UTC + (size_t)(b * 768 + c) * LCTX, n, LCTX, cw[c], cw[768 + c], cw[1536 + c], cb[c]);
  float x2 = sconv_at(UTC + (size_t)(b * 768 + 256 + c) * LCTX, n, LCTX, cw[256 + c], cw[768 + 256 + c], cw[1536 + 256 + c], cb[256 + c]);
  vs[n] = v;
  __syncthreads();
  float a = 0.f;
  for (int s = 0; s < 256; s++) a += k0s[n - s + 256] * vs[s];
  float z = x1 * (a + v * p.in[I_HBIAS][(l * 2 + 0) * 256 + c]);
  zs[n] = z;
  __syncthreads();
  float a2 = 0.f;
  for (int s = 0; s < 256; s++) a2 += k1s[n - s + 256] * zs[s];
  float y = x2 * (a2 + z * p.in[I_HBIAS][(l * 2 + 1) * 256 + c]);
  MIX[(size_t)(TLAT + b * LCTX + n) * 1024 + c] = f2bf(y);
  __syncthreads();
}

DI void phase_p4(const Params& p, int l, char* smem, int submask = 15) {
  const int n_al = 1024, n_ac = (l == 0 ? 32 : 0), n_hy = 512, n_r3 = (l == 0 ? 16 * NCH : 16 * 64), n_hc = (l == 0 ? 1024 : 0);
  const int total = n_al + n_ac + n_hy + n_r3 + n_hc;
  for (int it = blockIdx.x; it < total; it += gridDim.x) {
    int q = it;
    if (q < n_al) {
      int b = q >> 8, hh = (q >> 5) & 7, qb = q & 31;
      if (SUB_ON(0) && (submask & 1)) attn_item(p, b, hh, b * SEQ + qb * 256, 0, LKEY, smem);
    } else if ((q -= n_al) < n_ac) {
      int b = q >> 3, hh = q & 7;
      if (SUB_ON(0) && (submask & 1)) attn_item(p, b, hh, TLAT + b * LCTX, SEQ, LCTX, smem);
    } else if ((q -= n_ac) < n_hy) {
      if (SUB_ON(1) && (submask & 2)) hyena_item(p, l, q >> 1, q & 1, smem);
    } else if ((q -= n_hy) < n_r3) {
      int bh, ci;
      if (l == 0) { bh = q / NCH; ci = q - bh * NCH; } else { bh = q >> 6; ci = 2 + (q & 63); }
      if (SUB_ON(2) && (submask & 4)) ret_out_item(p, l, bh >> 2, bh & 3, ci, smem);
    } else {
      q -= n_r3;
      if (SUB_ON(3) && (submask & 8)) hyena_ctx_item(p, l, q >> 8, q & 255, smem);
    }
  }
}

DI void phase_res_gemm(const Params& p, int l, int which  , char* smem) {
  const char* wl = p.ws + OFF_W + (size_t)l * WL_SIZE;
  const u16* A = (const u16*)(p.ws + (which == 1 ? OFF_H : OFF_ACT));
  const int K = which == 1 ? 1024 : 4096;
  const u16* Bt = (const u16*)(wl + (which == 1 ? WL_WOUT : WL_W2));
  const bool first = (l == 0 && which == 1);
  const float* mod = (const float*)(p.ws + OFF_MOD);
  float* XC = (float*)(p.ws + OFF_XC);
  const int n_lat = 128 * 8, n_split = (l == 0 ? 32 * 16 : 0);
  for (int it = blockIdx.x; it < n_lat + n_split; it += gridDim.x) {
    if (it < n_lat) {
      int mt = it >> 3, nt = it & 7;
      int m0 = mt * 256;
      const u16* at = nullptr;
      if (which == 1) at = (const u16*)(p.ws + OFF_CQ) + (size_t)((m0 >> 13) * 256) * SEQ + (m0 & 8191);
      const float* ga = mod + (size_t)(l * 5 + (m0 >> 13)) * 6144 + (which == 1 ? 2048 : 5120);
      const float* src = first ? p.in[I_X] : p.out;
      float* dst = p.out;
      gemm_tile<false, false, false, 3>(A, K, Bt, K, K, m0, nt * 128, at, 8, smem,
        [](int, int, float v, const float*) __attribute__((always_inline)) { return v; },
        [&](int row, int col, float4 a) __attribute__((always_inline)) {
          size_t idx = (size_t)row * 1024 + col;
          float4 x = *(const float4*)(src + idx), g = *(const float4*)(ga + col);
          *(float4*)(dst + idx) = make_float4(x.x + g.x * a.x, x.y + g.y * a.y, x.z + g.z * a.z, x.w + g.w * a.w);
        });
    } else {
      int q = it - n_lat;
      int tile = q >> 4, kc = q & 15;
      int mt = 128 + (tile >> 3), nt = tile & 7;
      int kchunk = K >> 4, k0 = kc * kchunk;
      const float* ga = mod + (size_t)(l * 5 + 4) * 6144 + (which == 1 ? 2048 : 5120);
      float* dst = XC - (size_t)TLAT * 1024;
      gemm_tile<false, false, false, 0>(A + k0, K, Bt + k0, K, kchunk, mt * 256, nt * 128, nullptr, 0, smem,
        [&](int bm, int bn, const f32x16& acc, const float*) __attribute__((always_inline)) {
          const int lz_ = tidx() & 63, r = lz_ & 31, h = lz_ >> 5;
          int col = bn + r;
          float g = ga[col];
#pragma unroll
          for (int reg = 0; reg < 16; reg++) unsafeAtomicAdd(dst + (size_t)(bm + crow(reg, h)) * 1024 + col, g * acc[reg]);
        }, [](int, int) __attribute__((always_inline)) -> u16* { return nullptr; });
    }
  }
}

DI void phase_mlp1(const Params& p, int l, char* smem) {
  const int lane = tidx() & 63, r = lane & 31, h = lane >> 5;
  const int nmt = (l == 0 ? 132 : 128);
  const u16* A = (const u16*)(p.ws + OFF_H);
  const u16* Bt = (const u16*)(p.ws + OFF_W + (size_t)l * WL_SIZE + WL_W1);
  u16* ACT = (u16*)(p.ws + OFF_ACT);
  const int total = nmt * 32;
  for (int it = blockIdx.x; it < total; it += gridDim.x) {
    int mt = it >> 5, nt = it & 31;
    gemm_tile<false, false, false, 1>(A, 1024, Bt, 1024, 1024, mt * 256, nt * 128, nullptr, 0, smem,
      [](int, int, float v, const float*) __attribute__((always_inline)) { float x = fmaxf(v, 0.f); return x * x; },
      [&](int row, int col) __attribute__((always_inline)) -> u16* { return ACT + (size_t)row * 4096 + col; });
  }
}

DI void phase_final(const Params& p) {
  const int lane = tidx() & 63, wid = tidx() >> 6;
  const float* g = p.in[I_FNG];
  for (int it = blockIdx.x; it < TLAT / 8; it += gridDim.x) {
    float* row = p.out + (size_t)(it * 8 + wid * 2) * 1024;
    float4 v[8];
    float ssq0 = 0.f, ssq1 = 0.f;
#pragma unroll
    for (int i = 0; i < 4; i++) { v[i] = *(const float4*)(row + i * 256 + lane * 4); v[4 + i] = *(const float4*)(row + 1024 + i * 256 + lane * 4); }
#pragma unroll
    for (int i = 0; i < 4; i++) {
      ssq0 += v[i].x * v[i].x + v[i].y * v[i].y + v[i].z * v[i].z + v[i].w * v[i].w;
      ssq1 += v[4 + i].x * v[4 + i].x + v[4 + i].y * v[4 + i].y + v[4 + i].z * v[4 + i].z + v[4 + i].w * v[4 + i].w;
    }
    ssq0 = wave_sum(ssq0); ssq1 = wave_sum(ssq1);
    float r0 = rsqrtf(ssq0 * (1.f / 1024.f) + 1e-6f), r1 = rsqrtf(ssq1 * (1.f / 1024.f) + 1e-6f);
#pragma unroll
    for (int i = 0; i < 4; i++) {
      float4 gg = *(const float4*)(g + i * 256 + lane * 4);
      *(float4*)(row + i * 256 + lane * 4) = make_float4(v[i].x * r0 * gg.x, v[i].y * r0 * gg.y, v[i].z * r0 * gg.z, v[i].w * r0 * gg.w);
      *(float4*)(row + 1024 + i * 256 + lane * 4) = make_float4(v[4 + i].x * r1 * gg.x, v[4 + i].y * r1 * gg.y, v[4 + i].z * r1 * gg.z, v[4 + i].w * r1 * gg.w);
    }
  }
}


#define XB_TMO      128
#define XB_XCNT(j)  (256  + 64 * (j))
#define XB_XSUB(j)  (1280 + 64 * (j))
#define XB_XGEN(j)  (2304 + 64 * (j))
#define XB_TOP      3328
#define XB_TOPGEN   3392
#define XCD_BAR_WORDS 3456
#define XB_SPIN_CAP (1u << 22)
#define LAS __attribute__((address_space(3)))
DI unsigned xb_ld(unsigned* p) { return __hip_atomic_load(p, __ATOMIC_RELAXED, __HIP_MEMORY_SCOPE_AGENT); }
DI unsigned xb_add(unsigned* p, unsigned v) { return __hip_atomic_fetch_add(p, v, __ATOMIC_RELAXED, __HIP_MEMORY_SCOPE_AGENT); }
DI unsigned xb_xcc_id() { return (unsigned)__builtin_amdgcn_s_getreg((3 << 11) | 20) & 0xFu; }
#define XB_SPIN(cond, bar) do { unsigned _sp = 0; while (cond) { __builtin_amdgcn_s_sleep(1); \
    if ((++_sp & 255u) == 0u) { if (xb_ld(&(bar)[XB_TMO])) break; if (_sp > XB_SPIN_CAP) { atomicAdd(&(bar)[XB_TMO], 1u); break; } } } } while (0)
struct XcdBarrier { unsigned* bar; unsigned x; volatile LAS unsigned* st; };
DI XcdBarrier xcd_barrier_post(unsigned* bar, volatile LAS unsigned* st) {
  XcdBarrier b; b.bar = bar; b.x = xb_xcc_id(); b.st = st;
  if (threadIdx.x == 0) (void)xb_add(&bar[XB_XCNT(b.x)], 1u);
  return b;
}
DI void xcd_barrier_complete(unsigned* bar, unsigned x, unsigned& nloc, unsigned& nx) {
  const unsigned G = gridDim.x * gridDim.y * gridDim.z;
  unsigned sum, cnt, mine, sp = 0u;
  for (;;) {
    sum = 0u; cnt = 0u; mine = 0u;
#pragma unroll
    for (unsigned j = 0; j < 16; ++j) { const unsigned c = xb_ld(&bar[XB_XCNT(j)]); sum += c; cnt += (c > 0u) ? 1u : 0u; mine = (j == x) ? c : mine; }
    if (sum == G) break;
    __builtin_amdgcn_s_sleep(1);
    if ((++sp & 255u) == 0u) { if (xb_ld(&bar[XB_TMO])) break; if (sp > XB_SPIN_CAP) { atomicAdd(&bar[XB_TMO], 1u); break; } }
  }
  nloc = mine > 0u ? mine : 1u; nx = cnt > 0u ? cnt : 1u;
}
DI void xcd_barrier(const XcdBarrier& b) {
  asm volatile("s_waitcnt vmcnt(0)" ::: "memory");
  __syncthreads();
  if (threadIdx.x == 0) {
    unsigned* bar = b.bar;
    __builtin_amdgcn_s_waitcnt(0);
    unsigned nloc = b.st[0], nx = b.st[1];
    if (nloc == 0u) { xcd_barrier_complete(bar, b.x, nloc, nx); b.st[0] = nloc; b.st[1] = nx; }
    const unsigned old = xb_add(&bar[XB_XSUB(b.x)], 1u);
    const unsigned gen = old / nloc;
    if (old + 1u == (gen + 1u) * nloc) {
      __builtin_amdgcn_fence(__ATOMIC_RELEASE, "agent");
      asm volatile("s_waitcnt vmcnt(0)" ::: "memory");
      const unsigned og = xb_add(&bar[XB_TOP], 1u);
      const unsigned tg = og / nx;
      if (og + 1u == (tg + 1u) * nx) xb_add(&bar[XB_TOPGEN], 1u);
      else XB_SPIN(xb_ld(&bar[XB_TOPGEN]) == tg, bar);
      __builtin_amdgcn_fence(__ATOMIC_ACQUIRE, "agent");
      xb_add(&bar[XB_XGEN(b.x)], 1u);
      asm volatile("s_waitcnt vmcnt(0)" ::: "memory");
    } else {
      XB_SPIN(xb_ld(&bar[XB_XGEN(b.x)]) == gen, bar);
      __builtin_amdgcn_fence(__ATOMIC_ACQUIRE, "agent");
      asm volatile("s_waitcnt vmcnt(0)" ::: "memory");
    }
  }
  __syncthreads();
}

constexpr int NPHASE = 20;
#ifndef ONLY_PHASE
#define ONLY_PHASE -1
#endif
#define PH_ON(k) (ONLY_PHASE < 0 || ONLY_PHASE == (k))
DI void run_phase(const Params& p, int ph, char* smem, int submask = 15) {
  if (ph == 0) { if (PH_ON(0)) phase_s0(p, smem); return; }
  if (ph == NPHASE - 1) { if (PH_ON(8)) phase_final(p); return; }
  int l = (ph - 1) / 9, s = (ph - 1) % 9;
  switch (s) {
    case 0: if (PH_ON(1)) phase_norm(p, l, 1, TALL, true); break;
    case 1: if (PH_ON(2)) phase_win(p, l, smem); break;
    case 2: if (PH_ON(3)) phase_p3(p, l, smem); break;
    case 3: if (PH_ON(4)) phase_scan(p, l); break;
    case 4: if (PH_ON(5)) phase_p4(p, l, smem, submask); break;
    case 5: if (PH_ON(6)) phase_res_gemm(p, l, 1, smem); break;
    case 6: if (PH_ON(1)) phase_norm(p, l, 2, l == 0 ? TALL : TLAT, false); break;
    case 7: if (PH_ON(7)) phase_mlp1(p, l, smem); break;
    default: if (PH_ON(6)) phase_res_gemm(p, l, 2, smem); break;
  }
}

#if !MULTI_LAUNCH
extern "C" __global__ void __launch_bounds__(256, 2) mk_all(Params p) {
  extern __shared__ __attribute__((aligned(16))) char smem[];
  cg::grid_group grid = cg::this_grid();
  __shared__ uint4 xb_words;
  if (threadIdx.x == 0) xb_words = make_uint4(0u, 0u, 0u, 0u);
  __syncthreads();
  XcdBarrier xb = xcd_barrier_post((unsigned*)(p.ws + OFF_BAR), (volatile LAS unsigned*)&xb_words);
  if (p.ws == nullptr) grid.sync();
  for (int ph = 0; ph < NPHASE; ph++) {
    run_phase(p, ph, smem);
#ifdef PROBE_DUP
    if (ph == PROBE_DUP || ph == PROBE_DUP2) { xcd_barrier(xb); run_phase(p, ph, smem, PROBE_MASK); }
#endif
    if (ph + 1 < NPHASE) xcd_barrier(xb);
  }
}
#define MK_KERNEL mk_all
#else
#define MK_KERNEL mk_phase
extern "C" __global__ void __launch_bounds__(256, 2) mk_phase(Params p, int ph) {
  extern __shared__ __attribute__((aligned(16))) char smem[];
  run_phase(p, ph, smem);
}
#endif

extern "C" void kernel_launch(void* const* d_in, const int* in_sizes, int n_in, void* d_out, int out_size, void* d_ws, size_t ws_size,
                              hipStream_t stream) {
  Params p{};
  for (int i = 0; i < 27; i++) p.in[i] = (const float*)d_in[i];
  p.out = (float*)d_out;
  p.ws = (char*)d_ws;
  static int grid_blocks = 0;
  if (!grid_blocks) {
    int dev = 0, cus = 0, per_cu = 0;
    (void)hipGetDevice(&dev);
    (void)hipDeviceGetAttribute(&cus, hipDeviceAttributeMultiprocessorCount, dev);
    (void)hipFuncSetAttribute((const void*)MK_KERNEL, hipFuncAttributeMaxDynamicSharedMemorySize, SMEM_BYTES);
    (void)hipOccupancyMaxActiveBlocksPerMultiprocessor(&per_cu, MK_KERNEL, 256, SMEM_BYTES);
    if (per_cu < 1) per_cu = 1;
    if (per_cu > 2) per_cu = 2;
    grid_blocks = cus * per_cu;
  }
#if MULTI_LAUNCH
  for (int ph = 0; ph < NPHASE; ph++) hipLaunchKernelGGL(mk_phase, dim3(grid_blocks), dim3(256), SMEM_BYTES, stream, p, ph);
#else
  (void)hipMemsetAsync(p.ws + OFF_BAR, 0, XCD_BAR_WORDS * 4, stream);
  void* args[] = {&p};
  (void)hipLaunchCooperativeKernel((void*)mk_all, dim3(grid_blocks), dim3(256), args, SMEM_BYTES, stream);
#endif
}
```
